# Optimizing an MI355X kernel written in HIP

```python
import math, functools
import jax, jax.numpy as jnp
from jax import lax
import numpy as np

D_MODEL = 4096
BATCH = 4
SEQ = 4096
DEPTH = 1

MEM_LEN = 256
RMS_EPS = 1e-6
GLA_HEADS = 4
GLA_DV = D_MODEL // 2 // GLA_HEADS
GLA_DK = GLA_DV // 2
GLA_LOWRANK = 16
GLA_TAU = 16.0
GLA_CHUNK = 64
DIL_HEAD_DIM = 128
DIL_HEADS = D_MODEL // 2 // DIL_HEAD_DIM
DIL_CONFIGS = ((128, 1), (512, 4), (2048, 16))
REL_BUCKETS = 32
REL_MAX_DIST = 2048
XATTN_HEADS = 4
XATTN_HEAD_DIM = 128
XATTN_WIDTH = XATTN_HEADS * XATTN_HEAD_DIM
D_FF = ((8 * D_MODEL // 3 + 255) // 256) * 256
CONV_WIDTH = 3
MIX_WIDTH = GLA_HEADS * GLA_DV + DIL_HEADS * DIL_HEAD_DIM
NEG_INF = -1e30

kernel_name = 'hybrid_gla_dilated_parallel_heads'


def _proj_sizes():
    return (GLA_HEADS * GLA_DK,
            GLA_HEADS * GLA_DK,
            GLA_HEADS * GLA_DV,
            GLA_LOWRANK,
            GLA_HEADS * GLA_DV,
            DIL_HEADS * DIL_HEAD_DIM,
            DIL_HEADS * DIL_HEAD_DIM,
            DIL_HEADS * DIL_HEAD_DIM)


def rmsnorm(x, g):
    xf = x.astype(jnp.float32)
    y = xf * lax.rsqrt(jnp.mean(xf * xf, axis=-1, keepdims=True) + RMS_EPS)
    return (y * g.astype(jnp.float32)).astype(x.dtype)


def t5_bucket(dist):
    max_exact = REL_BUCKETS // 2
    d_f = jnp.maximum(dist, 1).astype(jnp.float32)
    large = max_exact + (jnp.log(d_f / max_exact) / math.log(REL_MAX_DIST / max_exact)
                         * (REL_BUCKETS - max_exact)).astype(jnp.int32)
    large = jnp.minimum(large, REL_BUCKETS - 1)
    return jnp.where(dist < max_exact, dist, large)


def gla_chunked(q, k, v, g_log):
    B, S, H, DK = q.shape
    DV = v.shape[-1]
    C = GLA_CHUNK
    N = S // C

    def chunk(t):
        return t.reshape(B, N, C, H, -1).transpose(1, 0, 3, 2, 4)

    q, k, v, g = map(chunk, (q * DK ** -0.5, k, v, g_log))
    b = jnp.cumsum(g, axis=3)
    b_last = b[:, :, :, -1:, :]
    b_mid = b[:, :, :, C // 2:C // 2 + 1, :]
    q_start = q * jnp.exp(b)
    k_end = k * jnp.exp(b_last - b)
    chunk_decay = jnp.exp(b_last[:, :, :, 0, :])

    def step(state, inp):
        q_c, k_c, v_c, dec = inp
        o_c = jnp.einsum('bhcd,bhde->bhce', q_c, state)
        state = state * dec[..., None] + jnp.einsum('bhcd,bhce->bhde', k_c, v_c)
        return state, o_c

    state0 = jnp.zeros((B, H, DK, DV), jnp.float32)
    _, o_inter = lax.scan(step, state0, (q_start, k_end, v, chunk_decay))

    att = jnp.einsum('nbhcd,nbhjd->nbhcj', q * jnp.exp(b - b_mid), k * jnp.exp(b_mid - b))
    att = jnp.where(jnp.tril(jnp.ones((C, C), bool)), att, 0.0)
    o = o_inter + jnp.einsum('nbhcj,nbhje->nbhce', att, v)
    return o.transpose(1, 0, 3, 2, 4).reshape(B, S, H, DV)


def dilated_branch(q, k, v, dilation, steps, rel_bias):
    B, S, H, E = q.shape
    L = S // dilation
    nb = -(-L // steps)
    Lp = nb * steps

    def to_blocks(t):
        t = t.reshape(B, L, dilation, H, E)
        t = jnp.pad(t, ((0, 0), (0, Lp - L), (0, 0), (0, 0), (0, 0)))
        return t.reshape(B, nb, steps, dilation, H, E)

    def with_prev(t):
        prev = jnp.pad(t, ((0, 0), (1, 0), (0, 0), (0, 0), (0, 0), (0, 0)))[:, :-1]
        return jnp.concatenate([prev, t], axis=2)

    qb, kb, vb = to_blocks(q), to_blocks(k), to_blocks(v)
    kw, vw = with_prev(kb), with_prev(vb)
    logits = jnp.einsum('bnqrhe,bnkrhe->bnrhqk', qb, kw,
                        preferred_element_type=jnp.float32) * (E ** -0.5)

    qi = jnp.arange(steps)[:, None]
    kj = jnp.arange(2 * steps)[None, :]
    rel = qi + steps - kj
    band = (rel >= 0) & (rel <= steps)
    key_exists = (jnp.arange(nb)[:, None, None] * steps + kj[None] - steps) >= 0
    valid = band[None] & key_exists
    bias = rel_bias[t5_bucket(jnp.clip(rel, 0, steps) * dilation)].astype(jnp.float32)
    logits = logits + jnp.transpose(bias, (2, 0, 1))[None, None, None]
    logits = jnp.where(valid[None, :, None, None], logits, NEG_INF)

    m = jnp.max(logits, axis=-1)
    p = jnp.exp(logits - m[..., None])
    s = jnp.sum(p, axis=-1)
    o = jnp.einsum('bnrhqk,bnkrhe->bnqrhe', p.astype(v.dtype), vw,
                   preferred_element_type=jnp.float32)

    o = o.reshape(B, Lp, dilation, H, E)[:, :L].reshape(B, S, H, E)
    m = jnp.transpose(m, (0, 1, 4, 2, 3)).reshape(B, Lp, dilation, H)[:, :L].reshape(B, S, H)
    s = jnp.transpose(s, (0, 1, 4, 2, 3)).reshape(B, Lp, dilation, H)[:, :L].reshape(B, S, H)
    return o, m, s


def dilated_attention(q, k, v, rel_bias):
    outs = [dilated_branch(q, k, v, d, w // d, rel_bias) for (w, d) in DIL_CONFIGS]
    m_max = functools.reduce(jnp.maximum, [m for _, m, _ in outs])
    num = jnp.zeros(q.shape, jnp.float32)
    den = jnp.zeros(q.shape[:-1], jnp.float32)
    for o, m, s in outs:
        wgt = jnp.exp(m - m_max)
        num = num + wgt[..., None] * o
        den = den + wgt * s
    return num / den[..., None]


def memory_cross_attention(hn, memn, w_q, w_k, w_v, w_o):
    B, S, _ = hn.shape
    M = memn.shape[1]
    q = (hn @ w_q).reshape(B, S, XATTN_HEADS, XATTN_HEAD_DIM)
    k = (memn @ w_k).reshape(B, M, XATTN_HEADS, XATTN_HEAD_DIM)
    v = (memn @ w_v).reshape(B, M, XATTN_HEADS, XATTN_HEAD_DIM)
    logits = jnp.einsum('bshe,bmhe->bhsm', q, k,
                        preferred_element_type=jnp.float32) * (XATTN_HEAD_DIM ** -0.5)
    p = jax.nn.softmax(logits, axis=-1)
    o = jnp.einsum('bhsm,bmhe->bshe', p.astype(v.dtype), v).reshape(B, S, XATTN_WIDTH)
    return o @ w_o


def causal_dwconv(u, w, b):
    K = w.shape[0]
    S = u.shape[1]
    up = jnp.pad(u, ((0, 0), (K - 1, 0), (0, 0)))
    y = b
    for i in range(K):
        y = y + up[:, i:i + S] * w[i]
    return y


def hybrid_layer(x, mem, rel_bias, norm_mix_g, w_in, gla_w_gate2, gla_b_gate, gla_norm_g,
                 w_out, norm_xattn_g, mem_norm_g, w_xq, w_xk, w_xv, w_xo, norm_ffn_g,
                 w_ffn_gate, w_ffn_up, ffn_conv_w, ffn_conv_b, w_ffn_down):
    B, S, _ = x.shape
    f32 = jnp.float32

    hn = rmsnorm(x, norm_mix_g)
    proj = hn @ w_in
    split_at = np.cumsum(_proj_sizes())[:-1].tolist()
    gq, gk, gv, glr, gr, dq, dk, dv = jnp.split(proj, split_at, axis=-1)

    g_log = jax.nn.log_sigmoid((glr @ gla_w_gate2 + gla_b_gate).astype(f32)) / GLA_TAU
    o_gla = gla_chunked(gq.reshape(B, S, GLA_HEADS, GLA_DK).astype(f32),
                        gk.reshape(B, S, GLA_HEADS, GLA_DK).astype(f32),
                        gv.reshape(B, S, GLA_HEADS, GLA_DV).astype(f32),
                        g_log.reshape(B, S, GLA_HEADS, GLA_DK))
    o_gla = rmsnorm(o_gla, gla_norm_g) * jax.nn.silu(
        gr.astype(f32)).reshape(B, S, GLA_HEADS, GLA_DV)
    o_gla = o_gla.reshape(B, S, GLA_HEADS * GLA_DV)

    o_dil = dilated_attention(dq.reshape(B, S, DIL_HEADS, DIL_HEAD_DIM),
                              dk.reshape(B, S, DIL_HEADS, DIL_HEAD_DIM),
                              dv.reshape(B, S, DIL_HEADS, DIL_HEAD_DIM), rel_bias)
    o_dil = o_dil.reshape(B, S, DIL_HEADS * DIL_HEAD_DIM)

    mix = jnp.concatenate([o_gla, o_dil], axis=-1).astype(x.dtype) @ w_out
    h = x + mix

    h = h + memory_cross_attention(rmsnorm(h, norm_xattn_g), rmsnorm(mem, mem_norm_g),
                                   w_xq, w_xk, w_xv, w_xo)

    hn = rmsnorm(h, norm_ffn_g)
    gate = causal_dwconv(hn @ w_ffn_gate, ffn_conv_w, ffn_conv_b)
    h = h + (jax.nn.silu(gate) * (hn @ w_ffn_up)) @ w_ffn_down
    return h


def setup_inputs(seed: int = 0) -> dict:
    key = jax.random.key(seed)
    ks = jax.random.split(key, 22)
    f32 = jnp.float32

    def nrm(k, shape, scale):
        return jax.random.normal(k, shape, f32) * scale

    def gain(k, shape):
        return 1.0 + 0.05 * jax.random.normal(k, shape, f32)

    L = DEPTH
    n_cols = sum(_proj_sizes())
    return {
        'x': nrm(ks[0], (BATCH, SEQ, D_MODEL), 1.0),
        'mem': nrm(ks[1], (BATCH, MEM_LEN, D_MODEL), 1.0),
        'rel_bias': nrm(ks[2], (REL_BUCKETS, DIL_HEADS), 0.5),
        'norm_mix_g': gain(ks[3], (L, D_MODEL)),
        'w_in': nrm(ks[4], (L, D_MODEL, n_cols), D_MODEL ** -0.5),
        'gla_w_gate2': nrm(ks[5], (L, GLA_LOWRANK, GLA_HEADS * GLA_DK), GLA_LOWRANK ** -0.5),
        'gla_b_gate': nrm(ks[6], (L, GLA_HEADS * GLA_DK), 0.1),
        'gla_norm_g': gain(ks[7], (L, GLA_DV)),
        'w_out': nrm(ks[8], (L, MIX_WIDTH, D_MODEL), MIX_WIDTH ** -0.5),
        'norm_xattn_g': gain(ks[9], (L, D_MODEL)),
        'mem_norm_g': gain(ks[10], (L, D_MODEL)),
        'w_xq': nrm(ks[11], (L, D_MODEL, XATTN_WIDTH), D_MODEL ** -0.5),
        'w_xk': nrm(ks[12], (L, D_MODEL, XATTN_WIDTH), D_MODEL ** -0.5),
        'w_xv': nrm(ks[13], (L, D_MODEL, XATTN_WIDTH), D_MODEL ** -0.5),
        'w_xo': nrm(ks[14], (L, XATTN_WIDTH, D_MODEL), XATTN_WIDTH ** -0.5),
        'norm_ffn_g': gain(ks[15], (L, D_MODEL)),
        'w_ffn_gate': nrm(ks[16], (L, D_MODEL, D_FF), D_MODEL ** -0.5),
        'w_ffn_up': nrm(ks[17], (L, D_MODEL, D_FF), D_MODEL ** -0.5),
        'ffn_conv_w': nrm(ks[18], (L, CONV_WIDTH, D_FF), CONV_WIDTH ** -0.5),
        'ffn_conv_b': nrm(ks[19], (L, D_FF), 0.02),
        'w_ffn_down': nrm(ks[20], (L, D_FF, D_MODEL), D_FF ** -0.5),
        'final_norm_g': gain(ks[21], (D_MODEL,)),
    }


def reference(x, mem, rel_bias, norm_mix_g, w_in, gla_w_gate2, gla_b_gate, gla_norm_g,
              w_out, norm_xattn_g, mem_norm_g, w_xq, w_xk, w_xv, w_xo, norm_ffn_g,
              w_ffn_gate, w_ffn_up, ffn_conv_w, ffn_conv_b, w_ffn_down, final_norm_g):
    h = x
    for i in range(DEPTH):
        h = hybrid_layer(h, mem, rel_bias, norm_mix_g[i], w_in[i], gla_w_gate2[i],
                         gla_b_gate[i], gla_norm_g[i], w_out[i], norm_xattn_g[i],
                         mem_norm_g[i], w_xq[i], w_xk[i], w_xv[i], w_xo[i], norm_ffn_g[i],
                         w_ffn_gate[i], w_ffn_up[i], ffn_conv_w[i], ffn_conv_b[i],
                         w_ffn_down[i])
    return rmsnorm(h, final_norm_g)
```

```cpp
#include <hip/hip_runtime.h>
#include <hip/hip_bf16.h>
#include <cstdio>
#include <cstdint>
#include <cmath>
#ifndef MK_N_LAUNCHES
#define MK_N_LAUNCHES 1
#endif
namespace pg8 {
#define PG8_LAS __attribute__((address_space(3)))
typedef unsigned short bf16_t;
typedef short bf16x8 __attribute__((ext_vector_type(8)));
typedef float f32x4 __attribute__((ext_vector_type(4)));
typedef unsigned u32x4 __attribute__((ext_vector_type(4)));
constexpr int BM = 256, BK = 64, HALF = 128, HTB = HALF * BK * 2  , STAGE_BYTES = 8 * HTB, NXCD = 8, WGM = 8;

__host__ __device__ __forceinline__ int lds_byte(int r, int c) { const int st = (r >> 4) * 2 + (c >> 5), rr = r & 15, cc = c & 31, ob = rr * 64 + cc * 2; return st * 1024 + (ob ^ (((ob >> 9) & 1) << 5)); }
__host__ __device__ __forceinline__ void stage_rc(int b, int& R, int& C) { const int st = b / 1024, sb = b % 1024, swz = sb ^ (((sb >> 9) & 1) << 5); R = (st >> 1) * 16 + swz / 64; C = (st & 1) * 32 + (swz % 64) / 2; }
__host__ __device__ __forceinline__ int perm32(int rho) { const int n = rho >> 4, i = rho & 15; return 8 * (i >> 2) + 4 * n + (i & 3); }

struct Unit { int pm, pn; };
struct Gemm { const bf16_t* A; const bf16_t* Bt; int M, N, K; };

struct StaticOrder {
    int nM, nN, nwg, G, c;
    __host__ __device__ void init(int M, int N, int G_, int c_) { nM = M / BM; nN = N / BM; nwg = nM * nN; G = G_; c = c_; }
    __host__ __device__ bool next(int i, Unit& u) const {
        const long L = (long)i * G + c; if (L >= nwg) return false;
        int wgid = (int)L; { const int q = nwg / NXCD, r = nwg % NXCD, xcd = wgid % NXCD, off = wgid / NXCD; wgid = (xcd < r ? xcd * (q + 1) : r * (q + 1) + (xcd - r) * q) + off; }
        const int nig = WGM * nN, gid = wgid / nig, fm = gid * WGM, gsz = (nM - fm) < WGM ? (nM - fm) : WGM;
        u.pm = fm + ((wgid % nig) % gsz); u.pn = (wgid % nig) / gsz; return true;
    }
    __device__ __forceinline__ void a_ready(const Unit&) const {}
    __device__ __forceinline__ void done(const Unit&) const {}
};

__device__ __forceinline__ unsigned cvt_pk_bf16(float lo, float hi) { unsigned r; asm volatile("v_cvt_pk_bf16_f32 %0, %1, %2" : "=v"(r) : "v"(lo), "v"(hi)); return r; }
typedef float f32x2 __attribute__((ext_vector_type(2)));
typedef unsigned u32x2 __attribute__((ext_vector_type(2)));
constexpr float RMS_EPS = 1e-6f;
constexpr float SS_SCALE = 1048576.0f;
__device__ __forceinline__ float rstd_of(const unsigned long long* ss, int row, float inv_n) { return 1.0f / sqrtf((float)ss[row] * (inv_n / SS_SCALE) + RMS_EPS); }

struct Seg { bf16_t* base; int ld; int col0; int pad; };
struct EpiProj {
    static constexpr bool PERM = true, AFTER_DRAIN = false, PREFETCH = false;
    bf16_t *gq, *gk, *gv, *gr, *dqkv;
    __device__ __forceinline__ void operator()(const f32x4 (&acc)[2][2][4][2], const Unit& u, int wr, int wc, int fr, int fq) const {
        const int colt = u.pn * BM; const int row0 = u.pm * BM + wr * 64 + fr;
        if (colt < 6144) {
            bf16_t* base; int ld, c0;
            if (colt < 1024) { base = gq; ld = 1024; c0 = colt; } else if (colt < 2048) { base = gk; ld = 1024; c0 = colt - 1024; }
            else if (colt < 4096) { base = gv; ld = 2048; c0 = colt - 2048; } else { base = gr; ld = 2048; c0 = colt - 4096; }
            const int col0 = c0 + wc * 32 + 8 * fq;
#pragma unroll
            for (int ai = 0; ai < 2; ++ai)
#pragma unroll
                for (int m = 0; m < 4; ++m) { bf16_t* rowp = base + (size_t)(row0 + ai * HALF + m * 16) * ld + col0;
#pragma unroll
                    for (int bj = 0; bj < 2; ++bj) { const f32x4 v0 = acc[ai][bj][m][0], v1 = acc[ai][bj][m][1];
                        u32x4 w; w.x = cvt_pk_bf16(v0[0], v0[1]); w.y = cvt_pk_bf16(v0[2], v0[3]); w.z = cvt_pk_bf16(v1[0], v1[1]); w.w = cvt_pk_bf16(v1[2], v1[3]);
                        __builtin_nontemporal_store(w, (u32x4*)(rowp + bj * HALF)); } }
        } else {
            const int c = colt - 6144, ten = c >> 11, h0 = (c & 2047) >> 7;
            bf16_t* base = dqkv + (size_t)ten * ((size_t)16384 * 2048) + wc * 32 + 8 * fq;
#pragma unroll
            for (int ai = 0; ai < 2; ++ai)
#pragma unroll
                for (int m = 0; m < 4; ++m) { const int row = row0 + ai * HALF + m * 16, b = row >> 12, sq = row & 4095;
#pragma unroll
                    for (int bj = 0; bj < 2; ++bj) { const f32x4 v0 = acc[ai][bj][m][0], v1 = acc[ai][bj][m][1];
                        u32x4 w; w.x = cvt_pk_bf16(v0[0], v0[1]); w.y = cvt_pk_bf16(v0[2], v0[3]); w.z = cvt_pk_bf16(v1[0], v1[1]); w.w = cvt_pk_bf16(v1[2], v1[3]);
                        __builtin_nontemporal_store(w, (u32x4*)(base + ((size_t)((b * 16 + h0 + bj) * 4096 + sq)) * 128)); } }
        }
    }
};
struct EpiScaleBf16 {
    static constexpr bool PERM = true, AFTER_DRAIN = false, PREFETCH = false;
    bf16_t* O; int ldc; const unsigned long long* ss; float inv_n;
    __device__ __forceinline__ void operator()(const f32x4 (&acc)[2][2][4][2], const Unit& u, int wr, int wc, int fr, int fq) const {
        const int row0 = u.pm * BM + wr * 64 + fr, col0 = u.pn * BM + wc * 32 + 8 * fq;
#pragma unroll
        for (int ai = 0; ai < 2; ++ai)
#pragma unroll
            for (int m = 0; m < 4; ++m) { const int row = row0 + ai * HALF + m * 16; const float rs = ss ? rstd_of(ss, row, inv_n) : 1.0f; bf16_t* rowp = O + (size_t)row * ldc + col0;
#pragma unroll
                for (int bj = 0; bj < 2; ++bj) { const f32x4 v0 = acc[ai][bj][m][0] * rs, v1 = acc[ai][bj][m][1] * rs;
                    u32x4 w; w.x = cvt_pk_bf16(v0[0], v0[1]); w.y = cvt_pk_bf16(v0[2], v0[3]); w.z = cvt_pk_bf16(v1[0], v1[1]); w.w = cvt_pk_bf16(v1[2], v1[3]);
                    *(u32x4*)(rowp + bj * HALF) = w; } }
    }
};
struct EpiResid {
    static constexpr bool PERM = true, AFTER_DRAIN = false, PREFETCH = false;
    const float* base32; const bf16_t* base16; bf16_t* hb; unsigned long long* ss; int ldc;
    __device__ __forceinline__ void operator()(const f32x4 (&acc)[2][2][4][2], const Unit& u, int wr, int wc, int fr, int fq) const {
        const int row0 = u.pm * BM + wr * 64 + fr, col0 = u.pn * BM + wc * 32 + 8 * fq;
        f32x4 bc[2][2], bn[2][2]; u32x4 hc[2], hn[2];
#define EPR_LOAD(d32, d16, g) do { const size_t o_ = (size_t)(row0 + ((g) >> 2) * HALF + ((g) & 3) * 16) * ldc + col0; \
        if (base32) { d32[0][0] = *(const f32x4*)(base32 + o_); d32[0][1] = *(const f32x4*)(base32 + o_ + 4); d32[1][0] = *(const f32x4*)(base32 + o_ + HALF); d32[1][1] = *(const f32x4*)(base32 + o_ + HALF + 4); } \
        else { d16[0] = *(const u32x4*)(base16 + o_); d16[1] = *(const u32x4*)(base16 + o_ + HALF); } } while (0)
        EPR_LOAD(bc, hc, 0);
#pragma unroll
        for (int g = 0; g < 8; ++g) {
            const int ai = g >> 2, m = g & 3; const int row = row0 + ai * HALF + m * 16; const size_t off = (size_t)row * ldc + col0; float s = 0.f;
            if (g < 7) EPR_LOAD(bn, hn, g + 1);
#pragma unroll
            for (int bj = 0; bj < 2; ++bj) {
                f32x4 b0, b1;
                if (base32) { b0 = bc[bj][0]; b1 = bc[bj][1]; }
                else { const u32x4 w = hc[bj]; b0 = (f32x4){__uint_as_float(w.x << 16), __uint_as_float(w.x & 0xffff0000u), __uint_as_float(w.y << 16), __uint_as_float(w.y & 0xffff0000u)};
                                              b1 = (f32x4){__uint_as_float(w.z << 16), __uint_as_float(w.z & 0xffff0000u), __uint_as_float(w.w << 16), __uint_as_float(w.w & 0xffff0000u)}; }
                const f32x4 v0 = acc[ai][bj][m][0] + b0, v1 = acc[ai][bj][m][1] + b1;
                s += (v0[0] * v0[0] + v0[1] * v0[1]) + (v0[2] * v0[2] + v0[3] * v0[3]) + (v1[0] * v1[0] + v1[1] * v1[1]) + (v1[2] * v1[2] + v1[3] * v1[3]);
                u32x4 w; w.x = cvt_pk_bf16(v0[0], v0[1]); w.y = cvt_pk_bf16(v0[2], v0[3]); w.z = cvt_pk_bf16(v1[0], v1[1]); w.w = cvt_pk_bf16(v1[2], v1[3]); *(u32x4*)(hb + off + bj * HALF) = w; }
            s += __shfl_xor(s, 16); s += __shfl_xor(s, 32);
            if (ss && fq == 0) atomicAdd(ss + row, (unsigned long long)(s * SS_SCALE + 0.5f));
#pragma unroll
            for (int bj = 0; bj < 2; ++bj) { bc[bj][0] = bn[bj][0]; bc[bj][1] = bn[bj][1]; hc[bj] = hn[bj]; }
            asm volatile("" ::: "memory");
        }
#undef EPR_LOAD
    }
};
struct EpiGateUp {
    static constexpr bool PERM = true, AFTER_DRAIN = false, PREFETCH = true;
    bf16_t* act; int ldc; const unsigned long long* ss; float inv_n; const float* cw; const float* cb; float* GF; float* UF; float* GL; int nff;
    PG8_LAS float* aux;
    __device__ __forceinline__ void prefetch(const Unit& u, int par) const {
        const int tid = (int)threadIdx.x, arr = tid >> 7, ch = tid & 127;
        const float v = arr < 3 ? cw[arr * nff + u.pn * HALF + ch] : cb[u.pn * HALF + ch];
        PG8_LAS float* a = aux + par * 768; a[tid] = v;
        if (tid < 256) a[512 + tid] = rstd_of(ss, u.pm * BM + tid, inv_n);
    }
    __device__ __forceinline__ void run(const f32x4 (&acc)[2][2][4][2], const Unit& u, int wr, int wc, int fr, int fq, int par, const Unit& nxt) const {
        const int tid = (int)threadIdx.x, arr = tid >> 7, chn = tid & 127;
        const float nv = arr < 3 ? cw[arr * nff + nxt.pn * HALF + chn] : cb[nxt.pn * HALF + chn];
        const unsigned long long nss = ss[nxt.pm * BM + (tid & 255)];
        const PG8_LAS float* a = aux + par * 768;
        const int c0 = wc * 32 + 8 * fq;
        const int ch0 = u.pn * HALF + c0;
        float w0[8], w1[8], w2[8], bb[8];
#pragma unroll
        for (int h4 = 0; h4 < 2; ++h4) { const f32x4 x0 = *(const PG8_LAS f32x4*)(a + c0 + 4 * h4), x1 = *(const PG8_LAS f32x4*)(a + 128 + c0 + 4 * h4), x2 = *(const PG8_LAS f32x4*)(a + 256 + c0 + 4 * h4), x3 = *(const PG8_LAS f32x4*)(a + 384 + c0 + 4 * h4);
#pragma unroll
            for (int j = 0; j < 4; ++j) { w0[4 * h4 + j] = x0[j]; w1[4 * h4 + j] = x1[j]; w2[4 * h4 + j] = x2[j]; bb[4 * h4 + j] = x3[j]; } }
#pragma unroll
        for (int ai = 0; ai < 2; ++ai) {
            const int blk = (u.pm * BM + ai * HALF + wr * 64) >> 6;
            float pg[8];
#pragma unroll
            for (int e = 0; e < 8; ++e) pg[e] = 0.f;
#pragma unroll
            for (int m = 0; m < 4; ++m) {
                const int lrow = ai * HALF + wr * 64 + m * 16 + fr; const int row = u.pm * BM + lrow; const float rs = a[512 + lrow];
                float g[8], up[8], av[8];
#pragma unroll
                for (int n = 0; n < 2; ++n)
#pragma unroll
                    for (int j = 0; j < 4; ++j) { g[4 * n + j] = acc[ai][0][m][n][j] * rs; up[4 * n + j] = acc[ai][1][m][n][j] * rs; }
#pragma unroll
                for (int e = 0; e < 8; ++e) {
                    const int gi = __float_as_int(g[e]), pi = __float_as_int(pg[e]);
                    const float p1 = __int_as_float(__builtin_amdgcn_update_dpp(__builtin_amdgcn_update_dpp(0, pi, 0x121, 0xf, 0xf, false), gi, 0x111, 0xf, 0xf, false));
                    const float p2 = __int_as_float(__builtin_amdgcn_update_dpp(__builtin_amdgcn_update_dpp(0, pi, 0x122, 0xf, 0xf, false), gi, 0x112, 0xf, 0xf, false));
                    const float y = bb[e] + w0[e] * p2 + w1[e] * p1 + w2[e] * g[e];
                    av[e] = y * __builtin_amdgcn_rcpf(1.0f + __expf(-y)) * up[e];
                }
                if (m > 0 || fr >= 2) { u32x4 w; w.x = cvt_pk_bf16(av[0], av[1]); w.y = cvt_pk_bf16(av[2], av[3]); w.z = cvt_pk_bf16(av[4], av[5]); w.w = cvt_pk_bf16(av[6], av[7]);
                    __builtin_nontemporal_store(w, (u32x4*)(act + (size_t)row * ldc + ch0)); }
                if (m == 0 && fr < 2) { float* gp = GF + ((size_t)blk * 2 + fr) * nff + ch0; float* upp = UF + ((size_t)blk * 2 + fr) * nff + ch0;
                    *(f32x4*)gp = (f32x4){g[0], g[1], g[2], g[3]}; *(f32x4*)(gp + 4) = (f32x4){g[4], g[5], g[6], g[7]};
                    *(f32x4*)upp = (f32x4){up[0], up[1], up[2], up[3]}; *(f32x4*)(upp + 4) = (f32x4){up[4], up[5], up[6], up[7]}; }
                if (m == 3 && fr >= 14) { float* gp = GL + ((size_t)blk * 2 + (fr - 14)) * nff + ch0;
                    *(f32x4*)gp = (f32x4){g[0], g[1], g[2], g[3]}; *(f32x4*)(gp + 4) = (f32x4){g[4], g[5], g[6], g[7]}; }
#pragma unroll
                for (int e = 0; e < 8; ++e) pg[e] = g[e];
            }
        }
        PG8_LAS float* an = aux + (par ^ 1) * 768; an[tid] = nv;
        if (tid < 256) an[512 + tid] = 1.0f / sqrtf((float)nss * (inv_n / SS_SCALE) + RMS_EPS);
    }
};
struct EpiNull {
    static constexpr bool PERM = true, AFTER_DRAIN = false, PREFETCH = false;
    __device__ __forceinline__ void operator()(const f32x4 (&acc)[2][2][4][2], const Unit& u, int wr, int wc, int fr, int fq) const {
#pragma unroll
        for (int ai = 0; ai < 2; ++ai)
#pragma unroll
            for (int bj = 0; bj < 2; ++bj)
#pragma unroll
                for (int m = 0; m < 4; ++m)
#pragma unroll
                    for (int n = 0; n < 2; ++n) asm volatile("" :: "v"(acc[ai][bj][m][n]));
    }
};
template <class Epi, class Sched, bool ALIGN_EPI = false, bool SP2 = false>
__device__ __forceinline__ void gemm_phase(PG8_LAS unsigned char* lds, const Gemm g, const Sched& S, const Epi& E) {
    const int tid = threadIdx.x, wid = __builtin_amdgcn_readfirstlane(tid >> 6), lane = tid & 63, wr = wid >> 2, wc = wid & 3, fr = lane & 15, fq = lane >> 4;
    const int K = g.K, nt = K / BK;
    unsigned voffA[2], voffB[2];
#pragma unroll
    for (int i = 0; i < 2; ++i) { int R, C; stage_rc(tid * 16 + i * 8192, R, C); const int Rb = Epi::PERM ? ((R & ~31) + perm32(R & 31)) : R;
        voffA[i] = (unsigned)(R * K + C) * 2u; voffB[i] = (unsigned)(Rb * K + C) * 2u; }
    const size_t kstep = (size_t)(BK * 2);
    const size_t hstep = (size_t)HALF * K * 2;
    const size_t tstep = 2 * hstep;
    const unsigned ldsw = (unsigned)wid * 1024u;
    const int aoff = lds_byte(wr * 64 + fr, fq * 8), boff = lds_byte(wc * 32 + fr, fq * 8);
#define PG8_SA(b, h) (((b) * 2 + (h)) * HTB)
#define PG8_SB(b, h) ((4 + (b) * 2 + (h)) * HTB)
#define PG8_STAGE(bufoff, gbase, voff) do { _Pragma("unroll") for (int _i = 0; _i < 2; ++_i) \
        __builtin_amdgcn_global_load_lds((const unsigned*)((const char*)(gbase) + (voff)[_i]), (PG8_LAS unsigned*)(lds + (bufoff) + ldsw + _i * 8192), 16, 0, 0); } while (0)
#define PG8_LDA(dst, b, h) do { _Pragma("unroll") for (int m = 0; m < 4; ++m) _Pragma("unroll") for (int k = 0; k < 2; ++k) dst[m][k] = *(const PG8_LAS bf16x8*)(lds + PG8_SA(b, h) + aoff + m * 2048 + k * 1024); } while (0)
#define PG8_LDB(dst, b, h) do { _Pragma("unroll") for (int n = 0; n < 2; ++n) _Pragma("unroll") for (int k = 0; k < 2; ++k) dst[n][k] = *(const PG8_LAS bf16x8*)(lds + PG8_SB(b, h) + boff + n * 2048 + k * 1024); } while (0)
#define PG8_MMA(ai, bj, At, Bt) do { __builtin_amdgcn_s_setprio(1); _Pragma("unroll") for (int m = 0; m < 4; ++m) _Pragma("unroll") for (int n = 0; n < 2; ++n) _Pragma("unroll") for (int k = 0; k < 2; ++k) \
        acc[ai][bj][m][n] = __builtin_amdgcn_mfma_f32_16x16x32_bf16(Bt[n][k], At[m][k], acc[ai][bj][m][n], 0, 0, 0); __builtin_amdgcn_s_setprio(0); } while (0)
#define PG8_WAIT_V(n) asm volatile("s_waitcnt vmcnt(" #n ")" ::: "memory")
#define PG8_WAIT_L(n) asm volatile("s_waitcnt lgkmcnt(" #n ")" ::: "memory")
#define PG8_BAR __builtin_amdgcn_s_barrier()
#define PG8_SCHED __builtin_amdgcn_sched_barrier(0)
    Unit cur, nxt; int ui = 0;
    if (!S.next(0, cur)) return;
    f32x4 acc[2][2][4][2];
#pragma unroll
    for (int a = 0; a < 2; ++a)
#pragma unroll
        for (int b = 0; b < 2; ++b)
#pragma unroll
            for (int m = 0; m < 4; ++m)
#pragma unroll
                for (int n = 0; n < 2; ++n) acc[a][b][m][n] = (f32x4){0.f, 0.f, 0.f, 0.f};
    bf16x8 At[4][2], B0[2][2], B1[2][2];
    const char* cA = (const char*)g.A + (size_t)cur.pm * tstep; const char* cB = (const char*)g.Bt + (size_t)cur.pn * tstep;
    S.a_ready(cur);
    if constexpr (Epi::PREFETCH) E.prefetch(cur, 0);
    if constexpr (SP2) {
        PG8_STAGE(PG8_SB(0, 0), cB, voffB); PG8_STAGE(PG8_SB(0, 1), cB + hstep, voffB); PG8_STAGE(PG8_SA(0, 0), cA, voffA); PG8_STAGE(PG8_SA(0, 1), cA + hstep, voffA);
        if (wr == 1) PG8_BAR;
        PG8_WAIT_V(2); PG8_BAR;
        PG8_STAGE(PG8_SB(1, 0), cB + kstep, voffB); PG8_STAGE(PG8_SA(1, 0), cA + kstep, voffA); PG8_STAGE(PG8_SB(1, 1), cB + hstep + kstep, voffB);
        PG8_WAIT_V(6); PG8_BAR;
    } else {
        PG8_STAGE(PG8_SB(0, 0), cB, voffB); PG8_STAGE(PG8_SA(0, 0), cA, voffA); PG8_STAGE(PG8_SB(0, 1), cB + hstep, voffB); PG8_STAGE(PG8_SA(0, 1), cA + hstep, voffA);
        if (wr == 1) PG8_BAR;
        PG8_WAIT_V(4); PG8_BAR;
        PG8_STAGE(PG8_SB(1, 0), cB + kstep, voffB); PG8_STAGE(PG8_SA(1, 0), cA + kstep, voffA); PG8_STAGE(PG8_SB(1, 1), cB + hstep + kstep, voffB);
        PG8_WAIT_V(6); PG8_BAR;
    }
    for (;;) {
        const bool has_next = S.next(ui + 1, nxt);
        const char* nA = has_next ? (const char*)g.A + (size_t)nxt.pm * tstep : cA; const char* nB = has_next ? (const char*)g.Bt + (size_t)nxt.pn * tstep : cB;
        for (int t = 0; t < nt; t += 2) {
            const bool last = (t == nt - 2);
            const char* a1 = cA + (size_t)(t + 1) * kstep;
            const char* a2 = last ? nA : cA + (size_t)(t + 2) * kstep; const char* b2 = last ? nB : cB + (size_t)(t + 2) * kstep;
            const char* a3 = a2 + kstep; const char* b3 = b2 + kstep;
            if (last && has_next) S.a_ready(nxt);
            if constexpr (SP2) {
            PG8_LDB(B0, 0, 0); PG8_LDB(B1, 0, 1); PG8_SCHED; PG8_LDA(At, 0, 0); PG8_STAGE(PG8_SA(1, 1), a1 + hstep, voffA);
            PG8_WAIT_V(8); PG8_WAIT_L(0); PG8_BAR; PG8_MMA(0, 0, At, B0); PG8_MMA(0, 1, At, B1); PG8_BAR; PG8_SCHED;
            PG8_LDA(At, 0, 1); PG8_STAGE(PG8_SB(0, 0), b2, voffB); PG8_STAGE(PG8_SB(0, 1), b2 + hstep, voffB); PG8_STAGE(PG8_SA(0, 0), a2, voffA);
            PG8_WAIT_V(8); PG8_WAIT_L(0); PG8_BAR; PG8_MMA(1, 0, At, B0); PG8_MMA(1, 1, At, B1); PG8_BAR; PG8_SCHED;
            PG8_LDB(B0, 1, 0); PG8_LDB(B1, 1, 1); PG8_SCHED; PG8_LDA(At, 1, 0); PG8_STAGE(PG8_SA(0, 1), a2 + hstep, voffA);
            PG8_WAIT_V(8); PG8_WAIT_L(0); PG8_BAR; PG8_MMA(0, 0, At, B0); PG8_MMA(0, 1, At, B1); PG8_BAR; PG8_SCHED;
            PG8_LDA(At, 1, 1); PG8_STAGE(PG8_SB(1, 0), b3, voffB); PG8_STAGE(PG8_SB(1, 1), b3 + hstep, voffB); PG8_STAGE(PG8_SA(1, 0), a3, voffA);
            PG8_WAIT_V(8); PG8_WAIT_L(0); PG8_BAR; PG8_MMA(1, 0, At, B0); PG8_MMA(1, 1, At, B1); PG8_BAR; PG8_SCHED;
            } else {
            PG8_LDB(B0, 0, 0); PG8_SCHED; PG8_LDA(At, 0, 0); PG8_STAGE(PG8_SA(1, 1), a1 + hstep, voffA);
            PG8_WAIT_L(8); PG8_BAR; PG8_WAIT_L(0); PG8_MMA(0, 0, At, B0); PG8_BAR; PG8_SCHED;
            PG8_LDB(B1, 0, 1); PG8_STAGE(PG8_SB(0, 0), b2, voffB);
            PG8_BAR; PG8_WAIT_L(0); PG8_MMA(0, 1, At, B1); PG8_BAR;
            PG8_LDA(At, 0, 1); PG8_STAGE(PG8_SA(0, 0), a2, voffA);
            PG8_BAR; PG8_WAIT_L(0); PG8_MMA(1, 0, At, B0); PG8_BAR; PG8_SCHED;
            PG8_STAGE(PG8_SB(0, 1), b2 + hstep, voffB);
            PG8_WAIT_V(6); PG8_BAR; PG8_MMA(1, 1, At, B1); PG8_BAR;
            PG8_LDB(B0, 1, 0); PG8_SCHED; PG8_LDA(At, 1, 0); PG8_STAGE(PG8_SA(0, 1), a2 + hstep, voffA);
            PG8_WAIT_L(8); PG8_BAR; PG8_WAIT_L(0); PG8_MMA(0, 0, At, B0); PG8_BAR; PG8_SCHED;
            PG8_LDB(B1, 1, 1); PG8_STAGE(PG8_SB(1, 0), b3, voffB);
            PG8_BAR; PG8_WAIT_L(0); PG8_MMA(0, 1, At, B1); PG8_BAR;
            PG8_LDA(At, 1, 1); PG8_STAGE(PG8_SA(1, 0), a3, voffA);
            PG8_BAR; PG8_WAIT_L(0); PG8_MMA(1, 0, At, B0); PG8_BAR; PG8_SCHED;
            PG8_STAGE(PG8_SB(1, 1), b3 + hstep, voffB);
            PG8_WAIT_V(6); PG8_BAR; PG8_MMA(1, 1, At, B1); PG8_BAR;
            }
        }
        if constexpr (ALIGN_EPI) { if (wr == 0) PG8_BAR; }
        if constexpr (!Epi::AFTER_DRAIN) { if constexpr (Epi::PREFETCH) E.run(acc, cur, wr, wc, fr, fq, ui & 1, has_next ? nxt : cur); else E(acc, cur, wr, wc, fr, fq); S.done(cur); }
        if (!has_next) break;
#pragma unroll
        for (int a = 0; a < 2; ++a)
#pragma unroll
            for (int b = 0; b < 2; ++b)
#pragma unroll
                for (int m = 0; m < 4; ++m)
#pragma unroll
                    for (int n = 0; n < 2; ++n) acc[a][b][m][n] = (f32x4){0.f, 0.f, 0.f, 0.f};
        cur = nxt; cA = nA; cB = nB; ++ui;
        if constexpr (ALIGN_EPI) { if (wr == 1) PG8_BAR; }
    }
    PG8_WAIT_V(0);
    if constexpr (!ALIGN_EPI) { if (wr == 0) PG8_BAR; }
    PG8_BAR;
    if constexpr (Epi::AFTER_DRAIN) { E.fused(acc, cur, wr, wc, fr, fq, lds, wid, lane); S.done(cur); }
#undef PG8_SA
#undef PG8_SB
#undef PG8_STAGE
#undef PG8_LDA
#undef PG8_LDB
#undef PG8_MMA
#undef PG8_WAIT_V
#undef PG8_WAIT_L
#undef PG8_BAR
#undef PG8_SCHED
}
}
namespace att {
constexpr int D = 128; constexpr float THR = 8.f; constexpr bool WSKIP = true;
constexpr float SCALE = 0.08838834764831845f;
constexpr int NW = 8, QBLK = 32, KVBLK = 64, QB = NW * QBLK;
constexpr int SHM_V = KVBLK * D * 2, SHM_K = KVBLK * D * 2;
constexpr int LDS_TAB = 2 * SHM_V + 2 * SHM_K + NW * 64 * 4, TAB_N = 328, TAB_OFF = 100, TAB_PITCH = 4 * TAB_N;
constexpr int LDS_BYTES = LDS_TAB + 2 * TAB_PITCH * 4;
using bf16 = __hip_bfloat16;
typedef short bf16x8 __attribute__((ext_vector_type(8)));
typedef short s16x4 __attribute__((ext_vector_type(4)));
typedef float f32x16 __attribute__((ext_vector_type(16)));
typedef float f32x4 __attribute__((ext_vector_type(4)));
typedef float f32x2 __attribute__((ext_vector_type(2)));
typedef unsigned u32x4 __attribute__((ext_vector_type(4)));
template <class A, class Bt> struct same_t { static constexpr bool v = false; };
template <class A> struct same_t<A, A> { static constexpr bool v = true; };

#define KSWZ(row, colB) ((row) * 256 + ((colB) ^ (((row) & 7) << 4)))
#define SBAR() __builtin_amdgcn_sched_barrier(0)
__device__ __forceinline__ int v_st(int k, int c) { const int kk = (k & ~0xC) | ((k & 4) << 1) | ((k & 8) >> 1); return ((kk >> 3) * 4 + (c >> 5)) * 512 + ((kk & 7) * 32 + (c & 31)) * 2; }
__device__ __forceinline__ int v_rd_base(int lane) { return ((lane & 3) << 3) | (((lane >> 2) & 3) << 6) | (((lane >> 4) & 1) << 5) | (((lane >> 5) & 1) << 8); }
constexpr int v_rd_off(int d0, int ks, int half) { return d0 * 512 + ks * 4096 + half * 2048; }
__device__ __forceinline__ int crow(int r, int hi) { return (r & 3) + 8 * (r >> 2) + 4 * hi; }
__device__ __forceinline__ unsigned cvtpk(float lo, float hi) {
    unsigned r; asm volatile("v_cvt_pk_bf16_f32 %0, %1, %2" : "=v"(r) : "v"(lo), "v"(hi)); return r;
}
__device__ __forceinline__ bf16x8 pack8(f32x4 a, f32x4 b) {
    u32x4 w = {cvtpk(a[0], a[1]), cvtpk(a[2], a[3]), cvtpk(b[0], b[1]), cvtpk(b[2], b[3])};
    return *reinterpret_cast<bf16x8*>(&w);
}
template <class T> __device__ __forceinline__ bf16x8 load8(const T* p) {
    if constexpr (same_t<T, float>::v) { return pack8(*(const f32x4*)p, *(const f32x4*)(p + 4)); }
    else { return *reinterpret_cast<const bf16x8*>(p); }
}
__device__ __forceinline__ void mask_tile(f32x16& p0, f32x16& p1, int dq, unsigned W) {
    const float NEG = -__builtin_inff();
#pragma unroll
    for (int r = 0; r < 16; ++r) {
        const int c = (r & 3) + 8 * (r >> 2);
        if ((unsigned)(dq - c) >= W) p0[r] = NEG;
        if ((unsigned)(dq - c - 32) >= W) p1[r] = NEG;
    }
}
__device__ __forceinline__ void bias_mask_tile(f32x16& p0, f32x16& p1, int dq, unsigned W, const float* tabu, bool needmask) {
    const float NEG = -__builtin_inff();
    const int sft = (4 - ((int)threadIdx.x & 3)) & 3;
    const float* t0 = tabu + (sft * (TAB_N - 1) + TAB_OFF + 128 - dq);
#pragma unroll
    for (int J = 0; J < 8; ++J) {
        const f32x4 b = *(const f32x4*)(t0 + 8 * J);
#pragma unroll
        for (int e = 0; e < 4; ++e) {
            const int r = 4 * (J & 3) + e; const int c = e + 8 * (J & 3) + (J >= 4 ? 32 : 0);
            float v = (J < 4 ? p0[r] : p1[r]) + b[e];
            if (needmask) { if ((unsigned)(dq - c) >= W) v = NEG; }
            if (J < 4) p0[r] = v; else p1[r] = v;
        }
        if ((J & 1) == 1) asm volatile("" ::: "memory");
    }
}
__device__ __forceinline__ void bias_fill(float* T, const float* bsrc, int tid) {
    asm volatile("" : "+v"(tid));
    if (tid < TAB_N) {
#pragma unroll
        for (int sf = 0; sf < 4; ++sf) { const int i = tid - TAB_OFF + sf; T[sf * TAB_N + tid] = (i >= 0 && i <= 128) ? bsrc[128 - i] : 0.f; }
    }
}
__device__ __forceinline__ void partialSM(f32x16& p0, f32x16& p1, float& m_reg, float& mn, float& alpha) {
    float pmax = p0[0]; for (int r = 1; r < 16; ++r) pmax = fmaxf(pmax, p0[r]); for (int r = 0; r < 16; ++r) pmax = fmaxf(pmax, p1[r]);
    { auto rr = __builtin_amdgcn_permlane32_swap(__float_as_uint(pmax), __float_as_uint(pmax), false, false);
      pmax = fmaxf(__uint_as_float(rr[0]), __uint_as_float(rr[1])); }
    constexpr float C2 = 1.4426950408889634f * SCALE;
    if (__builtin_expect(__all((pmax - m_reg) * SCALE <= THR), 1)) { mn = m_reg; alpha = 1.f; }
    else { mn = fmaxf(m_reg, pmax); alpha = __builtin_amdgcn_exp2f((m_reg - mn) * C2); m_reg = mn; }
    const float mnL = -mn * C2;
    for (int r = 0; r < 16; ++r) p0[r] = fmaf(p0[r], C2, mnL); for (int r = 0; r < 16; ++r) p1[r] = fmaf(p1[r], C2, mnL);
    for (int r = 0; r < 16; ++r) p0[r] = __builtin_amdgcn_exp2f(p0[r]);
}
__device__ __forceinline__ void finishSM(f32x16& p0, f32x16& p1, float alpha, float& l_reg, bf16x8& pa0, bf16x8& pa1, bf16x8& pa2, bf16x8& pa3) {
    for (int r = 0; r < 16; ++r) p1[r] = __builtin_amdgcn_exp2f(p1[r]);
    float ps = 0; for (int r = 0; r < 16; ++r) ps += p0[r]; for (int r = 0; r < 16; ++r) ps += p1[r];
    { auto rr = __builtin_amdgcn_permlane32_swap(__float_as_uint(ps), __float_as_uint(ps), false, false);
      ps = __uint_as_float(rr[0]) + __uint_as_float(rr[1]); }
    l_reg = l_reg * alpha + ps;
#define PK4(P, B_, OUT) do { unsigned a0 = cvtpk(P[B_+0], P[B_+1]), a1 = cvtpk(P[B_+2], P[B_+3]);                          \
        unsigned b0 = cvtpk(P[B_+4], P[B_+5]), b1 = cvtpk(P[B_+6], P[B_+7]);                                             \
        auto r0 = __builtin_amdgcn_permlane32_swap(a0, b0, false, false); auto r1 = __builtin_amdgcn_permlane32_swap(a1, b1, false, false); \
        u32x4 w = {r0[0], r1[0], r0[1], r1[1]}; OUT = *reinterpret_cast<bf16x8*>(&w); } while (0)
    PK4(p0, 0, pa0); PK4(p0, 8, pa1); PK4(p1, 0, pa2); PK4(p1, 8, pa3);
#undef PK4
}
template <int KB, bool SK>
__device__ __forceinline__ void qkt(f32x16& p0, f32x16& p1, const char* K_lds, int r32, int hi, const bf16x8* qr, bool act) {
    if (SK && !act) { const float NEG = -__builtin_inff();
#pragma unroll
        for (int r = 0; r < 16; ++r) { p0[r] = NEG; p1[r] = NEG; } return; }
    p0 = f32x16{}; p1 = f32x16{};
    const char* kb[4];
#pragma unroll
    for (int dd = 0; dd < 4; ++dd) kb[dd] = K_lds + KB * SHM_K + KSWZ(r32, (dd * 16 + hi * 8) * 2);
#pragma unroll
    for (int d0 = 0; d0 < 8; ++d0) { const char* a = kb[d0 & 3] + (d0 >> 2) * 128;
        bf16x8 b0 = *reinterpret_cast<const bf16x8*>(a);
        bf16x8 b1 = *reinterpret_cast<const bf16x8*>(a + 32 * 256);
        p0 = __builtin_amdgcn_mfma_f32_32x32x16_bf16(b0, qr[d0], p0, 0, 0, 0);
        p1 = __builtin_amdgcn_mfma_f32_32x32x16_bf16(b1, qr[d0], p1, 0, 0, 0); }
}
template <int VB, bool SK>
__device__ __forceinline__ void pv_tile(f32x16* o, int vb0, bf16x8 pa0, bf16x8 pa1, bf16x8 pa2, bf16x8 pa3, bool act) {
    if (SK && !act) return;
#define TRRD(dst, off) asm volatile("ds_read_b64_tr_b16 %0, %1 offset:%2" : "=&v"(dst) : "v"(vb0), "i"(off) : "memory")
#define PV_D0(d0) do { s16x4 l0, l1, l2, l3, h0, h1, h2, h3; constexpr int b_ = VB * SHM_V + v_rd_off(d0, 0, 0);     \
        TRRD(l0, b_); TRRD(h0, b_ + 2048); TRRD(l1, b_ + 4096); TRRD(h1, b_ + 6144); TRRD(l2, b_ + 8192); TRRD(h2, b_ + 10240); TRRD(l3, b_ + 12288); TRRD(h3, b_ + 14336); \
        asm volatile("s_waitcnt lgkmcnt(0)" ::: "memory"); SBAR();                 \
        o[d0] = __builtin_amdgcn_mfma_f32_32x32x16_bf16(pa0, (bf16x8){l0[0], l0[1], l0[2], l0[3], h0[0], h0[1], h0[2], h0[3]}, o[d0], 0, 0, 0);   \
        o[d0] = __builtin_amdgcn_mfma_f32_32x32x16_bf16(pa1, (bf16x8){l1[0], l1[1], l1[2], l1[3], h1[0], h1[1], h1[2], h1[3]}, o[d0], 0, 0, 0);   \
        o[d0] = __builtin_amdgcn_mfma_f32_32x32x16_bf16(pa2, (bf16x8){l2[0], l2[1], l2[2], l2[3], h2[0], h2[1], h2[2], h2[3]}, o[d0], 0, 0, 0);   \
        o[d0] = __builtin_amdgcn_mfma_f32_32x32x16_bf16(pa3, (bf16x8){l3[0], l3[1], l3[2], l3[3], h3[0], h3[1], h3[2], h3[3]}, o[d0], 0, 0, 0); } while (0)
    PV_D0(0); PV_D0(1); PV_D0(2); PV_D0(3);
#undef PV_D0
#undef TRRD
}

template <class TIn, class TOut> struct BlockRef { const TIn* Q; const TIn* K; const TIn* V; TOut* O; float* L; const float* bsrc; int P0, pq, pk, po, pl, skv, W; };
template <class TIn> struct Seam {
    bf16x8 qr[8];
    bf16x8 st_v0, st_v1, st_k0, st_k1; f32x4 sf0, sf1, sf2, sf3;
    f32x4 tq[16];
};
__device__ __forceinline__ int swa_jlo(int P0, int W) { const int lowk = P0 - W + 1; return lowk > 0 ? lowk / KVBLK : 0; }
#define ROW(p, pit, k0, rr) ((p) + (unsigned)(((k0) + (rr)) * (pit) + sc))
#define VMW() asm volatile("s_waitcnt vmcnt(0)" ::: "memory")
#define VMWN(n) asm volatile("s_waitcnt vmcnt(%0)" :: "i"(n) : "memory")
#define SLOAD_H(Kp, Vp, pit, k0) do { S.st_v0 = load8<TIn>(ROW(Vp, pit, k0, sr)); S.st_v1 = load8<TIn>(ROW(Vp, pit, k0, 32 + sr));              \
                         S.st_k0 = load8<TIn>(ROW(Kp, pit, k0, sr)); S.st_k1 = load8<TIn>(ROW(Kp, pit, k0, 32 + sr)); } while (0)
#define SWRITE_HK(bf) do { *(bf16x8*)(K_lds + (bf) * SHM_K + kws) = S.st_k0; *(bf16x8*)(K_lds + (bf) * SHM_K + kws + 32 * 256) = S.st_k1; } while (0)
#define SWRITE_HV(bf) do { *(bf16x8*)(V_lds + (bf) * SHM_V + vst0) = S.st_v0; *(bf16x8*)(V_lds + (bf) * SHM_V + vst1) = S.st_v1; } while (0)
#define SWRITE_H(bf) do { SWRITE_HV(bf); SWRITE_HK(bf); } while (0)
#define SLOAD_F(p, k0) do { S.sf0 = *(const f32x4*)ROW(p, D, k0, sr); S.sf1 = *(const f32x4*)(ROW(p, D, k0, sr) + 4);                \
                            S.sf2 = *(const f32x4*)ROW(p, D, k0, 32 + sr); S.sf3 = *(const f32x4*)(ROW(p, D, k0, 32 + sr) + 4); } while (0)
#define SWRITE_KF(bf) do { *(bf16x8*)(K_lds + (bf) * SHM_K + kws) = pack8(S.sf0, S.sf1); *(bf16x8*)(K_lds + (bf) * SHM_K + kws + 32 * 256) = pack8(S.sf2, S.sf3); } while (0)
#define SWRITE_VF(bf) do { *(bf16x8*)(V_lds + (bf) * SHM_V + vst0) = pack8(S.sf0, S.sf1); *(bf16x8*)(V_lds + (bf) * SHM_V + vst1) = pack8(S.sf2, S.sf3); } while (0)
template <int BIAS, class TIn, class TOut>
__device__ __forceinline__ void causal_swa_prime(const BlockRef<TIn, TOut>& cur, char* lds, Seam<TIn>& S) {
    const int W = cur.W;
    constexpr bool F32 = same_t<TIn, float>::v;
    const int tid = threadIdx.x, wid = __builtin_amdgcn_readfirstlane(tid >> 6), lane = tid & 63, r32 = lane & 31, hi = lane >> 5;
    const int sr = tid >> 4, sc = (tid & 15) * 8, kws = KSWZ(sr, sc * 2); char* K_lds = lds + 2 * SHM_V;
    const int kb0 = swa_jlo(cur.P0, W) * KVBLK;
    if (BIAS == 1 || BIAS == 3) bias_fill((float*)(lds + LDS_TAB), cur.bsrc, tid);
    for (int d0 = 0; d0 < 8; ++d0) S.qr[d0] = load8<TIn>(cur.Q + (unsigned)((wid * QBLK + r32) * cur.pq + d0 * 16 + hi * 8));
    if constexpr (F32) { SLOAD_F((const float*)cur.K, kb0); VMW(); SWRITE_KF(0); SBAR(); SLOAD_F((const float*)cur.V, kb0); }
    else { SLOAD_H(cur.K, cur.V, cur.pk, kb0); VMW(); SWRITE_HK(0); }
    __syncthreads();
}
template <int BIAS, class TIn, class TOut, class ItemFn>
__device__ __forceinline__ void causal_swa_block(const BlockRef<TIn, TOut>& cur, int Lnext, const ItemFn& itemfn, int par, char* lds, Seam<TIn>& S) {
    const int skv = cur.skv, W = cur.W;
    const float* tab = (const float*)(lds + LDS_TAB) + par * TAB_PITCH;
    constexpr bool F32 = same_t<TIn, float>::v;
    const int tid = threadIdx.x, wid = __builtin_amdgcn_readfirstlane(tid >> 6), lane = tid & 63, r32 = lane & 31, hi = lane >> 5;
    const int j_lo = swa_jlo(cur.P0, W);
    int j_hi = (cur.P0 + QB - 1) / KVBLK + 1; if (j_hi > skv / KVBLK) j_hi = skv / KVBLK;
    const int NT = j_hi - j_lo;
    const int qlo = cur.P0 + wid * QBLK, qm = qlo + r32 - 4 * hi;
    char* V_lds = lds; char* K_lds = lds + 2 * SHM_V;
    float* ws = (float*)(lds + 2 * SHM_V + 2 * SHM_K) + wid * 64; float* li_l = ws, * al_l = ws + 32;
    float m_reg = -1e30f, l_reg = 0; f32x16 o[4] = {};
    const int sr = tid >> 4, sc = (tid & 15) * 8, vst0 = v_st(sr, sc), vst1 = v_st(32 + sr, sc), kws = KSWZ(sr, sc * 2);
    const int vb0 = (int)(uintptr_t)V_lds + v_rd_base(lane);
    const TIn* Kh = cur.K; const TIn* Vh = cur.V;
#define RESC(a) do { if (__any((a) < 1.f)) { if (hi == 0) al_l[r32] = (a); asm volatile("s_waitcnt lgkmcnt(0)" ::: "memory");              \
                     for (int d_ = 0; d_ < 4; ++d_) for (int r = 0; r < 16; ++r) o[d_][r] *= al_l[crow(r, hi)]; } } while (0)
#define KBASE(t) ((j_lo + (t)) * KVBLK)
#define ACT(t) (KBASE(t) <= qlo + QBLK - 1 && KBASE(t) + KVBLK - 1 >= qlo - W + 1)
#define MASKT(P0_, P1_, t) do { const int kb_ = KBASE(t); if constexpr (BIAS == 1 || BIAS == 2) { if (!SK || ACT(t)) bias_mask_tile(P0_, P1_, qm - kb_, (unsigned)W, tab, kb_ + KVBLK - 1 > qlo || kb_ <= qlo + QBLK - 1 - W); } \
        else { if ((!SK || ACT(t)) && (kb_ + KVBLK - 1 > qlo || kb_ <= qlo + QBLK - 1 - W)) mask_tile(P0_, P1_, qm - kb_, (unsigned)W); } } while (0)
    constexpr int NQL = F32 ? 16 : 8;
    constexpr bool SK = WSKIP && !F32;
#define SEAM_K0() do { VMWN(NQL); if constexpr (F32) { SWRITE_KF(0); SBAR(); SLOAD_F((const float*)nxt.V, kbn); } else { SWRITE_HK(0); } SBAR(); } while (0)
    f32x16 pA0, pA1, pB0, pB1; float mnA, mnB, alA, alB; bf16x8 pa0, pa1, pa2, pa3;
    if constexpr (F32) { VMW(); SWRITE_VF(0); SBAR(); } else { SWRITE_HV(0); SBAR(); }
    if (NT > 1) { if constexpr (F32) SLOAD_F((const float*)Kh, KBASE(1)); else SLOAD_H(Kh, Vh, cur.pk, KBASE(1)); }
    SBAR(); qkt<0, SK>(pA0, pA1, K_lds, r32, hi, S.qr, ACT(0));
    if constexpr (F32) { if (NT > 1) { VMW(); SWRITE_KF(1); SBAR(); SLOAD_F((const float*)Vh, KBASE(1)); } }
    MASKT(pA0, pA1, 0); partialSM(pA0, pA1, m_reg, mnA, alA);
    if (NT > 1) { VMW(); if constexpr (F32) { SWRITE_VF(1); SBAR(); if (NT > 2) SLOAD_F((const float*)Kh, KBASE(2)); } else SWRITE_H(1); }
    __syncthreads();
#define HALF_STEP(PX0, PX1, mnX, alX, PY0, PY1, alY, t, KB, VB, SB) do {                                                      \
        SBAR(); qkt<KB, SK>(PX0, PX1, K_lds, r32, hi, S.qr, ACT(t));                                             \
        finishSM(PY0, PY1, alY, l_reg, pa0, pa1, pa2, pa3); SBAR();                                                           \
        if ((t) + 1 < NT) { if constexpr (F32) { VMW(); SWRITE_KF(SB); SBAR(); SLOAD_F((const float*)Vh, KBASE((t) + 1)); }  \
                            else { SLOAD_H(Kh, Vh, cur.pk, KBASE((t) + 1)); } SBAR(); }                                               \
        pv_tile<VB, SK>(o, vb0, pa0, pa1, pa2, pa3, ACT((t) - 1)); MASKT(PX0, PX1, (t)); partialSM(PX0, PX1, m_reg, mnX, alX);                                        \
        __syncthreads();                                                                                                      \
        if ((t) + 1 < NT) { VMW(); if constexpr (F32) { SWRITE_VF(SB); SBAR(); if ((t) + 2 < NT) SLOAD_F((const float*)Kh, KBASE((t) + 2)); } \
                            else { SWRITE_H(SB); } }                                                                          \
        RESC(alX); __syncthreads(); } while (0)
    for (int t = 1; t + 1 < NT; t += 2) {
        HALF_STEP(pB0, pB1, mnB, alB, pA0, pA1, alA, t, 1, 0, 0);
        HALF_STEP(pA0, pA1, mnA, alA, pB0, pB1, alB, t + 1, 0, 1, 1);
    }
    asm volatile("" : "+s"(Lnext));
    const BlockRef<TIn, TOut> nxt = itemfn(Lnext); const int kbn = swa_jlo(nxt.P0, nxt.W) * KVBLK;
    const bool even = (NT & 1) == 0;
    if (even) { SBAR(); qkt<1, SK>(pB0, pB1, K_lds, r32, hi, S.qr, ACT(NT - 1)); SBAR(); }
#define QROW(e) (nxt.Q + (size_t)(wid * QBLK + r32) * D + ((e) >> 1) * 16 + hi * 8 + ((e) & 1) * 4)
    if constexpr (F32) { SLOAD_F((const float*)nxt.K, kbn); SBAR();
#pragma unroll
        for (int e = 0; e < 8; ++e) S.tq[e] = *(const f32x4*)QROW(e); }
    else { SLOAD_H(nxt.K, nxt.V, nxt.pk, kbn); SBAR();
#pragma unroll
        for (int d0 = 0; d0 < 8; ++d0) S.qr[d0] = load8<TIn>(nxt.Q + (unsigned)((wid * QBLK + r32) * nxt.pq + d0 * 16 + hi * 8)); }
    SBAR();
    finishSM(pA0, pA1, alA, l_reg, pa0, pa1, pa2, pa3); SBAR();
    if constexpr (F32) {
#pragma unroll
        for (int e = 8; e < 16; ++e) S.tq[e] = *(const f32x4*)QROW(e); SBAR(); }
#undef QROW
    pv_tile<0, SK>(o, vb0, pa0, pa1, pa2, pa3, ACT(even ? NT - 2 : NT - 1));
    if (even) { MASKT(pB0, pB1, NT - 1); partialSM(pB0, pB1, m_reg, mnB, alB); __syncthreads(); RESC(alB);
        finishSM(pB0, pB1, alB, l_reg, pa0, pa1, pa2, pa3); SBAR(); pv_tile<1, SK>(o, vb0, pa0, pa1, pa2, pa3, ACT(NT - 1)); }
    SBAR(); SEAM_K0();
    if (hi == 0) li_l[r32] = l_reg; asm volatile("s_waitcnt lgkmcnt(0)" ::: "memory");
    float rli[16];
#pragma unroll
    for (int r = 0; r < 16; ++r) rli[r] = __builtin_amdgcn_rcpf(li_l[crow(r, hi)]);
    TOut* Ow = cur.O + (unsigned)((wid * QBLK) * cur.po); const int po = cur.po;
    if constexpr (BIAS == 1 || BIAS == 3) { if (hi == 0) { f32x2 ml = {m_reg * (1.4426950408889634f * SCALE), l_reg}; *(f32x2*)(cur.L + (unsigned)((wid * QBLK + r32) * cur.pl)) = ml; }
                          bias_fill((float*)(lds + LDS_TAB) + (par ^ 1) * TAB_PITCH, nxt.bsrc, tid); }
#pragma unroll
    for (int r = 0; r < 16; ++r) { const int orow = crow(r, hi);
#pragma unroll
        for (int d0 = 0; d0 < 4; ++d0) { const float v = o[d0][r] * rli[r];
            if constexpr (same_t<TOut, float>::v) { Ow[(unsigned)(orow * po + d0 * 32 + r32)] = v; }
            else { const float vn = __shfl_xor(v, 1);
                   if ((r32 & 1) == 0) *(unsigned*)(Ow + (unsigned)(orow * po + d0 * 32 + r32)) = cvtpk(v, vn); } } }
    if constexpr (F32) {
#pragma unroll
        for (int d0 = 0; d0 < 8; ++d0) S.qr[d0] = pack8(S.tq[2 * d0], S.tq[2 * d0 + 1]); }
    __syncthreads();
#undef RESC
#undef KBASE
#undef ACT
#undef MASKT
#undef SEAM_K0
#undef HALF_STEP
}
#undef ROW
#undef VMW
#undef VMWN
#undef SLOAD_H
#undef SWRITE_HK
#undef SWRITE_HV
#undef SWRITE_H
#undef SLOAD_F
#undef SWRITE_KF
#undef SWRITE_VF

}
constexpr int NWAVES = 8;
#ifndef MK_N_LAUNCHES
#define MK_N_LAUNCHES 1
#endif
constexpr int NPH = 13;
constexpr int N_LAUNCHES = MK_N_LAUNCHES;
static_assert(N_LAUNCHES == 1 || N_LAUNCHES == NPH, "MK_N_LAUNCHES is 1 or 13");

constexpr int NB = 4, SEQ = 4096, DM = 4096, M = NB * SEQ;
constexpr int MEMLEN = 256, MROWS = NB * MEMLEN;
constexpr int NIN = 12304, NPROJ = 12288;
constexpr int DFF = 11008, NGU = 2 * DFF;
constexpr int XW = 512;
constexpr float RMS_EPS = 1e-6f;

constexpr size_t MiB = 1u << 20;
constexpr size_t WS_CTL = 0, CTL_ZERO_BYTES = 1 * MiB;
constexpr size_t WS_BT = 1 * MiB;
constexpr size_t WS_Q0K0 = 1 * MiB + 64 * 1024;
constexpr size_t WS_WIN = 2 * MiB;
constexpr size_t WS_WLR = 98 * MiB;
constexpr size_t WS_WOUT = 99 * MiB;
constexpr size_t WS_WXQ = 131 * MiB;
constexpr size_t WS_WXKV = 135 * MiB;
constexpr size_t WS_WXO = 143 * MiB;
constexpr size_t WS_MEMN = 147 * MiB;
constexpr size_t WS_XKV = 155 * MiB;
constexpr size_t WS_WGU = 160 * MiB;
constexpr size_t WS_WDN = 332 * MiB;
constexpr size_t WS_DQKV = 160 * MiB;
constexpr size_t WS_GK = 352 * MiB;
constexpr size_t WS_GQ = 384 * MiB;
constexpr size_t WS_XN = 418 * MiB;
constexpr size_t WS_MIX = 546 * MiB;
constexpr size_t WS_GV = 546 * MiB;
constexpr size_t WS_VT = 610 * MiB;
constexpr size_t WS_GR = 674 * MiB;
constexpr size_t WS_KET = 738 * MiB;
constexpr size_t WS_ATT = 770 * MiB;
constexpr size_t WS_DEC = 778 * MiB;
constexpr size_t WS_OC = 780 * MiB;
constexpr size_t WS_LSE = 972 * MiB;
constexpr size_t WS_ACT = 546 * MiB;
constexpr size_t WS_HALO = 890 * MiB;
constexpr size_t WS_XQ = 980 * MiB;
constexpr size_t WS_XO = 996 * MiB;
constexpr size_t WS_GQ2 = 1012 * MiB;
constexpr size_t WS_END = 1044 * MiB;
constexpr size_t HALO_ONE = (size_t)256 * 2 * DFF * 4;
static_assert(WS_HALO + 3 * HALO_ONE <= WS_XQ && WS_ACT + (size_t)M * DFF * 2 <= WS_HALO && WS_WDN + (size_t)DM * DFF * 2 <= WS_XN && WS_WGU + (size_t)NGU * DM * 2 <= WS_WDN, "d_ws map");
static_assert(WS_OC + (size_t)3 * M * 2048 * 2 <= WS_LSE && WS_LSE + (size_t)3 * M * 16 * 2 * 4 <= WS_XQ && WS_GQ + (size_t)M * 1024 * 2 <= WS_XN, "d_ws map 2");
constexpr int CW_QUEUE = 2048;
constexpr int CW_BAR = 4096;
constexpr size_t CTL_SS = 256 * 1024;

constexpr int LDS_BYTES = 147456;
constexpr int MISC_OFF = LDS_BYTES - 256;

#define GAS __attribute__((address_space(1)))
#define LAS __attribute__((address_space(3)))
typedef unsigned short bf16;
typedef unsigned v4u __attribute__((ext_vector_type(4)));
typedef unsigned v2u __attribute__((ext_vector_type(2)));
typedef float f32x4 __attribute__((ext_vector_type(4)));
typedef float f32x2 __attribute__((ext_vector_type(2)));
typedef float f32x16 __attribute__((ext_vector_type(16)));
typedef short bf16x8 __attribute__((ext_vector_type(8)));
typedef short s16x4 __attribute__((ext_vector_type(4)));
typedef short v4i16_t __attribute__((ext_vector_type(4)));
typedef GAS unsigned gu32;
#define RLX_AGENT __ATOMIC_RELAXED, __HIP_MEMORY_SCOPE_AGENT
#define LDS_WAIT() asm volatile("s_waitcnt lgkmcnt(0)" ::: "memory")
#define VM_WAIT() asm volatile("s_waitcnt vmcnt(0)" ::: "memory")
__device__ __forceinline__ unsigned f2bf(float f) { unsigned u = __builtin_bit_cast(unsigned, f); return (u + 0x7fffu + ((u >> 16) & 1u)) >> 16; }
__device__ __forceinline__ unsigned pk2(float lo, float hi) { return f2bf(lo) | (f2bf(hi) << 16); }
__device__ __forceinline__ float bf2f(unsigned short b) { return __builtin_bit_cast(float, (unsigned)b << 16); }
__device__ __forceinline__ float bflo(unsigned w) { return __builtin_bit_cast(float, w << 16); }
__device__ __forceinline__ float bfhi(unsigned w) { return __builtin_bit_cast(float, w & 0xffff0000u); }
typedef __bf16 bf16x2_t __attribute__((ext_vector_type(2)));
__device__ __forceinline__ unsigned cvtpk_s(float lo, float hi) { f32x2 v = {lo, hi}; bf16x2_t b = __builtin_convertvector(v, bf16x2_t); return __builtin_bit_cast(unsigned, b); }
__device__ __forceinline__ bf16x8 pack8f(float a0, float a1, float a2, float a3, float a4, float a5, float a6, float a7) {
    v4u w = {cvtpk_s(a0, a1), cvtpk_s(a2, a3), cvtpk_s(a4, a5), cvtpk_s(a6, a7)}; return __builtin_bit_cast(bf16x8, w); }
#define XB_TMO      128
#define XB_XCNT(j)  (256  + 64 * (j))
#define XB_XSUB(j)  (1280 + 64 * (j))
#define XB_XGEN(j)  (2304 + 64 * (j))
#define XB_TOP      3328
#define XB_TOPGEN   3392
#define XCD_BAR_WORDS 3456
#define XB_SPIN_CAP (1u << 18)

__device__ __forceinline__ unsigned xb_ld(unsigned* p)              { return __hip_atomic_load(p, __ATOMIC_RELAXED, __HIP_MEMORY_SCOPE_AGENT); }
__device__ __forceinline__ unsigned xb_add(unsigned* p, unsigned v) { return __hip_atomic_fetch_add(p, v, __ATOMIC_RELAXED, __HIP_MEMORY_SCOPE_AGENT); }
__device__ __forceinline__ unsigned xb_xcc_id() { return (unsigned)__builtin_amdgcn_s_getreg((3 << 11) | 20) & 0xFu; }
#define XB_SPIN(cond, bar) do { unsigned _sp = 0; while (cond) { __builtin_amdgcn_s_sleep(1); \
    if ((++_sp & 255u) == 0u) { if (xb_ld(&(bar)[XB_TMO])) break; if (_sp > XB_SPIN_CAP) { atomicAdd(&(bar)[XB_TMO], 1u); break; } } } } while (0)

struct XcdBarrier {
    unsigned* bar; unsigned x;
    volatile LAS unsigned* st;
};

__device__ __forceinline__ XcdBarrier xcd_barrier_post(unsigned* bar, volatile LAS unsigned* st) {
    XcdBarrier b; b.bar = bar; b.x = xb_xcc_id(); b.st = st;
    if (threadIdx.x == 0) (void)xb_add(&bar[XB_XCNT(b.x)], 1u);
    return b;
}
__device__ __forceinline__ void xcd_barrier_complete(unsigned* bar, unsigned x, unsigned& nloc, unsigned& nx) {
    const unsigned G = gridDim.x * gridDim.y * gridDim.z;
    unsigned sum, cnt, mine, sp = 0u;
    for (;;) {
        sum = 0u; cnt = 0u; mine = 0u;
#pragma unroll
        for (unsigned j = 0; j < 16; ++j) { const unsigned c = xb_ld(&bar[XB_XCNT(j)]); sum += c; cnt += (c > 0u) ? 1u : 0u; mine = (j == x) ? c : mine; }
        if (sum == G) break;
        __builtin_amdgcn_s_sleep(1);
        if ((++sp & 255u) == 0u) { if (xb_ld(&bar[XB_TMO])) break; if (sp > XB_SPIN_CAP) { atomicAdd(&bar[XB_TMO], 1u); break; } }
    }
    nloc = mine > 0u ? mine : 1u; nx = cnt > 0u ? cnt : 1u;
}

__device__ __forceinline__ void xcd_barrier(const XcdBarrier& b) {
    asm volatile("s_waitcnt vmcnt(0)" ::: "memory");
    __syncthreads();
    if (threadIdx.x == 0) {
        unsigned* bar = b.bar;
        __builtin_amdgcn_s_waitcnt(0);
        unsigned nloc = b.st[0], nx = b.st[1];
        if (nloc == 0u) { xcd_barrier_complete(bar, b.x, nloc, nx); b.st[0] = nloc; b.st[1] = nx; }
        const unsigned old = xb_add(&bar[XB_XSUB(b.x)], 1u);
        const unsigned gen = old / nloc;
        if (old + 1u == (gen + 1u) * nloc) {
            __builtin_amdgcn_fence(__ATOMIC_RELEASE, "agent");
            asm volatile("s_waitcnt vmcnt(0)" ::: "memory");
            const unsigned og = xb_add(&bar[XB_TOP], 1u);
            const unsigned tg = og / nx;
            if (og + 1u == (tg + 1u) * nx) xb_add(&bar[XB_TOPGEN], 1u);
            else XB_SPIN(xb_ld(&bar[XB_TOPGEN]) == tg, bar);
            __builtin_amdgcn_fence(__ATOMIC_ACQUIRE, "agent");
            xb_add(&bar[XB_XGEN(b.x)], 1u);
            asm volatile("s_waitcnt vmcnt(0)" ::: "memory");
        } else {
            XB_SPIN(xb_ld(&bar[XB_XGEN(b.x)]) == gen, bar);
            __builtin_amdgcn_fence(__ATOMIC_ACQUIRE, "agent");
            asm volatile("s_waitcnt vmcnt(0)" ::: "memory");
        }
    }
    __syncthreads();
}
struct Frame {
    LAS unsigned char* lds; char* ldsg;
    volatile LAS unsigned* MISC;
    gu32* ctl;
    int wave, vcu, G;
    unsigned char* ws;
    const float* const __attribute__((address_space(4)))* kin;
    float* out;
};
__device__ __forceinline__ int tid_now() { int t = (int)threadIdx.x; asm volatile("" : "+v"(t)); return t; }
__device__ __forceinline__ float wave_sum(float v) {
#pragma unroll
    for (int o = 1; o < 64; o <<= 1) v += __shfl_xor(v, o);
    return v;
}
__device__ const unsigned char kBucket[3][132] = {
 {0,1,2,3,4,5,6,7,8,9,10,11,12,13,14,15,16,16,16,16,16,16,17,17,17,17,17,17,17,17,18,18,18,18,18,18,18,18,18,18,19,19,19,19,19,19,19,19,19,19,19,19,19,19,20,20,20,20,20,20,20,20,20,20,20,20,20,20,20,20,20,20,20,21,21,21,21,21,21,21,21,21,21,21,21,21,21,21,21,21,21,21,21,21,21,21,21,21,21,22,22,22,22,22,22,22,22,22,22,22,22,22,22,22,22,22,22,22,22,22,22,22,22,22,22,22,22,22,22,0,0,0},
 {0,4,8,12,16,16,17,17,18,18,19,19,19,19,20,20,20,20,20,21,21,21,21,21,21,22,22,22,22,22,22,22,22,22,23,23,23,23,23,23,23,23,23,23,23,23,24,24,24,24,24,24,24,24,24,24,24,24,24,24,24,24,25,25,25,25,25,25,25,25,25,25,25,25,25,25,25,25,25,25,25,25,25,26,26,26,26,26,26,26,26,26,26,26,26,26,26,26,26,26,26,26,26,26,26,26,26,26,26,26,26,26,26,27,27,27,27,27,27,27,27,27,27,27,27,27,27,27,27,0,0,0},
 {0,16,18,19,20,21,21,22,22,23,23,23,24,24,24,24,25,25,25,25,25,26,26,26,26,26,26,26,26,27,27,27,27,27,27,27,27,27,27,28,28,28,28,28,28,28,28,28,28,28,28,28,29,29,29,29,29,29,29,29,29,29,29,29,29,29,29,29,29,29,30,30,30,30,30,30,30,30,30,30,30,30,30,30,30,30,30,30,30,30,30,30,30,30,30,31,31,31,31,31,31,31,31,31,31,31,31,31,31,31,31,31,31,31,31,31,31,31,31,31,31,31,31,31,31,31,31,31,31,0,0,0}};

constexpr int TR_SCR = 17408;
__device__ __forceinline__ void tr_item(const float* W, int ldw, bf16* WT, int ldt, int src_c0, int dst_r0, int nvalid, const float* gain, LAS float* scr, int kb, int lane) {
    const int k0 = 64 * kb, a = lane >> 4, c4 = 4 * (lane & 15);
#pragma unroll 8
    for (int i = 0; i < 16; ++i) { const int kk = 4 * i + a; f32x4 v = *(const GAS f32x4*)(W + (size_t)(k0 + kk) * ldw + src_c0 + c4); if (gain) v = v * gain[k0 + kk];
        LAS float* d = scr + kk * 65 + c4; d[0] = v.x; d[1] = v.y; d[2] = v.z; d[3] = v.w; }
    LDS_WAIT(); asm volatile("" ::: "memory");
    const int c = lane & 7;
#pragma unroll
    for (int j = 0; j < 8; ++j) { const int n = (lane >> 3) + 8 * j; const LAS float* s = scr + (8 * c) * 65 + n;
        v4u o; o.x = pk2(s[0 * 65], s[1 * 65]); o.y = pk2(s[2 * 65], s[3 * 65]); o.z = pk2(s[4 * 65], s[5 * 65]); o.w = pk2(s[6 * 65], s[7 * 65]);
        if (n < nvalid) *(GAS v4u*)(WT + (size_t)(dst_r0 + n) * ldt + k0 + 8 * c) = o; }
    LDS_WAIT(); asm volatile("" ::: "memory");
}
__device__ __forceinline__ void rms_row_to_bf16(const float* xrow, const float* g, bf16* orow, int lane) {
    const GAS f32x4* xr = (const GAS f32x4*)xrow + lane; const GAS f32x4* gr = (const GAS f32x4*)g + lane;
    f32x4 v[16]; float s = 0.f;
#pragma unroll
    for (int j = 0; j < 16; ++j) { v[j] = xr[64 * j]; s += (v[j].x * v[j].x + v[j].y * v[j].y) + (v[j].z * v[j].z + v[j].w * v[j].w); }
    const float r = 1.0f / sqrtf(wave_sum(s) * (1.0f / 4096.0f) + RMS_EPS);
    GAS v2u* o8 = (GAS v2u*)orow + lane;
#pragma unroll
    for (int j = 0; j < 16; ++j) { const f32x4 gg = gr[64 * j]; v2u o; o.x = pk2(v[j].x * r * gg.x, v[j].y * r * gg.y); o.y = pk2(v[j].z * r * gg.z, v[j].w * r * gg.w); o8[64 * j] = o; }
}

__device__ __forceinline__ void p0_first_token(Frame& F) {
    const int tid = tid_now(), lane = tid & 63, w = F.wave;
    LAS float* red = (LAS float*)F.lds;
    const float* x = F.kin[0]; const float* g = F.kin[3]; const float* W = F.kin[4];
    float* Q0K0 = (float*)(F.ws + WS_Q0K0);
    for (int cb = blockIdx.x; cb < 256; cb += F.G) {
        float xv[4][8]; float gg[8]; f32x4 w0[8], w1[8];
#pragma unroll
        for (int i = 0; i < 8; ++i) { gg[i] = g[tid + 512 * i]; const GAS f32x4* wp = (const GAS f32x4*)(W + (size_t)(tid + 512 * i) * NIN + 8 * cb); w0[i] = wp[0]; w1[i] = wp[1];
#pragma unroll
            for (int b = 0; b < 4; ++b) xv[b][i] = x[(size_t)b * SEQ * DM + tid + 512 * i]; }
        float acc[4][8], ss[4];
#pragma unroll
        for (int b = 0; b < 4; ++b) { ss[b] = 0.f;
#pragma unroll
            for (int c = 0; c < 8; ++c) acc[b][c] = 0.f; }
#pragma unroll
        for (int i = 0; i < 8; ++i) { const float wv[8] = {w0[i].x, w0[i].y, w0[i].z, w0[i].w, w1[i].x, w1[i].y, w1[i].z, w1[i].w};
#pragma unroll
            for (int b = 0; b < 4; ++b) { ss[b] += xv[b][i] * xv[b][i]; const float xg = xv[b][i] * gg[i];
#pragma unroll
                for (int c = 0; c < 8; ++c) acc[b][c] += xg * wv[c]; } }
#pragma unroll
        for (int b = 0; b < 4; ++b) { const float s2 = wave_sum(ss[b]); if (lane == 0) red[w * 40 + 32 + b] = s2;
#pragma unroll
            for (int c = 0; c < 8; ++c) { const float s = wave_sum(acc[b][c]); if (lane == 0) red[w * 40 + b * 8 + c] = s; } }
        __syncthreads();
        if (tid < 32) { float s = 0.f, q = 0.f;
#pragma unroll
            for (int k = 0; k < 8; ++k) { s += red[k * 40 + tid]; q += red[k * 40 + 32 + (tid >> 3)]; }
            Q0K0[(tid >> 3) * 2048 + 8 * cb + (tid & 7)] = s * (1.0f / sqrtf(q * (1.0f / 4096.0f) + RMS_EPS)); }
        __syncthreads();
    }
}
__device__ __forceinline__ void p0_prologue(Frame& F) {
    const int tid = tid_now(), lane = tid & 63;
    LAS float* scr = (LAS float*)(F.lds + F.wave * TR_SCR);
    const int gw = F.vcu * NWAVES + F.wave, NGW = F.G * NWAVES;
    bf16* Win = (bf16*)(F.ws + WS_WIN); bf16* Wlr = (bf16*)(F.ws + WS_WLR); bf16* Wout = (bf16*)(F.ws + WS_WOUT); bf16* Wxq = (bf16*)(F.ws + WS_WXQ); bf16* Wxkv = (bf16*)(F.ws + WS_WXKV); bf16* Wxo = (bf16*)(F.ws + WS_WXO);
    constexpr int I_INA = 64 * (4096 / 64), I_INB = 64 * (8192 / 64), I_LR = 64, I_OUT = 64 * 64, I_XQ = 64 * 8, I_XO = 8 * 64;
    constexpr int NIT = I_INA + I_INB + I_LR + I_OUT + 3 * I_XQ + I_XO;
    for (int it = gw; it < NIT; it += NGW) {
        int r = it;
        if (r < I_INA) { const int nb = r % 64, kb = r / 64; tr_item(F.kin[4], NIN, Win, DM, 64 * nb, 64 * nb, 64, nullptr, scr, kb, lane); continue; } r -= I_INA;
        if (r < I_INB) { const int nb = r % 128, kb = r / 128; tr_item(F.kin[4], NIN, Win, DM, 4112 + 64 * nb, 4096 + 64 * nb, 64, nullptr, scr, kb, lane); continue; } r -= I_INB;
        if (r < I_LR) { tr_item(F.kin[4], NIN, Wlr, DM, 4096, 0, 16, nullptr, scr, r, lane); continue; } r -= I_LR;
        if (r < I_OUT) { const int nb = r % 64, kb = r / 64; tr_item(F.kin[8], DM, Wout, DM, 64 * nb, 64 * nb, 64, nullptr, scr, kb, lane); continue; } r -= I_OUT;
        if (r < I_XQ) { const int nb = r % 8, kb = r / 8; tr_item(F.kin[11], XW, Wxq, DM, 64 * nb, 64 * nb, 64, F.kin[9], scr, kb, lane); continue; } r -= I_XQ;
        if (r < I_XQ) { const int nb = r % 8, kb = r / 8; tr_item(F.kin[12], XW, Wxkv, DM, 64 * nb, 64 * nb, 64, nullptr, scr, kb, lane); continue; } r -= I_XQ;
        if (r < I_XQ) { const int nb = r % 8, kb = r / 8; tr_item(F.kin[13], XW, Wxkv, DM, 64 * nb, 512 + 64 * nb, 64, nullptr, scr, kb, lane); continue; } r -= I_XQ;
        { const int nb = r % 64, kb = r / 64; tr_item(F.kin[14], DM, Wxo, XW, 64 * nb, 64 * nb, 64, nullptr, scr, kb, lane); }
    }
    bf16* XN = (bf16*)(F.ws + WS_XN); bf16* MEMN = (bf16*)(F.ws + WS_MEMN);
    for (int m = gw; m < M + MROWS; m += NGW) {
        if (m < M) rms_row_to_bf16(F.kin[0] + (size_t)m * DM, F.kin[3], XN + (size_t)m * DM, lane);
        else rms_row_to_bf16(F.kin[1] + (size_t)(m - M) * DM, F.kin[10], MEMN + (size_t)(m - M) * DM, lane);
    }
    float* BT = (float*)(F.ws + WS_BT);
    for (int i = blockIdx.x * 512 + tid; i < 3 * 16 * 132; i += F.G * 512) { const int rel = i % 132, h = (i / 132) % 16, cfg = i / (132 * 16);
        BT[i] = rel < 129 ? F.kin[2][kBucket[cfg][rel] * 16 + h] * 11.313708498984761f : 0.f; }
}
constexpr int FW_IG = 64 * (DFF / 64), FW_ID = (DFF / 64) * 64, FW_ALL = 2 * FW_IG + FW_ID;
constexpr int FW_P6_LO = 2 * FW_IG - 3584, FW_P6_HI = 2 * FW_IG;
constexpr int FW_P9_LO = FW_ALL - 8192, FW_P9_HI = FW_ALL;
__device__ __forceinline__ void ffn_weight_item(Frame& F, int r, LAS float* scr, int lane) {
    bf16* Wgu = (bf16*)(F.ws + WS_WGU); bf16* Wdn = (bf16*)(F.ws + WS_WDN);
    if (r < FW_IG) { const int nb = r % 172, kb = r / 172, c0 = 64 * nb; tr_item(F.kin[16], DFF, Wgu, DM, c0, 256 * (c0 >> 7) + (c0 & 127), 64, F.kin[15], scr, kb, lane); return; } r -= FW_IG;
    if (r < FW_IG) { const int nb = r % 172, kb = r / 172, c0 = 64 * nb; tr_item(F.kin[17], DFF, Wgu, DM, c0, 256 * (c0 >> 7) + 128 + (c0 & 127), 64, F.kin[15], scr, kb, lane); return; } r -= FW_IG;
    { const int nb = r % 64, kb = r / 64; tr_item(F.kin[20], DM, Wdn, DFF, 64 * nb, 64 * nb, 64, nullptr, scr, kb, lane); }
}
__device__ __forceinline__ void ffn_weights(Frame& F, int lo, int hi, int iw, int nw) {
    const int lane = tid_now() & 63; LAS float* scr = (LAS float*)(F.lds + F.wave * TR_SCR);
    for (int it = lo + iw; it < hi; it += nw) ffn_weight_item(F, it, scr, lane);
}
__device__ __forceinline__ void p4_ffn_weights(Frame& F) {
    const int gw = F.vcu * NWAVES + F.wave, NGW = F.G * NWAVES;
    ffn_weights(F, 0, FW_P6_LO, gw, NGW); ffn_weights(F, FW_P6_HI, FW_P9_LO, gw, NGW);
}
constexpr int PP = 520;
constexpr int PREP_GLR = 0, PREP_QM = 8192, PREP_KM = 8192 + 64 * PP * 2;
static_assert(PREP_KM + 64 * PP * 2 <= MISC_OFF, "prep LDS");
__device__ __forceinline__ void gla_prep_unit(Frame& F, int b, int n) {
    const int tid = tid_now(), lane = tid & 63, w = F.wave;
    const int t0 = b * SEQ + 64 * n;
    const bf16* XN = (const bf16*)(F.ws + WS_XN); const bf16* Wlr = (const bf16*)(F.ws + WS_WLR);
    const bf16* GQ = (const bf16*)(F.ws + WS_GQ); bf16* GQ2 = (bf16*)(F.ws + WS_GQ2); const bf16* GK = (const bf16*)(F.ws + WS_GK);
    bf16* KET = (bf16*)(F.ws + WS_KET); bf16* ATT = (bf16*)(F.ws + WS_ATT); float* DEC = (float*)(F.ws + WS_DEC);
    LAS float* glr = (LAS float*)(F.lds + PREP_GLR);
    LAS bf16* QMs = (LAS bf16*)(F.lds + PREP_QM); LAS bf16* KMs = (LAS bf16*)(F.lds + PREP_KM);
    {
        const int rg = w & 3, kh = w >> 2, rr = lane & 15, kg = lane >> 4;
        const bf16* ap = XN + (size_t)(t0 + 16 * rg + rr) * DM + kh * 2048 + 8 * kg; const bf16* bp = Wlr + (size_t)rr * DM + kh * 2048 + 8 * kg;
        f32x4 acc = {0.f, 0.f, 0.f, 0.f};
#pragma unroll 8
        for (int s = 0; s < 64; ++s) { const bf16x8 a = *(const GAS bf16x8*)(ap + 32 * s), bq = *(const GAS bf16x8*)(bp + 32 * s); acc = __builtin_amdgcn_mfma_f32_16x16x32_bf16(a, bq, acc, 0, 0, 0); }
#pragma unroll
        for (int i = 0; i < 4; ++i) glr[(kh * 64 + 16 * rg + 4 * kg + i) * 16 + rr] = acc[i];
    }
    __syncthreads();
    for (int i = tid; i < 1024; i += 512) glr[i] += glr[1024 + i];
    __syncthreads();
    const int cid = (b * 64 + n) * 4;
    for (int hp = 0; hp < 2; ++hp) {
        {
            const int col = hp * 512 + tid, h = col >> 8, dk = col & 255;
            float w2[16];
#pragma unroll
            for (int j = 0; j < 16; ++j) w2[j] = F.kin[5][j * 1024 + col];
            const float bg = F.kin[6][col];
            float bc[64]; float run = 0.f;
#pragma unroll
            for (int c = 0; c < 64; ++c) {
                const LAS f32x4* gp = (const LAS f32x4*)(glr + c * 16); const f32x4 g0 = gp[0], g1 = gp[1], g2 = gp[2], g3 = gp[3];
                float z = bg;
                z += g0.x * w2[0] + g0.y * w2[1] + g0.z * w2[2] + g0.w * w2[3]; z += g1.x * w2[4] + g1.y * w2[5] + g1.z * w2[6] + g1.w * w2[7];
                z += g2.x * w2[8] + g2.y * w2[9] + g2.z * w2[10] + g2.w * w2[11]; z += g3.x * w2[12] + g3.y * w2[13] + g3.z * w2[14] + g3.w * w2[15];
                const float ls = fminf(z, 0.f) - __logf(1.0f + __expf(-fabsf(z)));
                run += ls * (1.0f / 16.0f); bc[c] = run;
            }
            const float blast = bc[63], bmid = bc[32];
            unsigned kep[32];
            const bf16* qp = GQ + (size_t)t0 * 1024 + col; bf16* qo = GQ2 + (size_t)t0 * 1024 + col; const bf16* kp = GK + (size_t)t0 * 1024 + col;
#pragma unroll
            for (int c2 = 0; c2 < 32; ++c2) {
                const int c = 2 * c2;
                const float qa = bf2f(qp[(size_t)c * 1024]) * (1.0f / 16.0f), ka = bf2f(kp[(size_t)c * 1024]);
                const float qb = bf2f(qp[(size_t)(c + 1) * 1024]) * (1.0f / 16.0f), kb = bf2f(kp[(size_t)(c + 1) * 1024]);
                const unsigned qt = cvtpk_s(qa * __expf(bc[c]), qb * __expf(bc[c + 1]));
                qo[(size_t)c * 1024] = (bf16)(qt & 0xffffu); qo[(size_t)(c + 1) * 1024] = (bf16)(qt >> 16);
                kep[c2] = cvtpk_s(ka * __expf(blast - bc[c]), kb * __expf(blast - bc[c + 1]));
                const unsigned qm = cvtpk_s(qa * __expf(bc[c] - bmid), qb * __expf(bc[c + 1] - bmid));
                const unsigned km = cvtpk_s(ka * __expf(bmid - bc[c]), kb * __expf(bmid - bc[c + 1]));
                QMs[c * PP + tid] = (bf16)(qm & 0xffffu); QMs[(c + 1) * PP + tid] = (bf16)(qm >> 16);
                KMs[c * PP + tid] = (bf16)(km & 0xffffu); KMs[(c + 1) * PP + tid] = (bf16)(km >> 16);
            }
            bf16* kt = KET + ((size_t)(cid + h) * 256 + dk) * 64;
#pragma unroll
            for (int i = 0; i < 8; ++i) { v4u o = {kep[4 * i], kep[4 * i + 1], kep[4 * i + 2], kep[4 * i + 3]}; *(GAS v4u*)(kt + 8 * i) = o; }
            DEC[(size_t)(cid + h) * 256 + dk] = __expf(blast);
        }
        __syncthreads();
        {
            const int rr = lane & 15, kg = lane >> 4;
#pragma unroll
            for (int q4 = 0; q4 < 4; ++q4) {
                const int id = w * 4 + q4, hl = id >> 4, mt = (id >> 2) & 3, nt = id & 3;
                const LAS bf16* ap = KMs + (16 * mt + rr) * PP + hl * 256 + 8 * kg; const LAS bf16* bp = QMs + (16 * nt + rr) * PP + hl * 256 + 8 * kg;
                f32x4 acc = {0.f, 0.f, 0.f, 0.f};
#pragma unroll
                for (int s = 0; s < 8; ++s) { const bf16x8 a = *(const LAS bf16x8*)(ap + 32 * s), bq = *(const LAS bf16x8*)(bp + 32 * s); acc = __builtin_amdgcn_mfma_f32_16x16x32_bf16(a, bq, acc, 0, 0, 0); }
                const int c = 16 * nt + rr, cp0 = 16 * mt + 4 * kg;
                v2u o; o.x = pk2(cp0 <= c ? acc[0] : 0.f, cp0 + 1 <= c ? acc[1] : 0.f); o.y = pk2(cp0 + 2 <= c ? acc[2] : 0.f, cp0 + 3 <= c ? acc[3] : 0.f);
                *(GAS v2u*)(ATT + ((size_t)(cid + 2 * hp + hl) * 64 + c) * 64 + cp0) = o;
            }
        }
        __syncthreads();
    }
    if (n == 0 && w < 4) {
        const float* q0 = (const float*)(F.ws + WS_Q0K0) + b * 2048 + w * 256; const float* k0 = q0 + 1024; float s = 0.f;
#pragma unroll
        for (int i = 0; i < 4; ++i) s += q0[lane + 64 * i] * k0[lane + 64 * i];
        s = wave_sum(s) * (1.0f / 16.0f);
        if (lane == 0) ATT[(size_t)(cid + w) * 4096] = (bf16)f2bf(s);
    }
}

constexpr int CH_QT = 0, CH_QP = 528, CH_KE = 64 * CH_QP, CH_KP = 144, CH_AT = CH_KE + 256 * CH_KP, CH_DC = CH_AT + 64 * CH_KP, CH_VS = CH_DC + 1024, CH_END = CH_VS + 16384;
static_assert(CH_END <= MISC_OFF, "chain LDS");
__device__ __forceinline__ void gla_chain_unit(Frame& F, int b, int h, int qd) {
    const int tid = tid_now(), lane = tid & 63, w = F.wave, r32 = lane & 31, hi = lane >> 5;
    const bool helper = w >= 4; const int htid = tid - 256;
    const bf16* GQ = (const bf16*)(F.ws + WS_GQ2); const bf16* KET = (const bf16*)(F.ws + WS_KET); const bf16* ATT = (const bf16*)(F.ws + WS_ATT);
    const float* DEC = (const float*)(F.ws + WS_DEC); const bf16* GV = (const bf16*)(F.ws + WS_GV); bf16* ORAW = (bf16*)(F.ws + WS_XN);
    LAS unsigned char* L = F.lds;
    if (helper) {
        v4u st[23];
#define CH_LOADS(nn) do { const int ch_ = (b * 64 + (nn)) * 4 + h; const int t0_ = b * SEQ + 64 * (nn); \
            _Pragma("unroll") for (int i = 0; i < 8; ++i) { const int id = htid + 256 * i; st[i] = *(const GAS v4u*)(GQ + (size_t)(t0_ + (id >> 5)) * 1024 + h * 256 + 8 * (id & 31)); } \
            _Pragma("unroll") for (int i = 0; i < 8; ++i) { const int id = htid + 256 * i; st[8 + i] = *(const GAS v4u*)(KET + ((size_t)ch_ * 256 + (id >> 3)) * 64 + 8 * (id & 7)); } \
            _Pragma("unroll") for (int i = 0; i < 2; ++i) { const int id = htid + 256 * i; st[16 + i] = *(const GAS v4u*)(ATT + ((size_t)ch_ * 64 + (id >> 3)) * 64 + 8 * (id & 7)); } \
            _Pragma("unroll") for (int i = 0; i < 4; ++i) { const int id = htid + 256 * i; st[19 + i] = *(const GAS v4u*)(GV + (size_t)(t0_ + (id >> 4)) * 2048 + h * 512 + qd * 128 + 8 * (id & 15)); } \
            st[18] = *(const GAS v4u*)(DEC + (size_t)ch_ * 256 + 4 * (htid & 63)); } while (0)
        CH_LOADS(0);
        for (int n = 0; n < 64; ++n) {
#pragma unroll
            for (int i = 0; i < 8; ++i) { const int id = htid + 256 * i; *(LAS v4u*)(L + CH_QT + (id >> 5) * CH_QP + 16 * (id & 31)) = st[i]; }
#pragma unroll
            for (int i = 0; i < 8; ++i) { const int id = htid + 256 * i; *(LAS v4u*)(L + CH_KE + (id >> 3) * CH_KP + 16 * (id & 7)) = st[8 + i]; }
#pragma unroll
            for (int i = 0; i < 2; ++i) { const int id = htid + 256 * i; *(LAS v4u*)(L + CH_AT + (id >> 3) * CH_KP + 16 * (id & 7)) = st[16 + i]; }
#pragma unroll
            for (int i = 0; i < 4; ++i) { const int id = htid + 256 * i; *(LAS v4u*)(L + CH_VS + att::v_st(id >> 4, 8 * (id & 15))) = st[19 + i]; }
            if (htid < 64) *(LAS v4u*)(L + CH_DC + 16 * htid) = st[18];
            __syncthreads();
            if (n + 1 < 64) CH_LOADS(n + 1);
            __syncthreads();
        }
#undef CH_LOADS
    } else {
        f32x16 S[8];
#pragma unroll
        for (int i = 0; i < 8; ++i)
#pragma unroll
            for (int r = 0; r < 16; ++r) S[i][r] = 0.f;
        for (int n = 0; n < 64; ++n) {
            __syncthreads();
            const int t0 = b * SEQ + 64 * n;
            bf16x8 vc[4];
#pragma unroll
            for (int s = 0; s < 4; ++s) { const LAS unsigned char* vp = L + CH_VS + att::v_rd_base(lane) + w * 512 + s * 4096;
                const s16x4 lo = __builtin_bit_cast(s16x4, __builtin_amdgcn_ds_read_tr16_b64_v4i16((LAS v4i16_t*)vp)), hh = __builtin_bit_cast(s16x4, __builtin_amdgcn_ds_read_tr16_b64_v4i16((LAS v4i16_t*)(vp + 2048)));
                vc[s] = (bf16x8){lo[0], lo[1], lo[2], lo[3], hh[0], hh[1], hh[2], hh[3]}; }
            f32x16 O[2];
#pragma unroll
            for (int r = 0; r < 16; ++r) { O[0][r] = 0.f; O[1][r] = 0.f; }
#pragma unroll
            for (int mt = 0; mt < 8; ++mt)
#pragma unroll
                for (int sp = 0; sp < 2; ++sp) {
                    const bf16x8 bs = pack8f(S[mt][8 * sp], S[mt][8 * sp + 1], S[mt][8 * sp + 2], S[mt][8 * sp + 3], S[mt][8 * sp + 4], S[mt][8 * sp + 5], S[mt][8 * sp + 6], S[mt][8 * sp + 7]);
#pragma unroll
                    for (int mc = 0; mc < 2; ++mc) {
                        const LAS unsigned char* ap = L + CH_QT + (32 * mc + r32) * CH_QP + (32 * mt + 16 * sp + 4 * hi) * 2;
                        const s16x4 lo = *(const LAS s16x4*)ap, hh = *(const LAS s16x4*)(ap + 16);
                        const bf16x8 a = {lo[0], lo[1], lo[2], lo[3], hh[0], hh[1], hh[2], hh[3]};
                        O[mc] = __builtin_amdgcn_mfma_f32_32x32x16_bf16(a, bs, O[mc], 0, 0, 0);
                    }
                }
#pragma unroll
            for (int s = 0; s < 4; ++s)
#pragma unroll
                for (int mc = 0; mc < 2; ++mc) { const bf16x8 a = *(const LAS bf16x8*)(L + CH_AT + (32 * mc + r32) * CH_KP + (16 * s + 8 * hi) * 2); O[mc] = __builtin_amdgcn_mfma_f32_32x32x16_bf16(a, vc[s], O[mc], 0, 0, 0); }
            bf16* rowbase = ORAW + (size_t)t0 * 2048 + h * 512 + qd * 128 + 32 * w;
            const unsigned loff = (unsigned)(r32 + hi * 4 * 2048);
#pragma unroll
            for (int mc = 0; mc < 2; ++mc)
#pragma unroll
                for (int r = 0; r < 16; ++r) { const float v = O[mc][r], vn = __shfl_xor(v, 1);
                    if ((r32 & 1) == 0) *(unsigned*)(rowbase + (32 * mc + (r & 3) + 8 * (r >> 2)) * 2048 + loff) = cvtpk_s(v, vn); }
#pragma unroll
            for (int mt = 0; mt < 8; ++mt) {
#pragma unroll
                for (int j = 0; j < 4; ++j) { const f32x4 d4 = *(const LAS f32x4*)(L + CH_DC + (32 * mt + 8 * j + 4 * hi) * 4);
                    S[mt][4 * j] *= d4.x; S[mt][4 * j + 1] *= d4.y; S[mt][4 * j + 2] *= d4.z; S[mt][4 * j + 3] *= d4.w; }
#pragma unroll
                for (int s = 0; s < 4; ++s) { const bf16x8 a = *(const LAS bf16x8*)(L + CH_KE + (32 * mt + r32) * CH_KP + (16 * s + 8 * hi) * 2); S[mt] = __builtin_amdgcn_mfma_f32_32x32x16_bf16(a, vc[s], S[mt], 0, 0, 0); }
            }
            __syncthreads();
        }
    }
}

__device__ __forceinline__ void mix_row(Frame& F, int t, int lane) {
    const bf16* ORAW = (const bf16*)(F.ws + WS_XN); const bf16* GR = (const bf16*)(F.ws + WS_GR); const bf16* OC = (const bf16*)(F.ws + WS_OC); const float* LSE = (const float*)(F.ws + WS_LSE);
    bf16* MIX = (bf16*)(F.ws + WS_MIX);
#pragma unroll
    for (int h = 0; h < 4; ++h) {
        const v4u ow = *(const GAS v4u*)(ORAW + (size_t)t * 2048 + h * 512 + 8 * lane); const f32x4 o0 = {bflo(ow.x), bfhi(ow.x), bflo(ow.y), bfhi(ow.y)}, o1 = {bflo(ow.z), bfhi(ow.z), bflo(ow.w), bfhi(ow.w)};
        const float ss = wave_sum((o0.x * o0.x + o0.y * o0.y) + (o0.z * o0.z + o0.w * o0.w) + (o1.x * o1.x + o1.y * o1.y) + (o1.z * o1.z + o1.w * o1.w));
        const float r = 1.0f / sqrtf(ss * (1.0f / 512.0f) + RMS_EPS);
        const GAS f32x4* gp = (const GAS f32x4*)F.kin[7] + 2 * lane; const f32x4 g0 = gp[0], g1 = gp[1];
        const v4u gw = *(const GAS v4u*)(GR + (size_t)t * 2048 + h * 512 + 8 * lane);
        float y[8] = {o0.x * r * g0.x, o0.y * r * g0.y, o0.z * r * g0.z, o0.w * r * g0.w, o1.x * r * g1.x, o1.y * r * g1.y, o1.z * r * g1.z, o1.w * r * g1.w};
        const float gv[8] = {bflo(gw.x), bfhi(gw.x), bflo(gw.y), bfhi(gw.y), bflo(gw.z), bfhi(gw.z), bflo(gw.w), bfhi(gw.w)};
#pragma unroll
        for (int e = 0; e < 8; ++e) y[e] *= gv[e] / (1.0f + __expf(-gv[e]));
        v4u o = {pk2(y[0], y[1]), pk2(y[2], y[3]), pk2(y[4], y[5]), pk2(y[6], y[7])};
        *(GAS v4u*)(MIX + (size_t)t * DM + h * 512 + 8 * lane) = o;
    }
    {
        const int hd = lane >> 2;
        float m2[3], l[3];
#pragma unroll
        for (int c = 0; c < 3; ++c) { const f32x2 v = *(const GAS f32x2*)(LSE + (((size_t)c * M + t) * 16 + hd) * 2); m2[c] = v.x; l[c] = v.y; }
        const float mx = fmaxf(m2[0], fmaxf(m2[1], m2[2]));
        float wgt[3]; float den = 0.f;
#pragma unroll
        for (int c = 0; c < 3; ++c) { wgt[c] = __builtin_amdgcn_exp2f(m2[c] - mx) * l[c]; den += wgt[c]; }
        const float rden = 1.0f / den;
        float acc[32];
#pragma unroll
        for (int e = 0; e < 32; ++e) acc[e] = 0.f;
#pragma unroll
        for (int c = 0; c < 3; ++c) { const float wc = wgt[c] * rden; const GAS v4u* p = (const GAS v4u*)(OC + (size_t)c * M * 2048 + ((size_t)((t >> 12) * 16 + hd) * SEQ + (t & 4095)) * 128 + 32 * (lane & 3));
#pragma unroll
            for (int q = 0; q < 4; ++q) { const v4u v = p[q];
                acc[8 * q + 0] += wc * bflo(v.x); acc[8 * q + 1] += wc * bfhi(v.x); acc[8 * q + 2] += wc * bflo(v.y); acc[8 * q + 3] += wc * bfhi(v.y);
                acc[8 * q + 4] += wc * bflo(v.z); acc[8 * q + 5] += wc * bfhi(v.z); acc[8 * q + 6] += wc * bflo(v.w); acc[8 * q + 7] += wc * bfhi(v.w); } }
        GAS v4u* op = (GAS v4u*)(MIX + (size_t)t * DM + 2048 + 32 * lane);
#pragma unroll
        for (int q = 0; q < 4; ++q) { v4u o = {pk2(acc[8 * q], acc[8 * q + 1]), pk2(acc[8 * q + 2], acc[8 * q + 3]), pk2(acc[8 * q + 4], acc[8 * q + 5]), pk2(acc[8 * q + 6], acc[8 * q + 7])}; op[q] = o; }
    }
}
__device__ __forceinline__ void halo_fix(Frame& F) {
    const int tid = tid_now();
    const float* GF = (const float*)(F.ws + WS_HALO); const float* UF = GF + HALO_ONE / 4; const float* GL = UF + HALO_ONE / 4;
    bf16* ACT = (bf16*)(F.ws + WS_ACT); const float* cw = F.kin[18]; const float* cb = F.kin[19];
    const int total = 256 * 2 * (DFF / 4);
    for (int i = blockIdx.x * 512 + tid; i < total; i += F.G * 512) {
        const int c4 = i % (DFF / 4), j = (i / (DFF / 4)) & 1, blk = i / (DFF / 2), ch = 4 * c4;
        const bool first = (blk & 63) == 0;
        const f32x4 g0 = *(const GAS f32x4*)(GF + ((size_t)blk * 2 + j) * DFF + ch), uu = *(const GAS f32x4*)(UF + ((size_t)blk * 2 + j) * DFF + ch);
        const f32x4 z = {0.f, 0.f, 0.f, 0.f};
        f32x4 g1, g2;
        if (j == 0) { g1 = first ? z : *(const GAS f32x4*)(GL + ((size_t)(blk - 1) * 2 + 1) * DFF + ch); g2 = first ? z : *(const GAS f32x4*)(GL + ((size_t)(blk - 1) * 2 + 0) * DFF + ch); }
        else { g1 = *(const GAS f32x4*)(GF + ((size_t)blk * 2 + 0) * DFF + ch); g2 = first ? z : *(const GAS f32x4*)(GL + ((size_t)(blk - 1) * 2 + 1) * DFF + ch); }
        const f32x4 w0 = *(const GAS f32x4*)(cw + ch), w1 = *(const GAS f32x4*)(cw + DFF + ch), w2 = *(const GAS f32x4*)(cw + 2 * DFF + ch), bb = *(const GAS f32x4*)(cb + ch);
        float a[4];
#pragma unroll
        for (int e = 0; e < 4; ++e) { const float y = bb[e] + w0[e] * g2[e] + w1[e] * g1[e] + w2[e] * g0[e]; a[e] = y / (1.0f + __expf(-y)) * uu[e]; }
        v2u o = {pk2(a[0], a[1]), pk2(a[2], a[3])};
        *(GAS v2u*)(ACT + (size_t)(64 * blk + j) * DFF + ch) = o;
    }
}
__device__ __forceinline__ void final_norm_row(Frame& F, int t, int lane) {
    const unsigned long long* ss = (const unsigned long long*)(F.ws + WS_CTL + CTL_SS) + 2 * (size_t)M;
    const float r = 1.0f / sqrtf((float)ss[t] * ((1.0f / 4096.0f) / 1048576.0f) + RMS_EPS);
    const GAS v4u* hr = (const GAS v4u*)((const bf16*)(F.ws + WS_XN) + (size_t)t * DM) + lane; GAS f32x4* xr = (GAS f32x4*)(F.out + (size_t)t * DM) + 2 * lane; const GAS f32x4* gr = (const GAS f32x4*)F.kin[21] + 2 * lane;
#pragma unroll
    for (int j = 0; j < 8; ++j) { const v4u w = hr[64 * j]; const f32x4 g0 = gr[128 * j], g1 = gr[128 * j + 1];
        xr[128 * j] = (f32x4){bflo(w.x) * r * g0.x, bfhi(w.x) * r * g0.y, bflo(w.y) * r * g0.z, bfhi(w.y) * r * g0.w};
        xr[128 * j + 1] = (f32x4){bflo(w.z) * r * g1.x, bfhi(w.z) * r * g1.y, bflo(w.w) * r * g1.z, bfhi(w.w) * r * g1.w}; }
}
typedef att::BlockRef<att::bf16, att::bf16> ABlk;
__device__ __forceinline__ ABlk dil_item(unsigned char* ws, int L) {
    const int bh = L / 48, rem = L - 48 * bh, cfg = rem >> 4, x = rem & 15, h = bh & 15, b = bh >> 4;
    const int d = cfg == 0 ? 1 : (cfg == 1 ? 4 : 16);
    const int r = cfg == 0 ? 0 : (cfg == 1 ? (x >> 2) : x), qb = cfg == 0 ? x : (cfg == 1 ? (x & 3) : 0);
    const att::bf16* DQ = (const att::bf16*)(ws + WS_DQKV); const att::bf16* DK = DQ + (size_t)M * 2048; const att::bf16* DV = DK + (size_t)M * 2048;
    const int sq = r + d * 256 * qb, tq = b * SEQ + sq; const size_t hb = (size_t)(b * 16 + h) * SEQ;
    ABlk R;
    R.Q = DQ + (hb + sq) * 128; R.K = DK + (hb + r) * 128; R.V = DV + (hb + r) * 128;
    R.O = (att::bf16*)(ws + WS_OC) + ((size_t)cfg * M * 2048) + (hb + sq) * 128;
    R.L = (float*)(ws + WS_LSE) + (((size_t)cfg * M + tq) * 16 + h) * 2;
    R.bsrc = (const float*)(ws + WS_BT) + (cfg * 16 + h) * 132;
    R.P0 = 256 * qb; R.pq = 128 * d; R.pk = 128 * d; R.po = 128 * d; R.pl = 32 * d; R.skv = SEQ / d; R.W = 129;
    return R;
}
__device__ __forceinline__ ABlk xat_item(unsigned char* ws, int L) {
    const int qb = L & 15, h = (L >> 4) & 3, b = L >> 6;
    const att::bf16* XQ = (const att::bf16*)(ws + WS_XQ); const att::bf16* XKV = (const att::bf16*)(ws + WS_XKV);
    ABlk R;
    R.Q = XQ + (size_t)(b * SEQ + 256 * qb) * XW + h * 128; R.K = XKV + (size_t)(b * MEMLEN) * 1024 + h * 128; R.V = R.K + 512;
    R.O = (att::bf16*)(ws + WS_XO) + (size_t)(b * SEQ + 256 * qb) * XW + h * 128; R.L = nullptr; R.bsrc = nullptr;
    R.P0 = 1 << 20; R.pq = XW; R.pk = 1024; R.po = XW; R.pl = 0; R.skv = MEMLEN; R.W = 1 << 30;
    return R;
}

#ifndef PG_ALIGN
#define PG_ALIGN true
#endif
#ifndef PG_SP2
#define PG_SP2 true
#endif
struct Args { const float* in[22]; float* out; unsigned char* ws; int ph_lo, ph_hi; };
__global__ void __launch_bounds__(NWAVES * 64, 2) hybrid_fwd(Args args) {
    extern __shared__ __attribute__((aligned(16))) unsigned char lds[];
    Frame F;
    F.lds = (LAS unsigned char*)lds; F.ldsg = (char*)lds;
    F.MISC = (volatile LAS unsigned*)(F.lds + MISC_OFF);
    F.wave = __builtin_amdgcn_readfirstlane((int)threadIdx.x >> 6);
    F.G = gridDim.x; { const int bx = blockIdx.x; F.vcu = (F.G % 8 == 0) ? (bx % 8) * (F.G / 8) + bx / 8 : bx; }
    F.ws = args.ws; F.ctl = (gu32*)(args.ws + WS_CTL); F.out = args.out;
    F.kin = (const float* const __attribute__((address_space(4)))*)__builtin_amdgcn_kernarg_segment_ptr();
    if (threadIdx.x < 64) F.MISC[threadIdx.x] = 0u;
    __syncthreads();
    XcdBarrier bar; bar.bar = (unsigned*)(F.ctl + CW_BAR); bar.x = 0; bar.st = nullptr;
    if (N_LAUNCHES == 1) bar = xcd_barrier_post((unsigned*)(F.ctl + CW_BAR), F.MISC + 8);
#define GRID_BAR() do { if (N_LAUNCHES == 1) xcd_barrier(bar); } while (0)
    const int lo = args.ph_lo, hi = args.ph_hi;
#ifndef PH_MASK
#define PH_MASK 0x1fff
#endif
#define IN(k) ((((PH_MASK) >> (k)) & 1) && lo <= (k) && (k) < hi)
#define BOTH(k) (IN(k) && IN((k) + 1))
#ifndef DUPMASK
#define DUPMASK 0
#endif
#ifndef XBAR
#define XBAR 0
#endif
#define DUPK(k, ...) { __VA_ARGS__ } if constexpr ((((DUPMASK) >> (k)) & 1) != 0) { __syncthreads(); { __VA_ARGS__ } }
#define GRID_BARX() do { GRID_BAR(); if constexpr (XBAR != 0) GRID_BAR(); } while (0)
    unsigned long long* SS1 = (unsigned long long*)(F.ws + WS_CTL + CTL_SS); unsigned long long* SS2 = SS1 + M; unsigned long long* SS3 = SS2 + M;
    const int gw = F.vcu * NWAVES + F.wave, NGW = F.G * NWAVES;

    if (IN(0)) { DUPK(0, p0_first_token(F); p0_prologue(F);)
#ifdef DUP_P0FT
        __syncthreads(); p0_first_token(F); __syncthreads(); p0_first_token(F); __syncthreads(); p0_first_token(F); __syncthreads(); p0_first_token(F);
#endif
        if (BOTH(0)) GRID_BARX(); }
    if (IN(1)) {
        { pg8::Gemm g{(const bf16*)(F.ws + WS_XN), (const bf16*)(F.ws + WS_WIN), M, NPROJ, DM}; pg8::StaticOrder S; S.init(M, NPROJ, F.G, (int)blockIdx.x);
          pg8::EpiProj E{(bf16*)(F.ws + WS_GQ), (bf16*)(F.ws + WS_GK), (bf16*)(F.ws + WS_GV), (bf16*)(F.ws + WS_GR), (bf16*)(F.ws + WS_DQKV)};
          pg8::gemm_phase<pg8::EpiProj, pg8::StaticOrder, PG_ALIGN, PG_SP2>(F.lds, g, S, E);
#ifdef DUP_P1NULL
          { pg8::EpiNull E0{}; pg8::Gemm g2{(const bf16*)(F.ws + WS_XN), (const bf16*)(F.ws + WS_WIN), M, 3072, DM}; pg8::StaticOrder S2; S2.init(M, 3072, F.G, (int)blockIdx.x); pg8::gemm_phase<pg8::EpiNull, pg8::StaticOrder, PG_ALIGN, PG_SP2>(F.lds, g2, S2, E0); pg8::gemm_phase<pg8::EpiNull, pg8::StaticOrder, PG_ALIGN, PG_SP2>(F.lds, g2, S2, E0); pg8::gemm_phase<pg8::EpiNull, pg8::StaticOrder, PG_ALIGN, PG_SP2>(F.lds, g2, S2, E0); pg8::gemm_phase<pg8::EpiNull, pg8::StaticOrder, PG_ALIGN, PG_SP2>(F.lds, g2, S2, E0); }
#endif
          }
        if (BOTH(1)) GRID_BARX();
    }
    if (IN(2)) { DUPK(2, for (int u = blockIdx.x; u < NB * 64; u += F.G) gla_prep_unit(F, u >> 6, u & 63);) if (BOTH(2)) GRID_BARX(); }
    if (IN(3)) {
#ifdef PRE_ATT_VARIANT
        {
            gu32* qctr = F.ctl + CW_QUEUE + 64;
#define NEXT_ITEM(dst) do { if (tid_now() == 0) F.MISC[16] = __hip_atomic_fetch_add(qctr, 1u, RLX_AGENT); __syncthreads(); dst = __builtin_amdgcn_readfirstlane((int)F.MISC[16]); __syncthreads(); } while (0)
            int L; NEXT_ITEM(L);
            if (L < 3072) {
                ABlk cur = dil_item(F.ws, L); att::Seam<att::bf16> S; int par = 0;
                att::causal_swa_prime<PRE_ATT_VARIANT, att::bf16, att::bf16>(cur, F.ldsg, S);
                unsigned char* const wsp = F.ws; auto itf = [wsp](int l) { return dil_item(wsp, l); };
                for (;;) { int Ln; NEXT_ITEM(Ln); const bool last = Ln >= 3072; const int Lx = last ? L : Ln;
                    att::causal_swa_block<PRE_ATT_VARIANT, att::bf16, att::bf16>(cur, Lx, itf, par, F.ldsg, S);
                    if (last) break; L = Ln; cur = dil_item(F.ws, L); par ^= 1; }
            }
#undef NEXT_ITEM
            __syncthreads();
        }
#endif
        if ((int)blockIdx.x < 64) gla_chain_unit(F, blockIdx.x >> 4, (blockIdx.x >> 2) & 3, blockIdx.x & 3);
        {
            gu32* qctr = F.ctl + CW_QUEUE;
#define NEXT_ITEM(dst) do { if (tid_now() == 0) F.MISC[16] = __hip_atomic_fetch_add(qctr, 1u, RLX_AGENT); __syncthreads(); dst = __builtin_amdgcn_readfirstlane((int)F.MISC[16]); __syncthreads(); } while (0)
            int L; NEXT_ITEM(L);
            if (L < 3072) {
                ABlk cur = dil_item(F.ws, L); att::Seam<att::bf16> S; int par = 0;
                att::causal_swa_prime<1, att::bf16, att::bf16>(cur, F.ldsg, S);
                unsigned char* const wsp = F.ws; auto itf = [wsp](int l) { return dil_item(wsp, l); };
                for (;;) { int Ln; NEXT_ITEM(Ln); const bool last = Ln >= 3072; const int Lx = last ? L : Ln;
                    att::causal_swa_block<1, att::bf16, att::bf16>(cur, Lx, itf, par, F.ldsg, S);
                    if (last) break; L = Ln; cur = dil_item(F.ws, L); par ^= 1; }
            }
#undef NEXT_ITEM
        }
#ifdef DUP_CHAIN
        __syncthreads(); if ((int)blockIdx.x < 64) gla_chain_unit(F, blockIdx.x >> 4, (blockIdx.x >> 2) & 3, blockIdx.x & 3);
#endif
        if (BOTH(3)) GRID_BARX();
    }
    if (IN(4)) { DUPK(4, { const int lane = tid_now() & 63; for (int t = gw; t < M; t += NGW) mix_row(F, t, lane); } p4_ffn_weights(F);) if (BOTH(4)) GRID_BARX(); }
    if (IN(5)) {
        pg8::Gemm g{(const bf16*)(F.ws + WS_MIX), (const bf16*)(F.ws + WS_WOUT), M, DM, DM}; pg8::StaticOrder S; S.init(M, DM, F.G, (int)blockIdx.x);
        pg8::EpiResid E{F.kin[0], nullptr, (bf16*)(F.ws + WS_XN), SS1, DM};
        pg8::gemm_phase<pg8::EpiResid, pg8::StaticOrder, PG_ALIGN, PG_SP2>(F.lds, g, S, E);
#ifdef DUP_P5
        { pg8::EpiResid E2{F.kin[0], nullptr, (bf16*)(F.ws + WS_XN), nullptr, DM}; pg8::gemm_phase<pg8::EpiResid, pg8::StaticOrder, PG_ALIGN, PG_SP2>(F.lds, g, S, E2); }
#endif
        if (BOTH(5)) GRID_BARX();
    }
    if (IN(6)) {
        DUPK(6,
        if ((int)blockIdx.x < 128 || F.G < 144) {
        pg8::Gemm g{(const bf16*)(F.ws + WS_XN), (const bf16*)(F.ws + WS_WXQ), M, XW, DM}; pg8::StaticOrder S; S.init(M, XW, F.G < 144 ? F.G : 128, (int)blockIdx.x);
        pg8::EpiScaleBf16 E{(bf16*)(F.ws + WS_XQ), XW, SS1, 1.0f / 4096.0f};
        pg8::gemm_phase<pg8::EpiScaleBf16, pg8::StaticOrder, PG_ALIGN, PG_SP2>(F.lds, g, S, E);
        }
        if ((int)blockIdx.x >= 128 || F.G < 144) {
        pg8::Gemm g{(const bf16*)(F.ws + WS_MEMN), (const bf16*)(F.ws + WS_WXKV), MROWS, 1024, DM}; pg8::StaticOrder S; S.init(MROWS, 1024, F.G < 144 ? F.G : F.G - 128, F.G < 144 ? (int)blockIdx.x : (int)blockIdx.x - 128);
        pg8::EpiScaleBf16 E{(bf16*)(F.ws + WS_XKV), 1024, nullptr, 0.f};
        pg8::gemm_phase<pg8::EpiScaleBf16, pg8::StaticOrder, PG_ALIGN, PG_SP2>(F.lds, g, S, E);
        }
        if (F.G >= 256) { if ((int)blockIdx.x >= 144) ffn_weights(F, FW_P6_LO, FW_P6_HI, ((int)blockIdx.x - 144) * NWAVES + F.wave, (F.G - 144) * NWAVES); }
        else ffn_weights(F, FW_P6_LO, FW_P6_HI, gw, NGW);
        )
        if (BOTH(6)) GRID_BARX();
    }
    if (IN(7)) {
        DUPK(7,
        if ((int)blockIdx.x < 256) {
            int L = blockIdx.x; ABlk cur = xat_item(F.ws, L); att::Seam<att::bf16> S; int par = 0;
            att::causal_swa_prime<0, att::bf16, att::bf16>(cur, F.ldsg, S);
            unsigned char* const wsp = F.ws; auto itf = [wsp](int l) { return xat_item(wsp, l); };
            for (;;) { const int Ln = L + F.G; const bool last = Ln >= 256; const int Lx = last ? L : Ln;
                att::causal_swa_block<0, att::bf16, att::bf16>(cur, Lx, itf, par, F.ldsg, S);
                if (last) break; L = Ln; cur = xat_item(F.ws, L); par ^= 1; }
        }
        )
        if (BOTH(7)) GRID_BARX();
    }
    if (IN(8)) {
        pg8::Gemm g{(const bf16*)(F.ws + WS_XO), (const bf16*)(F.ws + WS_WXO), M, DM, XW}; pg8::StaticOrder S; S.init(M, DM, F.G, (int)blockIdx.x);
        pg8::EpiResid E{nullptr, (const bf16*)(F.ws + WS_XN), (bf16*)(F.ws + WS_XN), SS2, DM};
        pg8::gemm_phase<pg8::EpiResid, pg8::StaticOrder, PG_ALIGN, PG_SP2>(F.lds, g, S, E);
        if (BOTH(8)) GRID_BARX();
    }
    if (IN(9)) {
        DUPK(9,
        pg8::Gemm g{(const bf16*)(F.ws + WS_XN), (const bf16*)(F.ws + WS_WGU), M, NGU, DM}; pg8::StaticOrder S; S.init(M, NGU, F.G, (int)blockIdx.x);
        float* GF = (float*)(F.ws + WS_HALO);
        pg8::EpiGateUp E{(bf16*)(F.ws + WS_ACT), DFF, SS2, 1.0f / 4096.0f, F.kin[18], F.kin[19], GF, GF + HALO_ONE / 4, GF + 2 * (HALO_ONE / 4), DFF, (LAS float*)(F.lds + 131072)};
        pg8::gemm_phase<pg8::EpiGateUp, pg8::StaticOrder, PG_ALIGN, PG_SP2>(F.lds, g, S, E);
#ifdef DUP_P9NULL
        { pg8::EpiNull E0{}; pg8::gemm_phase<pg8::EpiNull, pg8::StaticOrder, PG_ALIGN, PG_SP2>(F.lds, g, S, E0); }
#endif
        if (F.G == 256) { if ((int)blockIdx.x >= 128) ffn_weights(F, FW_P9_LO, FW_P9_HI, ((int)blockIdx.x - 128) * NWAVES + F.wave, 128 * NWAVES); }
        else ffn_weights(F, FW_P9_LO, FW_P9_HI, gw, NGW);
        )
        if (BOTH(9)) GRID_BARX();
    }
    if (IN(10)) { DUPK(10, halo_fix(F);) if (BOTH(10)) GRID_BARX(); }
    if (IN(11)) {
        pg8::Gemm g{(const bf16*)(F.ws + WS_ACT), (const bf16*)(F.ws + WS_WDN), M, DM, DFF}; pg8::StaticOrder S; S.init(M, DM, F.G, (int)blockIdx.x);
        pg8::EpiResid E{nullptr, (const bf16*)(F.ws + WS_XN), (bf16*)(F.ws + WS_XN), SS3, DM};
        pg8::gemm_phase<pg8::EpiResid, pg8::StaticOrder, PG_ALIGN, PG_SP2>(F.lds, g, S, E);
        if (BOTH(11)) GRID_BARX();
    }
    if (IN(12)) { DUPK(12, const int lane = tid_now() & 63; for (int t = gw; t < M; t += NGW) final_norm_row(F, t, lane);)
    }
#undef IN
#undef BOTH
#undef GRID_BAR
}

extern "C" void kernel_launch(void* const* d_in, const int* in_sizes, int n_in, void* d_out, int out_size, void* d_ws, size_t ws_size, hipStream_t stream) {
    static int grid = 0;
    if (grid == 0) {
        if (n_in != 22 || in_sizes[0] != M * DM || out_size != M * DM || ws_size < WS_END) { fprintf(stderr, "kernel_launch: unexpected shapes (n_in %d, in0 %d, out %d, ws %zu)\n", n_in, n_in > 0 ? in_sizes[0] : -1, out_size, ws_size); grid = -1; return; }
        int dev = 0, cus = 0, per_cu = 0;
        if (hipGetDevice(&dev) != hipSuccess || hipDeviceGetAttribute(&cus, hipDeviceAttributeMultiprocessorCount, dev) != hipSuccess) { grid = -1; return; }
        if (hipFuncSetAttribute((const void*)hybrid_fwd, hipFuncAttributeMaxDynamicSharedMemorySize, LDS_BYTES) != hipSuccess) { fprintf(stderr, "kernel_launch: hipFuncSetAttribute failed\n"); grid = -1; return; }
        if (hipOccupancyMaxActiveBlocksPerMultiprocessor(&per_cu, (const void*)hybrid_fwd, NWAVES * 64, LDS_BYTES) != hipSuccess || per_cu < 1) fprintf(stderr, "kernel_launch: occupancy query reports %d\n", per_cu);
        (void)hipGetLastError();
        grid = cus;
    }
    if (grid < 0) return;
    if (hipMemsetAsync((char*)d_ws + WS_CTL, 0, CTL_ZERO_BYTES, stream) != hipSuccess) return;
    Args a{};
    for (int i = 0; i < 22; ++i) a.in[i] = (const float*)d_in[i];
    a.out = (float*)d_out; a.ws = (unsigned char*)d_ws;
    for (int li = 0; li < N_LAUNCHES; ++li) {
        a.ph_lo = (N_LAUNCHES == 1) ? 0 : li; a.ph_hi = (N_LAUNCHES == 1) ? NPH : li + 1;
        hipLaunchKernelGGL(hybrid_fwd, dim3(grid), dim3(NWAVES * 64), LDS_BYTES, stream, a);
    }
}
```

```cpp
#include <hip/hip_runtime.h>
#include <hip/hip_bf16.h>
#include <cstdio>
#include <cstdint>
#include <cmath>
#include <type_traits>
#ifndef MK_N_LAUNCHES
#define MK_N_LAUNCHES 1
#endif
namespace pg8 {
#define PG8_LAS __attribute__((address_space(3)))
typedef unsigned short bf16_t;
typedef short bf16x8 __attribute__((ext_vector_type(8)));
typedef float f32x4 __attribute__((ext_vector_type(4)));
typedef unsigned u32x4 __attribute__((ext_vector_type(4)));
constexpr int BM = 256, BK = 64, HALF = 128, HTB = HALF * BK * 2  , STAGE_BYTES = 8 * HTB, NXCD = 8, WGM = 8;

__host__ __device__ __forceinline__ int lds_byte(int r, int c) { const int st = (r >> 4) * 2 + (c >> 5), rr = r & 15, cc = c & 31, ob = rr * 64 + cc * 2; return st * 1024 + (ob ^ (((ob >> 9) & 1) << 5)); }
__host__ __device__ __forceinline__ void stage_rc(int b, int& R, int& C) { const int st = b / 1024, sb = b % 1024, swz = sb ^ (((sb >> 9) & 1) << 5); R = (st >> 1) * 16 + swz / 64; C = (st & 1) * 32 + (swz % 64) / 2; }
__host__ __device__ __forceinline__ int perm32(int rho) { const int n = rho >> 4, i = rho & 15; return 8 * (i >> 2) + 4 * n + (i & 3); }

struct Unit { int pm, pn; };
struct Gemm { const bf16_t* A; const bf16_t* Bt; int M, N, K; };

struct StaticOrder {
    int nM, nN, nwg, G, c;
    __host__ __device__ void init(int M, int N, int G_, int c_) { nM = M / BM; nN = N / BM; nwg = nM * nN; G = G_; c = c_; }
    __host__ __device__ bool next(int i, Unit& u) const {
        const long L = (long)i * G + c; if (L >= nwg) return false;
        int wgid = (int)L; { const int q = nwg / NXCD, r = nwg % NXCD, xcd = wgid % NXCD, off = wgid / NXCD; wgid = (xcd < r ? xcd * (q + 1) : r * (q + 1) + (xcd - r) * q) + off; }
        const int nig = WGM * nN, gid = wgid / nig, fm = gid * WGM, gsz = (nM - fm) < WGM ? (nM - fm) : WGM;
        u.pm = fm + ((wgid % nig) % gsz); u.pn = (wgid % nig) / gsz; return true;
    }
    __device__ __forceinline__ void a_ready(const Unit&) const {}
    __device__ __forceinline__ void done(const Unit&) const {}
};

__device__ __forceinline__ unsigned cvt_pk_bf16(float lo, float hi) { unsigned r; asm volatile("v_cvt_pk_bf16_f32 %0, %1, %2" : "=v"(r) : "v"(lo), "v"(hi)); return r; }
typedef float f32x2 __attribute__((ext_vector_type(2)));
typedef unsigned u32x2 __attribute__((ext_vector_type(2)));
typedef int i32x4 __attribute__((ext_vector_type(4)));
constexpr float RMS_EPS = 1e-6f;
constexpr float SS_SCALE = 1048576.0f;
__device__ __forceinline__ float rstd_of(const unsigned long long* ss, int row, float inv_n) { return 1.0f / sqrtf((float)ss[row] * (inv_n / SS_SCALE) + RMS_EPS); }

struct Seg { bf16_t* base; int ld; int col0; int pad; };
struct EpiProj {
    static constexpr bool PERM = true, AFTER_DRAIN = false, PREFETCH = false, I8 = false; typedef f32x4 AccT;
    bf16_t *gq, *gk, *gv, *gr, *dqkv;
    __device__ __forceinline__ void operator()(const f32x4 (&acc)[2][2][4][2], const Unit& u, int wr, int wc, int fr, int fq) const {
        const int colt = u.pn * BM; const int row0 = u.pm * BM + wr * 64 + fr;
        if (colt < 6144) {
            bf16_t* base; int ld, c0;
            if (colt < 1024) { base = gq; ld = 1024; c0 = colt; } else if (colt < 2048) { base = gk; ld = 1024; c0 = colt - 1024; }
            else if (colt < 4096) { base = gv; ld = 2048; c0 = colt - 2048; } else { base = gr; ld = 2048; c0 = colt - 4096; }
            const int col0 = c0 + wc * 32 + 8 * fq;
#pragma unroll
            for (int ai = 0; ai < 2; ++ai)
#pragma unroll
                for (int m = 0; m < 4; ++m) { bf16_t* rowp = base + (size_t)(row0 + ai * HALF + m * 16) * ld + col0;
#pragma unroll
                    for (int bj = 0; bj < 2; ++bj) { const f32x4 v0 = acc[ai][bj][m][0], v1 = acc[ai][bj][m][1];
                        u32x4 w; w.x = cvt_pk_bf16(v0[0], v0[1]); w.y = cvt_pk_bf16(v0[2], v0[3]); w.z = cvt_pk_bf16(v1[0], v1[1]); w.w = cvt_pk_bf16(v1[2], v1[3]);
                        __builtin_nontemporal_store(w, (u32x4*)(rowp + bj * HALF)); } }
        } else {
            const int c = colt - 6144, ten = c >> 11, h0 = (c & 2047) >> 7;
            bf16_t* base = dqkv + (size_t)ten * ((size_t)16384 * 2048) + wc * 32 + 8 * fq;
#pragma unroll
            for (int ai = 0; ai < 2; ++ai)
#pragma unroll
                for (int m = 0; m < 4; ++m) { const int row = row0 + ai * HALF + m * 16, b = row >> 12, sq = row & 4095;
#pragma unroll
                    for (int bj = 0; bj < 2; ++bj) { const f32x4 v0 = acc[ai][bj][m][0], v1 = acc[ai][bj][m][1];
                        u32x4 w; w.x = cvt_pk_bf16(v0[0], v0[1]); w.y = cvt_pk_bf16(v0[2], v0[3]); w.z = cvt_pk_bf16(v1[0], v1[1]); w.w = cvt_pk_bf16(v1[2], v1[3]);
                        __builtin_nontemporal_store(w, (u32x4*)(base + ((size_t)((b * 16 + h0 + bj) * 4096 + sq)) * 128)); } }
        }
    }
};
struct EpiScaleBf16 {
    static constexpr bool PERM = true, AFTER_DRAIN = false, PREFETCH = false, I8 = false; typedef f32x4 AccT;
    bf16_t* O; int ldc; const unsigned long long* ss; float inv_n;
    __device__ __forceinline__ void operator()(const f32x4 (&acc)[2][2][4][2], const Unit& u, int wr, int wc, int fr, int fq) const {
        const int row0 = u.pm * BM + wr * 64 + fr, col0 = u.pn * BM + wc * 32 + 8 * fq;
#pragma unroll
        for (int ai = 0; ai < 2; ++ai)
#pragma unroll
            for (int m = 0; m < 4; ++m) { const int row = row0 + ai * HALF + m * 16; const float rs = ss ? rstd_of(ss, row, inv_n) : 1.0f; bf16_t* rowp = O + (size_t)row * ldc + col0;
#pragma unroll
                for (int bj = 0; bj < 2; ++bj) { const f32x4 v0 = acc[ai][bj][m][0] * rs, v1 = acc[ai][bj][m][1] * rs;
                    u32x4 w; w.x = cvt_pk_bf16(v0[0], v0[1]); w.y = cvt_pk_bf16(v0[2], v0[3]); w.z = cvt_pk_bf16(v1[0], v1[1]); w.w = cvt_pk_bf16(v1[2], v1[3]);
                    *(u32x4*)(rowp + bj * HALF) = w; } }
    }
};
struct EpiResid {
    static constexpr bool PERM = true, AFTER_DRAIN = false, PREFETCH = false, I8 = false; typedef f32x4 AccT;
    const float* base32; const bf16_t* base16; bf16_t* hb; unsigned long long* ss; int ldc; unsigned* amax;
    __device__ __forceinline__ void operator()(const f32x4 (&acc)[2][2][4][2], const Unit& u, int wr, int wc, int fr, int fq) const {
        const int row0 = u.pm * BM + wr * 64 + fr, col0 = u.pn * BM + wc * 32 + 8 * fq;
        f32x4 bc[2][2], bn[2][2]; u32x4 hc[2], hn[2];
#define EPR_LOAD(d32, d16, g) do { const size_t o_ = (size_t)(row0 + ((g) >> 2) * HALF + ((g) & 3) * 16) * ldc + col0; \
        if (base32) { d32[0][0] = *(const f32x4*)(base32 + o_); d32[0][1] = *(const f32x4*)(base32 + o_ + 4); d32[1][0] = *(const f32x4*)(base32 + o_ + HALF); d32[1][1] = *(const f32x4*)(base32 + o_ + HALF + 4); } \
        else { d16[0] = *(const u32x4*)(base16 + o_); d16[1] = *(const u32x4*)(base16 + o_ + HALF); } } while (0)
        EPR_LOAD(bc, hc, 0);
#pragma unroll
        for (int g = 0; g < 8; ++g) {
            const int ai = g >> 2, m = g & 3; const int row = row0 + ai * HALF + m * 16; const size_t off = (size_t)row * ldc + col0; float s = 0.f; float mx = 0.f;
            if (g < 7) EPR_LOAD(bn, hn, g + 1);
#pragma unroll
            for (int bj = 0; bj < 2; ++bj) {
                f32x4 b0, b1;
                if (base32) { b0 = bc[bj][0]; b1 = bc[bj][1]; }
                else { const u32x4 w = hc[bj]; b0 = (f32x4){__uint_as_float(w.x << 16), __uint_as_float(w.x & 0xffff0000u), __uint_as_float(w.y << 16), __uint_as_float(w.y & 0xffff0000u)};
                                              b1 = (f32x4){__uint_as_float(w.z << 16), __uint_as_float(w.z & 0xffff0000u), __uint_as_float(w.w << 16), __uint_as_float(w.w & 0xffff0000u)}; }
                const f32x4 v0 = acc[ai][bj][m][0] + b0, v1 = acc[ai][bj][m][1] + b1;
                s += (v0[0] * v0[0] + v0[1] * v0[1]) + (v0[2] * v0[2] + v0[3] * v0[3]) + (v1[0] * v1[0] + v1[1] * v1[1]) + (v1[2] * v1[2] + v1[3] * v1[3]);
                if (amax) { const f32x4 a0 = __builtin_elementwise_abs(v0), a1 = __builtin_elementwise_abs(v1); mx = fmaxf(mx, fmaxf(fmaxf(fmaxf(a0[0], a0[1]), fmaxf(a0[2], a0[3])), fmaxf(fmaxf(a1[0], a1[1]), fmaxf(a1[2], a1[3])))); }
                u32x4 w; w.x = cvt_pk_bf16(v0[0], v0[1]); w.y = cvt_pk_bf16(v0[2], v0[3]); w.z = cvt_pk_bf16(v1[0], v1[1]); w.w = cvt_pk_bf16(v1[2], v1[3]); *(u32x4*)(hb + off + bj * HALF) = w; }
            s += __shfl_xor(s, 16); s += __shfl_xor(s, 32);
            if (ss && fq == 0) atomicAdd(ss + row, (unsigned long long)(s * SS_SCALE + 0.5f));
            if (amax) { mx = fmaxf(mx, __shfl_xor(mx, 16)); mx = fmaxf(mx, __shfl_xor(mx, 32)); if (fq == 0) atomicMax(amax + row, __float_as_uint(mx)); }
#pragma unroll
            for (int bj = 0; bj < 2; ++bj) { bc[bj][0] = bn[bj][0]; bc[bj][1] = bn[bj][1]; hc[bj] = hn[bj]; }
            asm volatile("" ::: "memory");
        }
#undef EPR_LOAD
    }
};
template <bool Q> struct EpiGateUpT {
    static constexpr bool PERM = true, AFTER_DRAIN = false, PREFETCH = true, I8 = Q; typedef typename std::conditional<Q, i32x4, f32x4>::type AccT;
    static constexpr int AUXN = 1024;
    bf16_t* act; int ldc; const unsigned long long* ss; float inv_n; const float* cw; const float* cb; float* GF; float* UF; float* GL; int nff;
    PG8_LAS float* aux;
    const unsigned* colmax; const unsigned* amax;
    __device__ __forceinline__ float colscale(int tid, int pn) const { return Q ? __uint_as_float(colmax[(tid >> 7) * nff + pn * HALF + (tid & 127)]) * (1.0f / 127.0f) : 1.0f; }
    __device__ __forceinline__ float rowscale(unsigned long long s2, unsigned am) const { const float r = 1.0f / sqrtf((float)s2 * (inv_n / SS_SCALE) + RMS_EPS); return Q ? r * __uint_as_float(am) * (1.0f / 127.0f) : r; }
    __device__ __forceinline__ void prefetch(const Unit& u, int par) const {
        int tid = (int)threadIdx.x; asm volatile("" : "+v"(tid)); const int arr = tid >> 7, ch = tid & 127;
        const float v = arr < 3 ? cw[arr * nff + u.pn * HALF + ch] : cb[u.pn * HALF + ch];
        PG8_LAS float* a = aux + par * AUXN; a[tid] = v;
        if (tid < 256) { a[512 + tid] = colscale(tid, u.pn); const int row = u.pm * BM + tid; a[768 + tid] = rowscale(ss[row], Q ? amax[row] : 0u); }
    }
    __device__ __forceinline__ void run(const AccT (&acc)[2][2][4][2], const Unit& u, int wr, int wc, int fr, int fq, int par, const Unit& nxt) const {
        int tid = (int)threadIdx.x; asm volatile("" : "+v"(tid)); const int arr = tid >> 7, chn = tid & 127;
        const float nv = arr < 3 ? cw[arr * nff + nxt.pn * HALF + chn] : cb[nxt.pn * HALF + chn];
        const int nrow = nxt.pm * BM + (tid & 255);
        const unsigned long long nss = ss[nrow]; const unsigned nam = Q ? amax[nrow] : 0u; const float ncs = colscale(tid & 255, nxt.pn);
        const PG8_LAS float* a = aux + par * AUXN;
        const int c0 = wc * 32 + 8 * fq;
        const int ch0 = u.pn * HALF + c0;
        float w0[8], w1[8], w2[8], bb[8], sg[8], su[8];
#pragma unroll
        for (int h4 = 0; h4 < 2; ++h4) { const f32x4 x0 = *(const PG8_LAS f32x4*)(a + c0 + 4 * h4), x1 = *(const PG8_LAS f32x4*)(a + 128 + c0 + 4 * h4), x2 = *(const PG8_LAS f32x4*)(a + 256 + c0 + 4 * h4), x3 = *(const PG8_LAS f32x4*)(a + 384 + c0 + 4 * h4);
            const f32x4 x4 = *(const PG8_LAS f32x4*)(a + 512 + c0 + 4 * h4), x5 = *(const PG8_LAS f32x4*)(a + 640 + c0 + 4 * h4);
#pragma unroll
            for (int j = 0; j < 4; ++j) { w0[4 * h4 + j] = x0[j]; w1[4 * h4 + j] = x1[j]; w2[4 * h4 + j] = x2[j]; bb[4 * h4 + j] = x3[j]; sg[4 * h4 + j] = x4[j]; su[4 * h4 + j] = x5[j]; } }
#pragma unroll
        for (int ai = 0; ai < 2; ++ai) {
            const int blk = (u.pm * BM + ai * HALF + wr * 64) >> 6;
            float pg[8];
#pragma unroll
            for (int e = 0; e < 8; ++e) pg[e] = 0.f;
#pragma unroll
            for (int m = 0; m < 4; ++m) {
                const int lrow = ai * HALF + wr * 64 + m * 16 + fr; const int row = u.pm * BM + lrow; const float rs = a[768 + lrow];
                float g[8], up[8], av[8];
#pragma unroll
                for (int n = 0; n < 2; ++n)
#pragma unroll
                    for (int j = 0; j < 4; ++j) {
                        if constexpr (Q) { g[4 * n + j] = (float)acc[ai][0][m][n][j] * (rs * sg[4 * n + j]); up[4 * n + j] = (float)acc[ai][1][m][n][j] * (rs * su[4 * n + j]); }
                        else { g[4 * n + j] = acc[ai][0][m][n][j] * rs; up[4 * n + j] = acc[ai][1][m][n][j] * rs; } }
#pragma unroll
                for (int e = 0; e < 8; ++e) {
                    const int gi = __float_as_int(g[e]), pi = __float_as_int(pg[e]);
                    const float p1 = __int_as_float(__builtin_amdgcn_update_dpp(__builtin_amdgcn_update_dpp(0, pi, 0x121, 0xf, 0xf, false), gi, 0x111, 0xf, 0xf, false));
                    const float p2 = __int_as_float(__builtin_amdgcn_update_dpp(__builtin_amdgcn_update_dpp(0, pi, 0x122, 0xf, 0xf, false), gi, 0x112, 0xf, 0xf, false));
                    const float y = bb[e] + w0[e] * p2 + w1[e] * p1 + w2[e] * g[e];
                    av[e] = y * __builtin_amdgcn_rcpf(1.0f + __expf(-y)) * up[e];
                }
                if (m > 0 || fr >= 2) { u32x4 w; w.x = cvt_pk_bf16(av[0], av[1]); w.y = cvt_pk_bf16(av[2], av[3]); w.z = cvt_pk_bf16(av[4], av[5]); w.w = cvt_pk_bf16(av[6], av[7]);
                    __builtin_nontemporal_store(w, (u32x4*)(act + (size_t)row * ldc + ch0)); }
                if (m == 0 && fr < 2) { float* gp = GF + ((size_t)blk * 2 + fr) * nff + ch0; float* upp = UF + ((size_t)blk * 2 + fr) * nff + ch0;
                    *(f32x4*)gp = (f32x4){g[0], g[1], g[2], g[3]}; *(f32x4*)(gp + 4) = (f32x4){g[4], g[5], g[6], g[7]};
                    *(f32x4*)upp = (f32x4){up[0], up[1], up[2], up[3]}; *(f32x4*)(upp + 4) = (f32x4){up[4], up[5], up[6], up[7]}; }
                if (m == 3 && fr >= 14) { float* gp = GL + ((size_t)blk * 2 + (fr - 14)) * nff + ch0;
                    *(f32x4*)gp = (f32x4){g[0], g[1], g[2], g[3]}; *(f32x4*)(gp + 4) = (f32x4){g[4], g[5], g[6], g[7]}; }
#pragma unroll
                for (int e = 0; e < 8; ++e) pg[e] = g[e];
            }
        }
        PG8_LAS float* an = aux + (par ^ 1) * AUXN; an[tid] = nv;
        if (tid < 256) { an[512 + tid] = ncs; an[768 + tid] = rowscale(nss, nam); }
    }
};
typedef EpiGateUpT<false> EpiGateUp;
typedef EpiGateUpT<true> EpiGateUpQ;
struct EpiNull {
    static constexpr bool PERM = true, AFTER_DRAIN = false, PREFETCH = false, I8 = false; typedef f32x4 AccT;
    __device__ __forceinline__ void operator()(const f32x4 (&acc)[2][2][4][2], const Unit& u, int wr, int wc, int fr, int fq) const {
#pragma unroll
        for (int ai = 0; ai < 2; ++ai)
#pragma unroll
            for (int bj = 0; bj < 2; ++bj)
#pragma unroll
                for (int m = 0; m < 4; ++m)
#pragma unroll
                    for (int n = 0; n < 2; ++n) asm volatile("" :: "v"(acc[ai][bj][m][n]));
    }
};
template <bool I8> __device__ __forceinline__ auto pg8_mma(bf16x8 b, bf16x8 a, typename std::conditional<I8, i32x4, f32x4>::type c) {
    if constexpr (I8) return __builtin_amdgcn_mfma_i32_16x16x64_i8(__builtin_bit_cast(i32x4, b), __builtin_bit_cast(i32x4, a), c, 0, 0, 0);
    else return __builtin_amdgcn_mfma_f32_16x16x32_bf16(b, a, c, 0, 0, 0);
}
template <class Epi, class Sched, bool ALIGN_EPI = false, bool SP2 = false>
__device__ __forceinline__ void gemm_phase(PG8_LAS unsigned char* lds, const Gemm g, const Sched& S, const Epi& E) {
    const int tid = threadIdx.x, wid = __builtin_amdgcn_readfirstlane(tid >> 6), lane = tid & 63, wr = wid >> 2, wc = wid & 3, fr = lane & 15, fq = lane >> 4;
    const int K = g.K, nt = K / BK;
    unsigned voffA[2], voffB[2];
#pragma unroll
    for (int i = 0; i < 2; ++i) { int R, C; stage_rc(tid * 16 + i * 8192, R, C); const int Rb = Epi::PERM ? ((R & ~31) + perm32(R & 31)) : R;
        voffA[i] = (unsigned)(R * K + C) * 2u; voffB[i] = (unsigned)(Rb * K + C) * 2u; }
    const size_t kstep = (size_t)(BK * 2);
    const size_t hstep = (size_t)HALF * K * 2;
    const size_t tstep = 2 * hstep;
    const unsigned ldsw = (unsigned)wid * 1024u;
    const int aoff = lds_byte(wr * 64 + fr, fq * 8), boff = lds_byte(wc * 32 + fr, fq * 8);
#define PG8_SA(b, h) (((b) * 2 + (h)) * HTB)
#define PG8_SB(b, h) ((4 + (b) * 2 + (h)) * HTB)
#define PG8_STAGE(bufoff, gbase, voff) do { _Pragma("unroll") for (int _i = 0; _i < 2; ++_i) \
        __builtin_amdgcn_global_load_lds((const unsigned*)((const char*)(gbase) + (voff)[_i]), (PG8_LAS unsigned*)(lds + (bufoff) + ldsw + _i * 8192), 16, 0, 0); } while (0)
#define PG8_LDA(dst, b, h) do { _Pragma("unroll") for (int m = 0; m < 4; ++m) _Pragma("unroll") for (int k = 0; k < 2; ++k) dst[m][k] = *(const PG8_LAS bf16x8*)(lds + PG8_SA(b, h) + aoff + m * 2048 + k * 1024); } while (0)
#define PG8_LDB(dst, b, h) do { _Pragma("unroll") for (int n = 0; n < 2; ++n) _Pragma("unroll") for (int k = 0; k < 2; ++k) dst[n][k] = *(const PG8_LAS bf16x8*)(lds + PG8_SB(b, h) + boff + n * 2048 + k * 1024); } while (0)
#define PG8_MMA(ai, bj, At, Bt) do { __builtin_amdgcn_s_setprio(1); _Pragma("unroll") for (int m = 0; m < 4; ++m) _Pragma("unroll") for (int n = 0; n < 2; ++n) _Pragma("unroll") for (int k = 0; k < 2; ++k) \
        acc[ai][bj][m][n] = pg8_mma<Epi::I8>(Bt[n][k], At[m][k], acc[ai][bj][m][n]); __builtin_amdgcn_s_setprio(0); } while (0)
#define PG8_WAIT_V(n) asm volatile("s_waitcnt vmcnt(" #n ")" ::: "memory")
#define PG8_WAIT_L(n) asm volatile("s_waitcnt lgkmcnt(" #n ")" ::: "memory")
#define PG8_BAR __builtin_amdgcn_s_barrier()
#define PG8_SCHED __builtin_amdgcn_sched_barrier(0)
    Unit cur, nxt; int ui = 0;
    if (!S.next(0, cur)) return;
    typedef typename Epi::AccT AccT; AccT acc[2][2][4][2];
#pragma unroll
    for (int a = 0; a < 2; ++a)
#pragma unroll
        for (int b = 0; b < 2; ++b)
#pragma unroll
            for (int m = 0; m < 4; ++m)
#pragma unroll
                for (int n = 0; n < 2; ++n) acc[a][b][m][n] = AccT{};
    bf16x8 At[4][2], B0[2][2], B1[2][2];
    const char* cA = (const char*)g.A + (size_t)cur.pm * tstep; const char* cB = (const char*)g.Bt + (size_t)cur.pn * tstep;
    S.a_ready(cur);
    if constexpr (Epi::PREFETCH) E.prefetch(cur, 0);
    if constexpr (SP2) {
        PG8_STAGE(PG8_SB(0, 0), cB, voffB); PG8_STAGE(PG8_SB(0, 1), cB + hstep, voffB); PG8_STAGE(PG8_SA(0, 0), cA, voffA); PG8_STAGE(PG8_SA(0, 1), cA + hstep, voffA);
        if (wr == 1) PG8_BAR;
        PG8_WAIT_V(2); PG8_BAR;
        PG8_STAGE(PG8_SB(1, 0), cB + kstep, voffB); PG8_STAGE(PG8_SA(1, 0), cA + kstep, voffA); PG8_STAGE(PG8_SB(1, 1), cB + hstep + kstep, voffB);
        PG8_WAIT_V(6); PG8_BAR;
    } else {
        PG8_STAGE(PG8_SB(0, 0), cB, voffB); PG8_STAGE(PG8_SA(0, 0), cA, voffA); PG8_STAGE(PG8_SB(0, 1), cB + hstep, voffB); PG8_STAGE(PG8_SA(0, 1), cA + hstep, voffA);
        if (wr == 1) PG8_BAR;
        PG8_WAIT_V(4); PG8_BAR;
        PG8_STAGE(PG8_SB(1, 0), cB + kstep, voffB); PG8_STAGE(PG8_SA(1, 0), cA + kstep, voffA); PG8_STAGE(PG8_SB(1, 1), cB + hstep + kstep, voffB);
        PG8_WAIT_V(6); PG8_BAR;
    }
    for (;;) {
        const bool has_next = S.next(ui + 1, nxt);
        const char* nA = has_next ? (const char*)g.A + (size_t)nxt.pm * tstep : cA; const char* nB = has_next ? (const char*)g.Bt + (size_t)nxt.pn * tstep : cB;
        for (int t = 0; t < nt; t += 2) {
            const bool last = (t == nt - 2);
            const char* a1 = cA + (size_t)(t + 1) * kstep;
            const char* a2 = last ? nA : cA + (size_t)(t + 2) * kstep; const char* b2 = last ? nB : cB + (size_t)(t + 2) * kstep;
            const char* a3 = a2 + kstep; const char* b3 = b2 + kstep;
            if (last && has_next) S.a_ready(nxt);
            if constexpr (SP2) {
            PG8_LDB(B0, 0, 0); PG8_LDB(B1, 0, 1); PG8_SCHED; PG8_LDA(At, 0, 0); PG8_STAGE(PG8_SA(1, 1), a1 + hstep, voffA);
            PG8_WAIT_V(8); PG8_WAIT_L(0); PG8_BAR; PG8_MMA(0, 0, At, B0); PG8_MMA(0, 1, At, B1); PG8_BAR; PG8_SCHED;
            PG8_LDA(At, 0, 1); PG8_STAGE(PG8_SB(0, 0), b2, voffB); PG8_STAGE(PG8_SB(0, 1), b2 + hstep, voffB); PG8_STAGE(PG8_SA(0, 0), a2, voffA);
            PG8_WAIT_V(8); PG8_WAIT_L(0); PG8_BAR; PG8_MMA(1, 0, At, B0); PG8_MMA(1, 1, At, B1); PG8_BAR; PG8_SCHED;
            PG8_LDB(B0, 1, 0); PG8_LDB(B1, 1, 1); PG8_SCHED; PG8_LDA(At, 1, 0); PG8_STAGE(PG8_SA(0, 1), a2 + hstep, voffA);
            PG8_WAIT_V(8); PG8_WAIT_L(0); PG8_BAR; PG8_MMA(0, 0, At, B0); PG8_MMA(0, 1, At, B1); PG8_BAR; PG8_SCHED;
            PG8_LDA(At, 1, 1); PG8_STAGE(PG8_SB(1, 0), b3, voffB); PG8_STAGE(PG8_SB(1, 1), b3 + hstep, voffB); PG8_STAGE(PG8_SA(1, 0), a3, voffA);
            PG8_WAIT_V(8); PG8_WAIT_L(0); PG8_BAR; PG8_MMA(1, 0, At, B0); PG8_MMA(1, 1, At, B1); PG8_BAR; PG8_SCHED;
            } else {
            PG8_LDB(B0, 0, 0); PG8_SCHED; PG8_LDA(At, 0, 0); PG8_STAGE(PG8_SA(1, 1), a1 + hstep, voffA);
            PG8_WAIT_L(8); PG8_BAR; PG8_WAIT_L(0); PG8_MMA(0, 0, At, B0); PG8_BAR; PG8_SCHED;
            PG8_LDB(B1, 0, 1); PG8_STAGE(PG8_SB(0, 0), b2, voffB);
            PG8_BAR; PG8_WAIT_L(0); PG8_MMA(0, 1, At, B1); PG8_BAR;
            PG8_LDA(At, 0, 1); PG8_STAGE(PG8_SA(0, 0), a2, voffA);
            PG8_BAR; PG8_WAIT_L(0); PG8_MMA(1, 0, At, B0); PG8_BAR; PG8_SCHED;
            PG8_STAGE(PG8_SB(0, 1), b2 + hstep, voffB);
            PG8_WAIT_V(6); PG8_BAR; PG8_MMA(1, 1, At, B1); PG8_BAR;
            PG8_LDB(B0, 1, 0); PG8_SCHED; PG8_LDA(At, 1, 0); PG8_STAGE(PG8_SA(0, 1), a2 + hstep, voffA);
            PG8_WAIT_L(8); PG8_BAR; PG8_WAIT_L(0); PG8_MMA(0, 0, At, B0); PG8_BAR; PG8_SCHED;
            PG8_LDB(B1, 1, 1); PG8_STAGE(PG8_SB(1, 0), b3, voffB);
            PG8_BAR; PG8_WAIT_L(0); PG8_MMA(0, 1, At, B1); PG8_BAR;
            PG8_LDA(At, 1, 1); PG8_STAGE(PG8_SA(1, 0), a3, voffA);
            PG8_BAR; PG8_WAIT_L(0); PG8_MMA(1, 0, At, B0); PG8_BAR; PG8_SCHED;
            PG8_STAGE(PG8_SB(1, 1), b3 + hstep, voffB);
            PG8_WAIT_V(6); PG8_BAR; PG8_MMA(1, 1, At, B1); PG8_BAR;
            }
        }
        if constexpr (ALIGN_EPI) { if (wr == 0) PG8_BAR; }
        if constexpr (!Epi::AFTER_DRAIN) { if constexpr (Epi::PREFETCH) E.run(acc, cur, wr, wc, fr, fq, ui & 1, has_next ? nxt : cur); else E(acc, cur, wr, wc, fr, fq); S.done(cur); }
        if (!has_next) break;
#pragma unroll
        for (int a = 0; a < 2; ++a)
#pragma unroll
            for (int b = 0; b < 2; ++b)
#pragma unroll
                for (int m = 0; m < 4; ++m)
#pragma unroll
                    for (int n = 0; n < 2; ++n) acc[a][b][m][n] = AccT{};
        cur = nxt; cA = nA; cB = nB; ++ui;
        if constexpr (ALIGN_EPI) { if (wr == 1) PG8_BAR; }
    }
    PG8_WAIT_V(0);
    if constexpr (!ALIGN_EPI) { if (wr == 0) PG8_BAR; }
    PG8_BAR;
    if constexpr (Epi::AFTER_DRAIN) { E.fused(acc, cur, wr, wc, fr, fq, lds, wid, lane); S.done(cur); }
#undef PG8_SA
#undef PG8_SB
#undef PG8_STAGE
#undef PG8_LDA
#undef PG8_LDB
#undef PG8_MMA
#undef PG8_WAIT_V
#undef PG8_WAIT_L
#undef PG8_BAR
#undef PG8_SCHED
}
}
namespace att {
constexpr int D = 128; constexpr float THR = 8.f; constexpr bool WSKIP = true;
constexpr float SCALE = 0.08838834764831845f;
constexpr int NW = 8, QBLK = 32, KVBLK = 64, QB = NW * QBLK;
constexpr int SHM_V = KVBLK * D * 2, SHM_K = KVBLK * D * 2;
constexpr int LDS_TAB = 2 * SHM_V + 2 * SHM_K + NW * 64 * 4, TAB_N = 328, TAB_OFF = 100, TAB_PITCH = 4 * TAB_N;
constexpr int LDS_BYTES = LDS_TAB + 2 * TAB_PITCH * 4;
using bf16 = __hip_bfloat16;
typedef short bf16x8 __attribute__((ext_vector_type(8)));
typedef short s16x4 __attribute__((ext_vector_type(4)));
typedef float f32x16 __attribute__((ext_vector_type(16)));
typedef float f32x4 __attribute__((ext_vector_type(4)));
typedef float f32x2 __attribute__((ext_vector_type(2)));
typedef unsigned u32x4 __attribute__((ext_vector_type(4)));
template <class A, class Bt> struct same_t { static constexpr bool v = false; };
template <class A> struct same_t<A, A> { static constexpr bool v = true; };

#define KSWZ(row, colB) ((row) * 256 + ((colB) ^ (((row) & 7) << 4)))
#define SBAR() __builtin_amdgcn_sched_barrier(0)
__device__ __forceinline__ int v_st(int k, int c) { const int kk = (k & ~0xC) | ((k & 4) << 1) | ((k & 8) >> 1); return ((kk >> 3) * 4 + (c >> 5)) * 512 + ((kk & 7) * 32 + (c & 31)) * 2; }
__device__ __forceinline__ int v_rd_base(int lane) { return ((lane & 3) << 3) | (((lane >> 2) & 3) << 6) | (((lane >> 4) & 1) << 5) | (((lane >> 5) & 1) << 8); }
constexpr int v_rd_off(int d0, int ks, int half) { return d0 * 512 + ks * 4096 + half * 2048; }
__device__ __forceinline__ int crow(int r, int hi) { return (r & 3) + 8 * (r >> 2) + 4 * hi; }
__device__ __forceinline__ unsigned cvtpk(float lo, float hi) {
    unsigned r; asm volatile("v_cvt_pk_bf16_f32 %0, %1, %2" : "=v"(r) : "v"(lo), "v"(hi)); return r;
}
__device__ __forceinline__ bf16x8 pack8(f32x4 a, f32x4 b) {
    u32x4 w = {cvtpk(a[0], a[1]), cvtpk(a[2], a[3]), cvtpk(b[0], b[1]), cvtpk(b[2], b[3])};
    return *reinterpret_cast<bf16x8*>(&w);
}
template <class T> __device__ __forceinline__ bf16x8 load8(const T* p) {
    if constexpr (same_t<T, float>::v) { return pack8(*(const f32x4*)p, *(const f32x4*)(p + 4)); }
    else { return *reinterpret_cast<const bf16x8*>(p); }
}
__device__ __forceinline__ void mask_tile(f32x16& p0, f32x16& p1, int dq, unsigned W) {
    const float NEG = -__builtin_inff();
#pragma unroll
    for (int r = 0; r < 16; ++r) {
        const int c = (r & 3) + 8 * (r >> 2);
        if ((unsigned)(dq - c) >= W) p0[r] = NEG;
        if ((unsigned)(dq - c - 32) >= W) p1[r] = NEG;
    }
}
__device__ __forceinline__ void bias_mask_tile(f32x16& p0, f32x16& p1, int dq, unsigned W, const float* tabu, bool needmask) {
    const float NEG = -__builtin_inff();
    const int sft = (4 - ((int)threadIdx.x & 3)) & 3;
    const float* t0 = tabu + (sft * (TAB_N - 1) + TAB_OFF + 128 - dq);
#pragma unroll
    for (int J = 0; J < 8; ++J) {
        const f32x4 b = *(const f32x4*)(t0 + 8 * J);
#pragma unroll
        for (int e = 0; e < 4; ++e) {
            const int r = 4 * (J & 3) + e; const int c = e + 8 * (J & 3) + (J >= 4 ? 32 : 0);
            float v = (J < 4 ? p0[r] : p1[r]) + b[e];
            if (needmask) { if ((unsigned)(dq - c) >= W) v = NEG; }
            if (J < 4) p0[r] = v; else p1[r] = v;
        }
        if ((J & 1) == 1) asm volatile("" ::: "memory");
    }
}
__device__ __forceinline__ void bias_fill(float* T, const float* bsrc, int tid) {
    asm volatile("" : "+v"(tid));
    if (tid < TAB_N) {
#pragma unroll
        for (int sf = 0; sf < 4; ++sf) { const int i = tid - TAB_OFF + sf; T[sf * TAB_N + tid] = (i >= 0 && i <= 128) ? bsrc[128 - i] : 0.f; }
    }
}
__device__ __forceinline__ void partialSM(f32x16& p0, f32x16& p1, float& m_reg, float& mn, float& alpha) {
    float pmax = p0[0]; for (int r = 1; r < 16; ++r) pmax = fmaxf(pmax, p0[r]); for (int r = 0; r < 16; ++r) pmax = fmaxf(pmax, p1[r]);
    { auto rr = __builtin_amdgcn_permlane32_swap(__float_as_uint(pmax), __float_as_uint(pmax), false, false);
      pmax = fmaxf(__uint_as_float(rr[0]), __uint_as_float(rr[1])); }
    constexpr float C2 = 1.4426950408889634f * SCALE;
    if (__builtin_expect(__all((pmax - m_reg) * SCALE <= THR), 1)) { mn = m_reg; alpha = 1.f; }
    else { mn = fmaxf(m_reg, pmax); alpha = __builtin_amdgcn_exp2f((m_reg - mn) * C2); m_reg = mn; }
    const float mnL = -mn * C2;
    for (int r = 0; r < 16; ++r) p0[r] = fmaf(p0[r], C2, mnL); for (int r = 0; r < 16; ++r) p1[r] = fmaf(p1[r], C2, mnL);
    for (int r = 0; r < 16; ++r) p0[r] = __builtin_amdgcn_exp2f(p0[r]);
}
__device__ __forceinline__ void finishSM(f32x16& p0, f32x16& p1, float alpha, float& l_reg, bf16x8& pa0, bf16x8& pa1, bf16x8& pa2, bf16x8& pa3) {
    for (int r = 0; r < 16; ++r) p1[r] = __builtin_amdgcn_exp2f(p1[r]);
    float ps = 0; for (int r = 0; r < 16; ++r) ps += p0[r]; for (int r = 0; r < 16; ++r) ps += p1[r];
    { auto rr = __builtin_amdgcn_permlane32_swap(__float_as_uint(ps), __float_as_uint(ps), false, false);
      ps = __uint_as_float(rr[0]) + __uint_as_float(rr[1]); }
    l_reg = l_reg * alpha + ps;
#define PK4(P, B_, OUT) do { unsigned a0 = cvtpk(P[B_+0], P[B_+1]), a1 = cvtpk(P[B_+2], P[B_+3]);                          \
        unsigned b0 = cvtpk(P[B_+4], P[B_+5]), b1 = cvtpk(P[B_+6], P[B_+7]);                                             \
        auto r0 = __builtin_amdgcn_permlane32_swap(a0, b0, false, false); auto r1 = __builtin_amdgcn_permlane32_swap(a1, b1, false, false); \
        u32x4 w = {r0[0], r1[0], r0[1], r1[1]}; OUT = *reinterpret_cast<bf16x8*>(&w); } while (0)
    PK4(p0, 0, pa0); PK4(p0, 8, pa1); PK4(p1, 0, pa2); PK4(p1, 8, pa3);
#undef PK4
}
template <int KB, bool SK>
__device__ __forceinline__ void qkt(f32x16& p0, f32x16& p1, const char* K_lds, int r32, int hi, const bf16x8* qr, bool act) {
    if (SK && !act) { const float NEG = -__builtin_inff();
#pragma unroll
        for (int r = 0; r < 16; ++r) { p0[r] = NEG; p1[r] = NEG; } return; }
    p0 = f32x16{}; p1 = f32x16{};
    const char* kb[4];
#pragma unroll
    for (int dd = 0; dd < 4; ++dd) kb[dd] = K_lds + KB * SHM_K + KSWZ(r32, (dd * 16 + hi * 8) * 2);
#pragma unroll
    for (int d0 = 0; d0 < 8; ++d0) { const char* a = kb[d0 & 3] + (d0 >> 2) * 128;
        bf16x8 b0 = *reinterpret_cast<const bf16x8*>(a);
        bf16x8 b1 = *reinterpret_cast<const bf16x8*>(a + 32 * 256);
        p0 = __builtin_amdgcn_mfma_f32_32x32x16_bf16(b0, qr[d0], p0, 0, 0, 0);
        p1 = __builtin_amdgcn_mfma_f32_32x32x16_bf16(b1, qr[d0], p1, 0, 0, 0); }
}
template <int VB, bool SK>
__device__ __forceinline__ void pv_tile(f32x16* o, int vb0, bf16x8 pa0, bf16x8 pa1, bf16x8 pa2, bf16x8 pa3, bool act) {
    if (SK && !act) return;
#define TRRD(dst, off) asm volatile("ds_read_b64_tr_b16 %0, %1 offset:%2" : "=&v"(dst) : "v"(vb0), "i"(off) : "memory")
#define PV_D0(d0) do { s16x4 l0, l1, l2, l3, h0, h1, h2, h3; constexpr int b_ = VB * SHM_V + v_rd_off(d0, 0, 0);     \
        TRRD(l0, b_); TRRD(h0, b_ + 2048); TRRD(l1, b_ + 4096); TRRD(h1, b_ + 6144); TRRD(l2, b_ + 8192); TRRD(h2, b_ + 10240); TRRD(l3, b_ + 12288); TRRD(h3, b_ + 14336); \
        asm volatile("s_waitcnt lgkmcnt(0)" ::: "memory"); SBAR();                 \
        o[d0] = __builtin_amdgcn_mfma_f32_32x32x16_bf16(pa0, (bf16x8){l0[0], l0[1], l0[2], l0[3], h0[0], h0[1], h0[2], h0[3]}, o[d0], 0, 0, 0);   \
        o[d0] = __builtin_amdgcn_mfma_f32_32x32x16_bf16(pa1, (bf16x8){l1[0], l1[1], l1[2], l1[3], h1[0], h1[1], h1[2], h1[3]}, o[d0], 0, 0, 0);   \
        o[d0] = __builtin_amdgcn_mfma_f32_32x32x16_bf16(pa2, (bf16x8){l2[0], l2[1], l2[2], l2[3], h2[0], h2[1], h2[2], h2[3]}, o[d0], 0, 0, 0);   \
        o[d0] = __builtin_amdgcn_mfma_f32_32x32x16_bf16(pa3, (bf16x8){l3[0], l3[1], l3[2], l3[3], h3[0], h3[1], h3[2], h3[3]}, o[d0], 0, 0, 0); } while (0)
    PV_D0(0); PV_D0(1); PV_D0(2); PV_D0(3);
#undef PV_D0
#undef TRRD
}

template <class TIn, class TOut> struct BlockRef { const TIn* Q; const TIn* K; const TIn* V; TOut* O; float* L; const float* bsrc; int P0, pq, pk, po, pl, skv, W; };
template <class TIn> struct Seam {
    bf16x8 qr[8];
    bf16x8 st_v0, st_v1, st_k0, st_k1; f32x4 sf0, sf1, sf2, sf3;
    f32x4 tq[16];
};
__device__ __forceinline__ int swa_jlo(int P0, int W) { const int lowk = P0 - W + 1; return lowk > 0 ? lowk / KVBLK : 0; }
#define ROW(p, pit, k0, rr) ((p) + (unsigned)(((k0) + (rr)) * (pit) + sc))
#define VMW() asm volatile("s_waitcnt vmcnt(0)" ::: "memory")
#define VMWN(n) asm volatile("s_waitcnt vmcnt(%0)" :: "i"(n) : "memory")
#define SLOAD_H(Kp, Vp, pit, k0) do { S.st_v0 = load8<TIn>(ROW(Vp, pit, k0, sr)); S.st_v1 = load8<TIn>(ROW(Vp, pit, k0, 32 + sr));              \
                         S.st_k0 = load8<TIn>(ROW(Kp, pit, k0, sr)); S.st_k1 = load8<TIn>(ROW(Kp, pit, k0, 32 + sr)); } while (0)
#define SWRITE_HK(bf) do { *(bf16x8*)(K_lds + (bf) * SHM_K + kws) = S.st_k0; *(bf16x8*)(K_lds + (bf) * SHM_K + kws + 32 * 256) = S.st_k1; } while (0)
#define SWRITE_HV(bf) do { *(bf16x8*)(V_lds + (bf) * SHM_V + vst0) = S.st_v0; *(bf16x8*)(V_lds + (bf) * SHM_V + vst1) = S.st_v1; } while (0)
#define SWRITE_H(bf) do { SWRITE_HV(bf); SWRITE_HK(bf); } while (0)
#define SLOAD_F(p, k0) do { S.sf0 = *(const f32x4*)ROW(p, D, k0, sr); S.sf1 = *(const f32x4*)(ROW(p, D, k0, sr) + 4);                \
                            S.sf2 = *(const f32x4*)ROW(p, D, k0, 32 + sr); S.sf3 = *(const f32x4*)(ROW(p, D, k0, 32 + sr) + 4); } while (0)
#define SWRITE_KF(bf) do { *(bf16x8*)(K_lds + (bf) * SHM_K + kws) = pack8(S.sf0, S.sf1); *(bf16x8*)(K_lds + (bf) * SHM_K + kws + 32 * 256) = pack8(S.sf2, S.sf3); } while (0)
#define SWRITE_VF(bf) do { *(bf16x8*)(V_lds + (bf) * SHM_V + vst0) = pack8(S.sf0, S.sf1); *(bf16x8*)(V_lds + (bf) * SHM_V + vst1) = pack8(S.sf2, S.sf3); } while (0)
template <int BIAS, class TIn, class TOut>
__device__ __forceinline__ void causal_swa_prime(const BlockRef<TIn, TOut>& cur, char* lds, Seam<TIn>& S) {
    const int W = cur.W;
    constexpr bool F32 = same_t<TIn, float>::v;
    const int tid = threadIdx.x, wid = __builtin_amdgcn_readfirstlane(tid >> 6), lane = tid & 63, r32 = lane & 31, hi = lane >> 5;
    const int sr = tid >> 4, sc = (tid & 15) * 8, kws = KSWZ(sr, sc * 2); char* K_lds = lds + 2 * SHM_V;
    const int kb0 = swa_jlo(cur.P0, W) * KVBLK;
    if (BIAS == 1 || BIAS == 3) bias_fill((float*)(lds + LDS_TAB), cur.bsrc, tid);
    for (int d0 = 0; d0 < 8; ++d0) S.qr[d0] = load8<TIn>(cur.Q + (unsigned)((wid * QBLK + r32) * cur.pq + d0 * 16 + hi * 8));
    if constexpr (F32) { SLOAD_F((const float*)cur.K, kb0); VMW(); SWRITE_KF(0); SBAR(); SLOAD_F((const float*)cur.V, kb0); }
    else { SLOAD_H(cur.K, cur.V, cur.pk, kb0); VMW(); SWRITE_HK(0); }
    __syncthreads();
}
template <int BIAS, class TIn, class TOut, class ItemFn>
__device__ __forceinline__ void causal_swa_block(const BlockRef<TIn, TOut>& cur, int Lnext, const ItemFn& itemfn, int par, char* lds, Seam<TIn>& S) {
    const int skv = cur.skv, W = cur.W;
    const float* tab = (const float*)(lds + LDS_TAB) + par * TAB_PITCH;
    constexpr bool F32 = same_t<TIn, float>::v;
    const int tid = threadIdx.x, wid = __builtin_amdgcn_readfirstlane(tid >> 6), lane = tid & 63, r32 = lane & 31, hi = lane >> 5;
    const int j_lo = swa_jlo(cur.P0, W);
    int j_hi = (cur.P0 + QB - 1) / KVBLK + 1; if (j_hi > skv / KVBLK) j_hi = skv / KVBLK;
    const int NT = j_hi - j_lo;
    const int qlo = cur.P0 + wid * QBLK, qm = qlo + r32 - 4 * hi;
    char* V_lds = lds; char* K_lds = lds + 2 * SHM_V;
    float* ws = (float*)(lds + 2 * SHM_V + 2 * SHM_K) + wid * 64; float* li_l = ws, * al_l = ws + 32;
    float m_reg = -1e30f, l_reg = 0; f32x16 o[4] = {};
    const int sr = tid >> 4, sc = (tid & 15) * 8, vst0 = v_st(sr, sc), vst1 = v_st(32 + sr, sc), kws = KSWZ(sr, sc * 2);
    const int vb0 = (int)(uintptr_t)V_lds + v_rd_base(lane);
    const TIn* Kh = cur.K; const TIn* Vh = cur.V;
#define RESC(a) do { if (__any((a) < 1.f)) { if (hi == 0) al_l[r32] = (a); asm volatile("s_waitcnt lgkmcnt(0)" ::: "memory");              \
                     for (int d_ = 0; d_ < 4; ++d_) for (int r = 0; r < 16; ++r) o[d_][r] *= al_l[crow(r, hi)]; } } while (0)
#define KBASE(t) ((j_lo + (t)) * KVBLK)
#define ACT(t) (KBASE(t) <= qlo + QBLK - 1 && KBASE(t) + KVBLK - 1 >= qlo - W + 1)
#define MASKT(P0_, P1_, t) do { const int kb_ = KBASE(t); if constexpr (BIAS == 1 || BIAS == 2) { if (!SK || ACT(t)) bias_mask_tile(P0_, P1_, qm - kb_, (unsigned)W, tab, kb_ + KVBLK - 1 > qlo || kb_ <= qlo + QBLK - 1 - W); } \
        else { if ((!SK || ACT(t)) && (kb_ + KVBLK - 1 > qlo || kb_ <= qlo + QBLK - 1 - W)) mask_tile(P0_, P1_, qm - kb_, (unsigned)W); } } while (0)
    constexpr int NQL = F32 ? 16 : 8;
    constexpr bool SK = WSKIP && !F32;
#define SEAM_K0() do { VMWN(NQL); if constexpr (F32) { SWRITE_KF(0); SBAR(); SLOAD_F((const float*)nxt.V, kbn); } else { SWRITE_HK(0); } SBAR(); } while (0)
    f32x16 pA0, pA1, pB0, pB1; float mnA, mnB, alA, alB; bf16x8 pa0, pa1, pa2, pa3;
    if constexpr (F32) { VMW(); SWRITE_VF(0); SBAR(); } else { SWRITE_HV(0); SBAR(); }
    if (NT > 1) { if constexpr (F32) SLOAD_F((const float*)Kh, KBASE(1)); else SLOAD_H(Kh, Vh, cur.pk, KBASE(1)); }
    SBAR(); qkt<0, SK>(pA0, pA1, K_lds, r32, hi, S.qr, ACT(0));
    if constexpr (F32) { if (NT > 1) { VMW(); SWRITE_KF(1); SBAR(); SLOAD_F((const float*)Vh, KBASE(1)); } }
    MASKT(pA0, pA1, 0); partialSM(pA0, pA1, m_reg, mnA, alA);
    if (NT > 1) { VMW(); if constexpr (F32) { SWRITE_VF(1); SBAR(); if (NT > 2) SLOAD_F((const float*)Kh, KBASE(2)); } else SWRITE_H(1); }
    __syncthreads();
#define HALF_STEP(PX0, PX1, mnX, alX, PY0, PY1, alY, t, KB, VB, SB) do {                                                      \
        SBAR(); qkt<KB, SK>(PX0, PX1, K_lds, r32, hi, S.qr, ACT(t));                                             \
        finishSM(PY0, PY1, alY, l_reg, pa0, pa1, pa2, pa3); SBAR();                                                           \
        if ((t) + 1 < NT) { if constexpr (F32) { VMW(); SWRITE_KF(SB); SBAR(); SLOAD_F((const float*)Vh, KBASE((t) + 1)); }  \
                            else { SLOAD_H(Kh, Vh, cur.pk, KBASE((t) + 1)); } SBAR(); }                                               \
        pv_tile<VB, SK>(o, vb0, pa0, pa1, pa2, pa3, ACT((t) - 1)); MASKT(PX0, PX1, (t)); partialSM(PX0, PX1, m_reg, mnX, alX);                                        \
        __syncthreads();                                                                                                      \
        if ((t) + 1 < NT) { VMW(); if constexpr (F32) { SWRITE_VF(SB); SBAR(); if ((t) + 2 < NT) SLOAD_F((const float*)Kh, KBASE((t) + 2)); } \
                            else { SWRITE_H(SB); } }                                                                          \
        RESC(alX); __syncthreads(); } while (0)
    for (int t = 1; t + 1 < NT; t += 2) {
        HALF_STEP(pB0, pB1, mnB, alB, pA0, pA1, alA, t, 1, 0, 0);
        HALF_STEP(pA0, pA1, mnA, alA, pB0, pB1, alB, t + 1, 0, 1, 1);
    }
    asm volatile("" : "+s"(Lnext));
    const BlockRef<TIn, TOut> nxt = itemfn(Lnext); const int kbn = swa_jlo(nxt.P0, nxt.W) * KVBLK;
    const bool even = (NT & 1) == 0;
    if (even) { SBAR(); qkt<1, SK>(pB0, pB1, K_lds, r32, hi, S.qr, ACT(NT - 1)); SBAR(); }
#define QROW(e) (nxt.Q + (size_t)(wid * QBLK + r32) * D + ((e) >> 1) * 16 + hi * 8 + ((e) & 1) * 4)
    if constexpr (F32) { SLOAD_F((const float*)nxt.K, kbn); SBAR();
#pragma unroll
        for (int e = 0; e < 8; ++e) S.tq[e] = *(const f32x4*)QROW(e); }
    else { SLOAD_H(nxt.K, nxt.V, nxt.pk, kbn); SBAR();
#pragma unroll
        for (int d0 = 0; d0 < 8; ++d0) S.qr[d0] = load8<TIn>(nxt.Q + (unsigned)((wid * QBLK + r32) * nxt.pq + d0 * 16 + hi * 8)); }
    SBAR();
    finishSM(pA0, pA1, alA, l_reg, pa0, pa1, pa2, pa3); SBAR();
    if constexpr (F32) {
#pragma unroll
        for (int e = 8; e < 16; ++e) S.tq[e] = *(const f32x4*)QROW(e); SBAR(); }
#undef QROW
    pv_tile<0, SK>(o, vb0, pa0, pa1, pa2, pa3, ACT(even ? NT - 2 : NT - 1));
    if (even) { MASKT(pB0, pB1, NT - 1); partialSM(pB0, pB1, m_reg, mnB, alB); __syncthreads(); RESC(alB);
        finishSM(pB0, pB1, alB, l_reg, pa0, pa1, pa2, pa3); SBAR(); pv_tile<1, SK>(o, vb0, pa0, pa1, pa2, pa3, ACT(NT - 1)); }
    SBAR(); SEAM_K0();
    if (hi == 0) li_l[r32] = l_reg; asm volatile("s_waitcnt lgkmcnt(0)" ::: "memory");
    float rli[16];
#pragma unroll
    for (int r = 0; r < 16; ++r) rli[r] = __builtin_amdgcn_rcpf(li_l[crow(r, hi)]);
    TOut* Ow = cur.O + (unsigned)((wid * QBLK) * cur.po); const int po = cur.po;
    if constexpr (BIAS == 1 || BIAS == 3) { if (hi == 0) { f32x2 ml = {m_reg * (1.4426950408889634f * SCALE), l_reg}; *(f32x2*)(cur.L + (unsigned)((wid * QBLK + r32) * cur.pl)) = ml; }
                          bias_fill((float*)(lds + LDS_TAB) + (par ^ 1) * TAB_PITCH, nxt.bsrc, tid); }
#pragma unroll
    for (int r = 0; r < 16; ++r) { const int orow = crow(r, hi);
#pragma unroll
        for (int d0 = 0; d0 < 4; ++d0) { const float v = o[d0][r] * rli[r];
            if constexpr (same_t<TOut, float>::v) { Ow[(unsigned)(orow * po + d0 * 32 + r32)] = v; }
            else { const float vn = __shfl_xor(v, 1);
                   if ((r32 & 1) == 0) *(unsigned*)(Ow + (unsigned)(orow * po + d0 * 32 + r32)) = cvtpk(v, vn); } } }
    if constexpr (F32) {
#pragma unroll
        for (int d0 = 0; d0 < 8; ++d0) S.qr[d0] = pack8(S.tq[2 * d0], S.tq[2 * d0 + 1]); }
    __syncthreads();
#undef RESC
#undef KBASE
#undef ACT
#undef MASKT
#undef SEAM_K0
#undef HALF_STEP
}
#undef ROW
#undef VMW
#undef VMWN
#undef SLOAD_H
#undef SWRITE_HK
#undef SWRITE_HV
#undef SWRITE_H
#undef SLOAD_F
#undef SWRITE_KF
#undef SWRITE_VF

}
constexpr int NWAVES = 8;
#ifndef MK_N_LAUNCHES
#define MK_N_LAUNCHES 1
#endif
constexpr int NPH = 13;
constexpr int N_LAUNCHES = MK_N_LAUNCHES;
static_assert(N_LAUNCHES == 1 || N_LAUNCHES == NPH, "MK_N_LAUNCHES is 1 or 13");

#ifndef FFN_I8
#define FFN_I8 1
#endif
constexpr int NB = 4, SEQ = 4096, DM = 4096, M = NB * SEQ;
constexpr int MEMLEN = 256, MROWS = NB * MEMLEN;
constexpr int NIN = 12304, NPROJ = 12288;
constexpr int DFF = 11008, NGU = 2 * DFF;
constexpr int XW = 512;
constexpr float RMS_EPS = 1e-6f;

constexpr size_t MiB = 1u << 20;
constexpr size_t WS_CTL = 0, CTL_ZERO_BYTES = 1 * MiB;
constexpr size_t WS_BT = 1 * MiB;
constexpr size_t WS_Q0K0 = 1 * MiB + 64 * 1024;
constexpr size_t WS_WIN = 2 * MiB;
constexpr size_t WS_WLR = 98 * MiB;
constexpr size_t WS_WOUT = 99 * MiB;
constexpr size_t WS_WXQ = 131 * MiB;
constexpr size_t WS_WXKV = 135 * MiB;
constexpr size_t WS_WXO = 143 * MiB;
constexpr size_t WS_MEMN = 147 * MiB;
constexpr size_t WS_XKV = 155 * MiB;
constexpr size_t WS_WGU = 160 * MiB;
constexpr size_t WS_WDN = 332 * MiB;
constexpr size_t WS_DQKV = 160 * MiB;
constexpr size_t WS_GK = 352 * MiB;
constexpr size_t WS_GQ = 384 * MiB;
constexpr size_t WS_XN = 418 * MiB;
constexpr size_t WS_MIX = 546 * MiB;
constexpr size_t WS_GV = 546 * MiB;
constexpr size_t WS_VT = 610 * MiB;
constexpr size_t WS_GR = 674 * MiB;
constexpr size_t WS_KET = 738 * MiB;
constexpr size_t WS_ATT = 770 * MiB;
constexpr size_t WS_DEC = 778 * MiB;
constexpr size_t WS_OC = 780 * MiB;
constexpr size_t WS_LSE = 972 * MiB;
constexpr size_t WS_ACT = 546 * MiB;
constexpr size_t WS_HALO = 890 * MiB;
constexpr size_t WS_XQ = 980 * MiB;
constexpr size_t WS_XO = 996 * MiB;
constexpr size_t WS_GQ2 = 1012 * MiB;
constexpr size_t WS_H2Q = 980 * MiB;
constexpr size_t WS_END = 1044 * MiB;
constexpr size_t HALO_ONE = (size_t)256 * 2 * DFF * 4;
static_assert(WS_HALO + 3 * HALO_ONE <= WS_XQ && WS_ACT + (size_t)M * DFF * 2 <= WS_HALO && WS_WDN + (size_t)DM * DFF * 2 <= WS_XN && WS_WGU + (size_t)NGU * DM * 2 <= WS_WDN, "d_ws map");
static_assert(WS_OC + (size_t)3 * M * 2048 * 2 <= WS_LSE && WS_LSE + (size_t)3 * M * 16 * 2 * 4 <= WS_XQ && WS_GQ + (size_t)M * 1024 * 2 <= WS_XN, "d_ws map 2");
constexpr int CW_QUEUE = 2048;
constexpr int CW_BAR = 4096;
constexpr size_t CTL_COLMAX = 704 * 1024;
constexpr size_t CTL_AMAX = 800 * 1024;
constexpr size_t CTL_SS = 256 * 1024;

constexpr int LDS_BYTES = 147456;
constexpr int MISC_OFF = LDS_BYTES - 256;

#define GAS __attribute__((address_space(1)))
#define LAS __attribute__((address_space(3)))
typedef unsigned short bf16;
typedef unsigned v4u __attribute__((ext_vector_type(4)));
typedef unsigned v2u __attribute__((ext_vector_type(2)));
typedef float f32x4 __attribute__((ext_vector_type(4)));
typedef float f32x2 __attribute__((ext_vector_type(2)));
typedef float f32x16 __attribute__((ext_vector_type(16)));
typedef short bf16x8 __attribute__((ext_vector_type(8)));
typedef short s16x4 __attribute__((ext_vector_type(4)));
typedef short v4i16_t __attribute__((ext_vector_type(4)));
typedef GAS unsigned gu32;
#define RLX_AGENT __ATOMIC_RELAXED, __HIP_MEMORY_SCOPE_AGENT
#define LDS_WAIT() asm volatile("s_waitcnt lgkmcnt(0)" ::: "memory")
#define VM_WAIT() asm volatile("s_waitcnt vmcnt(0)" ::: "memory")
__device__ __forceinline__ unsigned f2bf(float f) { unsigned u = __builtin_bit_cast(unsigned, f); return (u + 0x7fffu + ((u >> 16) & 1u)) >> 16; }
__device__ __forceinline__ unsigned pk2(float lo, float hi) { return f2bf(lo) | (f2bf(hi) << 16); }
__device__ __forceinline__ float bf2f(unsigned short b) { return __builtin_bit_cast(float, (unsigned)b << 16); }
__device__ __forceinline__ float bflo(unsigned w) { return __builtin_bit_cast(float, w << 16); }
__device__ __forceinline__ float bfhi(unsigned w) { return __builtin_bit_cast(float, w & 0xffff0000u); }
typedef __bf16 bf16x2_t __attribute__((ext_vector_type(2)));
__device__ __forceinline__ unsigned cvtpk_s(float lo, float hi) { f32x2 v = {lo, hi}; bf16x2_t b = __builtin_convertvector(v, bf16x2_t); return __builtin_bit_cast(unsigned, b); }
__device__ __forceinline__ bf16x8 pack8f(float a0, float a1, float a2, float a3, float a4, float a5, float a6, float a7) {
    v4u w = {cvtpk_s(a0, a1), cvtpk_s(a2, a3), cvtpk_s(a4, a5), cvtpk_s(a6, a7)}; return __builtin_bit_cast(bf16x8, w); }
#define XB_TMO      128
#define XB_XCNT(j)  (256  + 64 * (j))
#define XB_XSUB(j)  (1280 + 64 * (j))
#define XB_XGEN(j)  (2304 + 64 * (j))
#define XB_TOP      3328
#define XB_TOPGEN   3392
#define XCD_BAR_WORDS 3456
#define XB_SPIN_CAP (1u << 18)

__device__ __forceinline__ unsigned xb_ld(unsigned* p)              { return __hip_atomic_load(p, __ATOMIC_RELAXED, __HIP_MEMORY_SCOPE_AGENT); }
__device__ __forceinline__ unsigned xb_add(unsigned* p, unsigned v) { return __hip_atomic_fetch_add(p, v, __ATOMIC_RELAXED, __HIP_MEMORY_SCOPE_AGENT); }
__device__ __forceinline__ unsigned xb_xcc_id() { return (unsigned)__builtin_amdgcn_s_getreg((3 << 11) | 20) & 0xFu; }
#define XB_SPIN(cond, bar) do { unsigned _sp = 0; while (cond) { __builtin_amdgcn_s_sleep(1); \
    if ((++_sp & 255u) == 0u) { if (xb_ld(&(bar)[XB_TMO])) break; if (_sp > XB_SPIN_CAP) { atomicAdd(&(bar)[XB_TMO], 1u); break; } } } } while (0)

struct XcdBarrier {
    unsigned* bar; unsigned x;
    volatile LAS unsigned* st;
};

__device__ __forceinline__ XcdBarrier xcd_barrier_post(unsigned* bar, volatile LAS unsigned* st) {
    XcdBarrier b; b.bar = bar; b.x = xb_xcc_id(); b.st = st;
    if (threadIdx.x == 0) (void)xb_add(&bar[XB_XCNT(b.x)], 1u);
    return b;
}
__device__ __forceinline__ void xcd_barrier_complete(unsigned* bar, unsigned x, unsigned& nloc, unsigned& nx) {
    const unsigned G = gridDim.x * gridDim.y * gridDim.z;
    unsigned sum, cnt, mine, sp = 0u;
    for (;;) {
        sum = 0u; cnt = 0u; mine = 0u;
#pragma unroll
        for (unsigned j = 0; j < 16; ++j) { const unsigned c = xb_ld(&bar[XB_XCNT(j)]); sum += c; cnt += (c > 0u) ? 1u : 0u; mine = (j == x) ? c : mine; }
        if (sum == G) break;
        __builtin_amdgcn_s_sleep(1);
        if ((++sp & 255u) == 0u) { if (xb_ld(&bar[XB_TMO])) break; if (sp > XB_SPIN_CAP) { atomicAdd(&bar[XB_TMO], 1u); break; } }
    }
    nloc = mine > 0u ? mine : 1u; nx = cnt > 0u ? cnt : 1u;
}

__device__ __forceinline__ void xcd_barrier(const XcdBarrier& b) {
    asm volatile("s_waitcnt vmcnt(0)" ::: "memory");
    __syncthreads();
    if (threadIdx.x == 0) {
        unsigned* bar = b.bar;
        __builtin_amdgcn_s_waitcnt(0);
        unsigned nloc = b.st[0], nx = b.st[1];
        if (nloc == 0u) { xcd_barrier_complete(bar, b.x, nloc, nx); b.st[0] = nloc; b.st[1] = nx; }
        const unsigned old = xb_add(&bar[XB_XSUB(b.x)], 1u);
        const unsigned gen = old / nloc;
        if (old + 1u == (gen + 1u) * nloc) {
            __builtin_amdgcn_fence(__ATOMIC_RELEASE, "agent");
            asm volatile("s_waitcnt vmcnt(0)" ::: "memory");
            const unsigned og = xb_add(&bar[XB_TOP], 1u);
            const unsigned tg = og / nx;
            if (og + 1u == (tg + 1u) * nx) xb_add(&bar[XB_TOPGEN], 1u);
            else XB_SPIN(xb_ld(&bar[XB_TOPGEN]) == tg, bar);
            __builtin_amdgcn_fence(__ATOMIC_ACQUIRE, "agent");
            xb_add(&bar[XB_XGEN(b.x)], 1u);
            asm volatile("s_waitcnt vmcnt(0)" ::: "memory");
        } else {
            XB_SPIN(xb_ld(&bar[XB_XGEN(b.x)]) == gen, bar);
            __builtin_amdgcn_fence(__ATOMIC_ACQUIRE, "agent");
            asm volatile("s_waitcnt vmcnt(0)" ::: "memory");
        }
    }
    __syncthreads();
}
struct Frame {
    LAS unsigned char* lds; char* ldsg;
    volatile LAS unsigned* MISC;
    gu32* ctl;
    int wave, vcu, G;
    unsigned char* ws;
    const float* const __attribute__((address_space(4)))* kin;
    float* out;
};
__device__ __forceinline__ int tid_now() { int t = (int)threadIdx.x; asm volatile("" : "+v"(t)); return t; }
__device__ __forceinline__ float wave_sum(float v) {
#pragma unroll
    for (int o = 1; o < 64; o <<= 1) v += __shfl_xor(v, o);
    return v;
}
__device__ const unsigned char kBucket[3][132] = {
 {0,1,2,3,4,5,6,7,8,9,10,11,12,13,14,15,16,16,16,16,16,16,17,17,17,17,17,17,17,17,18,18,18,18,18,18,18,18,18,18,19,19,19,19,19,19,19,19,19,19,19,19,19,19,20,20,20,20,20,20,20,20,20,20,20,20,20,20,20,20,20,20,20,21,21,21,21,21,21,21,21,21,21,21,21,21,21,21,21,21,21,21,21,21,21,21,21,21,21,22,22,22,22,22,22,22,22,22,22,22,22,22,22,22,22,22,22,22,22,22,22,22,22,22,22,22,22,22,22,0,0,0},
 {0,4,8,12,16,16,17,17,18,18,19,19,19,19,20,20,20,20,20,21,21,21,21,21,21,22,22,22,22,22,22,22,22,22,23,23,23,23,23,23,23,23,23,23,23,23,24,24,24,24,24,24,24,24,24,24,24,24,24,24,24,24,25,25,25,25,25,25,25,25,25,25,25,25,25,25,25,25,25,25,25,25,25,26,26,26,26,26,26,26,26,26,26,26,26,26,26,26,26,26,26,26,26,26,26,26,26,26,26,26,26,26,26,27,27,27,27,27,27,27,27,27,27,27,27,27,27,27,27,0,0,0},
 {0,16,18,19,20,21,21,22,22,23,23,23,24,24,24,24,25,25,25,25,25,26,26,26,26,26,26,26,26,27,27,27,27,27,27,27,27,27,27,28,28,28,28,28,28,28,28,28,28,28,28,28,29,29,29,29,29,29,29,29,29,29,29,29,29,29,29,29,29,29,30,30,30,30,30,30,30,30,30,30,30,30,30,30,30,30,30,30,30,30,30,30,30,30,30,31,31,31,31,31,31,31,31,31,31,31,31,31,31,31,31,31,31,31,31,31,31,31,31,31,31,31,31,31,31,31,31,31,31,0,0,0}};

constexpr int TR_SCR = 17408;
__device__ __forceinline__ void tr_item(const float* W, int ldw, bf16* WT, int ldt, int src_c0, int dst_r0, int nvalid, const float* gain, LAS float* scr, int kb, int lane) {
    const int k0 = 64 * kb, a = lane >> 4, c4 = 4 * (lane & 15);
#pragma unroll 8
    for (int i = 0; i < 16; ++i) { const int kk = 4 * i + a; f32x4 v = *(const GAS f32x4*)(W + (size_t)(k0 + kk) * ldw + src_c0 + c4); if (gain) v = v * gain[k0 + kk];
        LAS float* d = scr + kk * 65 + c4; d[0] = v.x; d[1] = v.y; d[2] = v.z; d[3] = v.w; }
    LDS_WAIT(); asm volatile("" ::: "memory");
    const int c = lane & 7;
#pragma unroll
    for (int j = 0; j < 8; ++j) { const int n = (lane >> 3) + 8 * j; const LAS float* s = scr + (8 * c) * 65 + n;
        v4u o; o.x = pk2(s[0 * 65], s[1 * 65]); o.y = pk2(s[2 * 65], s[3 * 65]); o.z = pk2(s[4 * 65], s[5 * 65]); o.w = pk2(s[6 * 65], s[7 * 65]);
        if (n < nvalid) *(GAS v4u*)(WT + (size_t)(dst_r0 + n) * ldt + k0 + 8 * c) = o; }
    LDS_WAIT(); asm volatile("" ::: "memory");
}
__device__ __forceinline__ void rms_row_to_bf16(const float* xrow, const float* g, bf16* orow, int lane) {
    const GAS f32x4* xr = (const GAS f32x4*)xrow + lane; const GAS f32x4* gr = (const GAS f32x4*)g + lane;
    f32x4 v[16]; float s = 0.f;
#pragma unroll
    for (int j = 0; j < 16; ++j) { v[j] = xr[64 * j]; s += (v[j].x * v[j].x + v[j].y * v[j].y) + (v[j].z * v[j].z + v[j].w * v[j].w); }
    const float r = 1.0f / sqrtf(wave_sum(s) * (1.0f / 4096.0f) + RMS_EPS);
    GAS v2u* o8 = (GAS v2u*)orow + lane;
#pragma unroll
    for (int j = 0; j < 16; ++j) { const f32x4 gg = gr[64 * j]; v2u o; o.x = pk2(v[j].x * r * gg.x, v[j].y * r * gg.y); o.y = pk2(v[j].z * r * gg.z, v[j].w * r * gg.w); o8[64 * j] = o; }
}

__device__ __forceinline__ void p0_first_token(Frame& F) {
    const int tid = tid_now(), lane = tid & 63, w = F.wave;
    LAS float* red = (LAS float*)F.lds;
    const float* x = F.kin[0]; const float* g = F.kin[3]; const float* W = F.kin[4];
    float* Q0K0 = (float*)(F.ws + WS_Q0K0);
    for (int cb = blockIdx.x; cb < 256; cb += F.G) {
        float xv[4][8]; float gg[8]; f32x4 w0[8], w1[8];
#pragma unroll
        for (int i = 0; i < 8; ++i) { gg[i] = g[tid + 512 * i]; const GAS f32x4* wp = (const GAS f32x4*)(W + (size_t)(tid + 512 * i) * NIN + 8 * cb); w0[i] = wp[0]; w1[i] = wp[1];
#pragma unroll
            for (int b = 0; b < 4; ++b) xv[b][i] = x[(size_t)b * SEQ * DM + tid + 512 * i]; }
        float acc[4][8], ss[4];
#pragma unroll
        for (int b = 0; b < 4; ++b) { ss[b] = 0.f;
#pragma unroll
            for (int c = 0; c < 8; ++c) acc[b][c] = 0.f; }
#pragma unroll
        for (int i = 0; i < 8; ++i) { const float wv[8] = {w0[i].x, w0[i].y, w0[i].z, w0[i].w, w1[i].x, w1[i].y, w1[i].z, w1[i].w};
#pragma unroll
            for (int b = 0; b < 4; ++b) { ss[b] += xv[b][i] * xv[b][i]; const float xg = xv[b][i] * gg[i];
#pragma unroll
                for (int c = 0; c < 8; ++c) acc[b][c] += xg * wv[c]; } }
#pragma unroll
        for (int b = 0; b < 4; ++b) { const float s2 = wave_sum(ss[b]); if (lane == 0) red[w * 40 + 32 + b] = s2;
#pragma unroll
            for (int c = 0; c < 8; ++c) { const float s = wave_sum(acc[b][c]); if (lane == 0) red[w * 40 + b * 8 + c] = s; } }
        __syncthreads();
        if (tid < 32) { float s = 0.f, q = 0.f;
#pragma unroll
            for (int k = 0; k < 8; ++k) { s += red[k * 40 + tid]; q += red[k * 40 + 32 + (tid >> 3)]; }
            Q0K0[(tid >> 3) * 2048 + 8 * cb + (tid & 7)] = s * (1.0f / sqrtf(q * (1.0f / 4096.0f) + RMS_EPS)); }
        __syncthreads();
    }
}
__device__ __forceinline__ void p0_prologue(Frame& F) {
    const int tid = tid_now(), lane = tid & 63;
    LAS float* scr = (LAS float*)(F.lds + F.wave * TR_SCR);
    const int gw = F.vcu * NWAVES + F.wave, NGW = F.G * NWAVES;
    bf16* Win = (bf16*)(F.ws + WS_WIN); bf16* Wlr = (bf16*)(F.ws + WS_WLR); bf16* Wout = (bf16*)(F.ws + WS_WOUT); bf16* Wxq = (bf16*)(F.ws + WS_WXQ); bf16* Wxkv = (bf16*)(F.ws + WS_WXKV); bf16* Wxo = (bf16*)(F.ws + WS_WXO);
    constexpr int I_INA = 64 * (4096 / 64), I_INB = 64 * (8192 / 64), I_LR = 64, I_OUT = 64 * 64, I_XQ = 64 * 8, I_XO = 8 * 64;
    constexpr int NIT = I_INA + I_INB + I_LR + I_OUT + 3 * I_XQ + I_XO;
    for (int it = gw; it < NIT; it += NGW) {
        int r = it;
        if (r < I_INA) { const int nb = r % 64, kb = r / 64; tr_item(F.kin[4], NIN, Win, DM, 64 * nb, 64 * nb, 64, nullptr, scr, kb, lane); continue; } r -= I_INA;
        if (r < I_INB) { const int nb = r % 128, kb = r / 128; tr_item(F.kin[4], NIN, Win, DM, 4112 + 64 * nb, 4096 + 64 * nb, 64, nullptr, scr, kb, lane); continue; } r -= I_INB;
        if (r < I_LR) { tr_item(F.kin[4], NIN, Wlr, DM, 4096, 0, 16, nullptr, scr, r, lane); continue; } r -= I_LR;
        if (r < I_OUT) { const int nb = r % 64, kb = r / 64; tr_item(F.kin[8], DM, Wout, DM, 64 * nb, 64 * nb, 64, nullptr, scr, kb, lane); continue; } r -= I_OUT;
        if (r < I_XQ) { const int nb = r % 8, kb = r / 8; tr_item(F.kin[11], XW, Wxq, DM, 64 * nb, 64 * nb, 64, F.kin[9], scr, kb, lane); continue; } r -= I_XQ;
        if (r < I_XQ) { const int nb = r % 8, kb = r / 8; tr_item(F.kin[12], XW, Wxkv, DM, 64 * nb, 64 * nb, 64, nullptr, scr, kb, lane); continue; } r -= I_XQ;
        if (r < I_XQ) { const int nb = r % 8, kb = r / 8; tr_item(F.kin[13], XW, Wxkv, DM, 64 * nb, 512 + 64 * nb, 64, nullptr, scr, kb, lane); continue; } r -= I_XQ;
        { const int nb = r % 64, kb = r / 64; tr_item(F.kin[14], DM, Wxo, XW, 64 * nb, 64 * nb, 64, nullptr, scr, kb, lane); }
    }
    bf16* XN = (bf16*)(F.ws + WS_XN); bf16* MEMN = (bf16*)(F.ws + WS_MEMN);
    for (int m = gw; m < M + MROWS; m += NGW) {
        if (m < M) rms_row_to_bf16(F.kin[0] + (size_t)m * DM, F.kin[3], XN + (size_t)m * DM, lane);
        else rms_row_to_bf16(F.kin[1] + (size_t)(m - M) * DM, F.kin[10], MEMN + (size_t)(m - M) * DM, lane);
    }
    float* BT = (float*)(F.ws + WS_BT);
    for (int i = blockIdx.x * 512 + tid; i < 3 * 16 * 132; i += F.G * 512) { const int rel = i % 132, h = (i / 132) % 16, cfg = i / (132 * 16);
        BT[i] = rel < 129 ? F.kin[2][kBucket[cfg][rel] * 16 + h] * 11.313708498984761f : 0.f; }
}
__device__ __forceinline__ void absmax_item(const float* W, int ldw, int src_c0, const float* gain, unsigned* cmax, int kb, int lane) {
    const int k0 = 64 * kb, a = lane >> 4, c4 = 4 * (lane & 15);
    f32x4 m = {0.f, 0.f, 0.f, 0.f};
#pragma unroll 8
    for (int i = 0; i < 16; ++i) { const int kk = 4 * i + a; const f32x4 v = *(const GAS f32x4*)(W + (size_t)(k0 + kk) * ldw + src_c0 + c4) * gain[k0 + kk];
        m.x = fmaxf(m.x, fabsf(v.x)); m.y = fmaxf(m.y, fabsf(v.y)); m.z = fmaxf(m.z, fabsf(v.z)); m.w = fmaxf(m.w, fabsf(v.w)); }
#pragma unroll
    for (int o = 16; o < 64; o <<= 1) { m.x = fmaxf(m.x, __shfl_xor(m.x, o)); m.y = fmaxf(m.y, __shfl_xor(m.y, o)); m.z = fmaxf(m.z, __shfl_xor(m.z, o)); m.w = fmaxf(m.w, __shfl_xor(m.w, o)); }
    if (lane < 16) { unsigned* p = cmax + src_c0 + c4; atomicMax(p, __float_as_uint(m.x)); atomicMax(p + 1, __float_as_uint(m.y)); atomicMax(p + 2, __float_as_uint(m.z)); atomicMax(p + 3, __float_as_uint(m.w)); }
}
__device__ __forceinline__ void quant_item(const float* W, int ldw, signed char* WQ, int ldq, int src_c0, int dst_r0, const float* gain, const unsigned* cmax, LAS float* scr, int kb, int lane) {
    const int k0 = 64 * kb, a = lane >> 4, c4 = 4 * (lane & 15);
#pragma unroll 8
    for (int i = 0; i < 16; ++i) { const int kk = 4 * i + a; const f32x4 v = *(const GAS f32x4*)(W + (size_t)(k0 + kk) * ldw + src_c0 + c4) * gain[k0 + kk];
        LAS float* d = scr + kk * 65 + c4; d[0] = v.x; d[1] = v.y; d[2] = v.z; d[3] = v.w; }
    LDS_WAIT(); asm volatile("" ::: "memory");
    const int c = lane & 3;
#pragma unroll
    for (int j = 0; j < 4; ++j) { const int n = (lane >> 2) + 16 * j; const LAS float* s = scr + (16 * c) * 65 + n;
        const float cm = __uint_as_float(cmax[src_c0 + n]); const float inv = cm > 0.f ? 127.0f / cm : 0.f;
        unsigned wq[4];
#pragma unroll
        for (int q = 0; q < 4; ++q) { unsigned acc = 0u;
#pragma unroll
            for (int e = 0; e < 4; ++e) { const float r = fminf(fmaxf(__builtin_rintf(s[(4 * q + e) * 65] * inv), -127.f), 127.f); acc |= ((unsigned)(int)r & 0xffu) << (8 * e); }
            wq[q] = acc; }
        v4u o = {wq[0], wq[1], wq[2], wq[3]};
        *(GAS v4u*)(WQ + (size_t)(dst_r0 + n) * ldq + k0 + 16 * c) = o; }
    LDS_WAIT(); asm volatile("" ::: "memory");
}

constexpr int FW_IG = 64 * (DFF / 64), FW_ID = (DFF / 64) * 64, FW_ALL = 2 * FW_IG + FW_ID;
constexpr int FW_P6_LO = 2 * FW_IG - 3584, FW_P6_HI = 2 * FW_IG;
constexpr int FW_P9_LO = FW_ALL - (FFN_I8 ? 4608 : 8192), FW_P9_HI = FW_ALL;
template <int MODE  >
__device__ __forceinline__ void ffn_weight_item(Frame& F, int r, LAS float* scr, int lane) {
    bf16* Wgu = (bf16*)(F.ws + WS_WGU); bf16* Wdn = (bf16*)(F.ws + WS_WDN); unsigned* cmax = (unsigned*)(F.ws + WS_CTL + CTL_COLMAX);
    if (r < 2 * FW_IG) { const int up = r >= FW_IG ? 1 : 0; const int rr = r - up * FW_IG; const int nb = rr % 172, kb = rr / 172, c0 = 64 * nb; const float* W = up ? F.kin[17] : F.kin[16];
        const int drow = 256 * (c0 >> 7) + 128 * up + (c0 & 127);
        if constexpr (MODE == 1) absmax_item(W, DFF, c0, F.kin[15], cmax + up * DFF, kb, lane);
        else if constexpr (FFN_I8) quant_item(W, DFF, (signed char*)Wgu, DM, c0, drow, F.kin[15], cmax + up * DFF, scr, kb, lane);
        else tr_item(W, DFF, Wgu, DM, c0, drow, 64, F.kin[15], scr, kb, lane);
        return; }
    if constexpr (MODE == 0) { r -= 2 * FW_IG; const int nb = r % 64, kb = r / 64; tr_item(F.kin[20], DM, Wdn, DFF, 64 * nb, 64 * nb, 64, nullptr, scr, kb, lane); }
}
template <int MODE> __device__ __forceinline__ void ffn_weights(Frame& F, int lo, int hi, int iw, int nw) {
    const int lane = tid_now() & 63; LAS float* scr = (LAS float*)(F.lds + F.wave * TR_SCR);
    for (int it = lo + iw; it < hi; it += nw) ffn_weight_item<MODE>(F, it, scr, lane);
}
constexpr int PP = 520;
constexpr int PREP_GLR = 0, PREP_QM = 8192, PREP_KM = 8192 + 64 * PP * 2;
static_assert(PREP_KM + 64 * PP * 2 <= MISC_OFF, "prep LDS");
__device__ __forceinline__ void gla_prep_unit(Frame& F, int b, int n) {
    const int tid = tid_now(), lane = tid & 63, w = F.wave;
    const int t0 = b * SEQ + 64 * n;
    const bf16* XN = (const bf16*)(F.ws + WS_XN); const bf16* Wlr = (const bf16*)(F.ws + WS_WLR);
    const bf16* GQ = (const bf16*)(F.ws + WS_GQ); bf16* GQ2 = (bf16*)(F.ws + WS_GQ2); const bf16* GK = (const bf16*)(F.ws + WS_GK);
    bf16* KET = (bf16*)(F.ws + WS_KET); bf16* ATT = (bf16*)(F.ws + WS_ATT); float* DEC = (float*)(F.ws + WS_DEC);
    LAS float* glr = (LAS float*)(F.lds + PREP_GLR);
    LAS bf16* QMs = (LAS bf16*)(F.lds + PREP_QM); LAS bf16* KMs = (LAS bf16*)(F.lds + PREP_KM);
    {
        const int rg = w & 3, kh = w >> 2, rr = lane & 15, kg = lane >> 4;
        const bf16* ap = XN + (size_t)(t0 + 16 * rg + rr) * DM + kh * 2048 + 8 * kg; const bf16* bp = Wlr + (size_t)rr * DM + kh * 2048 + 8 * kg;
        f32x4 acc = {0.f, 0.f, 0.f, 0.f};
#pragma unroll 8
        for (int s = 0; s < 64; ++s) { const bf16x8 a = *(const GAS bf16x8*)(ap + 32 * s), bq = *(const GAS bf16x8*)(bp + 32 * s); acc = __builtin_amdgcn_mfma_f32_16x16x32_bf16(a, bq, acc, 0, 0, 0); }
#pragma unroll
        for (int i = 0; i < 4; ++i) glr[(kh * 64 + 16 * rg + 4 * kg + i) * 16 + rr] = acc[i];
    }
    __syncthreads();
    for (int i = tid; i < 1024; i += 512) glr[i] += glr[1024 + i];
    __syncthreads();
    const int cid = (b * 64 + n) * 4;
    for (int hp = 0; hp < 2; ++hp) {
        {
            const int col = hp * 512 + tid, h = col >> 8, dk = col & 255;
            float w2[16];
#pragma unroll
            for (int j = 0; j < 16; ++j) w2[j] = F.kin[5][j * 1024 + col];
            const float bg = F.kin[6][col];
            float bc[64]; float run = 0.f;
#pragma unroll
            for (int c = 0; c < 64; ++c) {
                const LAS f32x4* gp = (const LAS f32x4*)(glr + c * 16); const f32x4 g0 = gp[0], g1 = gp[1], g2 = gp[2], g3 = gp[3];
                float z = bg;
                z += g0.x * w2[0] + g0.y * w2[1] + g0.z * w2[2] + g0.w * w2[3]; z += g1.x * w2[4] + g1.y * w2[5] + g1.z * w2[6] + g1.w * w2[7];
                z += g2.x * w2[8] + g2.y * w2[9] + g2.z * w2[10] + g2.w * w2[11]; z += g3.x * w2[12] + g3.y * w2[13] + g3.z * w2[14] + g3.w * w2[15];
                const float ls = fminf(z, 0.f) - __logf(1.0f + __expf(-fabsf(z)));
                run += ls * (1.0f / 16.0f); bc[c] = run;
            }
            const float blast = bc[63], bmid = bc[32];
            unsigned kep[32];
            const bf16* qp = GQ + (size_t)t0 * 1024 + col; bf16* qo = GQ2 + (size_t)t0 * 1024 + col; const bf16* kp = GK + (size_t)t0 * 1024 + col;
#pragma unroll
            for (int c2 = 0; c2 < 32; ++c2) {
                const int c = 2 * c2;
                const float qa = bf2f(qp[(size_t)c * 1024]) * (1.0f / 16.0f), ka = bf2f(kp[(size_t)c * 1024]);
                const float qb = bf2f(qp[(size_t)(c + 1) * 1024]) * (1.0f / 16.0f), kb = bf2f(kp[(size_t)(c + 1) * 1024]);
                const unsigned qt = cvtpk_s(qa * __expf(bc[c]), qb * __expf(bc[c + 1]));
                qo[(size_t)c * 1024] = (bf16)(qt & 0xffffu); qo[(size_t)(c + 1) * 1024] = (bf16)(qt >> 16);
                kep[c2] = cvtpk_s(ka * __expf(blast - bc[c]), kb * __expf(blast - bc[c + 1]));
                const unsigned qm = cvtpk_s(qa * __expf(bc[c] - bmid), qb * __expf(bc[c + 1] - bmid));
                const unsigned km = cvtpk_s(ka * __expf(bmid - bc[c]), kb * __expf(bmid - bc[c + 1]));
                QMs[c * PP + tid] = (bf16)(qm & 0xffffu); QMs[(c + 1) * PP + tid] = (bf16)(qm >> 16);
                KMs[c * PP + tid] = (bf16)(km & 0xffffu); KMs[(c + 1) * PP + tid] = (bf16)(km >> 16);
            }
            bf16* kt = KET + ((size_t)(cid + h) * 256 + dk) * 64;
#pragma unroll
            for (int i = 0; i < 8; ++i) { v4u o = {kep[4 * i], kep[4 * i + 1], kep[4 * i + 2], kep[4 * i + 3]}; *(GAS v4u*)(kt + 8 * i) = o; }
            DEC[(size_t)(cid + h) * 256 + dk] = __expf(blast);
        }
        __syncthreads();
        {
            const int rr = lane & 15, kg = lane >> 4;
#pragma unroll
            for (int q4 = 0; q4 < 4; ++q4) {
                const int id = w * 4 + q4, hl = id >> 4, mt = (id >> 2) & 3, nt = id & 3;
                const LAS bf16* ap = KMs + (16 * mt + rr) * PP + hl * 256 + 8 * kg; const LAS bf16* bp = QMs + (16 * nt + rr) * PP + hl * 256 + 8 * kg;
                f32x4 acc = {0.f, 0.f, 0.f, 0.f};
#pragma unroll
                for (int s = 0; s < 8; ++s) { const bf16x8 a = *(const LAS bf16x8*)(ap + 32 * s), bq = *(const LAS bf16x8*)(bp + 32 * s); acc = __builtin_amdgcn_mfma_f32_16x16x32_bf16(a, bq, acc, 0, 0, 0); }
                const int c = 16 * nt + rr, cp0 = 16 * mt + 4 * kg;
                v2u o; o.x = pk2(cp0 <= c ? acc[0] : 0.f, cp0 + 1 <= c ? acc[1] : 0.f); o.y = pk2(cp0 + 2 <= c ? acc[2] : 0.f, cp0 + 3 <= c ? acc[3] : 0.f);
                *(GAS v2u*)(ATT + ((size_t)(cid + 2 * hp + hl) * 64 + c) * 64 + cp0) = o;
            }
        }
        __syncthreads();
    }
    if (n == 0 && w < 4) {
        const float* q0 = (const float*)(F.ws + WS_Q0K0) + b * 2048 + w * 256; const float* k0 = q0 + 1024; float s = 0.f;
#pragma unroll
        for (int i = 0; i < 4; ++i) s += q0[lane + 64 * i] * k0[lane + 64 * i];
        s = wave_sum(s) * (1.0f / 16.0f);
        if (lane == 0) ATT[(size_t)(cid + w) * 4096] = (bf16)f2bf(s);
    }
}

constexpr int CH_QT = 0, CH_QP = 528, CH_KE = 64 * CH_QP, CH_KP = 144, CH_AT = CH_KE + 256 * CH_KP, CH_DC = CH_AT + 64 * CH_KP, CH_VS = CH_DC + 1024, CH_END = CH_VS + 16384;
static_assert(CH_END <= MISC_OFF, "chain LDS");
__device__ __forceinline__ void gla_chain_unit(Frame& F, int b, int h, int qd) {
    const int tid = tid_now(), lane = tid & 63, w = F.wave, r32 = lane & 31, hi = lane >> 5;
    const bool helper = w >= 4; const int htid = tid - 256;
    const bf16* GQ = (const bf16*)(F.ws + WS_GQ2); const bf16* KET = (const bf16*)(F.ws + WS_KET); const bf16* ATT = (const bf16*)(F.ws + WS_ATT);
    const float* DEC = (const float*)(F.ws + WS_DEC); const bf16* GV = (const bf16*)(F.ws + WS_GV); bf16* ORAW = (bf16*)(F.ws + WS_XN);
    LAS unsigned char* L = F.lds;
    if (helper) {
        v4u st[23];
#define CH_LOADS(nn) do { const int ch_ = (b * 64 + (nn)) * 4 + h; const int t0_ = b * SEQ + 64 * (nn); \
            _Pragma("unroll") for (int i = 0; i < 8; ++i) { const int id = htid + 256 * i; st[i] = *(const GAS v4u*)(GQ + (size_t)(t0_ + (id >> 5)) * 1024 + h * 256 + 8 * (id & 31)); } \
            _Pragma("unroll") for (int i = 0; i < 8; ++i) { const int id = htid + 256 * i; st[8 + i] = *(const GAS v4u*)(KET + ((size_t)ch_ * 256 + (id >> 3)) * 64 + 8 * (id & 7)); } \
            _Pragma("unroll") for (int i = 0; i < 2; ++i) { const int id = htid + 256 * i; st[16 + i] = *(const GAS v4u*)(ATT + ((size_t)ch_ * 64 + (id >> 3)) * 64 + 8 * (id & 7)); } \
            _Pragma("unroll") for (int i = 0; i < 4; ++i) { const int id = htid + 256 * i; st[19 + i] = *(const GAS v4u*)(GV + (size_t)(t0_ + (id >> 4)) * 2048 + h * 512 + qd * 128 + 8 * (id & 15)); } \
            st[18] = *(const GAS v4u*)(DEC + (size_t)ch_ * 256 + 4 * (htid & 63)); } while (0)
        CH_LOADS(0);
        for (int n = 0; n < 64; ++n) {
#pragma unroll
            for (int i = 0; i < 8; ++i) { const int id = htid + 256 * i; *(LAS v4u*)(L + CH_QT + (id >> 5) * CH_QP + 16 * (id & 31)) = st[i]; }
#pragma unroll
            for (int i = 0; i < 8; ++i) { const int id = htid + 256 * i; *(LAS v4u*)(L + CH_KE + (id >> 3) * CH_KP + 16 * (id & 7)) = st[8 + i]; }
#pragma unroll
            for (int i = 0; i < 2; ++i) { const int id = htid + 256 * i; *(LAS v4u*)(L + CH_AT + (id >> 3) * CH_KP + 16 * (id & 7)) = st[16 + i]; }
#pragma unroll
            for (int i = 0; i < 4; ++i) { const int id = htid + 256 * i; *(LAS v4u*)(L + CH_VS + att::v_st(id >> 4, 8 * (id & 15))) = st[19 + i]; }
            if (htid < 64) *(LAS v4u*)(L + CH_DC + 16 * htid) = st[18];
            __syncthreads();
            if (n + 1 < 64) CH_LOADS(n + 1);
            __syncthreads();
        }
#undef CH_LOADS
    } else {
        f32x16 S[8];
#pragma unroll
        for (int i = 0; i < 8; ++i)
#pragma unroll
            for (int r = 0; r < 16; ++r) S[i][r] = 0.f;
        for (int n = 0; n < 64; ++n) {
            __syncthreads();
            const int t0 = b * SEQ + 64 * n;
            bf16x8 vc[4];
#pragma unroll
            for (int s = 0; s < 4; ++s) { const LAS unsigned char* vp = L + CH_VS + att::v_rd_base(lane) + w * 512 + s * 4096;
                const s16x4 lo = __builtin_bit_cast(s16x4, __builtin_amdgcn_ds_read_tr16_b64_v4i16((LAS v4i16_t*)vp)), hh = __builtin_bit_cast(s16x4, __builtin_amdgcn_ds_read_tr16_b64_v4i16((LAS v4i16_t*)(vp + 2048)));
                vc[s] = (bf16x8){lo[0], lo[1], lo[2], lo[3], hh[0], hh[1], hh[2], hh[3]}; }
            f32x16 O[2];
#pragma unroll
            for (int r = 0; r < 16; ++r) { O[0][r] = 0.f; O[1][r] = 0.f; }
#pragma unroll
            for (int mt = 0; mt < 8; ++mt)
#pragma unroll
                for (int sp = 0; sp < 2; ++sp) {
                    const bf16x8 bs = pack8f(S[mt][8 * sp], S[mt][8 * sp + 1], S[mt][8 * sp + 2], S[mt][8 * sp + 3], S[mt][8 * sp + 4], S[mt][8 * sp + 5], S[mt][8 * sp + 6], S[mt][8 * sp + 7]);
#pragma unroll
                    for (int mc = 0; mc < 2; ++mc) {
                        const LAS unsigned char* ap = L + CH_QT + (32 * mc + r32) * CH_QP + (32 * mt + 16 * sp + 4 * hi) * 2;
                        const s16x4 lo = *(const LAS s16x4*)ap, hh = *(const LAS s16x4*)(ap + 16);
                        const bf16x8 a = {lo[0], lo[1], lo[2], lo[3], hh[0], hh[1], hh[2], hh[3]};
                        O[mc] = __builtin_amdgcn_mfma_f32_32x32x16_bf16(a, bs, O[mc], 0, 0, 0);
                    }
                }
#pragma unroll
            for (int s = 0; s < 4; ++s)
#pragma unroll
                for (int mc = 0; mc < 2; ++mc) { const bf16x8 a = *(const LAS bf16x8*)(L + CH_AT + (32 * mc + r32) * CH_KP + (16 * s + 8 * hi) * 2); O[mc] = __builtin_amdgcn_mfma_f32_32x32x16_bf16(a, vc[s], O[mc], 0, 0, 0); }
            bf16* rowbase = ORAW + (size_t)t0 * 2048 + h * 512 + qd * 128 + 32 * w;
            const unsigned loff = (unsigned)(r32 + hi * 4 * 2048);
#pragma unroll
            for (int mc = 0; mc < 2; ++mc)
#pragma unroll
                for (int r = 0; r < 16; ++r) { const float v = O[mc][r], vn = __shfl_xor(v, 1);
                    if ((r32 & 1) == 0) *(unsigned*)(rowbase + (32 * mc + (r & 3) + 8 * (r >> 2)) * 2048 + loff) = cvtpk_s(v, vn); }
#pragma unroll
            for (int mt = 0; mt < 8; ++mt) {
#pragma unroll
                for (int j = 0; j < 4; ++j) { const f32x4 d4 = *(const LAS f32x4*)(L + CH_DC + (32 * mt + 8 * j + 4 * hi) * 4);
                    S[mt][4 * j] *= d4.x; S[mt][4 * j + 1] *= d4.y; S[mt][4 * j + 2] *= d4.z; S[mt][4 * j + 3] *= d4.w; }
#pragma unroll
                for (int s = 0; s < 4; ++s) { const bf16x8 a = *(const LAS bf16x8*)(L + CH_KE + (32 * mt + r32) * CH_KP + (16 * s + 8 * hi) * 2); S[mt] = __builtin_amdgcn_mfma_f32_32x32x16_bf16(a, vc[s], S[mt], 0, 0, 0); }
            }
            __syncthreads();
        }
    }
}

__device__ __forceinline__ void mix_row(Frame& F, int t, int lane) {
    const bf16* ORAW = (const bf16*)(F.ws + WS_XN); const bf16* GR = (const bf16*)(F.ws + WS_GR); const bf16* OC = (const bf16*)(F.ws + WS_OC); const float* LSE = (const float*)(F.ws + WS_LSE);
    bf16* MIX = (bf16*)(F.ws + WS_MIX);
#pragma unroll
    for (int h = 0; h < 4; ++h) {
        const v4u ow = *(const GAS v4u*)(ORAW + (size_t)t * 2048 + h * 512 + 8 * lane); const f32x4 o0 = {bflo(ow.x), bfhi(ow.x), bflo(ow.y), bfhi(ow.y)}, o1 = {bflo(ow.z), bfhi(ow.z), bflo(ow.w), bfhi(ow.w)};
        const float ss = wave_sum((o0.x * o0.x + o0.y * o0.y) + (o0.z * o0.z + o0.w * o0.w) + (o1.x * o1.x + o1.y * o1.y) + (o1.z * o1.z + o1.w * o1.w));
        const float r = 1.0f / sqrtf(ss * (1.0f / 512.0f) + RMS_EPS);
        const GAS f32x4* gp = (const GAS f32x4*)F.kin[7] + 2 * lane; const f32x4 g0 = gp[0], g1 = gp[1];
        const v4u gw = *(const GAS v4u*)(GR + (size_t)t * 2048 + h * 512 + 8 * lane);
        float y[8] = {o0.x * r * g0.x, o0.y * r * g0.y, o0.z * r * g0.z, o0.w * r * g0.w, o1.x * r * g1.x, o1.y * r * g1.y, o1.z * r * g1.z, o1.w * r * g1.w};
        const float gv[8] = {bflo(gw.x), bfhi(gw.x), bflo(gw.y), bfhi(gw.y), bflo(gw.z), bfhi(gw.z), bflo(gw.w), bfhi(gw.w)};
#pragma unroll
        for (int e = 0; e < 8; ++e) y[e] *= gv[e] / (1.0f + __expf(-gv[e]));
        v4u o = {pk2(y[0], y[1]), pk2(y[2], y[3]), pk2(y[4], y[5]), pk2(y[6], y[7])};
        *(GAS v4u*)(MIX + (size_t)t * DM + h * 512 + 8 * lane) = o;
    }
    {
        const int hd = lane >> 2;
        float m2[3], l[3];
#pragma unroll
        for (int c = 0; c < 3; ++c) { const f32x2 v = *(const GAS f32x2*)(LSE + (((size_t)c * M + t) * 16 + hd) * 2); m2[c] = v.x; l[c] = v.y; }
        const float mx = fmaxf(m2[0], fmaxf(m2[1], m2[2]));
        float wgt[3]; float den = 0.f;
#pragma unroll
        for (int c = 0; c < 3; ++c) { wgt[c] = __builtin_amdgcn_exp2f(m2[c] - mx) * l[c]; den += wgt[c]; }
        const float rden = 1.0f / den;
        float acc[32];
#pragma unroll
        for (int e = 0; e < 32; ++e) acc[e] = 0.f;
#pragma unroll
        for (int c = 0; c < 3; ++c) { const float wc = wgt[c] * rden; const GAS v4u* p = (const GAS v4u*)(OC + (size_t)c * M * 2048 + ((size_t)((t >> 12) * 16 + hd) * SEQ + (t & 4095)) * 128 + 32 * (lane & 3));
#pragma unroll
            for (int q = 0; q < 4; ++q) { const v4u v = p[q];
                acc[8 * q + 0] += wc * bflo(v.x); acc[8 * q + 1] += wc * bfhi(v.x); acc[8 * q + 2] += wc * bflo(v.y); acc[8 * q + 3] += wc * bfhi(v.y);
                acc[8 * q + 4] += wc * bflo(v.z); acc[8 * q + 5] += wc * bfhi(v.z); acc[8 * q + 6] += wc * bflo(v.w); acc[8 * q + 7] += wc * bfhi(v.w); } }
        GAS v4u* op = (GAS v4u*)(MIX + (size_t)t * DM + 2048 + 32 * lane);
#pragma unroll
        for (int q = 0; q < 4; ++q) { v4u o = {pk2(acc[8 * q], acc[8 * q + 1]), pk2(acc[8 * q + 2], acc[8 * q + 3]), pk2(acc[8 * q + 4], acc[8 * q + 5]), pk2(acc[8 * q + 6], acc[8 * q + 7])}; op[q] = o; }
    }
}
__device__ __forceinline__ void halo_fix(Frame& F) {
    const int tid = tid_now();
    const float* GF = (const float*)(F.ws + WS_HALO); const float* UF = GF + HALO_ONE / 4; const float* GL = UF + HALO_ONE / 4;
    bf16* ACT = (bf16*)(F.ws + WS_ACT); const float* cw = F.kin[18]; const float* cb = F.kin[19];
    const int total = 256 * 2 * (DFF / 4);
    for (int i = blockIdx.x * 512 + tid; i < total; i += F.G * 512) {
        const int c4 = i % (DFF / 4), j = (i / (DFF / 4)) & 1, blk = i / (DFF / 2), ch = 4 * c4;
        const bool first = (blk & 63) == 0;
        const f32x4 g0 = *(const GAS f32x4*)(GF + ((size_t)blk * 2 + j) * DFF + ch), uu = *(const GAS f32x4*)(UF + ((size_t)blk * 2 + j) * DFF + ch);
        const f32x4 z = {0.f, 0.f, 0.f, 0.f};
        f32x4 g1, g2;
        if (j == 0) { g1 = first ? z : *(const GAS f32x4*)(GL + ((size_t)(blk - 1) * 2 + 1) * DFF + ch); g2 = first ? z : *(const GAS f32x4*)(GL + ((size_t)(blk - 1) * 2 + 0) * DFF + ch); }
        else { g1 = *(const GAS f32x4*)(GF + ((size_t)blk * 2 + 0) * DFF + ch); g2 = first ? z : *(const GAS f32x4*)(GL + ((size_t)(blk - 1) * 2 + 1) * DFF + ch); }
        const f32x4 w0 = *(const GAS f32x4*)(cw + ch), w1 = *(const GAS f32x4*)(cw + DFF + ch), w2 = *(const GAS f32x4*)(cw + 2 * DFF + ch), bb = *(const GAS f32x4*)(cb + ch);
        float a[4];
#pragma unroll
        for (int e = 0; e < 4; ++e) { const float y = bb[e] + w0[e] * g2[e] + w1[e] * g1[e] + w2[e] * g0[e]; a[e] = y / (1.0f + __expf(-y)) * uu[e]; }
        v2u o = {pk2(a[0], a[1]), pk2(a[2], a[3])};
        *(GAS v2u*)(ACT + (size_t)(64 * blk + j) * DFF + ch) = o;
    }
}
__device__ __forceinline__ void final_norm_row(Frame& F, int t, int lane) {
    const unsigned long long* ss = (const unsigned long long*)(F.ws + WS_CTL + CTL_SS) + 2 * (size_t)M;
    const float r = 1.0f / sqrtf((float)ss[t] * ((1.0f / 4096.0f) / 1048576.0f) + RMS_EPS);
    const GAS v4u* hr = (const GAS v4u*)((const bf16*)(F.ws + WS_XN) + (size_t)t * DM) + lane; GAS f32x4* xr = (GAS f32x4*)(F.out + (size_t)t * DM) + 2 * lane; const GAS f32x4* gr = (const GAS f32x4*)F.kin[21] + 2 * lane;
#pragma unroll
    for (int j = 0; j < 8; ++j) { const v4u w = hr[64 * j]; const f32x4 g0 = gr[128 * j], g1 = gr[128 * j + 1];
        xr[128 * j] = (f32x4){bflo(w.x) * r * g0.x, bfhi(w.x) * r * g0.y, bflo(w.y) * r * g0.z, bfhi(w.y) * r * g0.w};
        xr[128 * j + 1] = (f32x4){bflo(w.z) * r * g1.x, bfhi(w.z) * r * g1.y, bflo(w.w) * r * g1.z, bfhi(w.w) * r * g1.w}; }
}

__device__ __forceinline__ void quant_row(Frame& F, int t, int lane) {
    const unsigned* amax = (const unsigned*)(F.ws + WS_CTL + CTL_AMAX); const float am = __uint_as_float(amax[t]); const float inv = am > 0.f ? 127.0f / am : 0.f;
    const GAS v4u* hr = (const GAS v4u*)((const bf16*)(F.ws + WS_XN) + (size_t)t * DM) + lane; GAS v2u* qr = (GAS v2u*)((signed char*)(F.ws + WS_H2Q) + (size_t)t * DM) + lane;
#pragma unroll
    for (int j = 0; j < 8; ++j) { const v4u w = hr[64 * j];
        const float v[8] = {bflo(w.x), bfhi(w.x), bflo(w.y), bfhi(w.y), bflo(w.z), bfhi(w.z), bflo(w.w), bfhi(w.w)}; unsigned q[2] = {0u, 0u};
#pragma unroll
        for (int e = 0; e < 8; ++e) { const float r = fminf(fmaxf(__builtin_rintf(v[e] * inv), -127.f), 127.f); q[e >> 2] |= ((unsigned)(int)r & 0xffu) << (8 * (e & 3)); }
        qr[64 * j] = (v2u){q[0], q[1]}; }
}
typedef att::BlockRef<att::bf16, att::bf16> ABlk;
__device__ __forceinline__ ABlk dil_item(unsigned char* ws, int L) {
    const int bh = L / 48, rem = L - 48 * bh, cfg = rem >> 4, x = rem & 15, h = bh & 15, b = bh >> 4;
    const int d = cfg == 0 ? 1 : (cfg == 1 ? 4 : 16);
    const int r = cfg == 0 ? 0 : (cfg == 1 ? (x >> 2) : x), qb = cfg == 0 ? x : (cfg == 1 ? (x & 3) : 0);
    const att::bf16* DQ = (const att::bf16*)(ws + WS_DQKV); const att::bf16* DK = DQ + (size_t)M * 2048; const att::bf16* DV = DK + (size_t)M * 2048;
    const int sq = r + d * 256 * qb, tq = b * SEQ + sq; const size_t hb = (size_t)(b * 16 + h) * SEQ;
    ABlk R;
    R.Q = DQ + (hb + sq) * 128; R.K = DK + (hb + r) * 128; R.V = DV + (hb + r) * 128;
    R.O = (att::bf16*)(ws + WS_OC) + ((size_t)cfg * M * 2048) + (hb + sq) * 128;
    R.L = (float*)(ws + WS_LSE) + (((size_t)cfg * M + tq) * 16 + h) * 2;
    R.bsrc = (const float*)(ws + WS_BT) + (cfg * 16 + h) * 132;
    R.P0 = 256 * qb; R.pq = 128 * d; R.pk = 128 * d; R.po = 128 * d; R.pl = 32 * d; R.skv = SEQ / d; R.W = 129;
    return R;
}
__device__ __forceinline__ ABlk xat_item(unsigned char* ws, int L) {
    const int qb = L & 15, h = (L >> 4) & 3, b = L >> 6;
    const att::bf16* XQ = (const att::bf16*)(ws + WS_XQ); const att::bf16* XKV = (const att::bf16*)(ws + WS_XKV);
    ABlk R;
    R.Q = XQ + (size_t)(b * SEQ + 256 * qb) * XW + h * 128; R.K = XKV + (size_t)(b * MEMLEN) * 1024 + h * 128; R.V = R.K + 512;
    R.O = (att::bf16*)(ws + WS_XO) + (size_t)(b * SEQ + 256 * qb) * XW + h * 128; R.L = nullptr; R.bsrc = nullptr;
    R.P0 = 1 << 20; R.pq = XW; R.pk = 1024; R.po = XW; R.pl = 0; R.skv = MEMLEN; R.W = 1 << 30;
    return R;
}

#ifndef PG_ALIGN
#define PG_ALIGN true
#endif
#ifndef PG_SP2
#define PG_SP2 true
#endif
struct Args { const float* in[22]; float* out; unsigned char* ws; int ph_lo, ph_hi; };
__global__ void __launch_bounds__(NWAVES * 64, 2) hybrid_fwd(Args args) {
    extern __shared__ __attribute__((aligned(16))) unsigned char lds[];
    Frame F;
    F.lds = (LAS unsigned char*)lds; F.ldsg = (char*)lds;
    F.MISC = (volatile LAS unsigned*)(F.lds + MISC_OFF);
    F.wave = __builtin_amdgcn_readfirstlane((int)threadIdx.x >> 6);
    F.G = gridDim.x; { const int bx = blockIdx.x; F.vcu = (F.G % 8 == 0) ? (bx % 8) * (F.G / 8) + bx / 8 : bx; }
    F.ws = args.ws; F.ctl = (gu32*)(args.ws + WS_CTL); F.out = args.out;
    F.kin = (const float* const __attribute__((address_space(4)))*)__builtin_amdgcn_kernarg_segment_ptr();
    if (threadIdx.x < 64) F.MISC[threadIdx.x] = 0u;
    __syncthreads();
    XcdBarrier bar; bar.bar = (unsigned*)(F.ctl + CW_BAR); bar.x = 0; bar.st = nullptr;
    if (N_LAUNCHES == 1) bar = xcd_barrier_post((unsigned*)(F.ctl + CW_BAR), F.MISC + 8);
#define GRID_BAR() do { if (N_LAUNCHES == 1) xcd_barrier(bar); } while (0)
    const int lo = args.ph_lo, hi = args.ph_hi;
#ifndef PH_MASK
#define PH_MASK 0x1fff
#endif
#define IN(k) ((((PH_MASK) >> (k)) & 1) && lo <= (k) && (k) < hi)
#define BOTH(k) (IN(k) && IN((k) + 1))
#ifndef DUPMASK
#define DUPMASK 0
#endif
#ifndef XBAR
#define XBAR 0
#endif
#define DUPK(k, ...) { __VA_ARGS__ } if constexpr ((((DUPMASK) >> (k)) & 1) != 0) { __syncthreads(); { __VA_ARGS__ } }
#define GRID_BARX() do { GRID_BAR(); if constexpr (XBAR != 0) GRID_BAR(); } while (0)
    unsigned long long* SS1 = (unsigned long long*)(F.ws + WS_CTL + CTL_SS); unsigned long long* SS2 = SS1 + M; unsigned long long* SS3 = SS2 + M;
    const int gw = F.vcu * NWAVES + F.wave, NGW = F.G * NWAVES;

    if (IN(0)) { DUPK(0, p0_first_token(F); p0_prologue(F);)
#ifdef DUP_P0FT
        __syncthreads(); p0_first_token(F); __syncthreads(); p0_first_token(F); __syncthreads(); p0_first_token(F); __syncthreads(); p0_first_token(F);
#endif
        if (BOTH(0)) GRID_BARX(); }
    if (IN(1)) {
        { pg8::Gemm g{(const bf16*)(F.ws + WS_XN), (const bf16*)(F.ws + WS_WIN), M, NPROJ, DM}; pg8::StaticOrder S; S.init(M, NPROJ, F.G, (int)blockIdx.x);
          pg8::EpiProj E{(bf16*)(F.ws + WS_GQ), (bf16*)(F.ws + WS_GK), (bf16*)(F.ws + WS_GV), (bf16*)(F.ws + WS_GR), (bf16*)(F.ws + WS_DQKV)};
          pg8::gemm_phase<pg8::EpiProj, pg8::StaticOrder, PG_ALIGN, PG_SP2>(F.lds, g, S, E);
#ifdef DUP_P1NULL
          { pg8::EpiNull E0{}; pg8::Gemm g2{(const bf16*)(F.ws + WS_XN), (const bf16*)(F.ws + WS_WIN), M, 3072, DM}; pg8::StaticOrder S2; S2.init(M, 3072, F.G, (int)blockIdx.x); pg8::gemm_phase<pg8::EpiNull, pg8::StaticOrder, PG_ALIGN, PG_SP2>(F.lds, g2, S2, E0); pg8::gemm_phase<pg8::EpiNull, pg8::StaticOrder, PG_ALIGN, PG_SP2>(F.lds, g2, S2, E0); pg8::gemm_phase<pg8::EpiNull, pg8::StaticOrder, PG_ALIGN, PG_SP2>(F.lds, g2, S2, E0); pg8::gemm_phase<pg8::EpiNull, pg8::StaticOrder, PG_ALIGN, PG_SP2>(F.lds, g2, S2, E0); }
#endif
          }
        if (BOTH(1)) GRID_BARX();
    }
    if (IN(2)) { DUPK(2, for (int u = blockIdx.x; u < NB * 64; u += F.G) gla_prep_unit(F, u >> 6, u & 63);) if (BOTH(2)) GRID_BARX(); }
    if (IN(3)) {
#ifdef PRE_ATT_VARIANT
        {
            gu32* qctr = F.ctl + CW_QUEUE + 64;
#define NEXT_ITEM(dst) do { if (tid_now() == 0) F.MISC[16] = __hip_atomic_fetch_add(qctr, 1u, RLX_AGENT); __syncthreads(); dst = __builtin_amdgcn_readfirstlane((int)F.MISC[16]); __syncthreads(); } while (0)
            int L; NEXT_ITEM(L);
            if (L < 3072) {
                ABlk cur = dil_item(F.ws, L); att::Seam<att::bf16> S; int par = 0;
                att::causal_swa_prime<PRE_ATT_VARIANT, att::bf16, att::bf16>(cur, F.ldsg, S);
                unsigned char* const wsp = F.ws; auto itf = [wsp](int l) { return dil_item(wsp, l); };
                for (;;) { int Ln; NEXT_ITEM(Ln); const bool last = Ln >= 3072; const int Lx = last ? L : Ln;
                    att::causal_swa_block<PRE_ATT_VARIANT, att::bf16, att::bf16>(cur, Lx, itf, par, F.ldsg, S);
                    if (last) break; L = Ln; cur = dil_item(F.ws, L); par ^= 1; }
            }
#undef NEXT_ITEM
            __syncthreads();
        }
#endif
        if ((int)blockIdx.x < 64) gla_chain_unit(F, blockIdx.x >> 4, (blockIdx.x >> 2) & 3, blockIdx.x & 3);
        {
            gu32* qctr = F.ctl + CW_QUEUE;
#define NEXT_ITEM(dst) do { if (tid_now() == 0) F.MISC[16] = __hip_atomic_fetch_add(qctr, 1u, RLX_AGENT); __syncthreads(); dst = __builtin_amdgcn_readfirstlane((int)F.MISC[16]); __syncthreads(); } while (0)
            int L; NEXT_ITEM(L);
            if (L < 3072) {
                ABlk cur = dil_item(F.ws, L); att::Seam<att::bf16> S; int par = 0;
                att::causal_swa_prime<1, att::bf16, att::bf16>(cur, F.ldsg, S);
                unsigned char* const wsp = F.ws; auto itf = [wsp](int l) { return dil_item(wsp, l); };
                for (;;) { int Ln; NEXT_ITEM(Ln); const bool last = Ln >= 3072; const int Lx = last ? L : Ln;
                    att::causal_swa_block<1, att::bf16, att::bf16>(cur, Lx, itf, par, F.ldsg, S);
                    if (last) break; L = Ln; cur = dil_item(F.ws, L); par ^= 1; }
            }
#undef NEXT_ITEM
        }
#ifdef DUP_CHAIN
        __syncthreads(); if ((int)blockIdx.x < 64) gla_chain_unit(F, blockIdx.x >> 4, (blockIdx.x >> 2) & 3, blockIdx.x & 3);
#endif
        if (BOTH(3)) GRID_BARX();
    }
    if (IN(4)) {
        { const int lane = tid_now() & 63; for (int t = gw; t < M; t += NGW) mix_row(F, t, lane); }
        ffn_weights<0>(F, 2 * FW_IG, FW_P9_LO, gw, NGW);
        if constexpr (FFN_I8) { ffn_weights<1>(F, 0, 2 * FW_IG, gw, NGW); GRID_BAR(); }
        ffn_weights<0>(F, 0, FW_P6_LO, gw, NGW);
        if (BOTH(4)) GRID_BARX(); }
    if (IN(5)) {
        pg8::Gemm g{(const bf16*)(F.ws + WS_MIX), (const bf16*)(F.ws + WS_WOUT), M, DM, DM}; pg8::StaticOrder S; S.init(M, DM, F.G, (int)blockIdx.x);
        pg8::EpiResid E{F.kin[0], nullptr, (bf16*)(F.ws + WS_XN), SS1, DM, nullptr};
        pg8::gemm_phase<pg8::EpiResid, pg8::StaticOrder, PG_ALIGN, PG_SP2>(F.lds, g, S, E);
#ifdef DUP_P5
        { pg8::EpiResid E2{F.kin[0], nullptr, (bf16*)(F.ws + WS_XN), nullptr, DM, nullptr}; pg8::gemm_phase<pg8::EpiResid, pg8::StaticOrder, PG_ALIGN, PG_SP2>(F.lds, g, S, E2); }
#endif
        if (BOTH(5)) GRID_BARX();
    }
    if (IN(6)) {
        DUPK(6,
        if ((int)blockIdx.x < 128 || F.G < 144) {
        pg8::Gemm g{(const bf16*)(F.ws + WS_XN), (const bf16*)(F.ws + WS_WXQ), M, XW, DM}; pg8::StaticOrder S; S.init(M, XW, F.G < 144 ? F.G : 128, (int)blockIdx.x);
        pg8::EpiScaleBf16 E{(bf16*)(F.ws + WS_XQ), XW, SS1, 1.0f / 4096.0f};
        pg8::gemm_phase<pg8::EpiScaleBf16, pg8::StaticOrder, PG_ALIGN, PG_SP2>(F.lds, g, S, E);
        }
        if ((int)blockIdx.x >= 128 || F.G < 144) {
        pg8::Gemm g{(const bf16*)(F.ws + WS_MEMN), (const bf16*)(F.ws + WS_WXKV), MROWS, 1024, DM}; pg8::StaticOrder S; S.init(MROWS, 1024, F.G < 144 ? F.G : F.G - 128, F.G < 144 ? (int)blockIdx.x : (int)blockIdx.x - 128);
        pg8::EpiScaleBf16 E{(bf16*)(F.ws + WS_XKV), 1024, nullptr, 0.f};
        pg8::gemm_phase<pg8::EpiScaleBf16, pg8::StaticOrder, PG_ALIGN, PG_SP2>(F.lds, g, S, E);
        }
        if (F.G >= 256) { if ((int)blockIdx.x >= 144) ffn_weights<0>(F, FW_P6_LO, FW_P6_HI, ((int)blockIdx.x - 144) * NWAVES + F.wave, (F.G - 144) * NWAVES); }
        else ffn_weights<0>(F, FW_P6_LO, FW_P6_HI, gw, NGW);
        )
        if (BOTH(6)) GRID_BARX();
    }
    if (IN(7)) {
        DUPK(7,
        if ((int)blockIdx.x < 256) {
            int L = blockIdx.x; ABlk cur = xat_item(F.ws, L); att::Seam<att::bf16> S; int par = 0;
            att::causal_swa_prime<0, att::bf16, att::bf16>(cur, F.ldsg, S);
            unsigned char* const wsp = F.ws; auto itf = [wsp](int l) { return xat_item(wsp, l); };
            for (;;) { const int Ln = L + F.G; const bool last = Ln >= 256; const int Lx = last ? L : Ln;
                att::causal_swa_block<0, att::bf16, att::bf16>(cur, Lx, itf, par, F.ldsg, S);
                if (last) break; L = Ln; cur = xat_item(F.ws, L); par ^= 1; }
        }
        )
        if (BOTH(7)) GRID_BARX();
    }
    if (IN(8)) {
        pg8::Gemm g{(const bf16*)(F.ws + WS_XO), (const bf16*)(F.ws + WS_WXO), M, DM, XW}; pg8::StaticOrder S; S.init(M, DM, F.G, (int)blockIdx.x);
        pg8::EpiResid E{nullptr, (const bf16*)(F.ws + WS_XN), (bf16*)(F.ws + WS_XN), SS2, DM, FFN_I8 ? (unsigned*)(F.ws + WS_CTL + CTL_AMAX) : nullptr};
        pg8::gemm_phase<pg8::EpiResid, pg8::StaticOrder, PG_ALIGN, PG_SP2>(F.lds, g, S, E);
        if constexpr (FFN_I8) { GRID_BAR(); const int lane = tid_now() & 63; for (int t = gw; t < M; t += NGW) quant_row(F, t, lane); }
        if (BOTH(8)) GRID_BARX();
    }
    if (IN(9)) {
        DUPK(9,
        typedef pg8::EpiGateUpT<FFN_I8 != 0> EpiGU;
        pg8::Gemm g{(const bf16*)(F.ws + (FFN_I8 ? WS_H2Q : WS_XN)), (const bf16*)(F.ws + WS_WGU), M, NGU, FFN_I8 ? DM / 2 : DM}; pg8::StaticOrder S; S.init(M, NGU, F.G, (int)blockIdx.x);
        float* GF = (float*)(F.ws + WS_HALO);
        EpiGU E{(bf16*)(F.ws + WS_ACT), DFF, SS2, 1.0f / 4096.0f, F.kin[18], F.kin[19], GF, GF + HALO_ONE / 4, GF + 2 * (HALO_ONE / 4), DFF, (LAS float*)(F.lds + 131072),
                (const unsigned*)(F.ws + WS_CTL + CTL_COLMAX), (const unsigned*)(F.ws + WS_CTL + CTL_AMAX)};
        pg8::gemm_phase<EpiGU, pg8::StaticOrder, PG_ALIGN, PG_SP2>(F.lds, g, S, E);
        if (F.G == 256) { if ((int)blockIdx.x >= 128) ffn_weights<0>(F, FW_P9_LO, FW_P9_HI, ((int)blockIdx.x - 128) * NWAVES + F.wave, 128 * NWAVES); }
        else ffn_weights<0>(F, FW_P9_LO, FW_P9_HI, gw, NGW);
        )
        if (BOTH(9)) GRID_BARX();
    }
    if (IN(10)) { DUPK(10, halo_fix(F);) if (BOTH(10)) GRID_BARX(); }
    if (IN(11)) {
        pg8::Gemm g{(const bf16*)(F.ws + WS_ACT), (const bf16*)(F.ws + WS_WDN), M, DM, DFF}; pg8::StaticOrder S; S.init(M, DM, F.G, (int)blockIdx.x);
        pg8::EpiResid E{nullptr, (const bf16*)(F.ws + WS_XN), (bf16*)(F.ws + WS_XN), SS3, DM, nullptr};
        pg8::gemm_phase<pg8::EpiResid, pg8::StaticOrder, PG_ALIGN, PG_SP2>(F.lds, g, S, E);
        if (BOTH(11)) GRID_BARX();
    }
    if (IN(12)) { DUPK(12, const int lane = tid_now() & 63; for (int t = gw; t < M; t += NGW) final_norm_row(F, t, lane);)
    }
#undef IN
#undef BOTH
#undef GRID_BAR
}

extern "C" void kernel_launch(void* const* d_in, const int* in_sizes, int n_in, void* d_out, int out_size, void* d_ws, size_t ws_size, hipStream_t stream) {
    static int grid = 0;
    if (grid == 0) {
        if (n_in != 22 || in_sizes[0] != M * DM || out_size != M * DM || ws_size < WS_END) { fprintf(stderr, "kernel_launch: unexpected shapes (n_in %d, in0 %d, out %d, ws %zu)\n", n_in, n_in > 0 ? in_sizes[0] : -1, out_size, ws_size); grid = -1; return; }
        int dev = 0, cus = 0, per_cu = 0;
        if (hipGetDevice(&dev) != hipSuccess || hipDeviceGetAttribute(&cus, hipDeviceAttributeMultiprocessorCount, dev) != hipSuccess) { grid = -1; return; }
        if (hipFuncSetAttribute((const void*)hybrid_fwd, hipFuncAttributeMaxDynamicSharedMemorySize, LDS_BYTES) != hipSuccess) { fprintf(stderr, "kernel_launch: hipFuncSetAttribute failed\n"); grid = -1; return; }
        if (hipOccupancyMaxActiveBlocksPerMultiprocessor(&per_cu, (const void*)hybrid_fwd, NWAVES * 64, LDS_BYTES) != hipSuccess || per_cu < 1) fprintf(stderr, "kernel_launch: occupancy query reports %d\n", per_cu);
        (void)hipGetLastError();
        grid = cus;
    }
    if (grid < 0) return;
    if (hipMemsetAsync((char*)d_ws + WS_CTL, 0, CTL_ZERO_BYTES, stream) != hipSuccess) return;
    Args a{};
    for (int i = 0; i < 22; ++i) a.in[i] = (const float*)d_in[i];
    a.out = (float*)d_out; a.ws = (unsigned char*)d_ws;
    for (int li = 0; li < N_LAUNCHES; ++li) {
        a.ph_lo = (N_LAUNCHES == 1) ? 0 : li; a.ph_hi = (N_LAUNCHES == 1) ? NPH : li + 1;
        hipLaunchKernelGGL(hybrid_fwd, dim3(grid), dim3(NWAVES * 64), LDS_BYTES, stream, a);
    }
}
```

```cpp
#include <hip/hip_runtime.h>
#include <hip/hip_bf16.h>
#include <cstdio>
#include <cstdint>
#include <cmath>
#include <type_traits>
#ifndef MK_N_LAUNCHES
#define MK_N_LAUNCHES 1
#endif
namespace pg8 {
#define PG8_LAS __attribute__((address_space(3)))
typedef unsigned short bf16_t;
typedef short bf16x8 __attribute__((ext_vector_type(8)));
typedef float f32x4 __attribute__((ext_vector_type(4)));
typedef unsigned u32x4 __attribute__((ext_vector_type(4)));
constexpr int BM = 256, BK = 64, HALF = 128, HTB = HALF * BK * 2  , STAGE_BYTES = 8 * HTB, NXCD = 8, WGM = 8;

__host__ __device__ __forceinline__ int lds_byte(int r, int c) { const int st = (r >> 4) * 2 + (c >> 5), rr = r & 15, cc = c & 31, ob = rr * 64 + cc * 2; return st * 1024 + (ob ^ (((ob >> 9) & 1) << 5)); }
__host__ __device__ __forceinline__ void stage_rc(int b, int& R, int& C) { const int st = b / 1024, sb = b % 1024, swz = sb ^ (((sb >> 9) & 1) << 5); R = (st >> 1) * 16 + swz / 64; C = (st & 1) * 32 + (swz % 64) / 2; }
__host__ __device__ __forceinline__ int perm32(int rho) { const int n = rho >> 4, i = rho & 15; return 8 * (i >> 2) + 4 * n + (i & 3); }

struct Unit { int pm, pn; };
struct Gemm { const bf16_t* A; const bf16_t* Bt; int M, N, K; };

struct StaticOrder {
    int nM, nN, nwg, G, c;
    __host__ __device__ void init(int M, int N, int G_, int c_) { nM = M / BM; nN = N / BM; nwg = nM * nN; G = G_; c = c_; }
    __host__ __device__ bool next(int i, Unit& u) const {
        const long L = (long)i * G + c; if (L >= nwg) return false;
        int wgid = (int)L; { const int q = nwg / NXCD, r = nwg % NXCD, xcd = wgid % NXCD, off = wgid / NXCD; wgid = (xcd < r ? xcd * (q + 1) : r * (q + 1) + (xcd - r) * q) + off; }
        const int nig = WGM * nN, gid = wgid / nig, fm = gid * WGM, gsz = (nM - fm) < WGM ? (nM - fm) : WGM;
        u.pm = fm + ((wgid % nig) % gsz); u.pn = (wgid % nig) / gsz; return true;
    }
    __device__ __forceinline__ void a_ready(const Unit&) const {}
    __device__ __forceinline__ void done(const Unit&) const {}
};

__device__ __forceinline__ unsigned cvt_pk_bf16(float lo, float hi) { unsigned r; asm volatile("v_cvt_pk_bf16_f32 %0, %1, %2" : "=v"(r) : "v"(lo), "v"(hi)); return r; }
typedef float f32x2 __attribute__((ext_vector_type(2)));
typedef unsigned u32x2 __attribute__((ext_vector_type(2)));
typedef int i32x4 __attribute__((ext_vector_type(4)));
constexpr float RMS_EPS = 1e-6f;
constexpr float SS_SCALE = 1048576.0f;
__device__ __forceinline__ float rstd_of(const unsigned long long* ss, int row, float inv_n) { return 1.0f / sqrtf((float)ss[row] * (inv_n / SS_SCALE) + RMS_EPS); }

struct Seg { bf16_t* base; int ld; int col0; int pad; };
struct EpiProj {
    static constexpr bool PERM = true, AFTER_DRAIN = false, PREFETCH = false, I8 = false; typedef f32x4 AccT;
    bf16_t *gq, *gk, *gv, *gr, *dqkv;
    __device__ __forceinline__ void operator()(const f32x4 (&acc)[2][2][4][2], const Unit& u, int wr, int wc, int fr, int fq) const {
        const int colt = u.pn * BM; const int row0 = u.pm * BM + wr * 64 + fr;
        if (colt < 6144) {
            bf16_t* base; int ld, c0;
            if (colt < 1024) { base = gq; ld = 1024; c0 = colt; } else if (colt < 2048) { base = gk; ld = 1024; c0 = colt - 1024; }
            else if (colt < 4096) { base = gv; ld = 2048; c0 = colt - 2048; } else { base = gr; ld = 2048; c0 = colt - 4096; }
            const int col0 = c0 + wc * 32 + 8 * fq;
#pragma unroll
            for (int ai = 0; ai < 2; ++ai)
#pragma unroll
                for (int m = 0; m < 4; ++m) { bf16_t* rowp = base + (size_t)(row0 + ai * HALF + m * 16) * ld + col0;
#pragma unroll
                    for (int bj = 0; bj < 2; ++bj) { const f32x4 v0 = acc[ai][bj][m][0], v1 = acc[ai][bj][m][1];
                        u32x4 w; w.x = cvt_pk_bf16(v0[0], v0[1]); w.y = cvt_pk_bf16(v0[2], v0[3]); w.z = cvt_pk_bf16(v1[0], v1[1]); w.w = cvt_pk_bf16(v1[2], v1[3]);
                        __builtin_nontemporal_store(w, (u32x4*)(rowp + bj * HALF)); } }
        } else {
            const int c = colt - 6144, ten = c >> 11, h0 = (c & 2047) >> 7;
            bf16_t* base = dqkv + (size_t)ten * ((size_t)16384 * 2048) + wc * 32 + 8 * fq;
#pragma unroll
            for (int ai = 0; ai < 2; ++ai)
#pragma unroll
                for (int m = 0; m < 4; ++m) { const int row = row0 + ai * HALF + m * 16, b = row >> 12, sq = row & 4095;
#pragma unroll
                    for (int bj = 0; bj < 2; ++bj) { const f32x4 v0 = acc[ai][bj][m][0], v1 = acc[ai][bj][m][1];
                        u32x4 w; w.x = cvt_pk_bf16(v0[0], v0[1]); w.y = cvt_pk_bf16(v0[2], v0[3]); w.z = cvt_pk_bf16(v1[0], v1[1]); w.w = cvt_pk_bf16(v1[2], v1[3]);
                        __builtin_nontemporal_store(w, (u32x4*)(base + ((size_t)((b * 16 + h0 + bj) * 4096 + sq)) * 128)); } }
        }
    }
};
struct EpiProjQ {
    static constexpr bool PERM = true, AFTER_DRAIN = false, PREFETCH = false, I8 = true; typedef i32x4 AccT;
    bf16_t* dqkv; const float* rsc; const unsigned* cmax;
    __device__ __forceinline__ void operator()(const i32x4 (&acc)[2][2][4][2], const Unit& u, int wr, int wc, int fr, int fq) const {
        const int c = u.pn * BM, ten = c >> 11, h0 = (c & 2047) >> 7; const int row0 = u.pm * BM + wr * 64 + fr;
        bf16_t* base = dqkv + (size_t)ten * ((size_t)16384 * 2048) + wc * 32 + 8 * fq;
        float cs[2][8];
#pragma unroll
        for (int bj = 0; bj < 2; ++bj) { const u32x4 m0 = *(const u32x4*)(cmax + c + bj * HALF + wc * 32 + 8 * fq), m1 = *(const u32x4*)(cmax + c + bj * HALF + wc * 32 + 8 * fq + 4);
            cs[bj][0] = __uint_as_float(m0.x) * (1.0f / 127.0f); cs[bj][1] = __uint_as_float(m0.y) * (1.0f / 127.0f); cs[bj][2] = __uint_as_float(m0.z) * (1.0f / 127.0f); cs[bj][3] = __uint_as_float(m0.w) * (1.0f / 127.0f);
            cs[bj][4] = __uint_as_float(m1.x) * (1.0f / 127.0f); cs[bj][5] = __uint_as_float(m1.y) * (1.0f / 127.0f); cs[bj][6] = __uint_as_float(m1.z) * (1.0f / 127.0f); cs[bj][7] = __uint_as_float(m1.w) * (1.0f / 127.0f); }
#pragma unroll
        for (int ai = 0; ai < 2; ++ai)
#pragma unroll
            for (int m = 0; m < 4; ++m) { const int row = row0 + ai * HALF + m * 16, b = row >> 12, sq = row & 4095; const float rs = rsc[row];
#pragma unroll
                for (int bj = 0; bj < 2; ++bj) { const i32x4 a0 = acc[ai][bj][m][0], a1 = acc[ai][bj][m][1];
                    u32x4 w; w.x = cvt_pk_bf16((float)a0[0] * (rs * cs[bj][0]), (float)a0[1] * (rs * cs[bj][1])); w.y = cvt_pk_bf16((float)a0[2] * (rs * cs[bj][2]), (float)a0[3] * (rs * cs[bj][3]));
                    w.z = cvt_pk_bf16((float)a1[0] * (rs * cs[bj][4]), (float)a1[1] * (rs * cs[bj][5])); w.w = cvt_pk_bf16((float)a1[2] * (rs * cs[bj][6]), (float)a1[3] * (rs * cs[bj][7]));
                    __builtin_nontemporal_store(w, (u32x4*)(base + ((size_t)((b * 16 + h0 + bj) * 4096 + sq)) * 128)); } }
    }
};
struct EpiScaleBf16 {
    static constexpr bool PERM = true, AFTER_DRAIN = false, PREFETCH = false, I8 = false; typedef f32x4 AccT;
    bf16_t* O; int ldc; const unsigned long long* ss; float inv_n;
    __device__ __forceinline__ void operator()(const f32x4 (&acc)[2][2][4][2], const Unit& u, int wr, int wc, int fr, int fq) const {
        const int row0 = u.pm * BM + wr * 64 + fr, col0 = u.pn * BM + wc * 32 + 8 * fq;
#pragma unroll
        for (int ai = 0; ai < 2; ++ai)
#pragma unroll
            for (int m = 0; m < 4; ++m) { const int row = row0 + ai * HALF + m * 16; const float rs = ss ? rstd_of(ss, row, inv_n) : 1.0f; bf16_t* rowp = O + (size_t)row * ldc + col0;
#pragma unroll
                for (int bj = 0; bj < 2; ++bj) { const f32x4 v0 = acc[ai][bj][m][0] * rs, v1 = acc[ai][bj][m][1] * rs;
                    u32x4 w; w.x = cvt_pk_bf16(v0[0], v0[1]); w.y = cvt_pk_bf16(v0[2], v0[3]); w.z = cvt_pk_bf16(v1[0], v1[1]); w.w = cvt_pk_bf16(v1[2], v1[3]);
                    *(u32x4*)(rowp + bj * HALF) = w; } }
    }
};
struct EpiResid {
    static constexpr bool PERM = true, AFTER_DRAIN = false, PREFETCH = false, I8 = false; typedef f32x4 AccT;
    const float* base32; const bf16_t* base16; bf16_t* hb; unsigned long long* ss; int ldc; unsigned* amax;
    __device__ __forceinline__ void operator()(const f32x4 (&acc)[2][2][4][2], const Unit& u, int wr, int wc, int fr, int fq) const {
        const int row0 = u.pm * BM + wr * 64 + fr, col0 = u.pn * BM + wc * 32 + 8 * fq;
        f32x4 bc[2][2], bn[2][2]; u32x4 hc[2], hn[2];
#define EPR_LOAD(d32, d16, g) do { const size_t o_ = (size_t)(row0 + ((g) >> 2) * HALF + ((g) & 3) * 16) * ldc + col0; \
        if (base32) { d32[0][0] = *(const f32x4*)(base32 + o_); d32[0][1] = *(const f32x4*)(base32 + o_ + 4); d32[1][0] = *(const f32x4*)(base32 + o_ + HALF); d32[1][1] = *(const f32x4*)(base32 + o_ + HALF + 4); } \
        else { d16[0] = *(const u32x4*)(base16 + o_); d16[1] = *(const u32x4*)(base16 + o_ + HALF); } } while (0)
        EPR_LOAD(bc, hc, 0);
#pragma unroll
        for (int g = 0; g < 8; ++g) {
            const int ai = g >> 2, m = g & 3; const int row = row0 + ai * HALF + m * 16; const size_t off = (size_t)row * ldc + col0; float s = 0.f; float mx = 0.f;
            if (g < 7) EPR_LOAD(bn, hn, g + 1);
#pragma unroll
            for (int bj = 0; bj < 2; ++bj) {
                f32x4 b0, b1;
                if (base32) { b0 = bc[bj][0]; b1 = bc[bj][1]; }
                else { const u32x4 w = hc[bj]; b0 = (f32x4){__uint_as_float(w.x << 16), __uint_as_float(w.x & 0xffff0000u), __uint_as_float(w.y << 16), __uint_as_float(w.y & 0xffff0000u)};
                                              b1 = (f32x4){__uint_as_float(w.z << 16), __uint_as_float(w.z & 0xffff0000u), __uint_as_float(w.w << 16), __uint_as_float(w.w & 0xffff0000u)}; }
                const f32x4 v0 = acc[ai][bj][m][0] + b0, v1 = acc[ai][bj][m][1] + b1;
                s += (v0[0] * v0[0] + v0[1] * v0[1]) + (v0[2] * v0[2] + v0[3] * v0[3]) + (v1[0] * v1[0] + v1[1] * v1[1]) + (v1[2] * v1[2] + v1[3] * v1[3]);
                if (amax) { const f32x4 a0 = __builtin_elementwise_abs(v0), a1 = __builtin_elementwise_abs(v1); mx = fmaxf(mx, fmaxf(fmaxf(fmaxf(a0[0], a0[1]), fmaxf(a0[2], a0[3])), fmaxf(fmaxf(a1[0], a1[1]), fmaxf(a1[2], a1[3])))); }
                u32x4 w; w.x = cvt_pk_bf16(v0[0], v0[1]); w.y = cvt_pk_bf16(v0[2], v0[3]); w.z = cvt_pk_bf16(v1[0], v1[1]); w.w = cvt_pk_bf16(v1[2], v1[3]); *(u32x4*)(hb + off + bj * HALF) = w; }
            s += __shfl_xor(s, 16); s += __shfl_xor(s, 32);
            if (ss && fq == 0) atomicAdd(ss + row, (unsigned long long)(s * SS_SCALE + 0.5f));
            if (amax) { mx = fmaxf(mx, __shfl_xor(mx, 16)); mx = fmaxf(mx, __shfl_xor(mx, 32)); if (fq == 0) atomicMax(amax + row, __float_as_uint(mx)); }
#pragma unroll
            for (int bj = 0; bj < 2; ++bj) { bc[bj][0] = bn[bj][0]; bc[bj][1] = bn[bj][1]; hc[bj] = hn[bj]; }
            asm volatile("" ::: "memory");
        }
#undef EPR_LOAD
    }
};
template <bool Q> struct EpiGateUpT {
    static constexpr bool PERM = true, AFTER_DRAIN = false, PREFETCH = true, I8 = Q; typedef typename std::conditional<Q, i32x4, f32x4>::type AccT;
    static constexpr int AUXN = 1024;
    bf16_t* act; int ldc; const unsigned long long* ss; float inv_n; const float* cw; const float* cb; float* GF; float* UF; float* GL; int nff;
    PG8_LAS float* aux;
    const unsigned* colmax; const unsigned* amax;
    __device__ __forceinline__ float colscale(int tid, int pn) const { return Q ? __uint_as_float(colmax[(tid >> 7) * nff + pn * HALF + (tid & 127)]) * (1.0f / 127.0f) : 1.0f; }
    __device__ __forceinline__ float rowscale(unsigned long long s2, unsigned am) const { const float r = 1.0f / sqrtf((float)s2 * (inv_n / SS_SCALE) + RMS_EPS); return Q ? r * __uint_as_float(am) * (1.0f / 127.0f) : r; }
    __device__ __forceinline__ void prefetch(const Unit& u, int par) const {
        int tid = (int)threadIdx.x; asm volatile("" : "+v"(tid)); const int arr = tid >> 7, ch = tid & 127;
        const float v = arr < 3 ? cw[arr * nff + u.pn * HALF + ch] : cb[u.pn * HALF + ch];
        PG8_LAS float* a = aux + par * AUXN; a[tid] = v;
        if (tid < 256) { a[512 + tid] = colscale(tid, u.pn); const int row = u.pm * BM + tid; a[768 + tid] = rowscale(ss[row], Q ? amax[row] : 0u); }
    }
    __device__ __forceinline__ void run(const AccT (&acc)[2][2][4][2], const Unit& u, int wr, int wc, int fr, int fq, int par, const Unit& nxt) const {
        int tid = (int)threadIdx.x; asm volatile("" : "+v"(tid)); const int arr = tid >> 7, chn = tid & 127;
        const float nv = arr < 3 ? cw[arr * nff + nxt.pn * HALF + chn] : cb[nxt.pn * HALF + chn];
        const int nrow = nxt.pm * BM + (tid & 255);
        const unsigned long long nss = ss[nrow]; const unsigned nam = Q ? amax[nrow] : 0u; const float ncs = colscale(tid & 255, nxt.pn);
        const PG8_LAS float* a = aux + par * AUXN;
        const int c0 = wc * 32 + 8 * fq;
        const int ch0 = u.pn * HALF + c0;
        float w0[8], w1[8], w2[8], bb[8], sg[8], su[8];
#pragma unroll
        for (int h4 = 0; h4 < 2; ++h4) { const f32x4 x0 = *(const PG8_LAS f32x4*)(a + c0 + 4 * h4), x1 = *(const PG8_LAS f32x4*)(a + 128 + c0 + 4 * h4), x2 = *(const PG8_LAS f32x4*)(a + 256 + c0 + 4 * h4), x3 = *(const PG8_LAS f32x4*)(a + 384 + c0 + 4 * h4);
            const f32x4 x4 = *(const PG8_LAS f32x4*)(a + 512 + c0 + 4 * h4), x5 = *(const PG8_LAS f32x4*)(a + 640 + c0 + 4 * h4);
#pragma unroll
            for (int j = 0; j < 4; ++j) { w0[4 * h4 + j] = x0[j]; w1[4 * h4 + j] = x1[j]; w2[4 * h4 + j] = x2[j]; bb[4 * h4 + j] = x3[j]; sg[4 * h4 + j] = x4[j]; su[4 * h4 + j] = x5[j]; } }
#pragma unroll
        for (int ai = 0; ai < 2; ++ai) {
            const int blk = (u.pm * BM + ai * HALF + wr * 64) >> 6;
            float pg[8];
#pragma unroll
            for (int e = 0; e < 8; ++e) pg[e] = 0.f;
#pragma unroll
            for (int m = 0; m < 4; ++m) {
                const int lrow = ai * HALF + wr * 64 + m * 16 + fr; const int row = u.pm * BM + lrow; const float rs = a[768 + lrow];
                float g[8], up[8], av[8];
#pragma unroll
                for (int n = 0; n < 2; ++n)
#pragma unroll
                    for (int j = 0; j < 4; ++j) {
                        if constexpr (Q) { g[4 * n + j] = (float)acc[ai][0][m][n][j] * (rs * sg[4 * n + j]); up[4 * n + j] = (float)acc[ai][1][m][n][j] * (rs * su[4 * n + j]); }
                        else { g[4 * n + j] = acc[ai][0][m][n][j] * rs; up[4 * n + j] = acc[ai][1][m][n][j] * rs; } }
#pragma unroll
                for (int e = 0; e < 8; ++e) {
                    const int gi = __float_as_int(g[e]), pi = __float_as_int(pg[e]);
                    const float p1 = __int_as_float(__builtin_amdgcn_update_dpp(__builtin_amdgcn_update_dpp(0, pi, 0x121, 0xf, 0xf, false), gi, 0x111, 0xf, 0xf, false));
                    const float p2 = __int_as_float(__builtin_amdgcn_update_dpp(__builtin_amdgcn_update_dpp(0, pi, 0x122, 0xf, 0xf, false), gi, 0x112, 0xf, 0xf, false));
                    const float y = bb[e] + w0[e] * p2 + w1[e] * p1 + w2[e] * g[e];
                    av[e] = y * __builtin_amdgcn_rcpf(1.0f + __expf(-y)) * up[e];
                }
                if (m > 0 || fr >= 2) { u32x4 w; w.x = cvt_pk_bf16(av[0], av[1]); w.y = cvt_pk_bf16(av[2], av[3]); w.z = cvt_pk_bf16(av[4], av[5]); w.w = cvt_pk_bf16(av[6], av[7]);
                    __builtin_nontemporal_store(w, (u32x4*)(act + (size_t)row * ldc + ch0)); }
                if (m == 0 && fr < 2) { float* gp = GF + ((size_t)blk * 2 + fr) * nff + ch0; float* upp = UF + ((size_t)blk * 2 + fr) * nff + ch0;
                    *(f32x4*)gp = (f32x4){g[0], g[1], g[2], g[3]}; *(f32x4*)(gp + 4) = (f32x4){g[4], g[5], g[6], g[7]};
                    *(f32x4*)upp = (f32x4){up[0], up[1], up[2], up[3]}; *(f32x4*)(upp + 4) = (f32x4){up[4], up[5], up[6], up[7]}; }
                if (m == 3 && fr >= 14) { float* gp = GL + ((size_t)blk * 2 + (fr - 14)) * nff + ch0;
                    *(f32x4*)gp = (f32x4){g[0], g[1], g[2], g[3]}; *(f32x4*)(gp + 4) = (f32x4){g[4], g[5], g[6], g[7]}; }
#pragma unroll
                for (int e = 0; e < 8; ++e) pg[e] = g[e];
            }
        }
        PG8_LAS float* an = aux + (par ^ 1) * AUXN; an[tid] = nv;
        if (tid < 256) { an[512 + tid] = ncs; an[768 + tid] = rowscale(nss, nam); }
    }
};
typedef EpiGateUpT<false> EpiGateUp;
typedef EpiGateUpT<true> EpiGateUpQ;
struct EpiNull {
    static constexpr bool PERM = true, AFTER_DRAIN = false, PREFETCH = false, I8 = false; typedef f32x4 AccT;
    __device__ __forceinline__ void operator()(const f32x4 (&acc)[2][2][4][2], const Unit& u, int wr, int wc, int fr, int fq) const {
#pragma unroll
        for (int ai = 0; ai < 2; ++ai)
#pragma unroll
            for (int bj = 0; bj < 2; ++bj)
#pragma unroll
                for (int m = 0; m < 4; ++m)
#pragma unroll
                    for (int n = 0; n < 2; ++n) asm volatile("" :: "v"(acc[ai][bj][m][n]));
    }
};
template <bool I8> __device__ __forceinline__ auto pg8_mma(bf16x8 b, bf16x8 a, typename std::conditional<I8, i32x4, f32x4>::type c) {
    if constexpr (I8) return __builtin_amdgcn_mfma_i32_16x16x64_i8(__builtin_bit_cast(i32x4, b), __builtin_bit_cast(i32x4, a), c, 0, 0, 0);
    else return __builtin_amdgcn_mfma_f32_16x16x32_bf16(b, a, c, 0, 0, 0);
}
template <class Epi, class Sched, bool ALIGN_EPI = false, bool SP2 = false>
__device__ __forceinline__ void gemm_phase(PG8_LAS unsigned char* lds, const Gemm g, const Sched& S, const Epi& E) {
    const int tid = threadIdx.x, wid = __builtin_amdgcn_readfirstlane(tid >> 6), lane = tid & 63, wr = wid >> 2, wc = wid & 3, fr = lane & 15, fq = lane >> 4;
    const int K = g.K, nt = K / BK;
    unsigned voffA[2], voffB[2];
#pragma unroll
    for (int i = 0; i < 2; ++i) { int R, C; stage_rc(tid * 16 + i * 8192, R, C); const int Rb = Epi::PERM ? ((R & ~31) + perm32(R & 31)) : R;
        voffA[i] = (unsigned)(R * K + C) * 2u; voffB[i] = (unsigned)(Rb * K + C) * 2u; }
    const size_t kstep = (size_t)(BK * 2);
    const size_t hstep = (size_t)HALF * K * 2;
    const size_t tstep = 2 * hstep;
    const unsigned ldsw = (unsigned)wid * 1024u;
    const int aoff = lds_byte(wr * 64 + fr, fq * 8), boff = lds_byte(wc * 32 + fr, fq * 8);
#define PG8_SA(b, h) (((b) * 2 + (h)) * HTB)
#define PG8_SB(b, h) ((4 + (b) * 2 + (h)) * HTB)
#define PG8_STAGE(bufoff, gbase, voff) do { _Pragma("unroll") for (int _i = 0; _i < 2; ++_i) \
        __builtin_amdgcn_global_load_lds((const unsigned*)((const char*)(gbase) + (voff)[_i]), (PG8_LAS unsigned*)(lds + (bufoff) + ldsw + _i * 8192), 16, 0, 0); } while (0)
#define PG8_LDA(dst, b, h) do { _Pragma("unroll") for (int m = 0; m < 4; ++m) _Pragma("unroll") for (int k = 0; k < 2; ++k) dst[m][k] = *(const PG8_LAS bf16x8*)(lds + PG8_SA(b, h) + aoff + m * 2048 + k * 1024); } while (0)
#define PG8_LDB(dst, b, h) do { _Pragma("unroll") for (int n = 0; n < 2; ++n) _Pragma("unroll") for (int k = 0; k < 2; ++k) dst[n][k] = *(const PG8_LAS bf16x8*)(lds + PG8_SB(b, h) + boff + n * 2048 + k * 1024); } while (0)
#define PG8_MMA(ai, bj, At, Bt) do { __builtin_amdgcn_s_setprio(1); _Pragma("unroll") for (int m = 0; m < 4; ++m) _Pragma("unroll") for (int n = 0; n < 2; ++n) _Pragma("unroll") for (int k = 0; k < 2; ++k) \
        acc[ai][bj][m][n] = pg8_mma<Epi::I8>(Bt[n][k], At[m][k], acc[ai][bj][m][n]); __builtin_amdgcn_s_setprio(0); } while (0)
#define PG8_WAIT_V(n) asm volatile("s_waitcnt vmcnt(" #n ")" ::: "memory")
#define PG8_WAIT_L(n) asm volatile("s_waitcnt lgkmcnt(" #n ")" ::: "memory")
#define PG8_BAR __builtin_amdgcn_s_barrier()
#define PG8_SCHED __builtin_amdgcn_sched_barrier(0)
    Unit cur, nxt; int ui = 0;
    if (!S.next(0, cur)) return;
    typedef typename Epi::AccT AccT; AccT acc[2][2][4][2];
#pragma unroll
    for (int a = 0; a < 2; ++a)
#pragma unroll
        for (int b = 0; b < 2; ++b)
#pragma unroll
            for (int m = 0; m < 4; ++m)
#pragma unroll
                for (int n = 0; n < 2; ++n) acc[a][b][m][n] = AccT{};
    bf16x8 At[4][2], B0[2][2], B1[2][2];
    const char* cA = (const char*)g.A + (size_t)cur.pm * tstep; const char* cB = (const char*)g.Bt + (size_t)cur.pn * tstep;
    S.a_ready(cur);
    if constexpr (Epi::PREFETCH) E.prefetch(cur, 0);
    if constexpr (SP2) {
        PG8_STAGE(PG8_SB(0, 0), cB, voffB); PG8_STAGE(PG8_SB(0, 1), cB + hstep, voffB); PG8_STAGE(PG8_SA(0, 0), cA, voffA); PG8_STAGE(PG8_SA(0, 1), cA + hstep, voffA);
        if (wr == 1) PG8_BAR;
        PG8_WAIT_V(2); PG8_BAR;
        PG8_STAGE(PG8_SB(1, 0), cB + kstep, voffB); PG8_STAGE(PG8_SA(1, 0), cA + kstep, voffA); PG8_STAGE(PG8_SB(1, 1), cB + hstep + kstep, voffB);
        PG8_WAIT_V(6); PG8_BAR;
    } else {
        PG8_STAGE(PG8_SB(0, 0), cB, voffB); PG8_STAGE(PG8_SA(0, 0), cA, voffA); PG8_STAGE(PG8_SB(0, 1), cB + hstep, voffB); PG8_STAGE(PG8_SA(0, 1), cA + hstep, voffA);
        if (wr == 1) PG8_BAR;
        PG8_WAIT_V(4); PG8_BAR;
        PG8_STAGE(PG8_SB(1, 0), cB + kstep, voffB); PG8_STAGE(PG8_SA(1, 0), cA + kstep, voffA); PG8_STAGE(PG8_SB(1, 1), cB + hstep + kstep, voffB);
        PG8_WAIT_V(6); PG8_BAR;
    }
    for (;;) {
        const bool has_next = S.next(ui + 1, nxt);
        const char* nA = has_next ? (const char*)g.A + (size_t)nxt.pm * tstep : cA; const char* nB = has_next ? (const char*)g.Bt + (size_t)nxt.pn * tstep : cB;
        for (int t = 0; t < nt; t += 2) {
            const bool last = (t == nt - 2);
            const char* a1 = cA + (size_t)(t + 1) * kstep;
            const char* a2 = last ? nA : cA + (size_t)(t + 2) * kstep; const char* b2 = last ? nB : cB + (size_t)(t + 2) * kstep;
            const char* a3 = a2 + kstep; const char* b3 = b2 + kstep;
            if (last && has_next) S.a_ready(nxt);
            if constexpr (SP2) {
            PG8_LDB(B0, 0, 0); PG8_LDB(B1, 0, 1); PG8_SCHED; PG8_LDA(At, 0, 0); PG8_STAGE(PG8_SA(1, 1), a1 + hstep, voffA);
            PG8_WAIT_V(8); PG8_WAIT_L(0); PG8_BAR; PG8_MMA(0, 0, At, B0); PG8_MMA(0, 1, At, B1); PG8_BAR; PG8_SCHED;
            PG8_LDA(At, 0, 1); PG8_STAGE(PG8_SB(0, 0), b2, voffB); PG8_STAGE(PG8_SB(0, 1), b2 + hstep, voffB); PG8_STAGE(PG8_SA(0, 0), a2, voffA);
            PG8_WAIT_V(8); PG8_WAIT_L(0); PG8_BAR; PG8_MMA(1, 0, At, B0); PG8_MMA(1, 1, At, B1); PG8_BAR; PG8_SCHED;
            PG8_LDB(B0, 1, 0); PG8_LDB(B1, 1, 1); PG8_SCHED; PG8_LDA(At, 1, 0); PG8_STAGE(PG8_SA(0, 1), a2 + hstep, voffA);
            PG8_WAIT_V(8); PG8_WAIT_L(0); PG8_BAR; PG8_MMA(0, 0, At, B0); PG8_MMA(0, 1, At, B1); PG8_BAR; PG8_SCHED;
            PG8_LDA(At, 1, 1); PG8_STAGE(PG8_SB(1, 0), b3, voffB); PG8_STAGE(PG8_SB(1, 1), b3 + hstep, voffB); PG8_STAGE(PG8_SA(1, 0), a3, voffA);
            PG8_WAIT_V(8); PG8_WAIT_L(0); PG8_BAR; PG8_MMA(1, 0, At, B0); PG8_MMA(1, 1, At, B1); PG8_BAR; PG8_SCHED;
            } else {
            PG8_LDB(B0, 0, 0); PG8_SCHED; PG8_LDA(At, 0, 0); PG8_STAGE(PG8_SA(1, 1), a1 + hstep, voffA);
            PG8_WAIT_L(8); PG8_BAR; PG8_WAIT_L(0); PG8_MMA(0, 0, At, B0); PG8_BAR; PG8_SCHED;
            PG8_LDB(B1, 0, 1); PG8_STAGE(PG8_SB(0, 0), b2, voffB);
            PG8_BAR; PG8_WAIT_L(0); PG8_MMA(0, 1, At, B1); PG8_BAR;
            PG8_LDA(At, 0, 1); PG8_STAGE(PG8_SA(0, 0), a2, voffA);
            PG8_BAR; PG8_WAIT_L(0); PG8_MMA(1, 0, At, B0); PG8_BAR; PG8_SCHED;
            PG8_STAGE(PG8_SB(0, 1), b2 + hstep, voffB);
            PG8_WAIT_V(6); PG8_BAR; PG8_MMA(1, 1, At, B1); PG8_BAR;
            PG8_LDB(B0, 1, 0); PG8_SCHED; PG8_LDA(At, 1, 0); PG8_STAGE(PG8_SA(0, 1), a2 + hstep, voffA);
            PG8_WAIT_L(8); PG8_BAR; PG8_WAIT_L(0); PG8_MMA(0, 0, At, B0); PG8_BAR; PG8_SCHED;
            PG8_LDB(B1, 1, 1); PG8_STAGE(PG8_SB(1, 0), b3, voffB);
            PG8_BAR; PG8_WAIT_L(0); PG8_MMA(0, 1, At, B1); PG8_BAR;
            PG8_LDA(At, 1, 1); PG8_STAGE(PG8_SA(1, 0), a3, voffA);
            PG8_BAR; PG8_WAIT_L(0); PG8_MMA(1, 0, At, B0); PG8_BAR; PG8_SCHED;
            PG8_STAGE(PG8_SB(1, 1), b3 + hstep, voffB);
            PG8_WAIT_V(6); PG8_BAR; PG8_MMA(1, 1, At, B1); PG8_BAR;
            }
        }
        if constexpr (ALIGN_EPI) { if (wr == 0) PG8_BAR; }
        if constexpr (!Epi::AFTER_DRAIN) { if constexpr (Epi::PREFETCH) E.run(acc, cur, wr, wc, fr, fq, ui & 1, has_next ? nxt : cur); else E(acc, cur, wr, wc, fr, fq); S.done(cur); }
        if (!has_next) break;
#pragma unroll
        for (int a = 0; a < 2; ++a)
#pragma unroll
            for (int b = 0; b < 2; ++b)
#pragma unroll
                for (int m = 0; m < 4; ++m)
#pragma unroll
                    for (int n = 0; n < 2; ++n) acc[a][b][m][n] = AccT{};
        cur = nxt; cA = nA; cB = nB; ++ui;
        if constexpr (ALIGN_EPI) { if (wr == 1) PG8_BAR; }
    }
    PG8_WAIT_V(0);
    if constexpr (!ALIGN_EPI) { if (wr == 0) PG8_BAR; }
    PG8_BAR;
    if constexpr (Epi::AFTER_DRAIN) { E.fused(acc, cur, wr, wc, fr, fq, lds, wid, lane); S.done(cur); }
#undef PG8_SA
#undef PG8_SB
#undef PG8_STAGE
#undef PG8_LDA
#undef PG8_LDB
#undef PG8_MMA
#undef PG8_WAIT_V
#undef PG8_WAIT_L
#undef PG8_BAR
#undef PG8_SCHED
}
}
namespace att {
constexpr int D = 128; constexpr float THR = 8.f; constexpr bool WSKIP = true;
constexpr float SCALE = 0.08838834764831845f;
constexpr int NW = 8, QBLK = 32, KVBLK = 64, QB = NW * QBLK;
constexpr int SHM_V = KVBLK * D * 2, SHM_K = KVBLK * D * 2;
constexpr int LDS_TAB = 2 * SHM_V + 2 * SHM_K + NW * 64 * 4, TAB_N = 328, TAB_OFF = 100, TAB_PITCH = 4 * TAB_N;
constexpr int LDS_BYTES = LDS_TAB + 2 * TAB_PITCH * 4;
using bf16 = __hip_bfloat16;
typedef short bf16x8 __attribute__((ext_vector_type(8)));
typedef short s16x4 __attribute__((ext_vector_type(4)));
typedef float f32x16 __attribute__((ext_vector_type(16)));
typedef float f32x4 __attribute__((ext_vector_type(4)));
typedef float f32x2 __attribute__((ext_vector_type(2)));
typedef unsigned u32x4 __attribute__((ext_vector_type(4)));
template <class A, class Bt> struct same_t { static constexpr bool v = false; };
template <class A> struct same_t<A, A> { static constexpr bool v = true; };

#define KSWZ(row, colB) ((row) * 256 + ((colB) ^ (((row) & 7) << 4)))
#define SBAR() __builtin_amdgcn_sched_barrier(0)
__device__ __forceinline__ int v_st(int k, int c) { const int kk = (k & ~0xC) | ((k & 4) << 1) | ((k & 8) >> 1); return ((kk >> 3) * 4 + (c >> 5)) * 512 + ((kk & 7) * 32 + (c & 31)) * 2; }
__device__ __forceinline__ int v_rd_base(int lane) { return ((lane & 3) << 3) | (((lane >> 2) & 3) << 6) | (((lane >> 4) & 1) << 5) | (((lane >> 5) & 1) << 8); }
constexpr int v_rd_off(int d0, int ks, int half) { return d0 * 512 + ks * 4096 + half * 2048; }
__device__ __forceinline__ int crow(int r, int hi) { return (r & 3) + 8 * (r >> 2) + 4 * hi; }
__device__ __forceinline__ unsigned cvtpk(float lo, float hi) {
    unsigned r; asm volatile("v_cvt_pk_bf16_f32 %0, %1, %2" : "=v"(r) : "v"(lo), "v"(hi)); return r;
}
__device__ __forceinline__ bf16x8 pack8(f32x4 a, f32x4 b) {
    u32x4 w = {cvtpk(a[0], a[1]), cvtpk(a[2], a[3]), cvtpk(b[0], b[1]), cvtpk(b[2], b[3])};
    return *reinterpret_cast<bf16x8*>(&w);
}
template <class T> __device__ __forceinline__ bf16x8 load8(const T* p) {
    if constexpr (same_t<T, float>::v) { return pack8(*(const f32x4*)p, *(const f32x4*)(p + 4)); }
    else { return *reinterpret_cast<const bf16x8*>(p); }
}
__device__ __forceinline__ void mask_tile(f32x16& p0, f32x16& p1, int dq, unsigned W) {
    const float NEG = -__builtin_inff();
#pragma unroll
    for (int r = 0; r < 16; ++r) {
        const int c = (r & 3) + 8 * (r >> 2);
        if ((unsigned)(dq - c) >= W) p0[r] = NEG;
        if ((unsigned)(dq - c - 32) >= W) p1[r] = NEG;
    }
}
__device__ __forceinline__ void bias_mask_tile(f32x16& p0, f32x16& p1, int dq, unsigned W, const float* tabu, bool needmask) {
    const float NEG = -__builtin_inff();
    const int sft = (4 - ((int)threadIdx.x & 3)) & 3;
    const float* t0 = tabu + (sft * (TAB_N - 1) + TAB_OFF + 128 - dq);
#pragma unroll
    for (int J = 0; J < 8; ++J) {
        const f32x4 b = *(const f32x4*)(t0 + 8 * J);
#pragma unroll
        for (int e = 0; e < 4; ++e) {
            const int r = 4 * (J & 3) + e; const int c = e + 8 * (J & 3) + (J >= 4 ? 32 : 0);
            float v = (J < 4 ? p0[r] : p1[r]) + b[e];
            if (needmask) { if ((unsigned)(dq - c) >= W) v = NEG; }
            if (J < 4) p0[r] = v; else p1[r] = v;
        }
        if ((J & 1) == 1) asm volatile("" ::: "memory");
    }
}
__device__ __forceinline__ void bias_fill(float* T, const float* bsrc, int tid) {
    asm volatile("" : "+v"(tid));
    if (tid < TAB_N) {
#pragma unroll
        for (int sf = 0; sf < 4; ++sf) { const int i = tid - TAB_OFF + sf; T[sf * TAB_N + tid] = (i >= 0 && i <= 128) ? bsrc[128 - i] : 0.f; }
    }
}
__device__ __forceinline__ void partialSM(f32x16& p0, f32x16& p1, float& m_reg, float& mn, float& alpha) {
    float pmax = p0[0]; for (int r = 1; r < 16; ++r) pmax = fmaxf(pmax, p0[r]); for (int r = 0; r < 16; ++r) pmax = fmaxf(pmax, p1[r]);
    { auto rr = __builtin_amdgcn_permlane32_swap(__float_as_uint(pmax), __float_as_uint(pmax), false, false);
      pmax = fmaxf(__uint_as_float(rr[0]), __uint_as_float(rr[1])); }
    constexpr float C2 = 1.4426950408889634f * SCALE;
    if (__builtin_expect(__all((pmax - m_reg) * SCALE <= THR), 1)) { mn = m_reg; alpha = 1.f; }
    else { mn = fmaxf(m_reg, pmax); alpha = __builtin_amdgcn_exp2f((m_reg - mn) * C2); m_reg = mn; }
    const float mnL = -mn * C2;
    for (int r = 0; r < 16; ++r) p0[r] = fmaf(p0[r], C2, mnL); for (int r = 0; r < 16; ++r) p1[r] = fmaf(p1[r], C2, mnL);
    for (int r = 0; r < 16; ++r) p0[r] = __builtin_amdgcn_exp2f(p0[r]);
}
__device__ __forceinline__ void finishSM(f32x16& p0, f32x16& p1, float alpha, float& l_reg, bf16x8& pa0, bf16x8& pa1, bf16x8& pa2, bf16x8& pa3) {
    for (int r = 0; r < 16; ++r) p1[r] = __builtin_amdgcn_exp2f(p1[r]);
    float ps = 0; for (int r = 0; r < 16; ++r) ps += p0[r]; for (int r = 0; r < 16; ++r) ps += p1[r];
    { auto rr = __builtin_amdgcn_permlane32_swap(__float_as_uint(ps), __float_as_uint(ps), false, false);
      ps = __uint_as_float(rr[0]) + __uint_as_float(rr[1]); }
    l_reg = l_reg * alpha + ps;
#define PK4(P, B_, OUT) do { unsigned a0 = cvtpk(P[B_+0], P[B_+1]), a1 = cvtpk(P[B_+2], P[B_+3]);                          \
        unsigned b0 = cvtpk(P[B_+4], P[B_+5]), b1 = cvtpk(P[B_+6], P[B_+7]);                                             \
        auto r0 = __builtin_amdgcn_permlane32_swap(a0, b0, false, false); auto r1 = __builtin_amdgcn_permlane32_swap(a1, b1, false, false); \
        u32x4 w = {r0[0], r1[0], r0[1], r1[1]}; OUT = *reinterpret_cast<bf16x8*>(&w); } while (0)
    PK4(p0, 0, pa0); PK4(p0, 8, pa1); PK4(p1, 0, pa2); PK4(p1, 8, pa3);
#undef PK4
}
template <int KB, bool SK>
__device__ __forceinline__ void qkt(f32x16& p0, f32x16& p1, const char* K_lds, int r32, int hi, const bf16x8* qr, bool act) {
    if (SK && !act) { const float NEG = -__builtin_inff();
#pragma unroll
        for (int r = 0; r < 16; ++r) { p0[r] = NEG; p1[r] = NEG; } return; }
    p0 = f32x16{}; p1 = f32x16{};
    const char* kb[4];
#pragma unroll
    for (int dd = 0; dd < 4; ++dd) kb[dd] = K_lds + KB * SHM_K + KSWZ(r32, (dd * 16 + hi * 8) * 2);
#pragma unroll
    for (int d0 = 0; d0 < 8; ++d0) { const char* a = kb[d0 & 3] + (d0 >> 2) * 128;
        bf16x8 b0 = *reinterpret_cast<const bf16x8*>(a);
        bf16x8 b1 = *reinterpret_cast<const bf16x8*>(a + 32 * 256);
        p0 = __builtin_amdgcn_mfma_f32_32x32x16_bf16(b0, qr[d0], p0, 0, 0, 0);
        p1 = __builtin_amdgcn_mfma_f32_32x32x16_bf16(b1, qr[d0], p1, 0, 0, 0); }
}
template <int VB, bool SK>
__device__ __forceinline__ void pv_tile(f32x16* o, int vb0, bf16x8 pa0, bf16x8 pa1, bf16x8 pa2, bf16x8 pa3, bool act) {
    if (SK && !act) return;
#define TRRD(dst, off) asm volatile("ds_read_b64_tr_b16 %0, %1 offset:%2" : "=&v"(dst) : "v"(vb0), "i"(off) : "memory")
#define PV_D0(d0) do { s16x4 l0, l1, l2, l3, h0, h1, h2, h3; constexpr int b_ = VB * SHM_V + v_rd_off(d0, 0, 0);     \
        TRRD(l0, b_); TRRD(h0, b_ + 2048); TRRD(l1, b_ + 4096); TRRD(h1, b_ + 6144); TRRD(l2, b_ + 8192); TRRD(h2, b_ + 10240); TRRD(l3, b_ + 12288); TRRD(h3, b_ + 14336); \
        asm volatile("s_waitcnt lgkmcnt(0)" ::: "memory"); SBAR();                 \
        o[d0] = __builtin_amdgcn_mfma_f32_32x32x16_bf16(pa0, (bf16x8){l0[0], l0[1], l0[2], l0[3], h0[0], h0[1], h0[2], h0[3]}, o[d0], 0, 0, 0);   \
        o[d0] = __builtin_amdgcn_mfma_f32_32x32x16_bf16(pa1, (bf16x8){l1[0], l1[1], l1[2], l1[3], h1[0], h1[1], h1[2], h1[3]}, o[d0], 0, 0, 0);   \
        o[d0] = __builtin_amdgcn_mfma_f32_32x32x16_bf16(pa2, (bf16x8){l2[0], l2[1], l2[2], l2[3], h2[0], h2[1], h2[2], h2[3]}, o[d0], 0, 0, 0);   \
        o[d0] = __builtin_amdgcn_mfma_f32_32x32x16_bf16(pa3, (bf16x8){l3[0], l3[1], l3[2], l3[3], h3[0], h3[1], h3[2], h3[3]}, o[d0], 0, 0, 0); } while (0)
    PV_D0(0); PV_D0(1); PV_D0(2); PV_D0(3);
#undef PV_D0
#undef TRRD
}

template <class TIn, class TOut> struct BlockRef { const TIn* Q; const TIn* K; const TIn* V; TOut* O; float* L; const float* bsrc; int P0, pq, pk, po, pl, skv, W; };
template <class TIn> struct Seam {
    bf16x8 qr[8];
    bf16x8 st_v0, st_v1, st_k0, st_k1; f32x4 sf0, sf1, sf2, sf3;
    f32x4 tq[16];
};
__device__ __forceinline__ int swa_jlo(int P0, int W) { const int lowk = P0 - W + 1; return lowk > 0 ? lowk / KVBLK : 0; }
#define ROW(p, pit, k0, rr) ((p) + (unsigned)(((k0) + (rr)) * (pit) + sc))
#define VMW() asm volatile("s_waitcnt vmcnt(0)" ::: "memory")
#define VMWN(n) asm volatile("s_waitcnt vmcnt(%0)" :: "i"(n) : "memory")
#define SLOAD_H(Kp, Vp, pit, k0) do { S.st_v0 = load8<TIn>(ROW(Vp, pit, k0, sr)); S.st_v1 = load8<TIn>(ROW(Vp, pit, k0, 32 + sr));              \
                         S.st_k0 = load8<TIn>(ROW(Kp, pit, k0, sr)); S.st_k1 = load8<TIn>(ROW(Kp, pit, k0, 32 + sr)); } while (0)
#define SWRITE_HK(bf) do { *(bf16x8*)(K_lds + (bf) * SHM_K + kws) = S.st_k0; *(bf16x8*)(K_lds + (bf) * SHM_K + kws + 32 * 256) = S.st_k1; } while (0)
#define SWRITE_HV(bf) do { *(bf16x8*)(V_lds + (bf) * SHM_V + vst0) = S.st_v0; *(bf16x8*)(V_lds + (bf) * SHM_V + vst1) = S.st_v1; } while (0)
#define SWRITE_H(bf) do { SWRITE_HV(bf); SWRITE_HK(bf); } while (0)
#define SLOAD_F(p, k0) do { S.sf0 = *(const f32x4*)ROW(p, D, k0, sr); S.sf1 = *(const f32x4*)(ROW(p, D, k0, sr) + 4);                \
                            S.sf2 = *(const f32x4*)ROW(p, D, k0, 32 + sr); S.sf3 = *(const f32x4*)(ROW(p, D, k0, 32 + sr) + 4); } while (0)
#define SWRITE_KF(bf) do { *(bf16x8*)(K_lds + (bf) * SHM_K + kws) = pack8(S.sf0, S.sf1); *(bf16x8*)(K_lds + (bf) * SHM_K + kws + 32 * 256) = pack8(S.sf2, S.sf3); } while (0)
#define SWRITE_VF(bf) do { *(bf16x8*)(V_lds + (bf) * SHM_V + vst0) = pack8(S.sf0, S.sf1); *(bf16x8*)(V_lds + (bf) * SHM_V + vst1) = pack8(S.sf2, S.sf3); } while (0)
template <int BIAS, class TIn, class TOut>
__device__ __forceinline__ void causal_swa_prime(const BlockRef<TIn, TOut>& cur, char* lds, Seam<TIn>& S) {
    const int W = cur.W;
    constexpr bool F32 = same_t<TIn, float>::v;
    const int tid = threadIdx.x, wid = __builtin_amdgcn_readfirstlane(tid >> 6), lane = tid & 63, r32 = lane & 31, hi = lane >> 5;
    const int sr = tid >> 4, sc = (tid & 15) * 8, kws = KSWZ(sr, sc * 2); char* K_lds = lds + 2 * SHM_V;
    const int kb0 = swa_jlo(cur.P0, W) * KVBLK;
    if (BIAS == 1 || BIAS == 3) bias_fill((float*)(lds + LDS_TAB), cur.bsrc, tid);
    for (int d0 = 0; d0 < 8; ++d0) S.qr[d0] = load8<TIn>(cur.Q + (unsigned)((wid * QBLK + r32) * cur.pq + d0 * 16 + hi * 8));
    if constexpr (F32) { SLOAD_F((const float*)cur.K, kb0); VMW(); SWRITE_KF(0); SBAR(); SLOAD_F((const float*)cur.V, kb0); }
    else { SLOAD_H(cur.K, cur.V, cur.pk, kb0); VMW(); SWRITE_HK(0); }
    __syncthreads();
}
template <int BIAS, class TIn, class TOut, class ItemFn>
__device__ __forceinline__ void causal_swa_block(const BlockRef<TIn, TOut>& cur, int Lnext, const ItemFn& itemfn, int par, char* lds, Seam<TIn>& S) {
    const int skv = cur.skv, W = cur.W;
    const float* tab = (const float*)(lds + LDS_TAB) + par * TAB_PITCH;
    constexpr bool F32 = same_t<TIn, float>::v;
    const int tid = threadIdx.x, wid = __builtin_amdgcn_readfirstlane(tid >> 6), lane = tid & 63, r32 = lane & 31, hi = lane >> 5;
    const int j_lo = swa_jlo(cur.P0, W);
    int j_hi = (cur.P0 + QB - 1) / KVBLK + 1; if (j_hi > skv / KVBLK) j_hi = skv / KVBLK;
    const int NT = j_hi - j_lo;
    const int qlo = cur.P0 + wid * QBLK, qm = qlo + r32 - 4 * hi;
    char* V_lds = lds; char* K_lds = lds + 2 * SHM_V;
    float* ws = (float*)(lds + 2 * SHM_V + 2 * SHM_K) + wid * 64; float* li_l = ws, * al_l = ws + 32;
    float m_reg = -1e30f, l_reg = 0; f32x16 o[4] = {};
    const int sr = tid >> 4, sc = (tid & 15) * 8, vst0 = v_st(sr, sc), vst1 = v_st(32 + sr, sc), kws = KSWZ(sr, sc * 2);
    const int vb0 = (int)(uintptr_t)V_lds + v_rd_base(lane);
    const TIn* Kh = cur.K; const TIn* Vh = cur.V;
#define RESC(a) do { if (__any((a) < 1.f)) { if (hi == 0) al_l[r32] = (a); asm volatile("s_waitcnt lgkmcnt(0)" ::: "memory");              \
                     for (int d_ = 0; d_ < 4; ++d_) for (int r = 0; r < 16; ++r) o[d_][r] *= al_l[crow(r, hi)]; } } while (0)
#define KBASE(t) ((j_lo + (t)) * KVBLK)
#define ACT(t) (KBASE(t) <= qlo + QBLK - 1 && KBASE(t) + KVBLK - 1 >= qlo - W + 1)
#define MASKT(P0_, P1_, t) do { const int kb_ = KBASE(t); if constexpr (BIAS == 1 || BIAS == 2) { if (!SK || ACT(t)) bias_mask_tile(P0_, P1_, qm - kb_, (unsigned)W, tab, kb_ + KVBLK - 1 > qlo || kb_ <= qlo + QBLK - 1 - W); } \
        else { if ((!SK || ACT(t)) && (kb_ + KVBLK - 1 > qlo || kb_ <= qlo + QBLK - 1 - W)) mask_tile(P0_, P1_, qm - kb_, (unsigned)W); } } while (0)
    constexpr int NQL = F32 ? 16 : 8;
    constexpr bool SK = WSKIP && !F32;
#define SEAM_K0() do { VMWN(NQL); if constexpr (F32) { SWRITE_KF(0); SBAR(); SLOAD_F((const float*)nxt.V, kbn); } else { SWRITE_HK(0); } SBAR(); } while (0)
    f32x16 pA0, pA1, pB0, pB1; float mnA, mnB, alA, alB; bf16x8 pa0, pa1, pa2, pa3;
    if constexpr (F32) { VMW(); SWRITE_VF(0); SBAR(); } else { SWRITE_HV(0); SBAR(); }
    if (NT > 1) { if constexpr (F32) SLOAD_F((const float*)Kh, KBASE(1)); else SLOAD_H(Kh, Vh, cur.pk, KBASE(1)); }
    SBAR(); qkt<0, SK>(pA0, pA1, K_lds, r32, hi, S.qr, ACT(0));
    if constexpr (F32) { if (NT > 1) { VMW(); SWRITE_KF(1); SBAR(); SLOAD_F((const float*)Vh, KBASE(1)); } }
    MASKT(pA0, pA1, 0); partialSM(pA0, pA1, m_reg, mnA, alA);
    if (NT > 1) { VMW(); if constexpr (F32) { SWRITE_VF(1); SBAR(); if (NT > 2) SLOAD_F((const float*)Kh, KBASE(2)); } else SWRITE_H(1); }
    __syncthreads();
#define HALF_STEP(PX0, PX1, mnX, alX, PY0, PY1, alY, t, KB, VB, SB) do {                                                      \
        SBAR(); qkt<KB, SK>(PX0, PX1, K_lds, r32, hi, S.qr, ACT(t));                                             \
        finishSM(PY0, PY1, alY, l_reg, pa0, pa1, pa2, pa3); SBAR();                                                           \
        if ((t) + 1 < NT) { if constexpr (F32) { VMW(); SWRITE_KF(SB); SBAR(); SLOAD_F((const float*)Vh, KBASE((t) + 1)); }  \
                            else { SLOAD_H(Kh, Vh, cur.pk, KBASE((t) + 1)); } SBAR(); }                                               \
        pv_tile<VB, SK>(o, vb0, pa0, pa1, pa2, pa3, ACT((t) - 1)); MASKT(PX0, PX1, (t)); partialSM(PX0, PX1, m_reg, mnX, alX);                                        \
        __syncthreads();                                                                                                      \
        if ((t) + 1 < NT) { VMW(); if constexpr (F32) { SWRITE_VF(SB); SBAR(); if ((t) + 2 < NT) SLOAD_F((const float*)Kh, KBASE((t) + 2)); } \
                            else { SWRITE_H(SB); } }                                                                          \
        RESC(alX); __syncthreads(); } while (0)
    for (int t = 1; t + 1 < NT; t += 2) {
        HALF_STEP(pB0, pB1, mnB, alB, pA0, pA1, alA, t, 1, 0, 0);
        HALF_STEP(pA0, pA1, mnA, alA, pB0, pB1, alB, t + 1, 0, 1, 1);
    }
    asm volatile("" : "+s"(Lnext));
    const BlockRef<TIn, TOut> nxt = itemfn(Lnext); const int kbn = swa_jlo(nxt.P0, nxt.W) * KVBLK;
    const bool even = (NT & 1) == 0;
    if (even) { SBAR(); qkt<1, SK>(pB0, pB1, K_lds, r32, hi, S.qr, ACT(NT - 1)); SBAR(); }
#define QROW(e) (nxt.Q + (size_t)(wid * QBLK + r32) * D + ((e) >> 1) * 16 + hi * 8 + ((e) & 1) * 4)
    if constexpr (F32) { SLOAD_F((const float*)nxt.K, kbn); SBAR();
#pragma unroll
        for (int e = 0; e < 8; ++e) S.tq[e] = *(const f32x4*)QROW(e); }
    else { SLOAD_H(nxt.K, nxt.V, nxt.pk, kbn); SBAR();
#pragma unroll
        for (int d0 = 0; d0 < 8; ++d0) S.qr[d0] = load8<TIn>(nxt.Q + (unsigned)((wid * QBLK + r32) * nxt.pq + d0 * 16 + hi * 8)); }
    SBAR();
    finishSM(pA0, pA1, alA, l_reg, pa0, pa1, pa2, pa3); SBAR();
    if constexpr (F32) {
#pragma unroll
        for (int e = 8; e < 16; ++e) S.tq[e] = *(const f32x4*)QROW(e); SBAR(); }
#undef QROW
    pv_tile<0, SK>(o, vb0, pa0, pa1, pa2, pa3, ACT(even ? NT - 2 : NT - 1));
    if (even) { MASKT(pB0, pB1, NT - 1); partialSM(pB0, pB1, m_reg, mnB, alB); __syncthreads(); RESC(alB);
        finishSM(pB0, pB1, alB, l_reg, pa0, pa1, pa2, pa3); SBAR(); pv_tile<1, SK>(o, vb0, pa0, pa1, pa2, pa3, ACT(NT - 1)); }
    SBAR(); SEAM_K0();
    if (hi == 0) li_l[r32] = l_reg; asm volatile("s_waitcnt lgkmcnt(0)" ::: "memory");
    float rli[16];
#pragma unroll
    for (int r = 0; r < 16; ++r) rli[r] = __builtin_amdgcn_rcpf(li_l[crow(r, hi)]);
    TOut* Ow = cur.O + (unsigned)((wid * QBLK) * cur.po); const int po = cur.po;
    if constexpr (BIAS == 1 || BIAS == 3) { if (hi == 0) { f32x2 ml = {m_reg * (1.4426950408889634f * SCALE), l_reg}; *(f32x2*)(cur.L + (unsigned)((wid * QBLK + r32) * cur.pl)) = ml; }
                          bias_fill((float*)(lds + LDS_TAB) + (par ^ 1) * TAB_PITCH, nxt.bsrc, tid); }
#pragma unroll
    for (int r = 0; r < 16; ++r) { const int orow = crow(r, hi);
#pragma unroll
        for (int d0 = 0; d0 < 4; ++d0) { const float v = o[d0][r] * rli[r];
            if constexpr (same_t<TOut, float>::v) { Ow[(unsigned)(orow * po + d0 * 32 + r32)] = v; }
            else { const float vn = __shfl_xor(v, 1);
                   if ((r32 & 1) == 0) *(unsigned*)(Ow + (unsigned)(orow * po + d0 * 32 + r32)) = cvtpk(v, vn); } } }
    if constexpr (F32) {
#pragma unroll
        for (int d0 = 0; d0 < 8; ++d0) S.qr[d0] = pack8(S.tq[2 * d0], S.tq[2 * d0 + 1]); }
    __syncthreads();
#undef RESC
#undef KBASE
#undef ACT
#undef MASKT
#undef SEAM_K0
#undef HALF_STEP
}
#undef ROW
#undef VMW
#undef VMWN
#undef SLOAD_H
#undef SWRITE_HK
#undef SWRITE_HV
#undef SWRITE_H
#undef SLOAD_F
#undef SWRITE_KF
#undef SWRITE_VF

}
constexpr int NWAVES = 8;
#ifndef MK_N_LAUNCHES
#define MK_N_LAUNCHES 1
#endif
constexpr int NPH = 13;
constexpr int N_LAUNCHES = MK_N_LAUNCHES;
static_assert(N_LAUNCHES == 1 || N_LAUNCHES == NPH, "MK_N_LAUNCHES is 1 or 13");

#ifndef FFN_I8
#define FFN_I8 1
#endif
constexpr int NB = 4, SEQ = 4096, DM = 4096, M = NB * SEQ;
constexpr int MEMLEN = 256, MROWS = NB * MEMLEN;
constexpr int NIN = 12304, NPROJ = 12288;
constexpr int DFF = 11008, NGU = 2 * DFF;
constexpr int XW = 512;
constexpr float RMS_EPS = 1e-6f;

constexpr size_t MiB = 1u << 20;
constexpr size_t WS_CTL = 0, CTL_ZERO_BYTES = 1 * MiB;
constexpr size_t WS_BT = 1 * MiB;
constexpr size_t WS_Q0K0 = 1 * MiB + 64 * 1024;
constexpr size_t WS_RSC1 = 1 * MiB + 128 * 1024;
constexpr size_t WS_XNQ = 780 * MiB;
constexpr size_t WS_WINQ = 2 * MiB + (size_t)6144 * 4096 * 2;
constexpr size_t WS_WIN = 2 * MiB;
constexpr size_t WS_WLR = 98 * MiB;
constexpr size_t WS_WOUT = 99 * MiB;
constexpr size_t WS_WXQ = 131 * MiB;
constexpr size_t WS_WXKV = 135 * MiB;
constexpr size_t WS_WXO = 143 * MiB;
constexpr size_t WS_MEMN = 147 * MiB;
constexpr size_t WS_XKV = 155 * MiB;
constexpr size_t WS_WGU = 160 * MiB;
constexpr size_t WS_WDN = 332 * MiB;
constexpr size_t WS_DQKV = 160 * MiB;
constexpr size_t WS_GK = 352 * MiB;
constexpr size_t WS_GQ = 384 * MiB;
constexpr size_t WS_XN = 418 * MiB;
constexpr size_t WS_MIX = 546 * MiB;
constexpr size_t WS_GV = 546 * MiB;
constexpr size_t WS_VT = 610 * MiB;
constexpr size_t WS_GR = 674 * MiB;
constexpr size_t WS_KET = 738 * MiB;
constexpr size_t WS_ATT = 770 * MiB;
constexpr size_t WS_DEC = 778 * MiB;
constexpr size_t WS_OC = 780 * MiB;
constexpr size_t WS_LSE = 972 * MiB;
constexpr size_t WS_ACT = 546 * MiB;
constexpr size_t WS_HALO = 890 * MiB;
constexpr size_t WS_XQ = 980 * MiB;
constexpr size_t WS_XO = 996 * MiB;
constexpr size_t WS_GQ2 = 1012 * MiB;
constexpr size_t WS_H2Q = 980 * MiB;
constexpr size_t WS_END = 1044 * MiB;
constexpr size_t HALO_ONE = (size_t)256 * 2 * DFF * 4;
static_assert(WS_HALO + 3 * HALO_ONE <= WS_XQ && WS_ACT + (size_t)M * DFF * 2 <= WS_HALO && WS_WDN + (size_t)DM * DFF * 2 <= WS_XN && WS_WGU + (size_t)NGU * DM * 2 <= WS_WDN, "d_ws map");
static_assert(WS_OC + (size_t)3 * M * 2048 * 2 <= WS_LSE && WS_LSE + (size_t)3 * M * 16 * 2 * 4 <= WS_XQ && WS_GQ + (size_t)M * 1024 * 2 <= WS_XN, "d_ws map 2");
constexpr int CW_QUEUE = 2048;
constexpr int CW_BAR = 4096;
constexpr size_t CTL_COLMAX = 704 * 1024;
constexpr size_t CTL_CMAX1 = 864 * 1024;
constexpr size_t CTL_AMAX = 800 * 1024;
constexpr size_t CTL_SS = 256 * 1024;

constexpr int LDS_BYTES = 147456;
constexpr int MISC_OFF = LDS_BYTES - 256;

#define GAS __attribute__((address_space(1)))
#define LAS __attribute__((address_space(3)))
typedef unsigned short bf16;
typedef unsigned v4u __attribute__((ext_vector_type(4)));
typedef unsigned v2u __attribute__((ext_vector_type(2)));
typedef float f32x4 __attribute__((ext_vector_type(4)));
typedef float f32x2 __attribute__((ext_vector_type(2)));
typedef float f32x16 __attribute__((ext_vector_type(16)));
typedef short bf16x8 __attribute__((ext_vector_type(8)));
typedef short s16x4 __attribute__((ext_vector_type(4)));
typedef short v4i16_t __attribute__((ext_vector_type(4)));
typedef GAS unsigned gu32;
#define RLX_AGENT __ATOMIC_RELAXED, __HIP_MEMORY_SCOPE_AGENT
#define LDS_WAIT() asm volatile("s_waitcnt lgkmcnt(0)" ::: "memory")
#define VM_WAIT() asm volatile("s_waitcnt vmcnt(0)" ::: "memory")
__device__ __forceinline__ unsigned f2bf(float f) { unsigned u = __builtin_bit_cast(unsigned, f); return (u + 0x7fffu + ((u >> 16) & 1u)) >> 16; }
__device__ __forceinline__ unsigned pk2(float lo, float hi) { return f2bf(lo) | (f2bf(hi) << 16); }
__device__ __forceinline__ float bf2f(unsigned short b) { return __builtin_bit_cast(float, (unsigned)b << 16); }
__device__ __forceinline__ float bflo(unsigned w) { return __builtin_bit_cast(float, w << 16); }
__device__ __forceinline__ float bfhi(unsigned w) { return __builtin_bit_cast(float, w & 0xffff0000u); }
typedef __bf16 bf16x2_t __attribute__((ext_vector_type(2)));
__device__ __forceinline__ unsigned cvtpk_s(float lo, float hi) { f32x2 v = {lo, hi}; bf16x2_t b = __builtin_convertvector(v, bf16x2_t); return __builtin_bit_cast(unsigned, b); }
__device__ __forceinline__ bf16x8 pack8f(float a0, float a1, float a2, float a3, float a4, float a5, float a6, float a7) {
    v4u w = {cvtpk_s(a0, a1), cvtpk_s(a2, a3), cvtpk_s(a4, a5), cvtpk_s(a6, a7)}; return __builtin_bit_cast(bf16x8, w); }
#define XB_TMO      128
#define XB_XCNT(j)  (256  + 64 * (j))
#define XB_XSUB(j)  (1280 + 64 * (j))
#define XB_XGEN(j)  (2304 + 64 * (j))
#define XB_TOP      3328
#define XB_TOPGEN   3392
#define XCD_BAR_WORDS 3456
#define XB_SPIN_CAP (1u << 18)

__device__ __forceinline__ unsigned xb_ld(unsigned* p)              { return __hip_atomic_load(p, __ATOMIC_RELAXED, __HIP_MEMORY_SCOPE_AGENT); }
__device__ __forceinline__ unsigned xb_add(unsigned* p, unsigned v) { return __hip_atomic_fetch_add(p, v, __ATOMIC_RELAXED, __HIP_MEMORY_SCOPE_AGENT); }
__device__ __forceinline__ unsigned xb_xcc_id() { return (unsigned)__builtin_amdgcn_s_getreg((3 << 11) | 20) & 0xFu; }
#define XB_SPIN(cond, bar) do { unsigned _sp = 0; while (cond) { __builtin_amdgcn_s_sleep(1); \
    if ((++_sp & 255u) == 0u) { if (xb_ld(&(bar)[XB_TMO])) break; if (_sp > XB_SPIN_CAP) { atomicAdd(&(bar)[XB_TMO], 1u); break; } } } } while (0)

struct XcdBarrier {
    unsigned* bar; unsigned x;
    volatile LAS unsigned* st;
};

__device__ __forceinline__ XcdBarrier xcd_barrier_post(unsigned* bar, volatile LAS unsigned* st) {
    XcdBarrier b; b.bar = bar; b.x = xb_xcc_id(); b.st = st;
    if (threadIdx.x == 0) (void)xb_add(&bar[XB_XCNT(b.x)], 1u);
    return b;
}
__device__ __forceinline__ void xcd_barrier_complete(unsigned* bar, unsigned x, unsigned& nloc, unsigned& nx) {
    const unsigned G = gridDim.x * gridDim.y * gridDim.z;
    unsigned sum, cnt, mine, sp = 0u;
    for (;;) {
        sum = 0u; cnt = 0u; mine = 0u;
#pragma unroll
        for (unsigned j = 0; j < 16; ++j) { const unsigned c = xb_ld(&bar[XB_XCNT(j)]); sum += c; cnt += (c > 0u) ? 1u : 0u; mine = (j == x) ? c : mine; }
        if (sum == G) break;
        __builtin_amdgcn_s_sleep(1);
        if ((++sp & 255u) == 0u) { if (xb_ld(&bar[XB_TMO])) break; if (sp > XB_SPIN_CAP) { atomicAdd(&bar[XB_TMO], 1u); break; } }
    }
    nloc = mine > 0u ? mine : 1u; nx = cnt > 0u ? cnt : 1u;
}

__device__ __forceinline__ void xcd_barrier(const XcdBarrier& b) {
    asm volatile("s_waitcnt vmcnt(0)" ::: "memory");
    __syncthreads();
    if (threadIdx.x == 0) {
        unsigned* bar = b.bar;
        __builtin_amdgcn_s_waitcnt(0);
        unsigned nloc = b.st[0], nx = b.st[1];
        if (nloc == 0u) { xcd_barrier_complete(bar, b.x, nloc, nx); b.st[0] = nloc; b.st[1] = nx; }
        const unsigned old = xb_add(&bar[XB_XSUB(b.x)], 1u);
        const unsigned gen = old / nloc;
        if (old + 1u == (gen + 1u) * nloc) {
            __builtin_amdgcn_fence(__ATOMIC_RELEASE, "agent");
            asm volatile("s_waitcnt vmcnt(0)" ::: "memory");
            const unsigned og = xb_add(&bar[XB_TOP], 1u);
            const unsigned tg = og / nx;
            if (og + 1u == (tg + 1u) * nx) xb_add(&bar[XB_TOPGEN], 1u);
            else XB_SPIN(xb_ld(&bar[XB_TOPGEN]) == tg, bar);
            __builtin_amdgcn_fence(__ATOMIC_ACQUIRE, "agent");
            xb_add(&bar[XB_XGEN(b.x)], 1u);
            asm volatile("s_waitcnt vmcnt(0)" ::: "memory");
        } else {
            XB_SPIN(xb_ld(&bar[XB_XGEN(b.x)]) == gen, bar);
            __builtin_amdgcn_fence(__ATOMIC_ACQUIRE, "agent");
            asm volatile("s_waitcnt vmcnt(0)" ::: "memory");
        }
    }
    __syncthreads();
}
struct Frame {
    LAS unsigned char* lds; char* ldsg;
    volatile LAS unsigned* MISC;
    gu32* ctl;
    int wave, vcu, G;
    unsigned char* ws;
    const float* const __attribute__((address_space(4)))* kin;
    float* out;
};
__device__ __forceinline__ int tid_now() { int t = (int)threadIdx.x; asm volatile("" : "+v"(t)); return t; }
__device__ __forceinline__ float wave_sum(float v) {
#pragma unroll
    for (int o = 1; o < 64; o <<= 1) v += __shfl_xor(v, o);
    return v;
}
__device__ const unsigned char kBucket[3][132] = {
 {0,1,2,3,4,5,6,7,8,9,10,11,12,13,14,15,16,16,16,16,16,16,17,17,17,17,17,17,17,17,18,18,18,18,18,18,18,18,18,18,19,19,19,19,19,19,19,19,19,19,19,19,19,19,20,20,20,20,20,20,20,20,20,20,20,20,20,20,20,20,20,20,20,21,21,21,21,21,21,21,21,21,21,21,21,21,21,21,21,21,21,21,21,21,21,21,21,21,21,22,22,22,22,22,22,22,22,22,22,22,22,22,22,22,22,22,22,22,22,22,22,22,22,22,22,22,22,22,22,0,0,0},
 {0,4,8,12,16,16,17,17,18,18,19,19,19,19,20,20,20,20,20,21,21,21,21,21,21,22,22,22,22,22,22,22,22,22,23,23,23,23,23,23,23,23,23,23,23,23,24,24,24,24,24,24,24,24,24,24,24,24,24,24,24,24,25,25,25,25,25,25,25,25,25,25,25,25,25,25,25,25,25,25,25,25,25,26,26,26,26,26,26,26,26,26,26,26,26,26,26,26,26,26,26,26,26,26,26,26,26,26,26,26,26,26,26,27,27,27,27,27,27,27,27,27,27,27,27,27,27,27,27,0,0,0},
 {0,16,18,19,20,21,21,22,22,23,23,23,24,24,24,24,25,25,25,25,25,26,26,26,26,26,26,26,26,27,27,27,27,27,27,27,27,27,27,28,28,28,28,28,28,28,28,28,28,28,28,28,29,29,29,29,29,29,29,29,29,29,29,29,29,29,29,29,29,29,30,30,30,30,30,30,30,30,30,30,30,30,30,30,30,30,30,30,30,30,30,30,30,30,30,31,31,31,31,31,31,31,31,31,31,31,31,31,31,31,31,31,31,31,31,31,31,31,31,31,31,31,31,31,31,31,31,31,31,0,0,0}};

constexpr int TR_SCR = 17408;
__device__ __forceinline__ void tr_item(const float* W, int ldw, bf16* WT, int ldt, int src_c0, int dst_r0, int nvalid, const float* gain, LAS float* scr, int kb, int lane) {
    const int k0 = 64 * kb, a = lane >> 4, c4 = 4 * (lane & 15);
#pragma unroll 8
    for (int i = 0; i < 16; ++i) { const int kk = 4 * i + a; f32x4 v = *(const GAS f32x4*)(W + (size_t)(k0 + kk) * ldw + src_c0 + c4); if (gain) v = v * gain[k0 + kk];
        LAS float* d = scr + kk * 65 + c4; d[0] = v.x; d[1] = v.y; d[2] = v.z; d[3] = v.w; }
    LDS_WAIT(); asm volatile("" ::: "memory");
    const int c = lane & 7;
#pragma unroll
    for (int j = 0; j < 8; ++j) { const int n = (lane >> 3) + 8 * j; const LAS float* s = scr + (8 * c) * 65 + n;
        v4u o; o.x = pk2(s[0 * 65], s[1 * 65]); o.y = pk2(s[2 * 65], s[3 * 65]); o.z = pk2(s[4 * 65], s[5 * 65]); o.w = pk2(s[6 * 65], s[7 * 65]);
        if (n < nvalid) *(GAS v4u*)(WT + (size_t)(dst_r0 + n) * ldt + k0 + 8 * c) = o; }
    LDS_WAIT(); asm volatile("" ::: "memory");
}
constexpr float CM_WIDEN = 1.0f;
__device__ __forceinline__ void absmax_item(const float* W, int ldw, int src_c0, const float* gain, unsigned* cmax, int kb, int lane) {
    const int k0 = 64 * kb, a = lane >> 4, c4 = 4 * (lane & 15);
    f32x4 m = {0.f, 0.f, 0.f, 0.f};
#pragma unroll 8
    for (int i = 0; i < 16; ++i) { const int kk = 4 * i + a; const f32x4 v = *(const GAS f32x4*)(W + (size_t)(k0 + kk) * ldw + src_c0 + c4) * (gain ? gain[k0 + kk] : 1.0f);
        m.x = fmaxf(m.x, fabsf(v.x)); m.y = fmaxf(m.y, fabsf(v.y)); m.z = fmaxf(m.z, fabsf(v.z)); m.w = fmaxf(m.w, fabsf(v.w)); }
#pragma unroll
    for (int o = 16; o < 64; o <<= 1) { m.x = fmaxf(m.x, __shfl_xor(m.x, o)); m.y = fmaxf(m.y, __shfl_xor(m.y, o)); m.z = fmaxf(m.z, __shfl_xor(m.z, o)); m.w = fmaxf(m.w, __shfl_xor(m.w, o)); }
    if (lane < 16) { unsigned* p = cmax + c4;   atomicMax(p, __float_as_uint(m.x)); atomicMax(p + 1, __float_as_uint(m.y)); atomicMax(p + 2, __float_as_uint(m.z)); atomicMax(p + 3, __float_as_uint(m.w)); }
}
__device__ __forceinline__ void quant_item(const float* W, int ldw, signed char* WQ, int ldq, int src_c0, int dst_r0, const float* gain, const unsigned* cmax, LAS float* scr, int kb, int lane) {
    const int k0 = 64 * kb, a = lane >> 4, c4 = 4 * (lane & 15);
#pragma unroll 8
    for (int i = 0; i < 16; ++i) { const int kk = 4 * i + a; const f32x4 v = *(const GAS f32x4*)(W + (size_t)(k0 + kk) * ldw + src_c0 + c4) * (gain ? gain[k0 + kk] : 1.0f);
        LAS float* d = scr + kk * 65 + c4; d[0] = v.x; d[1] = v.y; d[2] = v.z; d[3] = v.w; }
    LDS_WAIT(); asm volatile("" ::: "memory");
    const int c = lane & 3;
#pragma unroll
    for (int j = 0; j < 4; ++j) { const int n = (lane >> 2) + 16 * j; const LAS float* s = scr + (16 * c) * 65 + n;
        const float cm = __uint_as_float(cmax[n]) * CM_WIDEN; const float inv = cm > 0.f ? 127.0f / cm : 0.f;
        unsigned wq[4];
#pragma unroll
        for (int q = 0; q < 4; ++q) { unsigned acc = 0u;
#pragma unroll
            for (int e = 0; e < 4; ++e) { const float r = fminf(fmaxf(__builtin_rintf(s[(4 * q + e) * 65] * inv), -127.f), 127.f); acc |= ((unsigned)(int)r & 0xffu) << (8 * e); }
            wq[q] = acc; }
        v4u o = {wq[0], wq[1], wq[2], wq[3]};
        *(GAS v4u*)(WQ + (size_t)(dst_r0 + n) * ldq + k0 + 16 * c) = o; }
    LDS_WAIT(); asm volatile("" ::: "memory");
}

__device__ __forceinline__ void rms_row_to_bf16(const float* xrow, const float* g, bf16* orow, int lane, signed char* qrow = nullptr, float* qscale = nullptr) {
    const GAS f32x4* xr = (const GAS f32x4*)xrow + lane; const GAS f32x4* gr = (const GAS f32x4*)g + lane;
    f32x4 v[16]; float s = 0.f;
#pragma unroll
    for (int j = 0; j < 16; ++j) { v[j] = xr[64 * j]; s += (v[j].x * v[j].x + v[j].y * v[j].y) + (v[j].z * v[j].z + v[j].w * v[j].w); }
    const float r = 1.0f / sqrtf(wave_sum(s) * (1.0f / 4096.0f) + RMS_EPS);
    GAS v2u* o8 = (GAS v2u*)orow + lane; float mx = 0.f;
#pragma unroll
    for (int j = 0; j < 16; ++j) { const f32x4 gg = gr[64 * j]; v[j] = (f32x4){v[j].x * r * gg.x, v[j].y * r * gg.y, v[j].z * r * gg.z, v[j].w * r * gg.w};
        v2u o; o.x = pk2(v[j].x, v[j].y); o.y = pk2(v[j].z, v[j].w); o8[64 * j] = o;
        mx = fmaxf(mx, fmaxf(fmaxf(fabsf(v[j].x), fabsf(v[j].y)), fmaxf(fabsf(v[j].z), fabsf(v[j].w)))); }
    if (qrow) {
#pragma unroll
        for (int o = 1; o < 64; o <<= 1) mx = fmaxf(mx, __shfl_xor(mx, o));
        const float inv = mx > 0.f ? 127.0f / mx : 0.f; GAS unsigned* q4 = (GAS unsigned*)qrow + lane;
#pragma unroll
        for (int j = 0; j < 16; ++j) { const int a = (int)__builtin_rintf(v[j].x * inv), b = (int)__builtin_rintf(v[j].y * inv), c = (int)__builtin_rintf(v[j].z * inv), d = (int)__builtin_rintf(v[j].w * inv);
            q4[64 * j] = ((unsigned)a & 0xffu) | (((unsigned)b & 0xffu) << 8) | (((unsigned)c & 0xffu) << 16) | (((unsigned)d & 0xffu) << 24); }
        if (lane == 0) *qscale = mx * (1.0f / 127.0f);
    }
}

__device__ __forceinline__ void p0_first_token(Frame& F) {
    const int tid = tid_now(), lane = tid & 63, w = F.wave;
    LAS float* red = (LAS float*)F.lds;
    const float* x = F.kin[0]; const float* g = F.kin[3]; const float* W = F.kin[4];
    float* Q0K0 = (float*)(F.ws + WS_Q0K0);
    for (int cb = blockIdx.x; cb < 256; cb += F.G) {
        float xv[4][8]; float gg[8]; f32x4 w0[8], w1[8];
#pragma unroll
        for (int i = 0; i < 8; ++i) { gg[i] = g[tid + 512 * i]; const GAS f32x4* wp = (const GAS f32x4*)(W + (size_t)(tid + 512 * i) * NIN + 8 * cb); w0[i] = wp[0]; w1[i] = wp[1];
#pragma unroll
            for (int b = 0; b < 4; ++b) xv[b][i] = x[(size_t)b * SEQ * DM + tid + 512 * i]; }
        float acc[4][8], ss[4];
#pragma unroll
        for (int b = 0; b < 4; ++b) { ss[b] = 0.f;
#pragma unroll
            for (int c = 0; c < 8; ++c) acc[b][c] = 0.f; }
#pragma unroll
        for (int i = 0; i < 8; ++i) { const float wv[8] = {w0[i].x, w0[i].y, w0[i].z, w0[i].w, w1[i].x, w1[i].y, w1[i].z, w1[i].w};
#pragma unroll
            for (int b = 0; b < 4; ++b) { ss[b] += xv[b][i] * xv[b][i]; const float xg = xv[b][i] * gg[i];
#pragma unroll
                for (int c = 0; c < 8; ++c) acc[b][c] += xg * wv[c]; } }
#pragma unroll
        for (int b = 0; b < 4; ++b) { const float s2 = wave_sum(ss[b]); if (lane == 0) red[w * 40 + 32 + b] = s2;
#pragma unroll
            for (int c = 0; c < 8; ++c) { const float s = wave_sum(acc[b][c]); if (lane == 0) red[w * 40 + b * 8 + c] = s; } }
        __syncthreads();
        if (tid < 32) { float s = 0.f, q = 0.f;
#pragma unroll
            for (int k = 0; k < 8; ++k) { s += red[k * 40 + tid]; q += red[k * 40 + 32 + (tid >> 3)]; }
            Q0K0[(tid >> 3) * 2048 + 8 * cb + (tid & 7)] = s * (1.0f / sqrtf(q * (1.0f / 4096.0f) + RMS_EPS)); }
        __syncthreads();
    }
}
__device__ __forceinline__ void p0_prologue(Frame& F) {
    const int tid = tid_now(), lane = tid & 63;
    LAS float* scr = (LAS float*)(F.lds + F.wave * TR_SCR);
    const int gw = F.vcu * NWAVES + F.wave, NGW = F.G * NWAVES;
    bf16* Win = (bf16*)(F.ws + WS_WIN); bf16* Wlr = (bf16*)(F.ws + WS_WLR); bf16* Wout = (bf16*)(F.ws + WS_WOUT); bf16* Wxq = (bf16*)(F.ws + WS_WXQ); bf16* Wxkv = (bf16*)(F.ws + WS_WXKV); bf16* Wxo = (bf16*)(F.ws + WS_WXO);
    constexpr int I_INA = 64 * (4096 / 64), I_INB = 64 * (2048 / 64), I_INQ = 64 * (6144 / 64), I_LR = 64, I_OUT = 64 * 64, I_XQ = 64 * 8, I_XO = 8 * 64;
    constexpr int NIT = I_INA + I_INB + I_INQ + I_LR + I_OUT + 3 * I_XQ + I_XO;
    unsigned* cmax1 = (unsigned*)(F.ws + WS_CTL + CTL_CMAX1);
    for (int it = gw; it < NIT; it += NGW) {
        int r = it;
        if (r < I_INA) { const int nb = r % 64, kb = r / 64; tr_item(F.kin[4], NIN, Win, DM, 64 * nb, 64 * nb, 64, nullptr, scr, kb, lane); continue; } r -= I_INA;
        if (r < I_INB) { const int nb = r % 32, kb = r / 32; tr_item(F.kin[4], NIN, Win, DM, 4112 + 64 * nb, 4096 + 64 * nb, 64, nullptr, scr, kb, lane); continue; } r -= I_INB;
        if (r < I_INQ) { const int nb = r % 96, kb = r / 96; absmax_item(F.kin[4], NIN, 6160 + 64 * nb, nullptr, cmax1 + 64 * nb, kb, lane); continue; } r -= I_INQ;
        if (r < I_LR) { tr_item(F.kin[4], NIN, Wlr, DM, 4096, 0, 16, nullptr, scr, r, lane); continue; } r -= I_LR;
        if (r < I_OUT) { const int nb = r % 64, kb = r / 64; tr_item(F.kin[8], DM, Wout, DM, 64 * nb, 64 * nb, 64, nullptr, scr, kb, lane); continue; } r -= I_OUT;
        if (r < I_XQ) { const int nb = r % 8, kb = r / 8; tr_item(F.kin[11], XW, Wxq, DM, 64 * nb, 64 * nb, 64, F.kin[9], scr, kb, lane); continue; } r -= I_XQ;
        if (r < I_XQ) { const int nb = r % 8, kb = r / 8; tr_item(F.kin[12], XW, Wxkv, DM, 64 * nb, 64 * nb, 64, nullptr, scr, kb, lane); continue; } r -= I_XQ;
        if (r < I_XQ) { const int nb = r % 8, kb = r / 8; tr_item(F.kin[13], XW, Wxkv, DM, 64 * nb, 512 + 64 * nb, 64, nullptr, scr, kb, lane); continue; } r -= I_XQ;
        { const int nb = r % 64, kb = r / 64; tr_item(F.kin[14], DM, Wxo, XW, 64 * nb, 64 * nb, 64, nullptr, scr, kb, lane); }
    }
    bf16* XN = (bf16*)(F.ws + WS_XN); bf16* MEMN = (bf16*)(F.ws + WS_MEMN);
    for (int m = gw; m < M + MROWS; m += NGW) {
        if (m < M) rms_row_to_bf16(F.kin[0] + (size_t)m * DM, F.kin[3], XN + (size_t)m * DM, lane, (signed char*)(F.ws + WS_XNQ) + (size_t)m * DM, (float*)(F.ws + WS_RSC1) + m);
        else rms_row_to_bf16(F.kin[1] + (size_t)(m - M) * DM, F.kin[10], MEMN + (size_t)(m - M) * DM, lane);
    }
    float* BT = (float*)(F.ws + WS_BT);
    for (int i = blockIdx.x * 512 + tid; i < 3 * 16 * 132; i += F.G * 512) { const int rel = i % 132, h = (i / 132) % 16, cfg = i / (132 * 16);
        BT[i] = rel < 129 ? F.kin[2][kBucket[cfg][rel] * 16 + h] * 11.313708498984761f : 0.f; }
}
constexpr int FW_IG = 64 * (DFF / 64), FW_ID = (DFF / 64) * 64, FW_ALL = 2 * FW_IG + FW_ID;
constexpr int FW_P6_LO = 2 * FW_IG - 3584, FW_P6_HI = 2 * FW_IG;
constexpr int FW_P9_LO = FW_ALL - (FFN_I8 ? 4608 : 8192), FW_P9_HI = FW_ALL;
template <int MODE  >
__device__ __forceinline__ void ffn_weight_item(Frame& F, int r, LAS float* scr, int lane) {
    bf16* Wgu = (bf16*)(F.ws + WS_WGU); bf16* Wdn = (bf16*)(F.ws + WS_WDN); unsigned* cmax = (unsigned*)(F.ws + WS_CTL + CTL_COLMAX);
    if (r < 2 * FW_IG) { const int up = r >= FW_IG ? 1 : 0; const int rr = r - up * FW_IG; const int nb = rr % 172, kb = rr / 172, c0 = 64 * nb; const float* W = up ? F.kin[17] : F.kin[16];
        const int drow = 256 * (c0 >> 7) + 128 * up + (c0 & 127);
        if constexpr (MODE == 1) absmax_item(W, DFF, c0, F.kin[15], cmax + up * DFF + c0, kb, lane);
        else if constexpr (FFN_I8) quant_item(W, DFF, (signed char*)Wgu, DM, c0, drow, F.kin[15], cmax + up * DFF + c0, scr, kb, lane);
        else tr_item(W, DFF, Wgu, DM, c0, drow, 64, F.kin[15], scr, kb, lane);
        return; }
    if constexpr (MODE == 0) { r -= 2 * FW_IG; const int nb = r % 64, kb = r / 64; tr_item(F.kin[20], DM, Wdn, DFF, 64 * nb, 64 * nb, 64, nullptr, scr, kb, lane); }
}
template <int MODE> __device__ __forceinline__ void ffn_weights(Frame& F, int lo, int hi, int iw, int nw) {
    const int lane = tid_now() & 63; LAS float* scr = (LAS float*)(F.lds + F.wave * TR_SCR);
    for (int it = lo + iw; it < hi; it += nw) ffn_weight_item<MODE>(F, it, scr, lane);
}

__device__ __forceinline__ void p0_quant_win(Frame& F) {
    const int lane = tid_now() & 63; LAS float* scr = (LAS float*)(F.lds + F.wave * TR_SCR);
    const int gw = F.vcu * NWAVES + F.wave, NGW = F.G * NWAVES;
    const unsigned* cmax1 = (const unsigned*)(F.ws + WS_CTL + CTL_CMAX1);
    for (int r = gw; r < 64 * 96; r += NGW) { const int nb = r % 96, kb = r / 96;
        quant_item(F.kin[4], NIN, (signed char*)(F.ws + WS_WINQ), DM, 6160 + 64 * nb, 64 * nb, nullptr, cmax1 + 64 * nb, scr, kb, lane); }
}
constexpr int PP = 520;
constexpr int PREP_GLR = 0, PREP_QM = 8192, PREP_KM = 8192 + 64 * PP * 2;
static_assert(PREP_KM + 64 * PP * 2 <= MISC_OFF, "prep LDS");
__device__ __forceinline__ void gla_prep_unit(Frame& F, int b, int n) {
    const int tid = tid_now(), lane = tid & 63, w = F.wave;
    const int t0 = b * SEQ + 64 * n;
    const bf16* XN = (const bf16*)(F.ws + WS_XN); const bf16* Wlr = (const bf16*)(F.ws + WS_WLR);
    const bf16* GQ = (const bf16*)(F.ws + WS_GQ); bf16* GQ2 = (bf16*)(F.ws + WS_GQ2); const bf16* GK = (const bf16*)(F.ws + WS_GK);
    bf16* KET = (bf16*)(F.ws + WS_KET); bf16* ATT = (bf16*)(F.ws + WS_ATT); float* DEC = (float*)(F.ws + WS_DEC);
    LAS float* glr = (LAS float*)(F.lds + PREP_GLR);
    LAS bf16* QMs = (LAS bf16*)(F.lds + PREP_QM); LAS bf16* KMs = (LAS bf16*)(F.lds + PREP_KM);
    {
        const int rg = w & 3, kh = w >> 2, rr = lane & 15, kg = lane >> 4;
        const bf16* ap = XN + (size_t)(t0 + 16 * rg + rr) * DM + kh * 2048 + 8 * kg; const bf16* bp = Wlr + (size_t)rr * DM + kh * 2048 + 8 * kg;
        f32x4 acc = {0.f, 0.f, 0.f, 0.f};
#pragma unroll 8
        for (int s = 0; s < 64; ++s) { const bf16x8 a = *(const GAS bf16x8*)(ap + 32 * s), bq = *(const GAS bf16x8*)(bp + 32 * s); acc = __builtin_amdgcn_mfma_f32_16x16x32_bf16(a, bq, acc, 0, 0, 0); }
#pragma unroll
        for (int i = 0; i < 4; ++i) glr[(kh * 64 + 16 * rg + 4 * kg + i) * 16 + rr] = acc[i];
    }
    __syncthreads();
    for (int i = tid; i < 1024; i += 512) glr[i] += glr[1024 + i];
    __syncthreads();
    const int cid = (b * 64 + n) * 4;
    for (int hp = 0; hp < 2; ++hp) {
        {
            const int col = hp * 512 + tid, h = col >> 8, dk = col & 255;
            float w2[16];
#pragma unroll
            for (int j = 0; j < 16; ++j) w2[j] = F.kin[5][j * 1024 + col];
            const float bg = F.kin[6][col];
            float bc[64]; float run = 0.f;
#pragma unroll
            for (int c = 0; c < 64; ++c) {
                const LAS f32x4* gp = (const LAS f32x4*)(glr + c * 16); const f32x4 g0 = gp[0], g1 = gp[1], g2 = gp[2], g3 = gp[3];
                float z = bg;
                z += g0.x * w2[0] + g0.y * w2[1] + g0.z * w2[2] + g0.w * w2[3]; z += g1.x * w2[4] + g1.y * w2[5] + g1.z * w2[6] + g1.w * w2[7];
                z += g2.x * w2[8] + g2.y * w2[9] + g2.z * w2[10] + g2.w * w2[11]; z += g3.x * w2[12] + g3.y * w2[13] + g3.z * w2[14] + g3.w * w2[15];
                const float ls = fminf(z, 0.f) - __logf(1.0f + __expf(-fabsf(z)));
                run += ls * (1.0f / 16.0f); bc[c] = run;
            }
            const float blast = bc[63], bmid = bc[32];
            unsigned kep[32];
            const bf16* qp = GQ + (size_t)t0 * 1024 + col; bf16* qo = GQ2 + (size_t)t0 * 1024 + col; const bf16* kp = GK + (size_t)t0 * 1024 + col;
#pragma unroll
            for (int c2 = 0; c2 < 32; ++c2) {
                const int c = 2 * c2;
                const float qa = bf2f(qp[(size_t)c * 1024]) * (1.0f / 16.0f), ka = bf2f(kp[(size_t)c * 1024]);
                const float qb = bf2f(qp[(size_t)(c + 1) * 1024]) * (1.0f / 16.0f), kb = bf2f(kp[(size_t)(c + 1) * 1024]);
                const unsigned qt = cvtpk_s(qa * __expf(bc[c]), qb * __expf(bc[c + 1]));
                qo[(size_t)c * 1024] = (bf16)(qt & 0xffffu); qo[(size_t)(c + 1) * 1024] = (bf16)(qt >> 16);
                kep[c2] = cvtpk_s(ka * __expf(blast - bc[c]), kb * __expf(blast - bc[c + 1]));
                const unsigned qm = cvtpk_s(qa * __expf(bc[c] - bmid), qb * __expf(bc[c + 1] - bmid));
                const unsigned km = cvtpk_s(ka * __expf(bmid - bc[c]), kb * __expf(bmid - bc[c + 1]));
                QMs[c * PP + tid] = (bf16)(qm & 0xffffu); QMs[(c + 1) * PP + tid] = (bf16)(qm >> 16);
                KMs[c * PP + tid] = (bf16)(km & 0xffffu); KMs[(c + 1) * PP + tid] = (bf16)(km >> 16);
            }
            bf16* kt = KET + ((size_t)(cid + h) * 256 + dk) * 64;
#pragma unroll
            for (int i = 0; i < 8; ++i) { v4u o = {kep[4 * i], kep[4 * i + 1], kep[4 * i + 2], kep[4 * i + 3]}; *(GAS v4u*)(kt + 8 * i) = o; }
            DEC[(size_t)(cid + h) * 256 + dk] = __expf(blast);
        }
        __syncthreads();
        {
            const int rr = lane & 15, kg = lane >> 4;
#pragma unroll
            for (int q4 = 0; q4 < 4; ++q4) {
                const int id = w * 4 + q4, hl = id >> 4, mt = (id >> 2) & 3, nt = id & 3;
                const LAS bf16* ap = KMs + (16 * mt + rr) * PP + hl * 256 + 8 * kg; const LAS bf16* bp = QMs + (16 * nt + rr) * PP + hl * 256 + 8 * kg;
                f32x4 acc = {0.f, 0.f, 0.f, 0.f};
#pragma unroll
                for (int s = 0; s < 8; ++s) { const bf16x8 a = *(const LAS bf16x8*)(ap + 32 * s), bq = *(const LAS bf16x8*)(bp + 32 * s); acc = __builtin_amdgcn_mfma_f32_16x16x32_bf16(a, bq, acc, 0, 0, 0); }
                const int c = 16 * nt + rr, cp0 = 16 * mt + 4 * kg;
                v2u o; o.x = pk2(cp0 <= c ? acc[0] : 0.f, cp0 + 1 <= c ? acc[1] : 0.f); o.y = pk2(cp0 + 2 <= c ? acc[2] : 0.f, cp0 + 3 <= c ? acc[3] : 0.f);
                *(GAS v2u*)(ATT + ((size_t)(cid + 2 * hp + hl) * 64 + c) * 64 + cp0) = o;
            }
        }
        __syncthreads();
    }
    if (n == 0 && w < 4) {
        const float* q0 = (const float*)(F.ws + WS_Q0K0) + b * 2048 + w * 256; const float* k0 = q0 + 1024; float s = 0.f;
#pragma unroll
        for (int i = 0; i < 4; ++i) s += q0[lane + 64 * i] * k0[lane + 64 * i];
        s = wave_sum(s) * (1.0f / 16.0f);
        if (lane == 0) ATT[(size_t)(cid + w) * 4096] = (bf16)f2bf(s);
    }
}

constexpr int CH_QT = 0, CH_QP = 528, CH_KE = 64 * CH_QP, CH_KP = 144, CH_AT = CH_KE + 256 * CH_KP, CH_DC = CH_AT + 64 * CH_KP, CH_VS = CH_DC + 1024, CH_END = CH_VS + 16384;
static_assert(CH_END <= MISC_OFF, "chain LDS");
__device__ __forceinline__ void gla_chain_unit(Frame& F, int b, int h, int qd) {
    const int tid = tid_now(), lane = tid & 63, w = F.wave, r32 = lane & 31, hi = lane >> 5;
    const bool helper = w >= 4; const int htid = tid - 256;
    const bf16* GQ = (const bf16*)(F.ws + WS_GQ2); const bf16* KET = (const bf16*)(F.ws + WS_KET); const bf16* ATT = (const bf16*)(F.ws + WS_ATT);
    const float* DEC = (const float*)(F.ws + WS_DEC); const bf16* GV = (const bf16*)(F.ws + WS_GV); bf16* ORAW = (bf16*)(F.ws + WS_XN);
    LAS unsigned char* L = F.lds;
    if (helper) {
        v4u st[23];
#define CH_LOADS(nn) do { const int ch_ = (b * 64 + (nn)) * 4 + h; const int t0_ = b * SEQ + 64 * (nn); \
            _Pragma("unroll") for (int i = 0; i < 8; ++i) { const int id = htid + 256 * i; st[i] = *(const GAS v4u*)(GQ + (size_t)(t0_ + (id >> 5)) * 1024 + h * 256 + 8 * (id & 31)); } \
            _Pragma("unroll") for (int i = 0; i < 8; ++i) { const int id = htid + 256 * i; st[8 + i] = *(const GAS v4u*)(KET + ((size_t)ch_ * 256 + (id >> 3)) * 64 + 8 * (id & 7)); } \
            _Pragma("unroll") for (int i = 0; i < 2; ++i) { const int id = htid + 256 * i; st[16 + i] = *(const GAS v4u*)(ATT + ((size_t)ch_ * 64 + (id >> 3)) * 64 + 8 * (id & 7)); } \
            _Pragma("unroll") for (int i = 0; i < 4; ++i) { const int id = htid + 256 * i; st[19 + i] = *(const GAS v4u*)(GV + (size_t)(t0_ + (id >> 4)) * 2048 + h * 512 + qd * 128 + 8 * (id & 15)); } \
            st[18] = *(const GAS v4u*)(DEC + (size_t)ch_ * 256 + 4 * (htid & 63)); } while (0)
        CH_LOADS(0);
        for (int n = 0; n < 64; ++n) {
#pragma unroll
            for (int i = 0; i < 8; ++i) { const int id = htid + 256 * i; *(LAS v4u*)(L + CH_QT + (id >> 5) * CH_QP + 16 * (id & 31)) = st[i]; }
#pragma unroll
            for (int i = 0; i < 8; ++i) { const int id = htid + 256 * i; *(LAS v4u*)(L + CH_KE + (id >> 3) * CH_KP + 16 * (id & 7)) = st[8 + i]; }
#pragma unroll
            for (int i = 0; i < 2; ++i) { const int id = htid + 256 * i; *(LAS v4u*)(L + CH_AT + (id >> 3) * CH_KP + 16 * (id & 7)) = st[16 + i]; }
#pragma unroll
            for (int i = 0; i < 4; ++i) { const int id = htid + 256 * i; *(LAS v4u*)(L + CH_VS + att::v_st(id >> 4, 8 * (id & 15))) = st[19 + i]; }
            if (htid < 64) *(LAS v4u*)(L + CH_DC + 16 * htid) = st[18];
            __syncthreads();
            if (n + 1 < 64) CH_LOADS(n + 1);
            __syncthreads();
        }
#undef CH_LOADS
    } else {
        f32x16 S[8];
#pragma unroll
        for (int i = 0; i < 8; ++i)
#pragma unroll
            for (int r = 0; r < 16; ++r) S[i][r] = 0.f;
        for (int n = 0; n < 64; ++n) {
            __syncthreads();
            const int t0 = b * SEQ + 64 * n;
            bf16x8 vc[4];
#pragma unroll
            for (int s = 0; s < 4; ++s) { const LAS unsigned char* vp = L + CH_VS + att::v_rd_base(lane) + w * 512 + s * 4096;
                const s16x4 lo = __builtin_bit_cast(s16x4, __builtin_amdgcn_ds_read_tr16_b64_v4i16((LAS v4i16_t*)vp)), hh = __builtin_bit_cast(s16x4, __builtin_amdgcn_ds_read_tr16_b64_v4i16((LAS v4i16_t*)(vp + 2048)));
                vc[s] = (bf16x8){lo[0], lo[1], lo[2], lo[3], hh[0], hh[1], hh[2], hh[3]}; }
            f32x16 O[2];
#pragma unroll
            for (int r = 0; r < 16; ++r) { O[0][r] = 0.f; O[1][r] = 0.f; }
#pragma unroll
            for (int mt = 0; mt < 8; ++mt)
#pragma unroll
                for (int sp = 0; sp < 2; ++sp) {
                    const bf16x8 bs = pack8f(S[mt][8 * sp], S[mt][8 * sp + 1], S[mt][8 * sp + 2], S[mt][8 * sp + 3], S[mt][8 * sp + 4], S[mt][8 * sp + 5], S[mt][8 * sp + 6], S[mt][8 * sp + 7]);
#pragma unroll
                    for (int mc = 0; mc < 2; ++mc) {
                        const LAS unsigned char* ap = L + CH_QT + (32 * mc + r32) * CH_QP + (32 * mt + 16 * sp + 4 * hi) * 2;
                        const s16x4 lo = *(const LAS s16x4*)ap, hh = *(const LAS s16x4*)(ap + 16);
                        const bf16x8 a = {lo[0], lo[1], lo[2], lo[3], hh[0], hh[1], hh[2], hh[3]};
                        O[mc] = __builtin_amdgcn_mfma_f32_32x32x16_bf16(a, bs, O[mc], 0, 0, 0);
                    }
                }
#pragma unroll
            for (int s = 0; s < 4; ++s)
#pragma unroll
                for (int mc = 0; mc < 2; ++mc) { const bf16x8 a = *(const LAS bf16x8*)(L + CH_AT + (32 * mc + r32) * CH_KP + (16 * s + 8 * hi) * 2); O[mc] = __builtin_amdgcn_mfma_f32_32x32x16_bf16(a, vc[s], O[mc], 0, 0, 0); }
            bf16* rowbase = ORAW + (size_t)t0 * 2048 + h * 512 + qd * 128 + 32 * w;
            const unsigned loff = (unsigned)(r32 + hi * 4 * 2048);
#pragma unroll
            for (int mc = 0; mc < 2; ++mc)
#pragma unroll
                for (int r = 0; r < 16; ++r) { const float v = O[mc][r], vn = __shfl_xor(v, 1);
                    if ((r32 & 1) == 0) *(unsigned*)(rowbase + (32 * mc + (r & 3) + 8 * (r >> 2)) * 2048 + loff) = cvtpk_s(v, vn); }
#pragma unroll
            for (int mt = 0; mt < 8; ++mt) {
#pragma unroll
                for (int j = 0; j < 4; ++j) { const f32x4 d4 = *(const LAS f32x4*)(L + CH_DC + (32 * mt + 8 * j + 4 * hi) * 4);
                    S[mt][4 * j] *= d4.x; S[mt][4 * j + 1] *= d4.y; S[mt][4 * j + 2] *= d4.z; S[mt][4 * j + 3] *= d4.w; }
#pragma unroll
                for (int s = 0; s < 4; ++s) { const bf16x8 a = *(const LAS bf16x8*)(L + CH_KE + (32 * mt + r32) * CH_KP + (16 * s + 8 * hi) * 2); S[mt] = __builtin_amdgcn_mfma_f32_32x32x16_bf16(a, vc[s], S[mt], 0, 0, 0); }
            }
            __syncthreads();
        }
    }
}

__device__ __forceinline__ void mix_row(Frame& F, int t, int lane) {
    const bf16* ORAW = (const bf16*)(F.ws + WS_XN); const bf16* GR = (const bf16*)(F.ws + WS_GR); const bf16* OC = (const bf16*)(F.ws + WS_OC); const float* LSE = (const float*)(F.ws + WS_LSE);
    bf16* MIX = (bf16*)(F.ws + WS_MIX);
#pragma unroll
    for (int h = 0; h < 4; ++h) {
        const v4u ow = *(const GAS v4u*)(ORAW + (size_t)t * 2048 + h * 512 + 8 * lane); const f32x4 o0 = {bflo(ow.x), bfhi(ow.x), bflo(ow.y), bfhi(ow.y)}, o1 = {bflo(ow.z), bfhi(ow.z), bflo(ow.w), bfhi(ow.w)};
        const float ss = wave_sum((o0.x * o0.x + o0.y * o0.y) + (o0.z * o0.z + o0.w * o0.w) + (o1.x * o1.x + o1.y * o1.y) + (o1.z * o1.z + o1.w * o1.w));
        const float r = 1.0f / sqrtf(ss * (1.0f / 512.0f) + RMS_EPS);
        const GAS f32x4* gp = (const GAS f32x4*)F.kin[7] + 2 * lane; const f32x4 g0 = gp[0], g1 = gp[1];
        const v4u gw = *(const GAS v4u*)(GR + (size_t)t * 2048 + h * 512 + 8 * lane);
        float y[8] = {o0.x * r * g0.x, o0.y * r * g0.y, o0.z * r * g0.z, o0.w * r * g0.w, o1.x * r * g1.x, o1.y * r * g1.y, o1.z * r * g1.z, o1.w * r * g1.w};
        const float gv[8] = {bflo(gw.x), bfhi(gw.x), bflo(gw.y), bfhi(gw.y), bflo(gw.z), bfhi(gw.z), bflo(gw.w), bfhi(gw.w)};
#pragma unroll
        for (int e = 0; e < 8; ++e) y[e] *= gv[e] / (1.0f + __expf(-gv[e]));
        v4u o = {pk2(y[0], y[1]), pk2(y[2], y[3]), pk2(y[4], y[5]), pk2(y[6], y[7])};
        *(GAS v4u*)(MIX + (size_t)t * DM + h * 512 + 8 * lane) = o;
    }
    {
        const int hd = lane >> 2;
        float m2[3], l[3];
#pragma unroll
        for (int c = 0; c < 3; ++c) { const f32x2 v = *(const GAS f32x2*)(LSE + (((size_t)c * M + t) * 16 + hd) * 2); m2[c] = v.x; l[c] = v.y; }
        const float mx = fmaxf(m2[0], fmaxf(m2[1], m2[2]));
        float wgt[3]; float den = 0.f;
#pragma unroll
        for (int c = 0; c < 3; ++c) { wgt[c] = __builtin_amdgcn_exp2f(m2[c] - mx) * l[c]; den += wgt[c]; }
        const float rden = 1.0f / den;
        float acc[32];
#pragma unroll
        for (int e = 0; e < 32; ++e) acc[e] = 0.f;
#pragma unroll
        for (int c = 0; c < 3; ++c) { const float wc = wgt[c] * rden; const GAS v4u* p = (const GAS v4u*)(OC + (size_t)c * M * 2048 + ((size_t)((t >> 12) * 16 + hd) * SEQ + (t & 4095)) * 128 + 32 * (lane & 3));
#pragma unroll
            for (int q = 0; q < 4; ++q) { const v4u v = p[q];
                acc[8 * q + 0] += wc * bflo(v.x); acc[8 * q + 1] += wc * bfhi(v.x); acc[8 * q + 2] += wc * bflo(v.y); acc[8 * q + 3] += wc * bfhi(v.y);
                acc[8 * q + 4] += wc * bflo(v.z); acc[8 * q + 5] += wc * bfhi(v.z); acc[8 * q + 6] += wc * bflo(v.w); acc[8 * q + 7] += wc * bfhi(v.w); } }
        GAS v4u* op = (GAS v4u*)(MIX + (size_t)t * DM + 2048 + 32 * lane);
#pragma unroll
        for (int q = 0; q < 4; ++q) { v4u o = {pk2(acc[8 * q], acc[8 * q + 1]), pk2(acc[8 * q + 2], acc[8 * q + 3]), pk2(acc[8 * q + 4], acc[8 * q + 5]), pk2(acc[8 * q + 6], acc[8 * q + 7])}; op[q] = o; }
    }
}
__device__ __forceinline__ void halo_fix(Frame& F) {
    const int tid = tid_now();
    const float* GF = (const float*)(F.ws + WS_HALO); const float* UF = GF + HALO_ONE / 4; const float* GL = UF + HALO_ONE / 4;
    bf16* ACT = (bf16*)(F.ws + WS_ACT); const float* cw = F.kin[18]; const float* cb = F.kin[19];
    const int total = 256 * 2 * (DFF / 4);
    for (int i = blockIdx.x * 512 + tid; i < total; i += F.G * 512) {
        const int c4 = i % (DFF / 4), j = (i / (DFF / 4)) & 1, blk = i / (DFF / 2), ch = 4 * c4;
        const bool first = (blk & 63) == 0;
        const f32x4 g0 = *(const GAS f32x4*)(GF + ((size_t)blk * 2 + j) * DFF + ch), uu = *(const GAS f32x4*)(UF + ((size_t)blk * 2 + j) * DFF + ch);
        const f32x4 z = {0.f, 0.f, 0.f, 0.f};
        f32x4 g1, g2;
        if (j == 0) { g1 = first ? z : *(const GAS f32x4*)(GL + ((size_t)(blk - 1) * 2 + 1) * DFF + ch); g2 = first ? z : *(const GAS f32x4*)(GL + ((size_t)(blk - 1) * 2 + 0) * DFF + ch); }
        else { g1 = *(const GAS f32x4*)(GF + ((size_t)blk * 2 + 0) * DFF + ch); g2 = first ? z : *(const GAS f32x4*)(GL + ((size_t)(blk - 1) * 2 + 1) * DFF + ch); }
        const f32x4 w0 = *(const GAS f32x4*)(cw + ch), w1 = *(const GAS f32x4*)(cw + DFF + ch), w2 = *(const GAS f32x4*)(cw + 2 * DFF + ch), bb = *(const GAS f32x4*)(cb + ch);
        float a[4];
#pragma unroll
        for (int e = 0; e < 4; ++e) { const float y = bb[e] + w0[e] * g2[e] + w1[e] * g1[e] + w2[e] * g0[e]; a[e] = y / (1.0f + __expf(-y)) * uu[e]; }
        v2u o = {pk2(a[0], a[1]), pk2(a[2], a[3])};
        *(GAS v2u*)(ACT + (size_t)(64 * blk + j) * DFF + ch) = o;
    }
}
__device__ __forceinline__ void final_norm_row(Frame& F, int t, int lane) {
    const unsigned long long* ss = (const unsigned long long*)(F.ws + WS_CTL + CTL_SS) + 2 * (size_t)M;
    const float r = 1.0f / sqrtf((float)ss[t] * ((1.0f / 4096.0f) / 1048576.0f) + RMS_EPS);
    const GAS v4u* hr = (const GAS v4u*)((const bf16*)(F.ws + WS_XN) + (size_t)t * DM) + lane; GAS f32x4* xr = (GAS f32x4*)(F.out + (size_t)t * DM) + 2 * lane; const GAS f32x4* gr = (const GAS f32x4*)F.kin[21] + 2 * lane;
#pragma unroll
    for (int j = 0; j < 8; ++j) { const v4u w = hr[64 * j]; const f32x4 g0 = gr[128 * j], g1 = gr[128 * j + 1];
        xr[128 * j] = (f32x4){bflo(w.x) * r * g0.x, bfhi(w.x) * r * g0.y, bflo(w.y) * r * g0.z, bfhi(w.y) * r * g0.w};
        xr[128 * j + 1] = (f32x4){bflo(w.z) * r * g1.x, bfhi(w.z) * r * g1.y, bflo(w.w) * r * g1.z, bfhi(w.w) * r * g1.w}; }
}

__device__ __forceinline__ void quant_row(Frame& F, int t, int lane) {
    const unsigned* amax = (const unsigned*)(F.ws + WS_CTL + CTL_AMAX); const float am = __uint_as_float(amax[t]); const float inv = am > 0.f ? 127.0f / am : 0.f;
    const GAS v4u* hr = (const GAS v4u*)((const bf16*)(F.ws + WS_XN) + (size_t)t * DM) + lane; GAS v2u* qr = (GAS v2u*)((signed char*)(F.ws + WS_H2Q) + (size_t)t * DM) + lane;
#pragma unroll
    for (int j = 0; j < 8; ++j) { const v4u w = hr[64 * j];
        const float v[8] = {bflo(w.x), bfhi(w.x), bflo(w.y), bfhi(w.y), bflo(w.z), bfhi(w.z), bflo(w.w), bfhi(w.w)}; unsigned q[2] = {0u, 0u};
#pragma unroll
        for (int e = 0; e < 8; ++e) { const float r = fminf(fmaxf(__builtin_rintf(v[e] * inv), -127.f), 127.f); q[e >> 2] |= ((unsigned)(int)r & 0xffu) << (8 * (e & 3)); }
        qr[64 * j] = (v2u){q[0], q[1]}; }
}
typedef att::BlockRef<att::bf16, att::bf16> ABlk;
__device__ __forceinline__ ABlk dil_item(unsigned char* ws, int L) {
    const int bh = L / 48, rem = L - 48 * bh, cfg = rem >> 4, x = rem & 15, h = bh & 15, b = bh >> 4;
    const int d = cfg == 0 ? 1 : (cfg == 1 ? 4 : 16);
    const int r = cfg == 0 ? 0 : (cfg == 1 ? (x >> 2) : x), qb = cfg == 0 ? x : (cfg == 1 ? (x & 3) : 0);
    const att::bf16* DQ = (const att::bf16*)(ws + WS_DQKV); const att::bf16* DK = DQ + (size_t)M * 2048; const att::bf16* DV = DK + (size_t)M * 2048;
    const int sq = r + d * 256 * qb, tq = b * SEQ + sq; const size_t hb = (size_t)(b * 16 + h) * SEQ;
    ABlk R;
    R.Q = DQ + (hb + sq) * 128; R.K = DK + (hb + r) * 128; R.V = DV + (hb + r) * 128;
    R.O = (att::bf16*)(ws + WS_OC) + ((size_t)cfg * M * 2048) + (hb + sq) * 128;
    R.L = (float*)(ws + WS_LSE) + (((size_t)cfg * M + tq) * 16 + h) * 2;
    R.bsrc = (const float*)(ws + WS_BT) + (cfg * 16 + h) * 132;
    R.P0 = 256 * qb; R.pq = 128 * d; R.pk = 128 * d; R.po = 128 * d; R.pl = 32 * d; R.skv = SEQ / d; R.W = 129;
    return R;
}
__device__ __forceinline__ ABlk xat_item(unsigned char* ws, int L) {
    const int qb = L & 15, h = (L >> 4) & 3, b = L >> 6;
    const att::bf16* XQ = (const att::bf16*)(ws + WS_XQ); const att::bf16* XKV = (const att::bf16*)(ws + WS_XKV);
    ABlk R;
    R.Q = XQ + (size_t)(b * SEQ + 256 * qb) * XW + h * 128; R.K = XKV + (size_t)(b * MEMLEN) * 1024 + h * 128; R.V = R.K + 512;
    R.O = (att::bf16*)(ws + WS_XO) + (size_t)(b * SEQ + 256 * qb) * XW + h * 128; R.L = nullptr; R.bsrc = nullptr;
    R.P0 = 1 << 20; R.pq = XW; R.pk = 1024; R.po = XW; R.pl = 0; R.skv = MEMLEN; R.W = 1 << 30;
    return R;
}

#ifndef PG_ALIGN
#define PG_ALIGN true
#endif
#ifndef PG_SP2
#define PG_SP2 true
#endif
struct Args { const float* in[22]; float* out; unsigned char* ws; int ph_lo, ph_hi; };
__global__ void __launch_bounds__(NWAVES * 64, 2) hybrid_fwd(Args args) {
    extern __shared__ __attribute__((aligned(16))) unsigned char lds[];
    Frame F;
    F.lds = (LAS unsigned char*)lds; F.ldsg = (char*)lds;
    F.MISC = (volatile LAS unsigned*)(F.lds + MISC_OFF);
    F.wave = __builtin_amdgcn_readfirstlane((int)threadIdx.x >> 6);
    F.G = gridDim.x; { const int bx = blockIdx.x; F.vcu = (F.G % 8 == 0) ? (bx % 8) * (F.G / 8) + bx / 8 : bx; }
    F.ws = args.ws; F.ctl = (gu32*)(args.ws + WS_CTL); F.out = args.out;
    F.kin = (const float* const __attribute__((address_space(4)))*)__builtin_amdgcn_kernarg_segment_ptr();
    if (threadIdx.x < 64) F.MISC[threadIdx.x] = 0u;
    __syncthreads();
    XcdBarrier bar; bar.bar = (unsigned*)(F.ctl + CW_BAR); bar.x = 0; bar.st = nullptr;
    if (N_LAUNCHES == 1) bar = xcd_barrier_post((unsigned*)(F.ctl + CW_BAR), F.MISC + 8);
#define GRID_BAR() do { if (N_LAUNCHES == 1) xcd_barrier(bar); } while (0)
    const int lo = args.ph_lo, hi = args.ph_hi;
#ifndef PH_MASK
#define PH_MASK 0x1fff
#endif
#define IN(k) ((((PH_MASK) >> (k)) & 1) && lo <= (k) && (k) < hi)
#define BOTH(k) (IN(k) && IN((k) + 1))
#ifndef DUPMASK
#define DUPMASK 0
#endif
#ifndef XBAR
#define XBAR 0
#endif
#define DUPK(k, ...) { __VA_ARGS__ } if constexpr ((((DUPMASK) >> (k)) & 1) != 0) { __syncthreads(); { __VA_ARGS__ } }
#define GRID_BARX() do { GRID_BAR(); if constexpr (XBAR != 0) GRID_BAR(); } while (0)
    unsigned long long* SS1 = (unsigned long long*)(F.ws + WS_CTL + CTL_SS); unsigned long long* SS2 = SS1 + M; unsigned long long* SS3 = SS2 + M;
    const int gw = F.vcu * NWAVES + F.wave, NGW = F.G * NWAVES;

    if (IN(0)) { DUPK(0, p0_first_token(F); p0_prologue(F);) GRID_BAR(); p0_quant_win(F);
#ifdef DUP_P0FT
        __syncthreads(); p0_first_token(F); __syncthreads(); p0_first_token(F); __syncthreads(); p0_first_token(F); __syncthreads(); p0_first_token(F);
#endif
        if (BOTH(0)) GRID_BARX(); }
    if (IN(1)) {
        { pg8::Gemm g{(const bf16*)(F.ws + WS_XN), (const bf16*)(F.ws + WS_WIN), M, 6144, DM}; pg8::StaticOrder S; S.init(M, 6144, F.G, (int)blockIdx.x);
          pg8::EpiProj E{(bf16*)(F.ws + WS_GQ), (bf16*)(F.ws + WS_GK), (bf16*)(F.ws + WS_GV), (bf16*)(F.ws + WS_GR), (bf16*)(F.ws + WS_DQKV)};
          pg8::gemm_phase<pg8::EpiProj, pg8::StaticOrder, PG_ALIGN, PG_SP2>(F.lds, g, S, E);
          { pg8::Gemm gq{(const bf16*)(F.ws + WS_XNQ), (const bf16*)(F.ws + WS_WINQ), M, 6144, DM / 2}; pg8::StaticOrder Sq; Sq.init(M, 6144, F.G, (int)blockIdx.x);
            pg8::EpiProjQ Eq{(bf16*)(F.ws + WS_DQKV), (const float*)(F.ws + WS_RSC1), (const unsigned*)(F.ws + WS_CTL + CTL_CMAX1)};
            pg8::gemm_phase<pg8::EpiProjQ, pg8::StaticOrder, PG_ALIGN, PG_SP2>(F.lds, gq, Sq, Eq); }
#ifdef DUP_P1NULL
          { pg8::EpiNull E0{}; pg8::Gemm g2{(const bf16*)(F.ws + WS_XN), (const bf16*)(F.ws + WS_WIN), M, 3072, DM}; pg8::StaticOrder S2; S2.init(M, 3072, F.G, (int)blockIdx.x); pg8::gemm_phase<pg8::EpiNull, pg8::StaticOrder, PG_ALIGN, PG_SP2>(F.lds, g2, S2, E0); pg8::gemm_phase<pg8::EpiNull, pg8::StaticOrder, PG_ALIGN, PG_SP2>(F.lds, g2, S2, E0); pg8::gemm_phase<pg8::EpiNull, pg8::StaticOrder, PG_ALIGN, PG_SP2>(F.lds, g2, S2, E0); pg8::gemm_phase<pg8::EpiNull, pg8::StaticOrder, PG_ALIGN, PG_SP2>(F.lds, g2, S2, E0); }
#endif
          }
        if (BOTH(1)) GRID_BARX();
    }
    if (IN(2)) { DUPK(2, for (int u = blockIdx.x; u < NB * 64; u += F.G) gla_prep_unit(F, u >> 6, u & 63);) if (BOTH(2)) GRID_BARX(); }
    if (IN(3)) {
#ifdef PRE_ATT_VARIANT
        {
            gu32* qctr = F.ctl + CW_QUEUE + 64;
#define NEXT_ITEM(dst) do { if (tid_now() == 0) F.MISC[16] = __hip_atomic_fetch_add(qctr, 1u, RLX_AGENT); __syncthreads(); dst = __builtin_amdgcn_readfirstlane((int)F.MISC[16]); __syncthreads(); } while (0)
            int L; NEXT_ITEM(L);
            if (L < 3072) {
                ABlk cur = dil_item(F.ws, L); att::Seam<att::bf16> S; int par = 0;
                att::causal_swa_prime<PRE_ATT_VARIANT, att::bf16, att::bf16>(cur, F.ldsg, S);
                unsigned char* const wsp = F.ws; auto itf = [wsp](int l) { return dil_item(wsp, l); };
                for (;;) { int Ln; NEXT_ITEM(Ln); const bool last = Ln >= 3072; const int Lx = last ? L : Ln;
                    att::causal_swa_block<PRE_ATT_VARIANT, att::bf16, att::bf16>(cur, Lx, itf, par, F.ldsg, S);
                    if (last) break; L = Ln; cur = dil_item(F.ws, L); par ^= 1; }
            }
#undef NEXT_ITEM
            __syncthreads();
        }
#endif
        if ((int)blockIdx.x < 64) gla_chain_unit(F, blockIdx.x >> 4, (blockIdx.x >> 2) & 3, blockIdx.x & 3);
        {
            gu32* qctr = F.ctl + CW_QUEUE;
#define NEXT_ITEM(dst) do { if (tid_now() == 0) F.MISC[16] = __hip_atomic_fetch_add(qctr, 1u, RLX_AGENT); __syncthreads(); dst = __builtin_amdgcn_readfirstlane((int)F.MISC[16]); __syncthreads(); } while (0)
            int L; NEXT_ITEM(L);
            if (L < 3072) {
                ABlk cur = dil_item(F.ws, L); att::Seam<att::bf16> S; int par = 0;
                att::causal_swa_prime<1, att::bf16, att::bf16>(cur, F.ldsg, S);
                unsigned char* const wsp = F.ws; auto itf = [wsp](int l) { return dil_item(wsp, l); };
                for (;;) { int Ln; NEXT_ITEM(Ln); const bool last = Ln >= 3072; const int Lx = last ? L : Ln;
                    att::causal_swa_block<1, att::bf16, att::bf16>(cur, Lx, itf, par, F.ldsg, S);
                    if (last) break; L = Ln; cur = dil_item(F.ws, L); par ^= 1; }
            }
#undef NEXT_ITEM
        }
#ifdef DUP_CHAIN
        __syncthreads(); if ((int)blockIdx.x < 64) gla_chain_unit(F, blockIdx.x >> 4, (blockIdx.x >> 2) & 3, blockIdx.x & 3);
#endif
        if (BOTH(3)) GRID_BARX();
    }
    if (IN(4)) {
        { const int lane = tid_now() & 63; for (int t = gw; t < M; t += NGW) mix_row(F, t, lane); }
        ffn_weights<0>(F, 2 * FW_IG, FW_P9_LO, gw, NGW);
        if constexpr (FFN_I8) { ffn_weights<1>(F, 0, 2 * FW_IG, gw, NGW); GRID_BAR(); }
        ffn_weights<0>(F, 0, FW_P6_LO, gw, NGW);
        if (BOTH(4)) GRID_BARX(); }
    if (IN(5)) {
        pg8::Gemm g{(const bf16*)(F.ws + WS_MIX), (const bf16*)(F.ws + WS_WOUT), M, DM, DM}; pg8::StaticOrder S; S.init(M, DM, F.G, (int)blockIdx.x);
        pg8::EpiResid E{F.kin[0], nullptr, (bf16*)(F.ws + WS_XN), SS1, DM, nullptr};
        pg8::gemm_phase<pg8::EpiResid, pg8::StaticOrder, PG_ALIGN, PG_SP2>(F.lds, g, S, E);
#ifdef DUP_P5
        { pg8::EpiResid E2{F.kin[0], nullptr, (bf16*)(F.ws + WS_XN), nullptr, DM, nullptr}; pg8::gemm_phase<pg8::EpiResid, pg8::StaticOrder, PG_ALIGN, PG_SP2>(F.lds, g, S, E2); }
#endif
        if (BOTH(5)) GRID_BARX();
    }
    if (IN(6)) {
        DUPK(6,
        if ((int)blockIdx.x < 128 || F.G < 144) {
        pg8::Gemm g{(const bf16*)(F.ws + WS_XN), (const bf16*)(F.ws + WS_WXQ), M, XW, DM}; pg8::StaticOrder S; S.init(M, XW, F.G < 144 ? F.G : 128, (int)blockIdx.x);
        pg8::EpiScaleBf16 E{(bf16*)(F.ws + WS_XQ), XW, SS1, 1.0f / 4096.0f};
        pg8::gemm_phase<pg8::EpiScaleBf16, pg8::StaticOrder, PG_ALIGN, PG_SP2>(F.lds, g, S, E);
        }
        if ((int)blockIdx.x >= 128 || F.G < 144) {
        pg8::Gemm g{(const bf16*)(F.ws + WS_MEMN), (const bf16*)(F.ws + WS_WXKV), MROWS, 1024, DM}; pg8::StaticOrder S; S.init(MROWS, 1024, F.G < 144 ? F.G : F.G - 128, F.G < 144 ? (int)blockIdx.x : (int)blockIdx.x - 128);
        pg8::EpiScaleBf16 E{(bf16*)(F.ws + WS_XKV), 1024, nullptr, 0.f};
        pg8::gemm_phase<pg8::EpiScaleBf16, pg8::StaticOrder, PG_ALIGN, PG_SP2>(F.lds, g, S, E);
        }
        if (F.G >= 256) { if ((int)blockIdx.x >= 144) ffn_weights<0>(F, FW_P6_LO, FW_P6_HI, ((int)blockIdx.x - 144) * NWAVES + F.wave, (F.G - 144) * NWAVES); }
        else ffn_weights<0>(F, FW_P6_LO, FW_P6_HI, gw, NGW);
        )
        if (BOTH(6)) GRID_BARX();
    }
    if (IN(7)) {
        DUPK(7,
        if ((int)blockIdx.x < 256) {
            int L = blockIdx.x; ABlk cur = xat_item(F.ws, L); att::Seam<att::bf16> S; int par = 0;
            att::causal_swa_prime<0, att::bf16, att::bf16>(cur, F.ldsg, S);
            unsigned char* const wsp = F.ws; auto itf = [wsp](int l) { return xat_item(wsp, l); };
            for (;;) { const int Ln = L + F.G; const bool last = Ln >= 256; const int Lx = last ? L : Ln;
                att::causal_swa_block<0, att::bf16, att::bf16>(cur, Lx, itf, par, F.ldsg, S);
                if (last) break; L = Ln; cur = xat_item(F.ws, L); par ^= 1; }
        }
        )
        if (BOTH(7)) GRID_BARX();
    }
    if (IN(8)) {
        pg8::Gemm g{(const bf16*)(F.ws + WS_XO), (const bf16*)(F.ws + WS_WXO), M, DM, XW}; pg8::StaticOrder S; S.init(M, DM, F.G, (int)blockIdx.x);
        pg8::EpiResid E{nullptr, (const bf16*)(F.ws + WS_XN), (bf16*)(F.ws + WS_XN), SS2, DM, FFN_I8 ? (unsigned*)(F.ws + WS_CTL + CTL_AMAX) : nullptr};
        pg8::gemm_phase<pg8::EpiResid, pg8::StaticOrder, PG_ALIGN, PG_SP2>(F.lds, g, S, E);
        if constexpr (FFN_I8) { GRID_BAR(); const int lane = tid_now() & 63; for (int t = gw; t < M; t += NGW) quant_row(F, t, lane); }
        if (BOTH(8)) GRID_BARX();
    }
    if (IN(9)) {
        DUPK(9,
        typedef pg8::EpiGateUpT<FFN_I8 != 0> EpiGU;
        pg8::Gemm g{(const bf16*)(F.ws + (FFN_I8 ? WS_H2Q : WS_XN)), (const bf16*)(F.ws + WS_WGU), M, NGU, FFN_I8 ? DM / 2 : DM}; pg8::StaticOrder S; S.init(M, NGU, F.G, (int)blockIdx.x);
        float* GF = (float*)(F.ws + WS_HALO);
        EpiGU E{(bf16*)(F.ws + WS_ACT), DFF, SS2, 1.0f / 4096.0f, F.kin[18], F.kin[19], GF, GF + HALO_ONE / 4, GF + 2 * (HALO_ONE / 4), DFF, (LAS float*)(F.lds + 131072),
                (const unsigned*)(F.ws + WS_CTL + CTL_COLMAX), (const unsigned*)(F.ws + WS_CTL + CTL_AMAX)};
        pg8::gemm_phase<EpiGU, pg8::StaticOrder, PG_ALIGN, PG_SP2>(F.lds, g, S, E);
        if (F.G == 256) { if ((int)blockIdx.x >= 128) ffn_weights<0>(F, FW_P9_LO, FW_P9_HI, ((int)blockIdx.x - 128) * NWAVES + F.wave, 128 * NWAVES); }
        else ffn_weights<0>(F, FW_P9_LO, FW_P9_HI, gw, NGW);
        )
        if (BOTH(9)) GRID_BARX();
    }
    if (IN(10)) { DUPK(10, halo_fix(F);) if (BOTH(10)) GRID_BARX(); }
    if (IN(11)) {
        pg8::Gemm g{(const bf16*)(F.ws + WS_ACT), (const bf16*)(F.ws + WS_WDN), M, DM, DFF}; pg8::StaticOrder S; S.init(M, DM, F.G, (int)blockIdx.x);
        pg8::EpiResid E{nullptr, (const bf16*)(F.ws + WS_XN), (bf16*)(F.ws + WS_XN), SS3, DM, nullptr};
        pg8::gemm_phase<pg8::EpiResid, pg8::StaticOrder, PG_ALIGN, PG_SP2>(F.lds, g, S, E);
        if (BOTH(11)) GRID_BARX();
    }
    if (IN(12)) { DUPK(12, const int lane = tid_now() & 63; for (int t = gw; t < M; t += NGW) final_norm_row(F, t, lane);)
    }
#undef IN
#undef BOTH
#undef GRID_BAR
}

extern "C" void kernel_launch(void* const* d_in, const int* in_sizes, int n_in, void* d_out, int out_size, void* d_ws, size_t ws_size, hipStream_t stream) {
    static int grid = 0;
    if (grid == 0) {
        if (n_in != 22 || in_sizes[0] != M * DM || out_size != M * DM || ws_size < WS_END) { fprintf(stderr, "kernel_launch: unexpected shapes (n_in %d, in0 %d, out %d, ws %zu)\n", n_in, n_in > 0 ? in_sizes[0] : -1, out_size, ws_size); grid = -1; return; }
        int dev = 0, cus = 0, per_cu = 0;
        if (hipGetDevice(&dev) != hipSuccess || hipDeviceGetAttribute(&cus, hipDeviceAttributeMultiprocessorCount, dev) != hipSuccess) { grid = -1; return; }
        if (hipFuncSetAttribute((const void*)hybrid_fwd, hipFuncAttributeMaxDynamicSharedMemorySize, LDS_BYTES) != hipSuccess) { fprintf(stderr, "kernel_launch: hipFuncSetAttribute failed\n"); grid = -1; return; }
        if (hipOccupancyMaxActiveBlocksPerMultiprocessor(&per_cu, (const void*)hybrid_fwd, NWAVES * 64, LDS_BYTES) != hipSuccess || per_cu < 1) fprintf(stderr, "kernel_launch: occupancy query reports %d\n", per_cu);
        (void)hipGetLastError();
        grid = cus;
    }
    if (grid < 0) return;
    if (hipMemsetAsync((char*)d_ws + WS_CTL, 0, CTL_ZERO_BYTES, stream) != hipSuccess) return;
    Args a{};
    for (int i = 0; i < 22; ++i) a.in[i] = (const float*)d_in[i];
    a.out = (float*)d_out; a.ws = (unsigned char*)d_ws;
    for (int li = 0; li < N_LAUNCHES; ++li) {
        a.ph_lo = (N_LAUNCHES == 1) ? 0 : li; a.ph_hi = (N_LAUNCHES == 1) ? NPH : li + 1;
        hipLaunchKernelGGL(hybrid_fwd, dim3(grid), dim3(NWAVES * 64), LDS_BYTES, stream, a);
    }
}
```

```cpp
#include <hip/hip_runtime.h>
#include <hip/hip_bf16.h>
#include <cstdio>
#include <cstdint>
#include <cmath>
#include <type_traits>
#ifndef MK_N_LAUNCHES
#define MK_N_LAUNCHES 1
#endif
namespace pg8 {
#define PG8_LAS __attribute__((address_space(3)))
typedef unsigned short bf16_t;
typedef short bf16x8 __attribute__((ext_vector_type(8)));
typedef float f32x4 __attribute__((ext_vector_type(4)));
typedef unsigned u32x4 __attribute__((ext_vector_type(4)));
constexpr int BM = 256, BK = 64, HALF = 128, HTB = HALF * BK * 2  , STAGE_BYTES = 8 * HTB, NXCD = 8, WGM = 8;

__host__ __device__ __forceinline__ int lds_byte(int r, int c) { const int st = (r >> 4) * 2 + (c >> 5), rr = r & 15, cc = c & 31, ob = rr * 64 + cc * 2; return st * 1024 + (ob ^ (((ob >> 9) & 1) << 5)); }
__host__ __device__ __forceinline__ void stage_rc(int b, int& R, int& C) { const int st = b / 1024, sb = b % 1024, swz = sb ^ (((sb >> 9) & 1) << 5); R = (st >> 1) * 16 + swz / 64; C = (st & 1) * 32 + (swz % 64) / 2; }
__host__ __device__ __forceinline__ int perm32(int rho) { const int n = rho >> 4, i = rho & 15; return 8 * (i >> 2) + 4 * n + (i & 3); }

struct Unit { int pm, pn; };
struct Gemm { const bf16_t* A; const bf16_t* Bt; int M, N, K; };

struct StaticOrder {
    int nM, nN, nwg, G, c;
    __host__ __device__ void init(int M, int N, int G_, int c_) { nM = M / BM; nN = N / BM; nwg = nM * nN; G = G_; c = c_; }
    __host__ __device__ bool next(int i, Unit& u) const {
        const long L = (long)i * G + c; if (L >= nwg) return false;
        int wgid = (int)L; { const int q = nwg / NXCD, r = nwg % NXCD, xcd = wgid % NXCD, off = wgid / NXCD; wgid = (xcd < r ? xcd * (q + 1) : r * (q + 1) + (xcd - r) * q) + off; }
        const int nig = WGM * nN, gid = wgid / nig, fm = gid * WGM, gsz = (nM - fm) < WGM ? (nM - fm) : WGM;
        u.pm = fm + ((wgid % nig) % gsz); u.pn = (wgid % nig) / gsz; return true;
    }
    __device__ __forceinline__ void a_ready(const Unit&) const {}
    __device__ __forceinline__ void done(const Unit&) const {}
};

__device__ __forceinline__ unsigned cvt_pk_bf16(float lo, float hi) { unsigned r; asm volatile("v_cvt_pk_bf16_f32 %0, %1, %2" : "=v"(r) : "v"(lo), "v"(hi)); return r; }
typedef float f32x2 __attribute__((ext_vector_type(2)));
typedef unsigned u32x2 __attribute__((ext_vector_type(2)));
typedef int i32x4 __attribute__((ext_vector_type(4)));
typedef __bf16 bf16x2v __attribute__((ext_vector_type(2)));
__device__ __forceinline__ unsigned cvtpk_e(float lo, float hi) { f32x2 v = {lo, hi}; bf16x2v b = __builtin_convertvector(v, bf16x2v); return __builtin_bit_cast(unsigned, b); }
constexpr float RMS_EPS = 1e-6f;
constexpr float SS_SCALE = 1048576.0f;
__device__ __forceinline__ float rstd_of(const unsigned long long* ss, int row, float inv_n) { return 1.0f / sqrtf((float)ss[row] * (inv_n / SS_SCALE) + RMS_EPS); }

struct Seg { bf16_t* base; int ld; int col0; int pad; };
struct EpiProj {
    static constexpr bool PERM = true, PERMA = false, AFTER_DRAIN = false, PREFETCH = false, I8 = false; typedef f32x4 AccT;
    bf16_t *gq, *gk, *gv, *gr, *dqkv;
    __device__ __forceinline__ void operator()(const f32x4 (&acc)[2][2][4][2], const Unit& u, int wr, int wc, int fr, int fq) const {
        const int colt = u.pn * BM; const int row0 = u.pm * BM + wr * 64 + fr;
        if (colt < 6144) {
            bf16_t* base; int ld, c0;
            if (colt < 1024) { base = gq; ld = 1024; c0 = colt; } else if (colt < 2048) { base = gk; ld = 1024; c0 = colt - 1024; }
            else if (colt < 4096) { base = gv; ld = 2048; c0 = colt - 2048; } else { base = gr; ld = 2048; c0 = colt - 4096; }
            const int col0 = c0 + wc * 32 + 8 * fq;
#pragma unroll
            for (int ai = 0; ai < 2; ++ai)
#pragma unroll
                for (int m = 0; m < 4; ++m) { bf16_t* rowp = base + (size_t)(row0 + ai * HALF + m * 16) * ld + col0;
#pragma unroll
                    for (int bj = 0; bj < 2; ++bj) { const f32x4 v0 = acc[ai][bj][m][0], v1 = acc[ai][bj][m][1];
                        u32x4 w; w.x = cvt_pk_bf16(v0[0], v0[1]); w.y = cvt_pk_bf16(v0[2], v0[3]); w.z = cvt_pk_bf16(v1[0], v1[1]); w.w = cvt_pk_bf16(v1[2], v1[3]);
                        __builtin_nontemporal_store(w, (u32x4*)(rowp + bj * HALF)); } }
        } else {
            const int c = colt - 6144, ten = c >> 11, h0 = (c & 2047) >> 7;
            bf16_t* base = dqkv + (size_t)ten * ((size_t)16384 * 2048) + wc * 32 + 8 * fq;
#pragma unroll
            for (int ai = 0; ai < 2; ++ai)
#pragma unroll
                for (int m = 0; m < 4; ++m) { const int row = row0 + ai * HALF + m * 16, b = row >> 12, sq = row & 4095;
#pragma unroll
                    for (int bj = 0; bj < 2; ++bj) { const f32x4 v0 = acc[ai][bj][m][0], v1 = acc[ai][bj][m][1];
                        u32x4 w; w.x = cvt_pk_bf16(v0[0], v0[1]); w.y = cvt_pk_bf16(v0[2], v0[3]); w.z = cvt_pk_bf16(v1[0], v1[1]); w.w = cvt_pk_bf16(v1[2], v1[3]);
                        __builtin_nontemporal_store(w, (u32x4*)(base + ((size_t)((b * 16 + h0 + bj) * 4096 + sq)) * 128)); } }
        }
    }
};
struct EpiProjQ {
    static constexpr bool PERM = true, PERMA = false, AFTER_DRAIN = false, PREFETCH = false, I8 = true; typedef i32x4 AccT;
    bf16_t* dqkv; const float* rsc; const unsigned* cmax;
    __device__ __forceinline__ void operator()(const i32x4 (&acc)[2][2][4][2], const Unit& u, int wr, int wc, int fr, int fq) const {
        const int c = u.pn * BM, ten = c >> 11, h0 = (c & 2047) >> 7; const int row0 = u.pm * BM + wr * 64 + fr;
        bf16_t* base = dqkv + (size_t)ten * ((size_t)16384 * 2048) + wc * 32 + 8 * fq;
        float cs[2][8];
#pragma unroll
        for (int bj = 0; bj < 2; ++bj) { const u32x4 m0 = *(const u32x4*)(cmax + c + bj * HALF + wc * 32 + 8 * fq), m1 = *(const u32x4*)(cmax + c + bj * HALF + wc * 32 + 8 * fq + 4);
            cs[bj][0] = __uint_as_float(m0.x) * (1.0f / 127.0f); cs[bj][1] = __uint_as_float(m0.y) * (1.0f / 127.0f); cs[bj][2] = __uint_as_float(m0.z) * (1.0f / 127.0f); cs[bj][3] = __uint_as_float(m0.w) * (1.0f / 127.0f);
            cs[bj][4] = __uint_as_float(m1.x) * (1.0f / 127.0f); cs[bj][5] = __uint_as_float(m1.y) * (1.0f / 127.0f); cs[bj][6] = __uint_as_float(m1.z) * (1.0f / 127.0f); cs[bj][7] = __uint_as_float(m1.w) * (1.0f / 127.0f); }
#pragma unroll
        for (int ai = 0; ai < 2; ++ai)
#pragma unroll
            for (int m = 0; m < 4; ++m) { const int row = row0 + ai * HALF + m * 16, b = row >> 12, sq = row & 4095; const float rs = rsc[row];
#pragma unroll
                for (int bj = 0; bj < 2; ++bj) { const i32x4 a0 = acc[ai][bj][m][0], a1 = acc[ai][bj][m][1];
                    u32x4 w; w.x = cvt_pk_bf16((float)a0[0] * (rs * cs[bj][0]), (float)a0[1] * (rs * cs[bj][1])); w.y = cvt_pk_bf16((float)a0[2] * (rs * cs[bj][2]), (float)a0[3] * (rs * cs[bj][3]));
                    w.z = cvt_pk_bf16((float)a1[0] * (rs * cs[bj][4]), (float)a1[1] * (rs * cs[bj][5])); w.w = cvt_pk_bf16((float)a1[2] * (rs * cs[bj][6]), (float)a1[3] * (rs * cs[bj][7]));
                    __builtin_nontemporal_store(w, (u32x4*)(base + ((size_t)((b * 16 + h0 + bj) * 4096 + sq)) * 128)); } }
    }
};
struct EpiScaleBf16 {
    static constexpr bool PERM = true, PERMA = false, AFTER_DRAIN = false, PREFETCH = false, I8 = false; typedef f32x4 AccT;
    bf16_t* O; int ldc; const unsigned long long* ss; float inv_n;
    __device__ __forceinline__ void operator()(const f32x4 (&acc)[2][2][4][2], const Unit& u, int wr, int wc, int fr, int fq) const {
        const int row0 = u.pm * BM + wr * 64 + fr, col0 = u.pn * BM + wc * 32 + 8 * fq;
#pragma unroll
        for (int ai = 0; ai < 2; ++ai)
#pragma unroll
            for (int m = 0; m < 4; ++m) { const int row = row0 + ai * HALF + m * 16; const float rs = ss ? rstd_of(ss, row, inv_n) : 1.0f; bf16_t* rowp = O + (size_t)row * ldc + col0;
#pragma unroll
                for (int bj = 0; bj < 2; ++bj) { const f32x4 v0 = acc[ai][bj][m][0] * rs, v1 = acc[ai][bj][m][1] * rs;
                    u32x4 w; w.x = cvt_pk_bf16(v0[0], v0[1]); w.y = cvt_pk_bf16(v0[2], v0[3]); w.z = cvt_pk_bf16(v1[0], v1[1]); w.w = cvt_pk_bf16(v1[2], v1[3]);
                    *(u32x4*)(rowp + bj * HALF) = w; } }
    }
};
struct EpiResid {
    static constexpr bool PERM = true, PERMA = false, AFTER_DRAIN = false, PREFETCH = false, I8 = false; typedef f32x4 AccT;
    const float* base32; const bf16_t* base16; bf16_t* hb; unsigned long long* ss; int ldc; unsigned* amax;
    __device__ __forceinline__ void operator()(const f32x4 (&acc)[2][2][4][2], const Unit& u, int wr, int wc, int fr, int fq) const {
        const int row0 = u.pm * BM + wr * 64 + fr, col0 = u.pn * BM + wc * 32 + 8 * fq;
        f32x4 bc[2][2], bn[2][2]; u32x4 hc[2], hn[2];
#define EPR_LOAD(d32, d16, g) do { const size_t o_ = (size_t)(row0 + ((g) >> 2) * HALF + ((g) & 3) * 16) * ldc + col0; \
        if (base32) { d32[0][0] = *(const f32x4*)(base32 + o_); d32[0][1] = *(const f32x4*)(base32 + o_ + 4); d32[1][0] = *(const f32x4*)(base32 + o_ + HALF); d32[1][1] = *(const f32x4*)(base32 + o_ + HALF + 4); } \
        else { d16[0] = *(const u32x4*)(base16 + o_); d16[1] = *(const u32x4*)(base16 + o_ + HALF); } } while (0)
        EPR_LOAD(bc, hc, 0);
#pragma unroll
        for (int g = 0; g < 8; ++g) {
            const int ai = g >> 2, m = g & 3; const int row = row0 + ai * HALF + m * 16; const size_t off = (size_t)row * ldc + col0; float s = 0.f; float mx = 0.f;
            if (g < 7) EPR_LOAD(bn, hn, g + 1);
#pragma unroll
            for (int bj = 0; bj < 2; ++bj) {
                f32x4 b0, b1;
                if (base32) { b0 = bc[bj][0]; b1 = bc[bj][1]; }
                else { const u32x4 w = hc[bj]; b0 = (f32x4){__uint_as_float(w.x << 16), __uint_as_float(w.x & 0xffff0000u), __uint_as_float(w.y << 16), __uint_as_float(w.y & 0xffff0000u)};
                                              b1 = (f32x4){__uint_as_float(w.z << 16), __uint_as_float(w.z & 0xffff0000u), __uint_as_float(w.w << 16), __uint_as_float(w.w & 0xffff0000u)}; }
                const f32x4 v0 = acc[ai][bj][m][0] + b0, v1 = acc[ai][bj][m][1] + b1;
                s += (v0[0] * v0[0] + v0[1] * v0[1]) + (v0[2] * v0[2] + v0[3] * v0[3]) + (v1[0] * v1[0] + v1[1] * v1[1]) + (v1[2] * v1[2] + v1[3] * v1[3]);
                if (amax) { const f32x4 a0 = __builtin_elementwise_abs(v0), a1 = __builtin_elementwise_abs(v1); mx = fmaxf(mx, fmaxf(fmaxf(fmaxf(a0[0], a0[1]), fmaxf(a0[2], a0[3])), fmaxf(fmaxf(a1[0], a1[1]), fmaxf(a1[2], a1[3])))); }
                u32x4 w; w.x = cvt_pk_bf16(v0[0], v0[1]); w.y = cvt_pk_bf16(v0[2], v0[3]); w.z = cvt_pk_bf16(v1[0], v1[1]); w.w = cvt_pk_bf16(v1[2], v1[3]); *(u32x4*)(hb + off + bj * HALF) = w; }
            s += __shfl_xor(s, 16); s += __shfl_xor(s, 32);
            if (ss && fq == 0) atomicAdd(ss + row, (unsigned long long)(s * SS_SCALE + 0.5f));
            if (amax) { mx = fmaxf(mx, __shfl_xor(mx, 16)); mx = fmaxf(mx, __shfl_xor(mx, 32)); if (fq == 0) atomicMax(amax + row, __float_as_uint(mx)); }
#pragma unroll
            for (int bj = 0; bj < 2; ++bj) { bc[bj][0] = bn[bj][0]; bc[bj][1] = bn[bj][1]; hc[bj] = hn[bj]; }
            asm volatile("" ::: "memory");
        }
#undef EPR_LOAD
    }
};
template <bool Q> struct EpiGateUpT {
    static constexpr bool PERM = true, PERMA = true, AFTER_DRAIN = false, PREFETCH = true, I8 = Q; typedef typename std::conditional<Q, i32x4, f32x4>::type AccT;
    static constexpr int AUXN = 1024;
    static constexpr float NLOG2E = -1.4426950408889634f, NLN2 = -0.6931471805599453f;
    bf16_t* act; int ldc; const unsigned long long* ss; float inv_n; const float* cw; const float* cb; float* GF; float* UF; float* GL; int nff;
    PG8_LAS float* aux;
    const unsigned* colmax; const unsigned* amax;
    __device__ __forceinline__ float rowscale(unsigned long long s2, unsigned am) const { const float r = 1.0f / sqrtf((float)s2 * (inv_n / SS_SCALE) + RMS_EPS); return Q ? r * __uint_as_float(am) * (1.0f / 127.0f) : r; }
    __device__ __forceinline__ void prefetch(const Unit& u, int par) const {
        int tid = (int)threadIdx.x; asm volatile("" : "+v"(tid)); const int arr = tid >> 7, c = u.pn * HALF + (tid & 127);
        const float gs = Q ? __uint_as_float(colmax[c]) * (1.0f / 127.0f) : 1.0f;
        const float v = (arr < 3 ? cw[arr * nff + c] * gs : cb[c]) * NLOG2E;
        PG8_LAS float* a = aux + par * AUXN; a[tid] = v;
        if (tid < 128) a[512 + tid] = (Q ? __uint_as_float(colmax[nff + c]) * (1.0f / 127.0f) : 1.0f) * NLN2;
        if (tid < 256) { const int row = u.pm * BM + tid; a[768 + tid] = rowscale(ss[row], Q ? amax[row] : 0u); }
    }
    __device__ __forceinline__ void run(const AccT (&acc)[2][2][4][2], const Unit& u, int wr, int wc, int fr, int fq, int par, const Unit& nxt) const {
        int tid = (int)threadIdx.x; asm volatile("" : "+v"(tid)); const int arr = tid >> 7, cn = nxt.pn * HALF + (tid & 127);
        const float ncw = arr < 3 ? cw[arr * nff + cn] : cb[cn];
        const unsigned ncg = Q ? colmax[cn] : 0u, ncu = Q ? colmax[nff + cn] : 0u;
        const int nrow = nxt.pm * BM + (tid & 255);
        const unsigned long long nss = ss[nrow]; const unsigned nam = Q ? amax[nrow] : 0u;
        const PG8_LAS float* a = aux + par * AUXN;
        const int c0 = wc * 32 + 8 * fq;
        const int ch0 = u.pn * HALF + c0;
        f32x2 w0[4], w1[4], w2[4], bb[4], sl[4];
#pragma unroll
        for (int h4 = 0; h4 < 2; ++h4) { const f32x4 x0 = *(const PG8_LAS f32x4*)(a + c0 + 4 * h4), x1 = *(const PG8_LAS f32x4*)(a + 128 + c0 + 4 * h4), x2 = *(const PG8_LAS f32x4*)(a + 256 + c0 + 4 * h4), x3 = *(const PG8_LAS f32x4*)(a + 384 + c0 + 4 * h4);
            const f32x4 x4 = *(const PG8_LAS f32x4*)(a + 512 + c0 + 4 * h4);
#pragma unroll
            for (int q = 0; q < 2; ++q) { w0[2 * h4 + q] = (f32x2){x0[2 * q], x0[2 * q + 1]}; w1[2 * h4 + q] = (f32x2){x1[2 * q], x1[2 * q + 1]}; w2[2 * h4 + q] = (f32x2){x2[2 * q], x2[2 * q + 1]};
                bb[2 * h4 + q] = (f32x2){x3[2 * q], x3[2 * q + 1]}; sl[2 * h4 + q] = (f32x2){x4[2 * q], x4[2 * q + 1]}; } }
#pragma unroll
        for (int ai = 0; ai < 2; ++ai) {
            const int lrow0 = ai * HALF + wr * 64 + fr * 4;
            const int blk = (u.pm * BM + ai * HALF + wr * 64) >> 6;
            const f32x4 rs4 = *(const PG8_LAS f32x4*)(a + 768 + lrow0);
            bf16_t* arow = act + (size_t)(u.pm * BM + lrow0) * ldc + ch0;
            f32x2 g[4][4];
#pragma unroll
            for (int m = 0; m < 4; ++m)
#pragma unroll
                for (int p = 0; p < 4; ++p) g[m][p] = (f32x2){(float)acc[ai][0][m][p >> 1][2 * (p & 1)], (float)acc[ai][0][m][p >> 1][2 * (p & 1) + 1]} * rs4[m];
            f32x2 gm1[4], gm2[4];
#pragma unroll
            for (int p = 0; p < 4; ++p) {
                gm1[p] = (f32x2){__int_as_float(__builtin_amdgcn_update_dpp(0, __float_as_int(g[3][p][0]), 0x111, 0xf, 0xf, true)), __int_as_float(__builtin_amdgcn_update_dpp(0, __float_as_int(g[3][p][1]), 0x111, 0xf, 0xf, true))};
                gm2[p] = (f32x2){__int_as_float(__builtin_amdgcn_update_dpp(0, __float_as_int(g[2][p][0]), 0x111, 0xf, 0xf, true)), __int_as_float(__builtin_amdgcn_update_dpp(0, __float_as_int(g[2][p][1]), 0x111, 0xf, 0xf, true))}; }
#pragma unroll
            for (int m = 0; m < 4; ++m) {
                u32x4 w; f32x2 upv[4];
#pragma unroll
                for (int p = 0; p < 4; ++p) {
                    const f32x2 r1 = m >= 1 ? g[m >= 1 ? m - 1 : 0][p] : gm1[p], r2 = m >= 2 ? g[m >= 2 ? m - 2 : 0][p] : (m == 1 ? gm1[p] : gm2[p]);
                    const f32x2 y = bb[p] + w2[p] * g[m][p] + w1[p] * r1 + w0[p] * r2;
                    const f32x2 d = (f32x2){__builtin_amdgcn_exp2f(y[0]), __builtin_amdgcn_exp2f(y[1])} + 1.0f;
                    const f32x2 sg = {__builtin_amdgcn_rcpf(d[0]), __builtin_amdgcn_rcpf(d[1])};
                    upv[p] = (f32x2){(float)acc[ai][1][m][p >> 1][2 * (p & 1)], (float)acc[ai][1][m][p >> 1][2 * (p & 1) + 1]} * (sl[p] * rs4[m]);
                    const f32x2 av = y * sg * upv[p];
                    w[p] = cvtpk_e(av[0], av[1]);
                }
                if (m >= 2 || fr != 0) __builtin_nontemporal_store(w, (u32x4*)(arow + (size_t)m * ldc));
                if (m < 2 && fr == 0) { float* gp = GF + ((size_t)blk * 2 + m) * nff + ch0; float* upp = UF + ((size_t)blk * 2 + m) * nff + ch0;
                    *(f32x4*)gp = (f32x4){g[m][0][0], g[m][0][1], g[m][1][0], g[m][1][1]}; *(f32x4*)(gp + 4) = (f32x4){g[m][2][0], g[m][2][1], g[m][3][0], g[m][3][1]};
                    *(f32x4*)upp = (f32x4){upv[0][0], upv[0][1], upv[1][0], upv[1][1]}; *(f32x4*)(upp + 4) = (f32x4){upv[2][0], upv[2][1], upv[3][0], upv[3][1]}; }
                if (m >= 2 && fr == 15) { float* gp = GL + ((size_t)blk * 2 + (m - 2)) * nff + ch0;
                    *(f32x4*)gp = (f32x4){g[m][0][0], g[m][0][1], g[m][1][0], g[m][1][1]}; *(f32x4*)(gp + 4) = (f32x4){g[m][2][0], g[m][2][1], g[m][3][0], g[m][3][1]}; }
            }
        }
        PG8_LAS float* an = aux + (par ^ 1) * AUXN;
        an[tid] = (arr < 3 ? ncw * (Q ? __uint_as_float(ncg) * (1.0f / 127.0f) : 1.0f) : ncw) * NLOG2E;
        if (tid < 128) an[512 + tid] = (Q ? __uint_as_float(ncu) * (1.0f / 127.0f) : 1.0f) * NLN2;
        if (tid < 256) an[768 + tid] = rowscale(nss, nam);
    }
};
typedef EpiGateUpT<false> EpiGateUp;
typedef EpiGateUpT<true> EpiGateUpQ;
struct EpiNull {
    static constexpr bool PERM = true, PERMA = false, AFTER_DRAIN = false, PREFETCH = false, I8 = false; typedef f32x4 AccT;
    __device__ __forceinline__ void operator()(const f32x4 (&acc)[2][2][4][2], const Unit& u, int wr, int wc, int fr, int fq) const {
#pragma unroll
        for (int ai = 0; ai < 2; ++ai)
#pragma unroll
            for (int bj = 0; bj < 2; ++bj)
#pragma unroll
                for (int m = 0; m < 4; ++m)
#pragma unroll
                    for (int n = 0; n < 2; ++n) asm volatile("" :: "v"(acc[ai][bj][m][n]));
    }
};
template <bool I8> __device__ __forceinline__ auto pg8_mma(bf16x8 b, bf16x8 a, typename std::conditional<I8, i32x4, f32x4>::type c) {
    if constexpr (I8) return __builtin_amdgcn_mfma_i32_16x16x64_i8(__builtin_bit_cast(i32x4, b), __builtin_bit_cast(i32x4, a), c, 0, 0, 0);
    else return __builtin_amdgcn_mfma_f32_16x16x32_bf16(b, a, c, 0, 0, 0);
}
template <class Epi, class Sched, bool ALIGN_EPI = false, bool SP2 = false>
__device__ __forceinline__ void gemm_phase(PG8_LAS unsigned char* lds, const Gemm g, const Sched& S, const Epi& E) {
    const int tid = threadIdx.x, wid = __builtin_amdgcn_readfirstlane(tid >> 6), lane = tid & 63, wr = wid >> 2, wc = wid & 3, fr = lane & 15, fq = lane >> 4;
    const int K = g.K, nt = K / BK;
    unsigned voffA[2], voffB[2];
#pragma unroll
    for (int i = 0; i < 2; ++i) { int R, C; stage_rc(tid * 16 + i * 8192, R, C); const int Rb = Epi::PERM ? ((R & ~31) + perm32(R & 31)) : R;
        const int Ra = Epi::PERMA ? ((R & 64) | ((R & 15) << 2) | ((R >> 4) & 3)) : R;
        voffA[i] = (unsigned)(Ra * K + C) * 2u; voffB[i] = (unsigned)(Rb * K + C) * 2u; }
    const size_t kstep = (size_t)(BK * 2);
    const size_t hstep = (size_t)HALF * K * 2;
    const size_t tstep = 2 * hstep;
    const unsigned ldsw = (unsigned)wid * 1024u;
    const int aoff = lds_byte(wr * 64 + fr, fq * 8), boff = lds_byte(wc * 32 + fr, fq * 8);
#define PG8_SA(b, h) (((b) * 2 + (h)) * HTB)
#define PG8_SB(b, h) ((4 + (b) * 2 + (h)) * HTB)
#define PG8_STAGE(bufoff, gbase, voff) do { _Pragma("unroll") for (int _i = 0; _i < 2; ++_i) \
        __builtin_amdgcn_global_load_lds((const unsigned*)((const char*)(gbase) + (voff)[_i]), (PG8_LAS unsigned*)(lds + (bufoff) + ldsw + _i * 8192), 16, 0, 0); } while (0)
#define PG8_LDA(dst, b, h) do { _Pragma("unroll") for (int m = 0; m < 4; ++m) _Pragma("unroll") for (int k = 0; k < 2; ++k) dst[m][k] = *(const PG8_LAS bf16x8*)(lds + PG8_SA(b, h) + aoff + m * 2048 + k * 1024); } while (0)
#define PG8_LDB(dst, b, h) do { _Pragma("unroll") for (int n = 0; n < 2; ++n) _Pragma("unroll") for (int k = 0; k < 2; ++k) dst[n][k] = *(const PG8_LAS bf16x8*)(lds + PG8_SB(b, h) + boff + n * 2048 + k * 1024); } while (0)
#define PG8_MMA(ai, bj, At, Bt) do { __builtin_amdgcn_s_setprio(1); _Pragma("unroll") for (int m = 0; m < 4; ++m) _Pragma("unroll") for (int n = 0; n < 2; ++n) _Pragma("unroll") for (int k = 0; k < 2; ++k) \
        acc[ai][bj][m][n] = pg8_mma<Epi::I8>(Bt[n][k], At[m][k], acc[ai][bj][m][n]); __builtin_amdgcn_s_setprio(0); } while (0)
#define PG8_WAIT_V(n) asm volatile("s_waitcnt vmcnt(" #n ")" ::: "memory")
#define PG8_WAIT_L(n) asm volatile("s_waitcnt lgkmcnt(" #n ")" ::: "memory")
#define PG8_BAR __builtin_amdgcn_s_barrier()
#define PG8_SCHED __builtin_amdgcn_sched_barrier(0)
    Unit cur, nxt; int ui = 0;
    if (!S.next(0, cur)) return;
    typedef typename Epi::AccT AccT; AccT acc[2][2][4][2];
#pragma unroll
    for (int a = 0; a < 2; ++a)
#pragma unroll
        for (int b = 0; b < 2; ++b)
#pragma unroll
            for (int m = 0; m < 4; ++m)
#pragma unroll
                for (int n = 0; n < 2; ++n) acc[a][b][m][n] = AccT{};
    bf16x8 At[4][2], B0[2][2], B1[2][2];
    const char* cA = (const char*)g.A + (size_t)cur.pm * tstep; const char* cB = (const char*)g.Bt + (size_t)cur.pn * tstep;
    S.a_ready(cur);
    if constexpr (Epi::PREFETCH) E.prefetch(cur, 0);
    if constexpr (SP2) {
        PG8_STAGE(PG8_SB(0, 0), cB, voffB); PG8_STAGE(PG8_SB(0, 1), cB + hstep, voffB); PG8_STAGE(PG8_SA(0, 0), cA, voffA); PG8_STAGE(PG8_SA(0, 1), cA + hstep, voffA);
        if (wr == 1) PG8_BAR;
        PG8_WAIT_V(2); PG8_BAR;
        PG8_STAGE(PG8_SB(1, 0), cB + kstep, voffB); PG8_STAGE(PG8_SA(1, 0), cA + kstep, voffA); PG8_STAGE(PG8_SB(1, 1), cB + hstep + kstep, voffB);
        PG8_WAIT_V(6); PG8_BAR;
    } else {
        PG8_STAGE(PG8_SB(0, 0), cB, voffB); PG8_STAGE(PG8_SA(0, 0), cA, voffA); PG8_STAGE(PG8_SB(0, 1), cB + hstep, voffB); PG8_STAGE(PG8_SA(0, 1), cA + hstep, voffA);
        if (wr == 1) PG8_BAR;
        PG8_WAIT_V(4); PG8_BAR;
        PG8_STAGE(PG8_SB(1, 0), cB + kstep, voffB); PG8_STAGE(PG8_SA(1, 0), cA + kstep, voffA); PG8_STAGE(PG8_SB(1, 1), cB + hstep + kstep, voffB);
        PG8_WAIT_V(6); PG8_BAR;
    }
    for (;;) {
        const bool has_next = S.next(ui + 1, nxt);
        const char* nA = has_next ? (const char*)g.A + (size_t)nxt.pm * tstep : cA; const char* nB = has_next ? (const char*)g.Bt + (size_t)nxt.pn * tstep : cB;
        for (int t = 0; t < nt; t += 2) {
            const bool last = (t == nt - 2);
            const char* a1 = cA + (size_t)(t + 1) * kstep;
            const char* a2 = last ? nA : cA + (size_t)(t + 2) * kstep; const char* b2 = last ? nB : cB + (size_t)(t + 2) * kstep;
            const char* a3 = a2 + kstep; const char* b3 = b2 + kstep;
            if (last && has_next) S.a_ready(nxt);
            if constexpr (SP2) {
            PG8_LDB(B0, 0, 0); PG8_LDB(B1, 0, 1); PG8_SCHED; PG8_LDA(At, 0, 0); PG8_STAGE(PG8_SA(1, 1), a1 + hstep, voffA);
            PG8_WAIT_V(8); PG8_WAIT_L(0); PG8_BAR; PG8_MMA(0, 0, At, B0); PG8_MMA(0, 1, At, B1); PG8_BAR; PG8_SCHED;
            PG8_LDA(At, 0, 1); PG8_STAGE(PG8_SB(0, 0), b2, voffB); PG8_STAGE(PG8_SB(0, 1), b2 + hstep, voffB); PG8_STAGE(PG8_SA(0, 0), a2, voffA);
            PG8_WAIT_V(8); PG8_WAIT_L(0); PG8_BAR; PG8_MMA(1, 0, At, B0); PG8_MMA(1, 1, At, B1); PG8_BAR; PG8_SCHED;
            PG8_LDB(B0, 1, 0); PG8_LDB(B1, 1, 1); PG8_SCHED; PG8_LDA(At, 1, 0); PG8_STAGE(PG8_SA(0, 1), a2 + hstep, voffA);
            PG8_WAIT_V(8); PG8_WAIT_L(0); PG8_BAR; PG8_MMA(0, 0, At, B0); PG8_MMA(0, 1, At, B1); PG8_BAR; PG8_SCHED;
            PG8_LDA(At, 1, 1); PG8_STAGE(PG8_SB(1, 0), b3, voffB); PG8_STAGE(PG8_SB(1, 1), b3 + hstep, voffB); PG8_STAGE(PG8_SA(1, 0), a3, voffA);
            PG8_WAIT_V(8); PG8_WAIT_L(0); PG8_BAR; PG8_MMA(1, 0, At, B0); PG8_MMA(1, 1, At, B1); PG8_BAR; PG8_SCHED;
            } else {
            PG8_LDB(B0, 0, 0); PG8_SCHED; PG8_LDA(At, 0, 0); PG8_STAGE(PG8_SA(1, 1), a1 + hstep, voffA);
            PG8_WAIT_L(8); PG8_BAR; PG8_WAIT_L(0); PG8_MMA(0, 0, At, B0); PG8_BAR; PG8_SCHED;
            PG8_LDB(B1, 0, 1); PG8_STAGE(PG8_SB(0, 0), b2, voffB);
            PG8_BAR; PG8_WAIT_L(0); PG8_MMA(0, 1, At, B1); PG8_BAR;
            PG8_LDA(At, 0, 1); PG8_STAGE(PG8_SA(0, 0), a2, voffA);
            PG8_BAR; PG8_WAIT_L(0); PG8_MMA(1, 0, At, B0); PG8_BAR; PG8_SCHED;
            PG8_STAGE(PG8_SB(0, 1), b2 + hstep, voffB);
            PG8_WAIT_V(6); PG8_BAR; PG8_MMA(1, 1, At, B1); PG8_BAR;
            PG8_LDB(B0, 1, 0); PG8_SCHED; PG8_LDA(At, 1, 0); PG8_STAGE(PG8_SA(0, 1), a2 + hstep, voffA);
            PG8_WAIT_L(8); PG8_BAR; PG8_WAIT_L(0); PG8_MMA(0, 0, At, B0); PG8_BAR; PG8_SCHED;
            PG8_LDB(B1, 1, 1); PG8_STAGE(PG8_SB(1, 0), b3, voffB);
            PG8_BAR; PG8_WAIT_L(0); PG8_MMA(0, 1, At, B1); PG8_BAR;
            PG8_LDA(At, 1, 1); PG8_STAGE(PG8_SA(1, 0), a3, voffA);
            PG8_BAR; PG8_WAIT_L(0); PG8_MMA(1, 0, At, B0); PG8_BAR; PG8_SCHED;
            PG8_STAGE(PG8_SB(1, 1), b3 + hstep, voffB);
            PG8_WAIT_V(6); PG8_BAR; PG8_MMA(1, 1, At, B1); PG8_BAR;
            }
        }
        if constexpr (ALIGN_EPI) { if (wr == 0) PG8_BAR; }
        if constexpr (!Epi::AFTER_DRAIN) { if constexpr (Epi::PREFETCH) E.run(acc, cur, wr, wc, fr, fq, ui & 1, has_next ? nxt : cur); else E(acc, cur, wr, wc, fr, fq); S.done(cur); }
        if (!has_next) break;
#pragma unroll
        for (int a = 0; a < 2; ++a)
#pragma unroll
            for (int b = 0; b < 2; ++b)
#pragma unroll
                for (int m = 0; m < 4; ++m)
#pragma unroll
                    for (int n = 0; n < 2; ++n) acc[a][b][m][n] = AccT{};
        cur = nxt; cA = nA; cB = nB; ++ui;
        if constexpr (ALIGN_EPI) { if (wr == 1) PG8_BAR; }
    }
    PG8_WAIT_V(0);
    if constexpr (!ALIGN_EPI) { if (wr == 0) PG8_BAR; }
    PG8_BAR;
    if constexpr (Epi::AFTER_DRAIN) { E.fused(acc, cur, wr, wc, fr, fq, lds, wid, lane); S.done(cur); }
#undef PG8_SA
#undef PG8_SB
#undef PG8_STAGE
#undef PG8_LDA
#undef PG8_LDB
#undef PG8_MMA
#undef PG8_WAIT_V
#undef PG8_WAIT_L
#undef PG8_BAR
#undef PG8_SCHED
}
}
namespace att {
constexpr int D = 128; constexpr float THR = 8.f; constexpr bool WSKIP = true;
constexpr float SCALE = 0.08838834764831845f;
constexpr int NW = 8, QBLK = 32, KVBLK = 64, QB = NW * QBLK;
constexpr int SHM_V = KVBLK * D * 2, SHM_K = KVBLK * D * 2;
constexpr int LDS_TAB = 2 * SHM_V + 2 * SHM_K + NW * 64 * 4, TAB_N = 328, TAB_OFF = 100, TAB_PITCH = 4 * TAB_N;
constexpr int LDS_BYTES = LDS_TAB + 2 * TAB_PITCH * 4;
using bf16 = __hip_bfloat16;
typedef short bf16x8 __attribute__((ext_vector_type(8)));
typedef short s16x4 __attribute__((ext_vector_type(4)));
typedef float f32x16 __attribute__((ext_vector_type(16)));
typedef float f32x4 __attribute__((ext_vector_type(4)));
typedef float f32x2 __attribute__((ext_vector_type(2)));
typedef unsigned u32x4 __attribute__((ext_vector_type(4)));
template <class A, class Bt> struct same_t { static constexpr bool v = false; };
template <class A> struct same_t<A, A> { static constexpr bool v = true; };

#define KSWZ(row, colB) ((row) * 256 + ((colB) ^ (((row) & 7) << 4)))
#define SBAR() __builtin_amdgcn_sched_barrier(0)
__device__ __forceinline__ int v_st(int k, int c) { const int kk = (k & ~0xC) | ((k & 4) << 1) | ((k & 8) >> 1); return ((kk >> 3) * 4 + (c >> 5)) * 512 + ((kk & 7) * 32 + (c & 31)) * 2; }
__device__ __forceinline__ int v_rd_base(int lane) { return ((lane & 3) << 3) | (((lane >> 2) & 3) << 6) | (((lane >> 4) & 1) << 5) | (((lane >> 5) & 1) << 8); }
constexpr int v_rd_off(int d0, int ks, int half) { return d0 * 512 + ks * 4096 + half * 2048; }
__device__ __forceinline__ int crow(int r, int hi) { return (r & 3) + 8 * (r >> 2) + 4 * hi; }
__device__ __forceinline__ unsigned cvtpk(float lo, float hi) {
    unsigned r; asm volatile("v_cvt_pk_bf16_f32 %0, %1, %2" : "=v"(r) : "v"(lo), "v"(hi)); return r;
}
__device__ __forceinline__ bf16x8 pack8(f32x4 a, f32x4 b) {
    u32x4 w = {cvtpk(a[0], a[1]), cvtpk(a[2], a[3]), cvtpk(b[0], b[1]), cvtpk(b[2], b[3])};
    return *reinterpret_cast<bf16x8*>(&w);
}
template <class T> __device__ __forceinline__ bf16x8 load8(const T* p) {
    if constexpr (same_t<T, float>::v) { return pack8(*(const f32x4*)p, *(const f32x4*)(p + 4)); }
    else { return *reinterpret_cast<const bf16x8*>(p); }
}
__device__ __forceinline__ void mask_tile(f32x16& p0, f32x16& p1, int dq, unsigned W) {
    const float NEG = -__builtin_inff();
#pragma unroll
    for (int r = 0; r < 16; ++r) {
        const int c = (r & 3) + 8 * (r >> 2);
        if ((unsigned)(dq - c) >= W) p0[r] = NEG;
        if ((unsigned)(dq - c - 32) >= W) p1[r] = NEG;
    }
}
__device__ __forceinline__ void bias_mask_tile(f32x16& p0, f32x16& p1, int dq, unsigned W, const float* tabu, bool needmask) {
    const float NEG = -__builtin_inff();
    const int sft = (4 - ((int)threadIdx.x & 3)) & 3;
    const float* t0 = tabu + (sft * (TAB_N - 1) + TAB_OFF + 128 - dq);
#pragma unroll
    for (int J = 0; J < 8; ++J) {
        const f32x4 b = *(const f32x4*)(t0 + 8 * J);
#pragma unroll
        for (int e = 0; e < 4; ++e) {
            const int r = 4 * (J & 3) + e; const int c = e + 8 * (J & 3) + (J >= 4 ? 32 : 0);
            float v = (J < 4 ? p0[r] : p1[r]) + b[e];
            if (needmask) { if ((unsigned)(dq - c) >= W) v = NEG; }
            if (J < 4) p0[r] = v; else p1[r] = v;
        }
        if ((J & 1) == 1) asm volatile("" ::: "memory");
    }
}
__device__ __forceinline__ void bias_fill(float* T, const float* bsrc, int tid) {
    asm volatile("" : "+v"(tid));
    if (tid < TAB_N) {
#pragma unroll
        for (int sf = 0; sf < 4; ++sf) { const int i = tid - TAB_OFF + sf; T[sf * TAB_N + tid] = (i >= 0 && i <= 128) ? bsrc[128 - i] : 0.f; }
    }
}
__device__ __forceinline__ void partialSM(f32x16& p0, f32x16& p1, float& m_reg, float& mn, float& alpha) {
    float pmax = p0[0]; for (int r = 1; r < 16; ++r) pmax = fmaxf(pmax, p0[r]); for (int r = 0; r < 16; ++r) pmax = fmaxf(pmax, p1[r]);
    { auto rr = __builtin_amdgcn_permlane32_swap(__float_as_uint(pmax), __float_as_uint(pmax), false, false);
      pmax = fmaxf(__uint_as_float(rr[0]), __uint_as_float(rr[1])); }
    constexpr float C2 = 1.4426950408889634f * SCALE;
    if (__builtin_expect(__all((pmax - m_reg) * SCALE <= THR), 1)) { mn = m_reg; alpha = 1.f; }
    else { mn = fmaxf(m_reg, pmax); alpha = __builtin_amdgcn_exp2f((m_reg - mn) * C2); m_reg = mn; }
    const float mnL = -mn * C2;
    for (int r = 0; r < 16; ++r) p0[r] = fmaf(p0[r], C2, mnL); for (int r = 0; r < 16; ++r) p1[r] = fmaf(p1[r], C2, mnL);
    for (int r = 0; r < 16; ++r) p0[r] = __builtin_amdgcn_exp2f(p0[r]);
}
__device__ __forceinline__ void finishSM(f32x16& p0, f32x16& p1, float alpha, float& l_reg, bf16x8& pa0, bf16x8& pa1, bf16x8& pa2, bf16x8& pa3) {
    for (int r = 0; r < 16; ++r) p1[r] = __builtin_amdgcn_exp2f(p1[r]);
    float ps = 0; for (int r = 0; r < 16; ++r) ps += p0[r]; for (int r = 0; r < 16; ++r) ps += p1[r];
    { auto rr = __builtin_amdgcn_permlane32_swap(__float_as_uint(ps), __float_as_uint(ps), false, false);
      ps = __uint_as_float(rr[0]) + __uint_as_float(rr[1]); }
    l_reg = l_reg * alpha + ps;
#define PK4(P, B_, OUT) do { unsigned a0 = cvtpk(P[B_+0], P[B_+1]), a1 = cvtpk(P[B_+2], P[B_+3]);                          \
        unsigned b0 = cvtpk(P[B_+4], P[B_+5]), b1 = cvtpk(P[B_+6], P[B_+7]);                                             \
        auto r0 = __builtin_amdgcn_permlane32_swap(a0, b0, false, false); auto r1 = __builtin_amdgcn_permlane32_swap(a1, b1, false, false); \
        u32x4 w = {r0[0], r1[0], r0[1], r1[1]}; OUT = *reinterpret_cast<bf16x8*>(&w); } while (0)
    PK4(p0, 0, pa0); PK4(p0, 8, pa1); PK4(p1, 0, pa2); PK4(p1, 8, pa3);
#undef PK4
}
template <int KB, bool SK>
__device__ __forceinline__ void qkt(f32x16& p0, f32x16& p1, const char* K_lds, int r32, int hi, const bf16x8* qr, bool act) {
    if (SK && !act) { const float NEG = -__builtin_inff();
#pragma unroll
        for (int r = 0; r < 16; ++r) { p0[r] = NEG; p1[r] = NEG; } return; }
    p0 = f32x16{}; p1 = f32x16{};
    const char* kb[4];
#pragma unroll
    for (int dd = 0; dd < 4; ++dd) kb[dd] = K_lds + KB * SHM_K + KSWZ(r32, (dd * 16 + hi * 8) * 2);
#pragma unroll
    for (int d0 = 0; d0 < 8; ++d0) { const char* a = kb[d0 & 3] + (d0 >> 2) * 128;
        bf16x8 b0 = *reinterpret_cast<const bf16x8*>(a);
        bf16x8 b1 = *reinterpret_cast<const bf16x8*>(a + 32 * 256);
        p0 = __builtin_amdgcn_mfma_f32_32x32x16_bf16(b0, qr[d0], p0, 0, 0, 0);
        p1 = __builtin_amdgcn_mfma_f32_32x32x16_bf16(b1, qr[d0], p1, 0, 0, 0); }
}
template <int VB, bool SK>
__device__ __forceinline__ void pv_tile(f32x16* o, int vb0, bf16x8 pa0, bf16x8 pa1, bf16x8 pa2, bf16x8 pa3, bool act) {
    if (SK && !act) return;
#define TRRD(dst, off) asm volatile("ds_read_b64_tr_b16 %0, %1 offset:%2" : "=&v"(dst) : "v"(vb0), "i"(off) : "memory")
#define PV_D0(d0) do { s16x4 l0, l1, l2, l3, h0, h1, h2, h3; constexpr int b_ = VB * SHM_V + v_rd_off(d0, 0, 0);     \
        TRRD(l0, b_); TRRD(h0, b_ + 2048); TRRD(l1, b_ + 4096); TRRD(h1, b_ + 6144); TRRD(l2, b_ + 8192); TRRD(h2, b_ + 10240); TRRD(l3, b_ + 12288); TRRD(h3, b_ + 14336); \
        asm volatile("s_waitcnt lgkmcnt(0)" ::: "memory"); SBAR();                 \
        o[d0] = __builtin_amdgcn_mfma_f32_32x32x16_bf16(pa0, (bf16x8){l0[0], l0[1], l0[2], l0[3], h0[0], h0[1], h0[2], h0[3]}, o[d0], 0, 0, 0);   \
        o[d0] = __builtin_amdgcn_mfma_f32_32x32x16_bf16(pa1, (bf16x8){l1[0], l1[1], l1[2], l1[3], h1[0], h1[1], h1[2], h1[3]}, o[d0], 0, 0, 0);   \
        o[d0] = __builtin_amdgcn_mfma_f32_32x32x16_bf16(pa2, (bf16x8){l2[0], l2[1], l2[2], l2[3], h2[0], h2[1], h2[2], h2[3]}, o[d0], 0, 0, 0);   \
        o[d0] = __builtin_amdgcn_mfma_f32_32x32x16_bf16(pa3, (bf16x8){l3[0], l3[1], l3[2], l3[3], h3[0], h3[1], h3[2], h3[3]}, o[d0], 0, 0, 0); } while (0)
    PV_D0(0); PV_D0(1); PV_D0(2); PV_D0(3);
#undef PV_D0
#undef TRRD
}

template <class TIn, class TOut> struct BlockRef { const TIn* Q; const TIn* K; const TIn* V; TOut* O; float* L; const float* bsrc; int P0, pq, pk, po, pl, skv, W; };
template <class TIn> struct Seam {
    bf16x8 qr[8];
    bf16x8 st_v0, st_v1, st_k0, st_k1; f32x4 sf0, sf1, sf2, sf3;
    f32x4 tq[16];
};
__device__ __forceinline__ int swa_jlo(int P0, int W) { const int lowk = P0 - W + 1; return lowk > 0 ? lowk / KVBLK : 0; }
#define ROW(p, pit, k0, rr) ((p) + (unsigned)(((k0) + (rr)) * (pit) + sc))
#define VMW() asm volatile("s_waitcnt vmcnt(0)" ::: "memory")
#define VMWN(n) asm volatile("s_waitcnt vmcnt(%0)" :: "i"(n) : "memory")
#define SLOAD_H(Kp, Vp, pit, k0) do { S.st_v0 = load8<TIn>(ROW(Vp, pit, k0, sr)); S.st_v1 = load8<TIn>(ROW(Vp, pit, k0, 32 + sr));              \
                         S.st_k0 = load8<TIn>(ROW(Kp, pit, k0, sr)); S.st_k1 = load8<TIn>(ROW(Kp, pit, k0, 32 + sr)); } while (0)
#define SWRITE_HK(bf) do { *(bf16x8*)(K_lds + (bf) * SHM_K + kws) = S.st_k0; *(bf16x8*)(K_lds + (bf) * SHM_K + kws + 32 * 256) = S.st_k1; } while (0)
#define SWRITE_HV(bf) do { *(bf16x8*)(V_lds + (bf) * SHM_V + vst0) = S.st_v0; *(bf16x8*)(V_lds + (bf) * SHM_V + vst1) = S.st_v1; } while (0)
#define SWRITE_H(bf) do { SWRITE_HV(bf); SWRITE_HK(bf); } while (0)
#define SLOAD_F(p, k0) do { S.sf0 = *(const f32x4*)ROW(p, D, k0, sr); S.sf1 = *(const f32x4*)(ROW(p, D, k0, sr) + 4);                \
                            S.sf2 = *(const f32x4*)ROW(p, D, k0, 32 + sr); S.sf3 = *(const f32x4*)(ROW(p, D, k0, 32 + sr) + 4); } while (0)
#define SWRITE_KF(bf) do { *(bf16x8*)(K_lds + (bf) * SHM_K + kws) = pack8(S.sf0, S.sf1); *(bf16x8*)(K_lds + (bf) * SHM_K + kws + 32 * 256) = pack8(S.sf2, S.sf3); } while (0)
#define SWRITE_VF(bf) do { *(bf16x8*)(V_lds + (bf) * SHM_V + vst0) = pack8(S.sf0, S.sf1); *(bf16x8*)(V_lds + (bf) * SHM_V + vst1) = pack8(S.sf2, S.sf3); } while (0)
template <int BIAS, class TIn, class TOut>
__device__ __forceinline__ void causal_swa_prime(const BlockRef<TIn, TOut>& cur, char* lds, Seam<TIn>& S) {
    const int W = cur.W;
    constexpr bool F32 = same_t<TIn, float>::v;
    const int tid = threadIdx.x, wid = __builtin_amdgcn_readfirstlane(tid >> 6), lane = tid & 63, r32 = lane & 31, hi = lane >> 5;
    const int sr = tid >> 4, sc = (tid & 15) * 8, kws = KSWZ(sr, sc * 2); char* K_lds = lds + 2 * SHM_V;
    const int kb0 = swa_jlo(cur.P0, W) * KVBLK;
    if (BIAS == 1 || BIAS == 3) bias_fill((float*)(lds + LDS_TAB), cur.bsrc, tid);
    for (int d0 = 0; d0 < 8; ++d0) S.qr[d0] = load8<TIn>(cur.Q + (unsigned)((wid * QBLK + r32) * cur.pq + d0 * 16 + hi * 8));
    if constexpr (F32) { SLOAD_F((const float*)cur.K, kb0); VMW(); SWRITE_KF(0); SBAR(); SLOAD_F((const float*)cur.V, kb0); }
    else { SLOAD_H(cur.K, cur.V, cur.pk, kb0); VMW(); SWRITE_HK(0); }
    __syncthreads();
}
template <int BIAS, class TIn, class TOut, class ItemFn>
__device__ __forceinline__ void causal_swa_block(const BlockRef<TIn, TOut>& cur, int Lnext, const ItemFn& itemfn, int par, char* lds, Seam<TIn>& S) {
    const int skv = cur.skv, W = cur.W;
    const float* tab = (const float*)(lds + LDS_TAB) + par * TAB_PITCH;
    constexpr bool F32 = same_t<TIn, float>::v;
    const int tid = threadIdx.x, wid = __builtin_amdgcn_readfirstlane(tid >> 6), lane = tid & 63, r32 = lane & 31, hi = lane >> 5;
    const int j_lo = swa_jlo(cur.P0, W);
    int j_hi = (cur.P0 + QB - 1) / KVBLK + 1; if (j_hi > skv / KVBLK) j_hi = skv / KVBLK;
    const int NT = j_hi - j_lo;
    const int qlo = cur.P0 + wid * QBLK, qm = qlo + r32 - 4 * hi;
    char* V_lds = lds; char* K_lds = lds + 2 * SHM_V;
    float* ws = (float*)(lds + 2 * SHM_V + 2 * SHM_K) + wid * 64; float* li_l = ws, * al_l = ws + 32;
    float m_reg = -1e30f, l_reg = 0; f32x16 o[4] = {};
    const int sr = tid >> 4, sc = (tid & 15) * 8, vst0 = v_st(sr, sc), vst1 = v_st(32 + sr, sc), kws = KSWZ(sr, sc * 2);
    const int vb0 = (int)(uintptr_t)V_lds + v_rd_base(lane);
    const TIn* Kh = cur.K; const TIn* Vh = cur.V;
#define RESC(a) do { if (__any((a) < 1.f)) { if (hi == 0) al_l[r32] = (a); asm volatile("s_waitcnt lgkmcnt(0)" ::: "memory");              \
                     for (int d_ = 0; d_ < 4; ++d_) for (int r = 0; r < 16; ++r) o[d_][r] *= al_l[crow(r, hi)]; } } while (0)
#define KBASE(t) ((j_lo + (t)) * KVBLK)
#define ACT(t) (KBASE(t) <= qlo + QBLK - 1 && KBASE(t) + KVBLK - 1 >= qlo - W + 1)
#define MASKT(P0_, P1_, t) do { const int kb_ = KBASE(t); if constexpr (BIAS == 1 || BIAS == 2) { if (!SK || ACT(t)) bias_mask_tile(P0_, P1_, qm - kb_, (unsigned)W, tab, kb_ + KVBLK - 1 > qlo || kb_ <= qlo + QBLK - 1 - W); } \
        else { if ((!SK || ACT(t)) && (kb_ + KVBLK - 1 > qlo || kb_ <= qlo + QBLK - 1 - W)) mask_tile(P0_, P1_, qm - kb_, (unsigned)W); } } while (0)
    constexpr int NQL = F32 ? 16 : 8;
    constexpr bool SK = WSKIP && !F32;
#define SEAM_K0() do { VMWN(NQL); if constexpr (F32) { SWRITE_KF(0); SBAR(); SLOAD_F((const float*)nxt.V, kbn); } else { SWRITE_HK(0); } SBAR(); } while (0)
    f32x16 pA0, pA1, pB0, pB1; float mnA, mnB, alA, alB; bf16x8 pa0, pa1, pa2, pa3;
    if constexpr (F32) { VMW(); SWRITE_VF(0); SBAR(); } else { SWRITE_HV(0); SBAR(); }
    if (NT > 1) { if constexpr (F32) SLOAD_F((const float*)Kh, KBASE(1)); else SLOAD_H(Kh, Vh, cur.pk, KBASE(1)); }
    SBAR(); qkt<0, SK>(pA0, pA1, K_lds, r32, hi, S.qr, ACT(0));
    if constexpr (F32) { if (NT > 1) { VMW(); SWRITE_KF(1); SBAR(); SLOAD_F((const float*)Vh, KBASE(1)); } }
    MASKT(pA0, pA1, 0); partialSM(pA0, pA1, m_reg, mnA, alA);
    if (NT > 1) { VMW(); if constexpr (F32) { SWRITE_VF(1); SBAR(); if (NT > 2) SLOAD_F((const float*)Kh, KBASE(2)); } else SWRITE_H(1); }
    __syncthreads();
#define HALF_STEP(PX0, PX1, mnX, alX, PY0, PY1, alY, t, KB, VB, SB) do {                                                      \
        SBAR(); qkt<KB, SK>(PX0, PX1, K_lds, r32, hi, S.qr, ACT(t));                                             \
        finishSM(PY0, PY1, alY, l_reg, pa0, pa1, pa2, pa3); SBAR();                                                           \
        if ((t) + 1 < NT) { if constexpr (F32) { VMW(); SWRITE_KF(SB); SBAR(); SLOAD_F((const float*)Vh, KBASE((t) + 1)); }  \
                            else { SLOAD_H(Kh, Vh, cur.pk, KBASE((t) + 1)); } SBAR(); }                                               \
        pv_tile<VB, SK>(o, vb0, pa0, pa1, pa2, pa3, ACT((t) - 1)); MASKT(PX0, PX1, (t)); partialSM(PX0, PX1, m_reg, mnX, alX);                                        \
        __syncthreads();                                                                                                      \
        if ((t) + 1 < NT) { VMW(); if constexpr (F32) { SWRITE_VF(SB); SBAR(); if ((t) + 2 < NT) SLOAD_F((const float*)Kh, KBASE((t) + 2)); } \
                            else { SWRITE_H(SB); } }                                                                          \
        RESC(alX); __syncthreads(); } while (0)
    for (int t = 1; t + 1 < NT; t += 2) {
        HALF_STEP(pB0, pB1, mnB, alB, pA0, pA1, alA, t, 1, 0, 0);
        HALF_STEP(pA0, pA1, mnA, alA, pB0, pB1, alB, t + 1, 0, 1, 1);
    }
    asm volatile("" : "+s"(Lnext));
    const BlockRef<TIn, TOut> nxt = itemfn(Lnext); const int kbn = swa_jlo(nxt.P0, nxt.W) * KVBLK;
    const bool even = (NT & 1) == 0;
    if (even) { SBAR(); qkt<1, SK>(pB0, pB1, K_lds, r32, hi, S.qr, ACT(NT - 1)); SBAR(); }
#define QROW(e) (nxt.Q + (size_t)(wid * QBLK + r32) * D + ((e) >> 1) * 16 + hi * 8 + ((e) & 1) * 4)
    if constexpr (F32) { SLOAD_F((const float*)nxt.K, kbn); SBAR();
#pragma unroll
        for (int e = 0; e < 8; ++e) S.tq[e] = *(const f32x4*)QROW(e); }
    else { SLOAD_H(nxt.K, nxt.V, nxt.pk, kbn); SBAR();
#pragma unroll
        for (int d0 = 0; d0 < 8; ++d0) S.qr[d0] = load8<TIn>(nxt.Q + (unsigned)((wid * QBLK + r32) * nxt.pq + d0 * 16 + hi * 8)); }
    SBAR();
    finishSM(pA0, pA1, alA, l_reg, pa0, pa1, pa2, pa3); SBAR();
    if constexpr (F32) {
#pragma unroll
        for (int e = 8; e < 16; ++e) S.tq[e] = *(const f32x4*)QROW(e); SBAR(); }
#undef QROW
    pv_tile<0, SK>(o, vb0, pa0, pa1, pa2, pa3, ACT(even ? NT - 2 : NT - 1));
    if (even) { MASKT(pB0, pB1, NT - 1); partialSM(pB0, pB1, m_reg, mnB, alB); __syncthreads(); RESC(alB);
        finishSM(pB0, pB1, alB, l_reg, pa0, pa1, pa2, pa3); SBAR(); pv_tile<1, SK>(o, vb0, pa0, pa1, pa2, pa3, ACT(NT - 1)); }
    SBAR(); SEAM_K0();
    if (hi == 0) li_l[r32] = l_reg; asm volatile("s_waitcnt lgkmcnt(0)" ::: "memory");
    float rli[16];
#pragma unroll
    for (int r = 0; r < 16; ++r) rli[r] = __builtin_amdgcn_rcpf(li_l[crow(r, hi)]);
    TOut* Ow = cur.O + (unsigned)((wid * QBLK) * cur.po); const int po = cur.po;
    if constexpr (BIAS == 1 || BIAS == 3) { if (hi == 0) { f32x2 ml = {m_reg * (1.4426950408889634f * SCALE), l_reg}; *(f32x2*)(cur.L + (unsigned)((wid * QBLK + r32) * cur.pl)) = ml; }
                          bias_fill((float*)(lds + LDS_TAB) + (par ^ 1) * TAB_PITCH, nxt.bsrc, tid); }
#pragma unroll
    for (int r = 0; r < 16; ++r) { const int orow = crow(r, hi);
#pragma unroll
        for (int d0 = 0; d0 < 4; ++d0) { const float v = o[d0][r] * rli[r];
            if constexpr (same_t<TOut, float>::v) { Ow[(unsigned)(orow * po + d0 * 32 + r32)] = v; }
            else { const float vn = __shfl_xor(v, 1);
                   if ((r32 & 1) == 0) *(unsigned*)(Ow + (unsigned)(orow * po + d0 * 32 + r32)) = cvtpk(v, vn); } } }
    if constexpr (F32) {
#pragma unroll
        for (int d0 = 0; d0 < 8; ++d0) S.qr[d0] = pack8(S.tq[2 * d0], S.tq[2 * d0 + 1]); }
    __syncthreads();
#undef RESC
#undef KBASE
#undef ACT
#undef MASKT
#undef SEAM_K0
#undef HALF_STEP
}
#undef ROW
#undef VMW
#undef VMWN
#undef SLOAD_H
#undef SWRITE_HK
#undef SWRITE_HV
#undef SWRITE_H
#undef SLOAD_F
#undef SWRITE_KF
#undef SWRITE_VF

}
constexpr int NWAVES = 8;
#ifndef MK_N_LAUNCHES
#define MK_N_LAUNCHES 1
#endif
constexpr int NPH = 13;
constexpr int N_LAUNCHES = MK_N_LAUNCHES;
static_assert(N_LAUNCHES == 1 || N_LAUNCHES == NPH, "MK_N_LAUNCHES is 1 or 13");

#ifndef FFN_I8
#define FFN_I8 1
#endif
constexpr int NB = 4, SEQ = 4096, DM = 4096, M = NB * SEQ;
constexpr int MEMLEN = 256, MROWS = NB * MEMLEN;
constexpr int NIN = 12304, NPROJ = 12288;
constexpr int DFF = 11008, NGU = 2 * DFF;
constexpr int XW = 512;
constexpr float RMS_EPS = 1e-6f;

constexpr size_t MiB = 1u << 20;
constexpr size_t WS_CTL = 0, CTL_ZERO_BYTES = 1 * MiB;
constexpr size_t WS_BT = 1 * MiB;
constexpr size_t WS_Q0K0 = 1 * MiB + 64 * 1024;
constexpr size_t WS_RSC1 = 1 * MiB + 128 * 1024;
constexpr size_t WS_XNQ = 780 * MiB;
constexpr size_t WS_WINQ = 2 * MiB + (size_t)6144 * 4096 * 2;
constexpr size_t WS_WIN = 2 * MiB;
constexpr size_t WS_WLR = 98 * MiB;
constexpr size_t WS_WOUT = 99 * MiB;
constexpr size_t WS_WXQ = 131 * MiB;
constexpr size_t WS_WXKV = 135 * MiB;
constexpr size_t WS_WXO = 143 * MiB;
constexpr size_t WS_MEMN = 147 * MiB;
constexpr size_t WS_XKV = 155 * MiB;
constexpr size_t WS_WGU = 160 * MiB;
constexpr size_t WS_WDN = 332 * MiB;
constexpr size_t WS_DQKV = 160 * MiB;
constexpr size_t WS_GK = 352 * MiB;
constexpr size_t WS_GQ = 384 * MiB;
constexpr size_t WS_XN = 418 * MiB;
constexpr size_t WS_MIX = 546 * MiB;
constexpr size_t WS_GV = 546 * MiB;
constexpr size_t WS_VT = 610 * MiB;
constexpr size_t WS_GR = 674 * MiB;
constexpr size_t WS_KET = 738 * MiB;
constexpr size_t WS_ATT = 770 * MiB;
constexpr size_t WS_DEC = 778 * MiB;
constexpr size_t WS_OC = 780 * MiB;
constexpr size_t WS_LSE = 972 * MiB;
constexpr size_t WS_ACT = 546 * MiB;
constexpr size_t WS_HALO = 890 * MiB;
constexpr size_t WS_XQ = 980 * MiB;
constexpr size_t WS_XO = 996 * MiB;
constexpr size_t WS_GQ2 = 1012 * MiB;
constexpr size_t WS_H2Q = 980 * MiB;
constexpr size_t WS_END = 1044 * MiB;
constexpr size_t HALO_ONE = (size_t)256 * 2 * DFF * 4;
static_assert(WS_HALO + 3 * HALO_ONE <= WS_XQ && WS_ACT + (size_t)M * DFF * 2 <= WS_HALO && WS_WDN + (size_t)DM * DFF * 2 <= WS_XN && WS_WGU + (size_t)NGU * DM * 2 <= WS_WDN, "d_ws map");
static_assert(WS_OC + (size_t)3 * M * 2048 * 2 <= WS_LSE && WS_LSE + (size_t)3 * M * 16 * 2 * 4 <= WS_XQ && WS_GQ + (size_t)M * 1024 * 2 <= WS_XN, "d_ws map 2");
constexpr int CW_QUEUE = 2048;
constexpr int CW_BAR = 4096;
constexpr size_t CTL_COLMAX = 704 * 1024;
constexpr size_t CTL_CMAX1 = 864 * 1024;
constexpr size_t CTL_AMAX = 800 * 1024;
constexpr size_t CTL_SS = 256 * 1024;

constexpr int LDS_BYTES = 147456;
constexpr int MISC_OFF = LDS_BYTES - 256;

#define GAS __attribute__((address_space(1)))
#define LAS __attribute__((address_space(3)))
typedef unsigned short bf16;
typedef unsigned v4u __attribute__((ext_vector_type(4)));
typedef unsigned v2u __attribute__((ext_vector_type(2)));
typedef float f32x4 __attribute__((ext_vector_type(4)));
typedef float f32x2 __attribute__((ext_vector_type(2)));
typedef float f32x16 __attribute__((ext_vector_type(16)));
typedef short bf16x8 __attribute__((ext_vector_type(8)));
typedef short s16x4 __attribute__((ext_vector_type(4)));
typedef short v4i16_t __attribute__((ext_vector_type(4)));
typedef GAS unsigned gu32;
#define RLX_AGENT __ATOMIC_RELAXED, __HIP_MEMORY_SCOPE_AGENT
#define LDS_WAIT() asm volatile("s_waitcnt lgkmcnt(0)" ::: "memory")
#define VM_WAIT() asm volatile("s_waitcnt vmcnt(0)" ::: "memory")
__device__ __forceinline__ unsigned f2bf(float f) { unsigned u = __builtin_bit_cast(unsigned, f); return (u + 0x7fffu + ((u >> 16) & 1u)) >> 16; }
__device__ __forceinline__ unsigned pk2(float lo, float hi) { return f2bf(lo) | (f2bf(hi) << 16); }
__device__ __forceinline__ float bf2f(unsigned short b) { return __builtin_bit_cast(float, (unsigned)b << 16); }
__device__ __forceinline__ float bflo(unsigned w) { return __builtin_bit_cast(float, w << 16); }
__device__ __forceinline__ float bfhi(unsigned w) { return __builtin_bit_cast(float, w & 0xffff0000u); }
typedef __bf16 bf16x2_t __attribute__((ext_vector_type(2)));
__device__ __forceinline__ unsigned cvtpk_s(float lo, float hi) { f32x2 v = {lo, hi}; bf16x2_t b = __builtin_convertvector(v, bf16x2_t); return __builtin_bit_cast(unsigned, b); }
__device__ __forceinline__ bf16x8 pack8f(float a0, float a1, float a2, float a3, float a4, float a5, float a6, float a7) {
    v4u w = {cvtpk_s(a0, a1), cvtpk_s(a2, a3), cvtpk_s(a4, a5), cvtpk_s(a6, a7)}; return __builtin_bit_cast(bf16x8, w); }
#define XB_TMO      128
#define XB_XCNT(j)  (256  + 64 * (j))
#define XB_XSUB(j)  (1280 + 64 * (j))
#define XB_XGEN(j)  (2304 + 64 * (j))
#define XB_TOP      3328
#define XB_TOPGEN   3392
#define XCD_BAR_WORDS 3456
#define XB_SPIN_CAP (1u << 18)

__device__ __forceinline__ unsigned xb_ld(unsigned* p)              { return __hip_atomic_load(p, __ATOMIC_RELAXED, __HIP_MEMORY_SCOPE_AGENT); }
__device__ __forceinline__ unsigned xb_add(unsigned* p, unsigned v) { return __hip_atomic_fetch_add(p, v, __ATOMIC_RELAXED, __HIP_MEMORY_SCOPE_AGENT); }
__device__ __forceinline__ unsigned xb_xcc_id() { return (unsigned)__builtin_amdgcn_s_getreg((3 << 11) | 20) & 0xFu; }
#define XB_SPIN(cond, bar) do { unsigned _sp = 0; while (cond) { __builtin_amdgcn_s_sleep(1); \
    if ((++_sp & 255u) == 0u) { if (xb_ld(&(bar)[XB_TMO])) break; if (_sp > XB_SPIN_CAP) { atomicAdd(&(bar)[XB_TMO], 1u); break; } } } } while (0)

struct XcdBarrier {
    unsigned* bar; unsigned x;
    volatile LAS unsigned* st;
};

__device__ __forceinline__ XcdBarrier xcd_barrier_post(unsigned* bar, volatile LAS unsigned* st) {
    XcdBarrier b; b.bar = bar; b.x = xb_xcc_id(); b.st = st;
    if (threadIdx.x == 0) (void)xb_add(&bar[XB_XCNT(b.x)], 1u);
    return b;
}
__device__ __forceinline__ void xcd_barrier_complete(unsigned* bar, unsigned x, unsigned& nloc, unsigned& nx) {
    const unsigned G = gridDim.x * gridDim.y * gridDim.z;
    unsigned sum, cnt, mine, sp = 0u;
    for (;;) {
        sum = 0u; cnt = 0u; mine = 0u;
#pragma unroll
        for (unsigned j = 0; j < 16; ++j) { const unsigned c = xb_ld(&bar[XB_XCNT(j)]); sum += c; cnt += (c > 0u) ? 1u : 0u; mine = (j == x) ? c : mine; }
        if (sum == G) break;
        __builtin_amdgcn_s_sleep(1);
        if ((++sp & 255u) == 0u) { if (xb_ld(&bar[XB_TMO])) break; if (sp > XB_SPIN_CAP) { atomicAdd(&bar[XB_TMO], 1u); break; } }
    }
    nloc = mine > 0u ? mine : 1u; nx = cnt > 0u ? cnt : 1u;
}

__device__ __forceinline__ void xcd_barrier(const XcdBarrier& b) {
    asm volatile("s_waitcnt vmcnt(0)" ::: "memory");
    __syncthreads();
    if (threadIdx.x == 0) {
        unsigned* bar = b.bar;
        __builtin_amdgcn_s_waitcnt(0);
        unsigned nloc = b.st[0], nx = b.st[1];
        if (nloc == 0u) { xcd_barrier_complete(bar, b.x, nloc, nx); b.st[0] = nloc; b.st[1] = nx; }
        const unsigned old = xb_add(&bar[XB_XSUB(b.x)], 1u);
        const unsigned gen = old / nloc;
        if (old + 1u == (gen + 1u) * nloc) {
            __builtin_amdgcn_fence(__ATOMIC_RELEASE, "agent");
            asm volatile("s_waitcnt vmcnt(0)" ::: "memory");
            const unsigned og = xb_add(&bar[XB_TOP], 1u);
            const unsigned tg = og / nx;
            if (og + 1u == (tg + 1u) * nx) xb_add(&bar[XB_TOPGEN], 1u);
            else XB_SPIN(xb_ld(&bar[XB_TOPGEN]) == tg, bar);
            __builtin_amdgcn_fence(__ATOMIC_ACQUIRE, "agent");
            xb_add(&bar[XB_XGEN(b.x)], 1u);
            asm volatile("s_waitcnt vmcnt(0)" ::: "memory");
        } else {
            XB_SPIN(xb_ld(&bar[XB_XGEN(b.x)]) == gen, bar);
            __builtin_amdgcn_fence(__ATOMIC_ACQUIRE, "agent");
            asm volatile("s_waitcnt vmcnt(0)" ::: "memory");
        }
    }
    __syncthreads();
}
struct Frame {
    LAS unsigned char* lds; char* ldsg;
    volatile LAS unsigned* MISC;
    gu32* ctl;
    int wave, vcu, G;
    unsigned char* ws;
    const float* const __attribute__((address_space(4)))* kin;
    float* out;
};
__device__ __forceinline__ int tid_now() { int t = (int)threadIdx.x; asm volatile("" : "+v"(t)); return t; }
__device__ __forceinline__ float wave_sum(float v) {
#pragma unroll
    for (int o = 1; o < 64; o <<= 1) v += __shfl_xor(v, o);
    return v;
}
__device__ const unsigned char kBucket[3][132] = {
 {0,1,2,3,4,5,6,7,8,9,10,11,12,13,14,15,16,16,16,16,16,16,17,17,17,17,17,17,17,17,18,18,18,18,18,18,18,18,18,18,19,19,19,19,19,19,19,19,19,19,19,19,19,19,20,20,20,20,20,20,20,20,20,20,20,20,20,20,20,20,20,20,20,21,21,21,21,21,21,21,21,21,21,21,21,21,21,21,21,21,21,21,21,21,21,21,21,21,21,22,22,22,22,22,22,22,22,22,22,22,22,22,22,22,22,22,22,22,22,22,22,22,22,22,22,22,22,22,22,0,0,0},
 {0,4,8,12,16,16,17,17,18,18,19,19,19,19,20,20,20,20,20,21,21,21,21,21,21,22,22,22,22,22,22,22,22,22,23,23,23,23,23,23,23,23,23,23,23,23,24,24,24,24,24,24,24,24,24,24,24,24,24,24,24,24,25,25,25,25,25,25,25,25,25,25,25,25,25,25,25,25,25,25,25,25,25,26,26,26,26,26,26,26,26,26,26,26,26,26,26,26,26,26,26,26,26,26,26,26,26,26,26,26,26,26,26,27,27,27,27,27,27,27,27,27,27,27,27,27,27,27,27,0,0,0},
 {0,16,18,19,20,21,21,22,22,23,23,23,24,24,24,24,25,25,25,25,25,26,26,26,26,26,26,26,26,27,27,27,27,27,27,27,27,27,27,28,28,28,28,28,28,28,28,28,28,28,28,28,29,29,29,29,29,29,29,29,29,29,29,29,29,29,29,29,29,29,30,30,30,30,30,30,30,30,30,30,30,30,30,30,30,30,30,30,30,30,30,30,30,30,30,31,31,31,31,31,31,31,31,31,31,31,31,31,31,31,31,31,31,31,31,31,31,31,31,31,31,31,31,31,31,31,31,31,31,0,0,0}};

constexpr int TR_SCR = 17408;
__device__ __forceinline__ void tr_item(const float* W, int ldw, bf16* WT, int ldt, int src_c0, int dst_r0, int nvalid, const float* gain, LAS float* scr, int kb, int lane) {
    const int k0 = 64 * kb, a = lane >> 4, c4 = 4 * (lane & 15);
#pragma unroll 8
    for (int i = 0; i < 16; ++i) { const int kk = 4 * i + a; f32x4 v = *(const GAS f32x4*)(W + (size_t)(k0 + kk) * ldw + src_c0 + c4); if (gain) v = v * gain[k0 + kk];
        LAS float* d = scr + kk * 65 + c4; d[0] = v.x; d[1] = v.y; d[2] = v.z; d[3] = v.w; }
    LDS_WAIT(); asm volatile("" ::: "memory");
    const int c = lane & 7;
#pragma unroll
    for (int j = 0; j < 8; ++j) { const int n = (lane >> 3) + 8 * j; const LAS float* s = scr + (8 * c) * 65 + n;
        v4u o; o.x = pk2(s[0 * 65], s[1 * 65]); o.y = pk2(s[2 * 65], s[3 * 65]); o.z = pk2(s[4 * 65], s[5 * 65]); o.w = pk2(s[6 * 65], s[7 * 65]);
        if (n < nvalid) *(GAS v4u*)(WT + (size_t)(dst_r0 + n) * ldt + k0 + 8 * c) = o; }
    LDS_WAIT(); asm volatile("" ::: "memory");
}
constexpr float CM_WIDEN = 1.0f;
__device__ __forceinline__ void absmax_item(const float* W, int ldw, int src_c0, const float* gain, unsigned* cmax, int kb, int lane) {
    const int k0 = 64 * kb, a = lane >> 4, c4 = 4 * (lane & 15);
    f32x4 m = {0.f, 0.f, 0.f, 0.f};
#pragma unroll 8
    for (int i = 0; i < 16; ++i) { const int kk = 4 * i + a; const f32x4 v = *(const GAS f32x4*)(W + (size_t)(k0 + kk) * ldw + src_c0 + c4) * (gain ? gain[k0 + kk] : 1.0f);
        m.x = fmaxf(m.x, fabsf(v.x)); m.y = fmaxf(m.y, fabsf(v.y)); m.z = fmaxf(m.z, fabsf(v.z)); m.w = fmaxf(m.w, fabsf(v.w)); }
#pragma unroll
    for (int o = 16; o < 64; o <<= 1) { m.x = fmaxf(m.x, __shfl_xor(m.x, o)); m.y = fmaxf(m.y, __shfl_xor(m.y, o)); m.z = fmaxf(m.z, __shfl_xor(m.z, o)); m.w = fmaxf(m.w, __shfl_xor(m.w, o)); }
    if (lane < 16) { unsigned* p = cmax + c4;   atomicMax(p, __float_as_uint(m.x)); atomicMax(p + 1, __float_as_uint(m.y)); atomicMax(p + 2, __float_as_uint(m.z)); atomicMax(p + 3, __float_as_uint(m.w)); }
}
__device__ __forceinline__ void quant_item(const float* W, int ldw, signed char* WQ, int ldq, int src_c0, int dst_r0, const float* gain, const unsigned* cmax, LAS float* scr, int kb, int lane) {
    const int k0 = 64 * kb, a = lane >> 4, c4 = 4 * (lane & 15);
#pragma unroll 8
    for (int i = 0; i < 16; ++i) { const int kk = 4 * i + a; const f32x4 v = *(const GAS f32x4*)(W + (size_t)(k0 + kk) * ldw + src_c0 + c4) * (gain ? gain[k0 + kk] : 1.0f);
        LAS float* d = scr + kk * 65 + c4; d[0] = v.x; d[1] = v.y; d[2] = v.z; d[3] = v.w; }
    LDS_WAIT(); asm volatile("" ::: "memory");
    const int c = lane & 3;
#pragma unroll
    for (int j = 0; j < 4; ++j) { const int n = (lane >> 2) + 16 * j; const LAS float* s = scr + (16 * c) * 65 + n;
        const float cm = __uint_as_float(cmax[n]) * CM_WIDEN; const float inv = cm > 0.f ? 127.0f / cm : 0.f;
        unsigned wq[4];
#pragma unroll
        for (int q = 0; q < 4; ++q) { unsigned acc = 0u;
#pragma unroll
            for (int e = 0; e < 4; ++e) { const float r = fminf(fmaxf(__builtin_rintf(s[(4 * q + e) * 65] * inv), -127.f), 127.f); acc |= ((unsigned)(int)r & 0xffu) << (8 * e); }
            wq[q] = acc; }
        v4u o = {wq[0], wq[1], wq[2], wq[3]};
        *(GAS v4u*)(WQ + (size_t)(dst_r0 + n) * ldq + k0 + 16 * c) = o; }
    LDS_WAIT(); asm volatile("" ::: "memory");
}

__device__ __forceinline__ void rms_row_to_bf16(const float* xrow, const float* g, bf16* orow, int lane, signed char* qrow = nullptr, float* qscale = nullptr) {
    const GAS f32x4* xr = (const GAS f32x4*)xrow + lane; const GAS f32x4* gr = (const GAS f32x4*)g + lane;
    f32x4 v[16]; float s = 0.f;
#pragma unroll
    for (int j = 0; j < 16; ++j) { v[j] = xr[64 * j]; s += (v[j].x * v[j].x + v[j].y * v[j].y) + (v[j].z * v[j].z + v[j].w * v[j].w); }
    const float r = 1.0f / sqrtf(wave_sum(s) * (1.0f / 4096.0f) + RMS_EPS);
    GAS v2u* o8 = (GAS v2u*)orow + lane; float mx = 0.f;
#pragma unroll
    for (int j = 0; j < 16; ++j) { const f32x4 gg = gr[64 * j]; v[j] = (f32x4){v[j].x * r * gg.x, v[j].y * r * gg.y, v[j].z * r * gg.z, v[j].w * r * gg.w};
        v2u o; o.x = pk2(v[j].x, v[j].y); o.y = pk2(v[j].z, v[j].w); o8[64 * j] = o;
        mx = fmaxf(mx, fmaxf(fmaxf(fabsf(v[j].x), fabsf(v[j].y)), fmaxf(fabsf(v[j].z), fabsf(v[j].w)))); }
    if (qrow) {
#pragma unroll
        for (int o = 1; o < 64; o <<= 1) mx = fmaxf(mx, __shfl_xor(mx, o));
        const float inv = mx > 0.f ? 127.0f / mx : 0.f; GAS unsigned* q4 = (GAS unsigned*)qrow + lane;
#pragma unroll
        for (int j = 0; j < 16; ++j) { const int a = (int)__builtin_rintf(v[j].x * inv), b = (int)__builtin_rintf(v[j].y * inv), c = (int)__builtin_rintf(v[j].z * inv), d = (int)__builtin_rintf(v[j].w * inv);
            q4[64 * j] = ((unsigned)a & 0xffu) | (((unsigned)b & 0xffu) << 8) | (((unsigned)c & 0xffu) << 16) | (((unsigned)d & 0xffu) << 24); }
        if (lane == 0) *qscale = mx * (1.0f / 127.0f);
    }
}

__device__ __forceinline__ void p0_first_token(Frame& F) {
    const int tid = tid_now(), lane = tid & 63, w = F.wave;
    LAS float* red = (LAS float*)F.lds;
    const float* x = F.kin[0]; const float* g = F.kin[3]; const float* W = F.kin[4];
    float* Q0K0 = (float*)(F.ws + WS_Q0K0);
    for (int cb = blockIdx.x; cb < 256; cb += F.G) {
        float xv[4][8]; float gg[8]; f32x4 w0[8], w1[8];
#pragma unroll
        for (int i = 0; i < 8; ++i) { gg[i] = g[tid + 512 * i]; const GAS f32x4* wp = (const GAS f32x4*)(W + (size_t)(tid + 512 * i) * NIN + 8 * cb); w0[i] = wp[0]; w1[i] = wp[1];
#pragma unroll
            for (int b = 0; b < 4; ++b) xv[b][i] = x[(size_t)b * SEQ * DM + tid + 512 * i]; }
        float acc[4][8], ss[4];
#pragma unroll
        for (int b = 0; b < 4; ++b) { ss[b] = 0.f;
#pragma unroll
            for (int c = 0; c < 8; ++c) acc[b][c] = 0.f; }
#pragma unroll
        for (int i = 0; i < 8; ++i) { const float wv[8] = {w0[i].x, w0[i].y, w0[i].z, w0[i].w, w1[i].x, w1[i].y, w1[i].z, w1[i].w};
#pragma unroll
            for (int b = 0; b < 4; ++b) { ss[b] += xv[b][i] * xv[b][i]; const float xg = xv[b][i] * gg[i];
#pragma unroll
                for (int c = 0; c < 8; ++c) acc[b][c] += xg * wv[c]; } }
#pragma unroll
        for (int b = 0; b < 4; ++b) { const float s2 = wave_sum(ss[b]); if (lane == 0) red[w * 40 + 32 + b] = s2;
#pragma unroll
            for (int c = 0; c < 8; ++c) { const float s = wave_sum(acc[b][c]); if (lane == 0) red[w * 40 + b * 8 + c] = s; } }
        __syncthreads();
        if (tid < 32) { float s = 0.f, q = 0.f;
#pragma unroll
            for (int k = 0; k < 8; ++k) { s += red[k * 40 + tid]; q += red[k * 40 + 32 + (tid >> 3)]; }
            Q0K0[(tid >> 3) * 2048 + 8 * cb + (tid & 7)] = s * (1.0f / sqrtf(q * (1.0f / 4096.0f) + RMS_EPS)); }
        __syncthreads();
    }
}
__device__ __forceinline__ void p0_prologue(Frame& F) {
    const int tid = tid_now(), lane = tid & 63;
    LAS float* scr = (LAS float*)(F.lds + F.wave * TR_SCR);
    const int gw = F.vcu * NWAVES + F.wave, NGW = F.G * NWAVES;
    bf16* Win = (bf16*)(F.ws + WS_WIN); bf16* Wlr = (bf16*)(F.ws + WS_WLR); bf16* Wout = (bf16*)(F.ws + WS_WOUT); bf16* Wxq = (bf16*)(F.ws + WS_WXQ); bf16* Wxkv = (bf16*)(F.ws + WS_WXKV); bf16* Wxo = (bf16*)(F.ws + WS_WXO);
    constexpr int I_INA = 64 * (4096 / 64), I_INB = 64 * (2048 / 64), I_INQ = 64 * (6144 / 64), I_LR = 64, I_OUT = 64 * 64, I_XQ = 64 * 8, I_XO = 8 * 64;
    constexpr int NIT = I_INA + I_INB + I_INQ + I_LR + I_OUT + 3 * I_XQ + I_XO;
    unsigned* cmax1 = (unsigned*)(F.ws + WS_CTL + CTL_CMAX1);
    for (int it = gw; it < NIT; it += NGW) {
        int r = it;
        if (r < I_INA) { const int nb = r % 64, kb = r / 64; tr_item(F.kin[4], NIN, Win, DM, 64 * nb, 64 * nb, 64, nullptr, scr, kb, lane); continue; } r -= I_INA;
        if (r < I_INB) { const int nb = r % 32, kb = r / 32; tr_item(F.kin[4], NIN, Win, DM, 4112 + 64 * nb, 4096 + 64 * nb, 64, nullptr, scr, kb, lane); continue; } r -= I_INB;
        if (r < I_INQ) { const int nb = r % 96, kb = r / 96; absmax_item(F.kin[4], NIN, 6160 + 64 * nb, nullptr, cmax1 + 64 * nb, kb, lane); continue; } r -= I_INQ;
        if (r < I_LR) { tr_item(F.kin[4], NIN, Wlr, DM, 4096, 0, 16, nullptr, scr, r, lane); continue; } r -= I_LR;
        if (r < I_OUT) { const int nb = r % 64, kb = r / 64; tr_item(F.kin[8], DM, Wout, DM, 64 * nb, 64 * nb, 64, nullptr, scr, kb, lane); continue; } r -= I_OUT;
        if (r < I_XQ) { const int nb = r % 8, kb = r / 8; tr_item(F.kin[11], XW, Wxq, DM, 64 * nb, 64 * nb, 64, F.kin[9], scr, kb, lane); continue; } r -= I_XQ;
        if (r < I_XQ) { const int nb = r % 8, kb = r / 8; tr_item(F.kin[12], XW, Wxkv, DM, 64 * nb, 64 * nb, 64, nullptr, scr, kb, lane); continue; } r -= I_XQ;
        if (r < I_XQ) { const int nb = r % 8, kb = r / 8; tr_item(F.kin[13], XW, Wxkv, DM, 64 * nb, 512 + 64 * nb, 64, nullptr, scr, kb, lane); continue; } r -= I_XQ;
        { const int nb = r % 64, kb = r / 64; tr_item(F.kin[14], DM, Wxo, XW, 64 * nb, 64 * nb, 64, nullptr, scr, kb, lane); }
    }
    bf16* XN = (bf16*)(F.ws + WS_XN); bf16* MEMN = (bf16*)(F.ws + WS_MEMN);
    for (int m = gw; m < M + MROWS; m += NGW) {
        if (m < M) rms_row_to_bf16(F.kin[0] + (size_t)m * DM, F.kin[3], XN + (size_t)m * DM, lane, (signed char*)(F.ws + WS_XNQ) + (size_t)m * DM, (float*)(F.ws + WS_RSC1) + m);
        else rms_row_to_bf16(F.kin[1] + (size_t)(m - M) * DM, F.kin[10], MEMN + (size_t)(m - M) * DM, lane);
    }
    float* BT = (float*)(F.ws + WS_BT);
    for (int i = blockIdx.x * 512 + tid; i < 3 * 16 * 132; i += F.G * 512) { const int rel = i % 132, h = (i / 132) % 16, cfg = i / (132 * 16);
        BT[i] = rel < 129 ? F.kin[2][kBucket[cfg][rel] * 16 + h] * 11.313708498984761f : 0.f; }
}
constexpr int FW_IG = 64 * (DFF / 64), FW_ID = (DFF / 64) * 64, FW_ALL = 2 * FW_IG + FW_ID;
constexpr int FW_P6_LO = 2 * FW_IG - 3584, FW_P6_HI = 2 * FW_IG;
constexpr int FW_P9_LO = FW_ALL - (FFN_I8 ? 4608 : 8192), FW_P9_HI = FW_ALL;
template <int MODE  >
__device__ __forceinline__ void ffn_weight_item(Frame& F, int r, LAS float* scr, int lane) {
    bf16* Wgu = (bf16*)(F.ws + WS_WGU); bf16* Wdn = (bf16*)(F.ws + WS_WDN); unsigned* cmax = (unsigned*)(F.ws + WS_CTL + CTL_COLMAX);
    if (r < 2 * FW_IG) { const int up = r >= FW_IG ? 1 : 0; const int rr = r - up * FW_IG; const int nb = rr % 172, kb = rr / 172, c0 = 64 * nb; const float* W = up ? F.kin[17] : F.kin[16];
        const int drow = 256 * (c0 >> 7) + 128 * up + (c0 & 127);
        if constexpr (MODE == 1) absmax_item(W, DFF, c0, F.kin[15], cmax + up * DFF + c0, kb, lane);
        else if constexpr (FFN_I8) quant_item(W, DFF, (signed char*)Wgu, DM, c0, drow, F.kin[15], cmax + up * DFF + c0, scr, kb, lane);
        else tr_item(W, DFF, Wgu, DM, c0, drow, 64, F.kin[15], scr, kb, lane);
        return; }
    if constexpr (MODE == 0) { r -= 2 * FW_IG; const int nb = r % 64, kb = r / 64; tr_item(F.kin[20], DM, Wdn, DFF, 64 * nb, 64 * nb, 64, nullptr, scr, kb, lane); }
}
template <int MODE> __device__ __forceinline__ void ffn_weights(Frame& F, int lo, int hi, int iw, int nw) {
    const int lane = tid_now() & 63; LAS float* scr = (LAS float*)(F.lds + F.wave * TR_SCR);
    for (int it = lo + iw; it < hi; it += nw) ffn_weight_item<MODE>(F, it, scr, lane);
}

__device__ __forceinline__ void p0_quant_win(Frame& F) {
    const int lane = tid_now() & 63; LAS float* scr = (LAS float*)(F.lds + F.wave * TR_SCR);
    const int gw = F.vcu * NWAVES + F.wave, NGW = F.G * NWAVES;
    const unsigned* cmax1 = (const unsigned*)(F.ws + WS_CTL + CTL_CMAX1);
    for (int r = gw; r < 64 * 96; r += NGW) { const int nb = r % 96, kb = r / 96;
        quant_item(F.kin[4], NIN, (signed char*)(F.ws + WS_WINQ), DM, 6160 + 64 * nb, 64 * nb, nullptr, cmax1 + 64 * nb, scr, kb, lane); }
}
constexpr int PP = 520;
constexpr int PREP_GLR = 0, PREP_QM = 8192, PREP_KM = 8192 + 64 * PP * 2;
static_assert(PREP_KM + 64 * PP * 2 <= MISC_OFF, "prep LDS");
__device__ __forceinline__ void gla_prep_unit(Frame& F, int b, int n) {
    const int tid = tid_now(), lane = tid & 63, w = F.wave;
    const int t0 = b * SEQ + 64 * n;
    const bf16* XN = (const bf16*)(F.ws + WS_XN); const bf16* Wlr = (const bf16*)(F.ws + WS_WLR);
    const bf16* GQ = (const bf16*)(F.ws + WS_GQ); bf16* GQ2 = (bf16*)(F.ws + WS_GQ2); const bf16* GK = (const bf16*)(F.ws + WS_GK);
    bf16* KET = (bf16*)(F.ws + WS_KET); bf16* ATT = (bf16*)(F.ws + WS_ATT); float* DEC = (float*)(F.ws + WS_DEC);
    LAS float* glr = (LAS float*)(F.lds + PREP_GLR);
    LAS bf16* QMs = (LAS bf16*)(F.lds + PREP_QM); LAS bf16* KMs = (LAS bf16*)(F.lds + PREP_KM);
    {
        const int rg = w & 3, kh = w >> 2, rr = lane & 15, kg = lane >> 4;
        const bf16* ap = XN + (size_t)(t0 + 16 * rg + rr) * DM + kh * 2048 + 8 * kg; const bf16* bp = Wlr + (size_t)rr * DM + kh * 2048 + 8 * kg;
        f32x4 acc = {0.f, 0.f, 0.f, 0.f};
#pragma unroll 8
        for (int s = 0; s < 64; ++s) { const bf16x8 a = *(const GAS bf16x8*)(ap + 32 * s), bq = *(const GAS bf16x8*)(bp + 32 * s); acc = __builtin_amdgcn_mfma_f32_16x16x32_bf16(a, bq, acc, 0, 0, 0); }
#pragma unroll
        for (int i = 0; i < 4; ++i) glr[(kh * 64 + 16 * rg + 4 * kg + i) * 16 + rr] = acc[i];
    }
    __syncthreads();
    for (int i = tid; i < 1024; i += 512) glr[i] += glr[1024 + i];
    __syncthreads();
    const int cid = (b * 64 + n) * 4;
    for (int hp = 0; hp < 2; ++hp) {
        {
            const int col = hp * 512 + tid, h = col >> 8, dk = col & 255;
            float w2[16];
#pragma unroll
            for (int j = 0; j < 16; ++j) w2[j] = F.kin[5][j * 1024 + col];
            const float bg = F.kin[6][col];
            float bc[64]; float run = 0.f;
#pragma unroll
            for (int c = 0; c < 64; ++c) {
                const LAS f32x4* gp = (const LAS f32x4*)(glr + c * 16); const f32x4 g0 = gp[0], g1 = gp[1], g2 = gp[2], g3 = gp[3];
                float z = bg;
                z += g0.x * w2[0] + g0.y * w2[1] + g0.z * w2[2] + g0.w * w2[3]; z += g1.x * w2[4] + g1.y * w2[5] + g1.z * w2[6] + g1.w * w2[7];
                z += g2.x * w2[8] + g2.y * w2[9] + g2.z * w2[10] + g2.w * w2[11]; z += g3.x * w2[12] + g3.y * w2[13] + g3.z * w2[14] + g3.w * w2[15];
                const float ls = fminf(z, 0.f) - __logf(1.0f + __expf(-fabsf(z)));
                run += ls * (1.0f / 16.0f); bc[c] = run;
            }
            const float blast = bc[63], bmid = bc[32];
            unsigned kep[32];
            const bf16* qp = GQ + (size_t)t0 * 1024 + col; bf16* qo = GQ2 + (size_t)t0 * 1024 + col; const bf16* kp = GK + (size_t)t0 * 1024 + col;
#pragma unroll
            for (int c2 = 0; c2 < 32; ++c2) {
                const int c = 2 * c2;
                const float qa = bf2f(qp[(size_t)c * 1024]) * (1.0f / 16.0f), ka = bf2f(kp[(size_t)c * 1024]);
                const float qb = bf2f(qp[(size_t)(c + 1) * 1024]) * (1.0f / 16.0f), kb = bf2f(kp[(size_t)(c + 1) * 1024]);
                const unsigned qt = cvtpk_s(qa * __expf(bc[c]), qb * __expf(bc[c + 1]));
                qo[(size_t)c * 1024] = (bf16)(qt & 0xffffu); qo[(size_t)(c + 1) * 1024] = (bf16)(qt >> 16);
                kep[c2] = cvtpk_s(ka * __expf(blast - bc[c]), kb * __expf(blast - bc[c + 1]));
                const unsigned qm = cvtpk_s(qa * __expf(bc[c] - bmid), qb * __expf(bc[c + 1] - bmid));
                const unsigned km = cvtpk_s(ka * __expf(bmid - bc[c]), kb * __expf(bmid - bc[c + 1]));
                QMs[c * PP + tid] = (bf16)(qm & 0xffffu); QMs[(c + 1) * PP + tid] = (bf16)(qm >> 16);
                KMs[c * PP + tid] = (bf16)(km & 0xffffu); KMs[(c + 1) * PP + tid] = (bf16)(km >> 16);
            }
            bf16* kt = KET + ((size_t)(cid + h) * 256 + dk) * 64;
#pragma unroll
            for (int i = 0; i < 8; ++i) { v4u o = {kep[4 * i], kep[4 * i + 1], kep[4 * i + 2], kep[4 * i + 3]}; *(GAS v4u*)(kt + 8 * i) = o; }
            DEC[(size_t)(cid + h) * 256 + dk] = __expf(blast);
        }
        __syncthreads();
        {
            const int rr = lane & 15, kg = lane >> 4;
#pragma unroll
            for (int q4 = 0; q4 < 4; ++q4) {
                const int id = w * 4 + q4, hl = id >> 4, mt = (id >> 2) & 3, nt = id & 3;
                const LAS bf16* ap = KMs + (16 * mt + rr) * PP + hl * 256 + 8 * kg; const LAS bf16* bp = QMs + (16 * nt + rr) * PP + hl * 256 + 8 * kg;
                f32x4 acc = {0.f, 0.f, 0.f, 0.f};
#pragma unroll
                for (int s = 0; s < 8; ++s) { const bf16x8 a = *(const LAS bf16x8*)(ap + 32 * s), bq = *(const LAS bf16x8*)(bp + 32 * s); acc = __builtin_amdgcn_mfma_f32_16x16x32_bf16(a, bq, acc, 0, 0, 0); }
                const int c = 16 * nt + rr, cp0 = 16 * mt + 4 * kg;
                v2u o; o.x = pk2(cp0 <= c ? acc[0] : 0.f, cp0 + 1 <= c ? acc[1] : 0.f); o.y = pk2(cp0 + 2 <= c ? acc[2] : 0.f, cp0 + 3 <= c ? acc[3] : 0.f);
                *(GAS v2u*)(ATT + ((size_t)(cid + 2 * hp + hl) * 64 + c) * 64 + cp0) = o;
            }
        }
        __syncthreads();
    }
    if (n == 0 && w < 4) {
        const float* q0 = (const float*)(F.ws + WS_Q0K0) + b * 2048 + w * 256; const float* k0 = q0 + 1024; float s = 0.f;
#pragma unroll
        for (int i = 0; i < 4; ++i) s += q0[lane + 64 * i] * k0[lane + 64 * i];
        s = wave_sum(s) * (1.0f / 16.0f);
        if (lane == 0) ATT[(size_t)(cid + w) * 4096] = (bf16)f2bf(s);
    }
}

constexpr int CH_QT = 0, CH_QP = 528, CH_KE = 64 * CH_QP, CH_KP = 144, CH_AT = CH_KE + 256 * CH_KP, CH_DC = CH_AT + 64 * CH_KP, CH_VS = CH_DC + 1024, CH_END = CH_VS + 16384;
static_assert(CH_END <= MISC_OFF, "chain LDS");
__device__ __forceinline__ void gla_chain_unit(Frame& F, int b, int h, int qd) {
    const int tid = tid_now(), lane = tid & 63, w = F.wave, r32 = lane & 31, hi = lane >> 5;
    const bool helper = w >= 4; const int htid = tid - 256;
    const bf16* GQ = (const bf16*)(F.ws + WS_GQ2); const bf16* KET = (const bf16*)(F.ws + WS_KET); const bf16* ATT = (const bf16*)(F.ws + WS_ATT);
    const float* DEC = (const float*)(F.ws + WS_DEC); const bf16* GV = (const bf16*)(F.ws + WS_GV); bf16* ORAW = (bf16*)(F.ws + WS_XN);
    LAS unsigned char* L = F.lds;
    if (helper) {
        v4u st[23];
#define CH_LOADS(nn) do { const int ch_ = (b * 64 + (nn)) * 4 + h; const int t0_ = b * SEQ + 64 * (nn); \
            _Pragma("unroll") for (int i = 0; i < 8; ++i) { const int id = htid + 256 * i; st[i] = *(const GAS v4u*)(GQ + (size_t)(t0_ + (id >> 5)) * 1024 + h * 256 + 8 * (id & 31)); } \
            _Pragma("unroll") for (int i = 0; i < 8; ++i) { const int id = htid + 256 * i; st[8 + i] = *(const GAS v4u*)(KET + ((size_t)ch_ * 256 + (id >> 3)) * 64 + 8 * (id & 7)); } \
            _Pragma("unroll") for (int i = 0; i < 2; ++i) { const int id = htid + 256 * i; st[16 + i] = *(const GAS v4u*)(ATT + ((size_t)ch_ * 64 + (id >> 3)) * 64 + 8 * (id & 7)); } \
            _Pragma("unroll") for (int i = 0; i < 4; ++i) { const int id = htid + 256 * i; st[19 + i] = *(const GAS v4u*)(GV + (size_t)(t0_ + (id >> 4)) * 2048 + h * 512 + qd * 128 + 8 * (id & 15)); } \
            st[18] = *(const GAS v4u*)(DEC + (size_t)ch_ * 256 + 4 * (htid & 63)); } while (0)
        CH_LOADS(0);
        for (int n = 0; n < 64; ++n) {
#pragma unroll
            for (int i = 0; i < 8; ++i) { const int id = htid + 256 * i; *(LAS v4u*)(L + CH_QT + (id >> 5) * CH_QP + 16 * (id & 31)) = st[i]; }
#pragma unroll
            for (int i = 0; i < 8; ++i) { const int id = htid + 256 * i; *(LAS v4u*)(L + CH_KE + (id >> 3) * CH_KP + 16 * (id & 7)) = st[8 + i]; }
#pragma unroll
            for (int i = 0; i < 2; ++i) { const int id = htid + 256 * i; *(LAS v4u*)(L + CH_AT + (id >> 3) * CH_KP + 16 * (id & 7)) = st[16 + i]; }
#pragma unroll
            for (int i = 0; i < 4; ++i) { const int id = htid + 256 * i; *(LAS v4u*)(L + CH_VS + att::v_st(id >> 4, 8 * (id & 15))) = st[19 + i]; }
            if (htid < 64) *(LAS v4u*)(L + CH_DC + 16 * htid) = st[18];
            __syncthreads();
            if (n + 1 < 64) CH_LOADS(n + 1);
            __syncthreads();
        }
#undef CH_LOADS
    } else {
        f32x16 S[8];
#pragma unroll
        for (int i = 0; i < 8; ++i)
#pragma unroll
            for (int r = 0; r < 16; ++r) S[i][r] = 0.f;
        for (int n = 0; n < 64; ++n) {
            __syncthreads();
            const int t0 = b * SEQ + 64 * n;
            bf16x8 vc[4];
#pragma unroll
            for (int s = 0; s < 4; ++s) { const LAS unsigned char* vp = L + CH_VS + att::v_rd_base(lane) + w * 512 + s * 4096;
                const s16x4 lo = __builtin_bit_cast(s16x4, __builtin_amdgcn_ds_read_tr16_b64_v4i16((LAS v4i16_t*)vp)), hh = __builtin_bit_cast(s16x4, __builtin_amdgcn_ds_read_tr16_b64_v4i16((LAS v4i16_t*)(vp + 2048)));
                vc[s] = (bf16x8){lo[0], lo[1], lo[2], lo[3], hh[0], hh[1], hh[2], hh[3]}; }
            f32x16 O[2];
#pragma unroll
            for (int r = 0; r < 16; ++r) { O[0][r] = 0.f; O[1][r] = 0.f; }
#pragma unroll
            for (int mt = 0; mt < 8; ++mt)
#pragma unroll
                for (int sp = 0; sp < 2; ++sp) {
                    const bf16x8 bs = pack8f(S[mt][8 * sp], S[mt][8 * sp + 1], S[mt][8 * sp + 2], S[mt][8 * sp + 3], S[mt][8 * sp + 4], S[mt][8 * sp + 5], S[mt][8 * sp + 6], S[mt][8 * sp + 7]);
#pragma unroll
                    for (int mc = 0; mc < 2; ++mc) {
                        const LAS unsigned char* ap = L + CH_QT + (32 * mc + r32) * CH_QP + (32 * mt + 16 * sp + 4 * hi) * 2;
                        const s16x4 lo = *(const LAS s16x4*)ap, hh = *(const LAS s16x4*)(ap + 16);
                        const bf16x8 a = {lo[0], lo[1], lo[2], lo[3], hh[0], hh[1], hh[2], hh[3]};
                        O[mc] = __builtin_amdgcn_mfma_f32_32x32x16_bf16(a, bs, O[mc], 0, 0, 0);
                    }
                }
#pragma unroll
            for (int s = 0; s < 4; ++s)
#pragma unroll
                for (int mc = 0; mc < 2; ++mc) { const bf16x8 a = *(const LAS bf16x8*)(L + CH_AT + (32 * mc + r32) * CH_KP + (16 * s + 8 * hi) * 2); O[mc] = __builtin_amdgcn_mfma_f32_32x32x16_bf16(a, vc[s], O[mc], 0, 0, 0); }
            bf16* rowbase = ORAW + (size_t)t0 * 2048 + h * 512 + qd * 128 + 32 * w;
            const unsigned loff = (unsigned)(r32 + hi * 4 * 2048);
#pragma unroll
            for (int mc = 0; mc < 2; ++mc)
#pragma unroll
                for (int r = 0; r < 16; ++r) { const float v = O[mc][r], vn = __shfl_xor(v, 1);
                    if ((r32 & 1) == 0) *(unsigned*)(rowbase + (32 * mc + (r & 3) + 8 * (r >> 2)) * 2048 + loff) = cvtpk_s(v, vn); }
#pragma unroll
            for (int mt = 0; mt < 8; ++mt) {
#pragma unroll
                for (int j = 0; j < 4; ++j) { const f32x4 d4 = *(const LAS f32x4*)(L + CH_DC + (32 * mt + 8 * j + 4 * hi) * 4);
                    S[mt][4 * j] *= d4.x; S[mt][4 * j + 1] *= d4.y; S[mt][4 * j + 2] *= d4.z; S[mt][4 * j + 3] *= d4.w; }
#pragma unroll
                for (int s = 0; s < 4; ++s) { const bf16x8 a = *(const LAS bf16x8*)(L + CH_KE + (32 * mt + r32) * CH_KP + (16 * s + 8 * hi) * 2); S[mt] = __builtin_amdgcn_mfma_f32_32x32x16_bf16(a, vc[s], S[mt], 0, 0, 0); }
            }
            __syncthreads();
        }
    }
}

__device__ __forceinline__ void mix_row(Frame& F, int t, int lane) {
    const bf16* ORAW = (const bf16*)(F.ws + WS_XN); const bf16* GR = (const bf16*)(F.ws + WS_GR); const bf16* OC = (const bf16*)(F.ws + WS_OC); const float* LSE = (const float*)(F.ws + WS_LSE);
    bf16* MIX = (bf16*)(F.ws + WS_MIX);
#pragma unroll
    for (int h = 0; h < 4; ++h) {
        const v4u ow = *(const GAS v4u*)(ORAW + (size_t)t * 2048 + h * 512 + 8 * lane); const f32x4 o0 = {bflo(ow.x), bfhi(ow.x), bflo(ow.y), bfhi(ow.y)}, o1 = {bflo(ow.z), bfhi(ow.z), bflo(ow.w), bfhi(ow.w)};
        const float ss = wave_sum((o0.x * o0.x + o0.y * o0.y) + (o0.z * o0.z + o0.w * o0.w) + (o1.x * o1.x + o1.y * o1.y) + (o1.z * o1.z + o1.w * o1.w));
        const float r = 1.0f / sqrtf(ss * (1.0f / 512.0f) + RMS_EPS);
        const GAS f32x4* gp = (const GAS f32x4*)F.kin[7] + 2 * lane; const f32x4 g0 = gp[0], g1 = gp[1];
        const v4u gw = *(const GAS v4u*)(GR + (size_t)t * 2048 + h * 512 + 8 * lane);
        float y[8] = {o0.x * r * g0.x, o0.y * r * g0.y, o0.z * r * g0.z, o0.w * r * g0.w, o1.x * r * g1.x, o1.y * r * g1.y, o1.z * r * g1.z, o1.w * r * g1.w};
        const float gv[8] = {bflo(gw.x), bfhi(gw.x), bflo(gw.y), bfhi(gw.y), bflo(gw.z), bfhi(gw.z), bflo(gw.w), bfhi(gw.w)};
#pragma unroll
        for (int e = 0; e < 8; ++e) y[e] *= gv[e] / (1.0f + __expf(-gv[e]));
        v4u o = {pk2(y[0], y[1]), pk2(y[2], y[3]), pk2(y[4], y[5]), pk2(y[6], y[7])};
        *(GAS v4u*)(MIX + (size_t)t * DM + h * 512 + 8 * lane) = o;
    }
    {
        const int hd = lane >> 2;
        float m2[3], l[3];
#pragma unroll
        for (int c = 0; c < 3; ++c) { const f32x2 v = *(const GAS f32x2*)(LSE + (((size_t)c * M + t) * 16 + hd) * 2); m2[c] = v.x; l[c] = v.y; }
        const float mx = fmaxf(m2[0], fmaxf(m2[1], m2[2]));
        float wgt[3]; float den = 0.f;
#pragma unroll
        for (int c = 0; c < 3; ++c) { wgt[c] = __builtin_amdgcn_exp2f(m2[c] - mx) * l[c]; den += wgt[c]; }
        const float rden = 1.0f / den;
        float acc[32];
#pragma unroll
        for (int e = 0; e < 32; ++e) acc[e] = 0.f;
#pragma unroll
        for (int c = 0; c < 3; ++c) { const float wc = wgt[c] * rden; const GAS v4u* p = (const GAS v4u*)(OC + (size_t)c * M * 2048 + ((size_t)((t >> 12) * 16 + hd) * SEQ + (t & 4095)) * 128 + 32 * (lane & 3));
#pragma unroll
            for (int q = 0; q < 4; ++q) { const v4u v = p[q];
                acc[8 * q + 0] += wc * bflo(v.x); acc[8 * q + 1] += wc * bfhi(v.x); acc[8 * q + 2] += wc * bflo(v.y); acc[8 * q + 3] += wc * bfhi(v.y);
                acc[8 * q + 4] += wc * bflo(v.z); acc[8 * q + 5] += wc * bfhi(v.z); acc[8 * q + 6] += wc * bflo(v.w); acc[8 * q + 7] += wc * bfhi(v.w); } }
        GAS v4u* op = (GAS v4u*)(MIX + (size_t)t * DM + 2048 + 32 * lane);
#pragma unroll
        for (int q = 0; q < 4; ++q) { v4u o = {pk2(acc[8 * q], acc[8 * q + 1]), pk2(acc[8 * q + 2], acc[8 * q + 3]), pk2(acc[8 * q + 4], acc[8 * q + 5]), pk2(acc[8 * q + 6], acc[8 * q + 7])}; op[q] = o; }
    }
}
__device__ __forceinline__ void halo_fix(Frame& F) {
    const int tid = tid_now();
    const float* GF = (const float*)(F.ws + WS_HALO); const float* UF = GF + HALO_ONE / 4; const float* GL = UF + HALO_ONE / 4;
    bf16* ACT = (bf16*)(F.ws + WS_ACT); const float* cw = F.kin[18]; const float* cb = F.kin[19]; const unsigned* colmax = (const unsigned*)(F.ws + WS_CTL + CTL_COLMAX);
    const int total = 256 * 2 * (DFF / 4);
    for (int i = blockIdx.x * 512 + tid; i < total; i += F.G * 512) {
        const int c4 = i % (DFF / 4), j = (i / (DFF / 4)) & 1, blk = i / (DFF / 2), ch = 4 * c4;
        const bool first = (blk & 63) == 0;
        const f32x4 g0 = *(const GAS f32x4*)(GF + ((size_t)blk * 2 + j) * DFF + ch), uu = *(const GAS f32x4*)(UF + ((size_t)blk * 2 + j) * DFF + ch);
        const f32x4 z = {0.f, 0.f, 0.f, 0.f};
        f32x4 g1, g2;
        if (j == 0) { g1 = first ? z : *(const GAS f32x4*)(GL + ((size_t)(blk - 1) * 2 + 1) * DFF + ch); g2 = first ? z : *(const GAS f32x4*)(GL + ((size_t)(blk - 1) * 2 + 0) * DFF + ch); }
        else { g1 = *(const GAS f32x4*)(GF + ((size_t)blk * 2 + 0) * DFF + ch); g2 = first ? z : *(const GAS f32x4*)(GL + ((size_t)(blk - 1) * 2 + 1) * DFF + ch); }
        const f32x4 w0 = *(const GAS f32x4*)(cw + ch), w1 = *(const GAS f32x4*)(cw + DFF + ch), w2 = *(const GAS f32x4*)(cw + 2 * DFF + ch), bb = *(const GAS f32x4*)(cb + ch);
        float a[4];
#pragma unroll
        for (int e = 0; e < 4; ++e) { const float sg = FFN_I8 ? __uint_as_float(colmax[ch + e]) * (1.0f / 127.0f) : 1.0f;
            const float y = bb[e] + sg * (w0[e] * g2[e] + w1[e] * g1[e] + w2[e] * g0[e]); a[e] = y / (1.0f + __expf(-y)) * (uu[e] * -1.4426950408889634f); }
        v2u o = {pk2(a[0], a[1]), pk2(a[2], a[3])};
        *(GAS v2u*)(ACT + (size_t)(64 * blk + j) * DFF + ch) = o;
    }
}
__device__ __forceinline__ void final_norm_row(Frame& F, int t, int lane) {
    const unsigned long long* ss = (const unsigned long long*)(F.ws + WS_CTL + CTL_SS) + 2 * (size_t)M;
    const float r = 1.0f / sqrtf((float)ss[t] * ((1.0f / 4096.0f) / 1048576.0f) + RMS_EPS);
    const GAS v4u* hr = (const GAS v4u*)((const bf16*)(F.ws + WS_XN) + (size_t)t * DM) + lane; GAS f32x4* xr = (GAS f32x4*)(F.out + (size_t)t * DM) + 2 * lane; const GAS f32x4* gr = (const GAS f32x4*)F.kin[21] + 2 * lane;
#pragma unroll
    for (int j = 0; j < 8; ++j) { const v4u w = hr[64 * j]; const f32x4 g0 = gr[128 * j], g1 = gr[128 * j + 1];
        xr[128 * j] = (f32x4){bflo(w.x) * r * g0.x, bfhi(w.x) * r * g0.y, bflo(w.y) * r * g0.z, bfhi(w.y) * r * g0.w};
        xr[128 * j + 1] = (f32x4){bflo(w.z) * r * g1.x, bfhi(w.z) * r * g1.y, bflo(w.w) * r * g1.z, bfhi(w.w) * r * g1.w}; }
}

__device__ __forceinline__ void quant_row(Frame& F, int t, int lane) {
    const unsigned* amax = (const unsigned*)(F.ws + WS_CTL + CTL_AMAX); const float am = __uint_as_float(amax[t]); const float inv = am > 0.f ? 127.0f / am : 0.f;
    const GAS v4u* hr = (const GAS v4u*)((const bf16*)(F.ws + WS_XN) + (size_t)t * DM) + lane; GAS v2u* qr = (GAS v2u*)((signed char*)(F.ws + WS_H2Q) + (size_t)t * DM) + lane;
#pragma unroll
    for (int j = 0; j < 8; ++j) { const v4u w = hr[64 * j];
        const float v[8] = {bflo(w.x), bfhi(w.x), bflo(w.y), bfhi(w.y), bflo(w.z), bfhi(w.z), bflo(w.w), bfhi(w.w)}; unsigned q[2] = {0u, 0u};
#pragma unroll
        for (int e = 0; e < 8; ++e) { const float r = fminf(fmaxf(__builtin_rintf(v[e] * inv), -127.f), 127.f); q[e >> 2] |= ((unsigned)(int)r & 0xffu) << (8 * (e & 3)); }
        qr[64 * j] = (v2u){q[0], q[1]}; }
}
typedef att::BlockRef<att::bf16, att::bf16> ABlk;
__device__ __forceinline__ ABlk dil_item(unsigned char* ws, int L) {
    const int bh = L / 48, rem = L - 48 * bh, cfg = rem >> 4, x = rem & 15, h = bh & 15, b = bh >> 4;
    const int d = cfg == 0 ? 1 : (cfg == 1 ? 4 : 16);
    const int r = cfg == 0 ? 0 : (cfg == 1 ? (x >> 2) : x), qb = cfg == 0 ? x : (cfg == 1 ? (x & 3) : 0);
    const att::bf16* DQ = (const att::bf16*)(ws + WS_DQKV); const att::bf16* DK = DQ + (size_t)M * 2048; const att::bf16* DV = DK + (size_t)M * 2048;
    const int sq = r + d * 256 * qb, tq = b * SEQ + sq; const size_t hb = (size_t)(b * 16 + h) * SEQ;
    ABlk R;
    R.Q = DQ + (hb + sq) * 128; R.K = DK + (hb + r) * 128; R.V = DV + (hb + r) * 128;
    R.O = (att::bf16*)(ws + WS_OC) + ((size_t)cfg * M * 2048) + (hb + sq) * 128;
    R.L = (float*)(ws + WS_LSE) + (((size_t)cfg * M + tq) * 16 + h) * 2;
    R.bsrc = (const float*)(ws + WS_BT) + (cfg * 16 + h) * 132;
    R.P0 = 256 * qb; R.pq = 128 * d; R.pk = 128 * d; R.po = 128 * d; R.pl = 32 * d; R.skv = SEQ / d; R.W = 129;
    return R;
}
__device__ __forceinline__ ABlk xat_item(unsigned char* ws, int L) {
    const int qb = L & 15, h = (L >> 4) & 3, b = L >> 6;
    const att::bf16* XQ = (const att::bf16*)(ws + WS_XQ); const att::bf16* XKV = (const att::bf16*)(ws + WS_XKV);
    ABlk R;
    R.Q = XQ + (size_t)(b * SEQ + 256 * qb) * XW + h * 128; R.K = XKV + (size_t)(b * MEMLEN) * 1024 + h * 128; R.V = R.K + 512;
    R.O = (att::bf16*)(ws + WS_XO) + (size_t)(b * SEQ + 256 * qb) * XW + h * 128; R.L = nullptr; R.bsrc = nullptr;
    R.P0 = 1 << 20; R.pq = XW; R.pk = 1024; R.po = XW; R.pl = 0; R.skv = MEMLEN; R.W = 1 << 30;
    return R;
}

#ifndef PG_ALIGN
#define PG_ALIGN true
#endif
#ifndef PG_SP2
#define PG_SP2 true
#endif
struct Args { const float* in[22]; float* out; unsigned char* ws; int ph_lo, ph_hi; };
__global__ void __launch_bounds__(NWAVES * 64, 2) hybrid_fwd(Args args) {
    extern __shared__ __attribute__((aligned(16))) unsigned char lds[];
    Frame F;
    F.lds = (LAS unsigned char*)lds; F.ldsg = (char*)lds;
    F.MISC = (volatile LAS unsigned*)(F.lds + MISC_OFF);
    F.wave = __builtin_amdgcn_readfirstlane((int)threadIdx.x >> 6);
    F.G = gridDim.x; { const int bx = blockIdx.x; F.vcu = (F.G % 8 == 0) ? (bx % 8) * (F.G / 8) + bx / 8 : bx; }
    F.ws = args.ws; F.ctl = (gu32*)(args.ws + WS_CTL); F.out = args.out;
    F.kin = (const float* const __attribute__((address_space(4)))*)__builtin_amdgcn_kernarg_segment_ptr();
    if (threadIdx.x < 64) F.MISC[threadIdx.x] = 0u;
    __syncthreads();
    XcdBarrier bar; bar.bar = (unsigned*)(F.ctl + CW_BAR); bar.x = 0; bar.st = nullptr;
    if (N_LAUNCHES == 1) bar = xcd_barrier_post((unsigned*)(F.ctl + CW_BAR), F.MISC + 8);
#define GRID_BAR() do { if (N_LAUNCHES == 1) xcd_barrier(bar); } while (0)
    const int lo = args.ph_lo, hi = args.ph_hi;
#ifndef PH_MASK
#define PH_MASK 0x1fff
#endif
#define IN(k) ((((PH_MASK) >> (k)) & 1) && lo <= (k) && (k) < hi)
#define BOTH(k) (IN(k) && IN((k) + 1))
#ifndef DUPMASK
#define DUPMASK 0
#endif
#ifndef XBAR
#define XBAR 0
#endif
#define DUPK(k, ...) { __VA_ARGS__ } if constexpr ((((DUPMASK) >> (k)) & 1) != 0) { __syncthreads(); { __VA_ARGS__ } }
#define GRID_BARX() do { GRID_BAR(); if constexpr (XBAR != 0) GRID_BAR(); } while (0)
    unsigned long long* SS1 = (unsigned long long*)(F.ws + WS_CTL + CTL_SS); unsigned long long* SS2 = SS1 + M; unsigned long long* SS3 = SS2 + M;
    const int gw = F.vcu * NWAVES + F.wave, NGW = F.G * NWAVES;

    if (IN(0)) { DUPK(0, p0_first_token(F); p0_prologue(F);) GRID_BAR(); p0_quant_win(F);
#ifdef DUP_P0FT
        __syncthreads(); p0_first_token(F); __syncthreads(); p0_first_token(F); __syncthreads(); p0_first_token(F); __syncthreads(); p0_first_token(F);
#endif
        if (BOTH(0)) GRID_BARX(); }
    if (IN(1)) {
        { pg8::Gemm g{(const bf16*)(F.ws + WS_XN), (const bf16*)(F.ws + WS_WIN), M, 6144, DM}; pg8::StaticOrder S; S.init(M, 6144, F.G, (int)blockIdx.x);
          pg8::EpiProj E{(bf16*)(F.ws + WS_GQ), (bf16*)(F.ws + WS_GK), (bf16*)(F.ws + WS_GV), (bf16*)(F.ws + WS_GR), (bf16*)(F.ws + WS_DQKV)};
          pg8::gemm_phase<pg8::EpiProj, pg8::StaticOrder, PG_ALIGN, PG_SP2>(F.lds, g, S, E);
          { pg8::Gemm gq{(const bf16*)(F.ws + WS_XNQ), (const bf16*)(F.ws + WS_WINQ), M, 6144, DM / 2}; pg8::StaticOrder Sq; Sq.init(M, 6144, F.G, (int)blockIdx.x);
            pg8::EpiProjQ Eq{(bf16*)(F.ws + WS_DQKV), (const float*)(F.ws + WS_RSC1), (const unsigned*)(F.ws + WS_CTL + CTL_CMAX1)};
            pg8::gemm_phase<pg8::EpiProjQ, pg8::StaticOrder, PG_ALIGN, PG_SP2>(F.lds, gq, Sq, Eq); }
#ifdef DUP_P1NULL
          { pg8::EpiNull E0{}; pg8::Gemm g2{(const bf16*)(F.ws + WS_XN), (const bf16*)(F.ws + WS_WIN), M, 3072, DM}; pg8::StaticOrder S2; S2.init(M, 3072, F.G, (int)blockIdx.x); pg8::gemm_phase<pg8::EpiNull, pg8::StaticOrder, PG_ALIGN, PG_SP2>(F.lds, g2, S2, E0); pg8::gemm_phase<pg8::EpiNull, pg8::StaticOrder, PG_ALIGN, PG_SP2>(F.lds, g2, S2, E0); pg8::gemm_phase<pg8::EpiNull, pg8::StaticOrder, PG_ALIGN, PG_SP2>(F.lds, g2, S2, E0); pg8::gemm_phase<pg8::EpiNull, pg8::StaticOrder, PG_ALIGN, PG_SP2>(F.lds, g2, S2, E0); }
#endif
          }
        if (BOTH(1)) GRID_BARX();
    }
    if (IN(2)) { DUPK(2, for (int u = blockIdx.x; u < NB * 64; u += F.G) gla_prep_unit(F, u >> 6, u & 63);) if (BOTH(2)) GRID_BARX(); }
    if (IN(3)) {
#ifdef PRE_ATT_VARIANT
        {
            gu32* qctr = F.ctl + CW_QUEUE + 64;
#define NEXT_ITEM(dst) do { if (tid_now() == 0) F.MISC[16] = __hip_atomic_fetch_add(qctr, 1u, RLX_AGENT); __syncthreads(); dst = __builtin_amdgcn_readfirstlane((int)F.MISC[16]); __syncthreads(); } while (0)
            int L; NEXT_ITEM(L);
            if (L < 3072) {
                ABlk cur = dil_item(F.ws, L); att::Seam<att::bf16> S; int par = 0;
                att::causal_swa_prime<PRE_ATT_VARIANT, att::bf16, att::bf16>(cur, F.ldsg, S);
                unsigned char* const wsp = F.ws; auto itf = [wsp](int l) { return dil_item(wsp, l); };
                for (;;) { int Ln; NEXT_ITEM(Ln); const bool last = Ln >= 3072; const int Lx = last ? L : Ln;
                    att::causal_swa_block<PRE_ATT_VARIANT, att::bf16, att::bf16>(cur, Lx, itf, par, F.ldsg, S);
                    if (last) break; L = Ln; cur = dil_item(F.ws, L); par ^= 1; }
            }
#undef NEXT_ITEM
            __syncthreads();
        }
#endif
        if ((int)blockIdx.x < 64) gla_chain_unit(F, blockIdx.x >> 4, (blockIdx.x >> 2) & 3, blockIdx.x & 3);
        {
            gu32* qctr = F.ctl + CW_QUEUE;
#define NEXT_ITEM(dst) do { if (tid_now() == 0) F.MISC[16] = __hip_atomic_fetch_add(qctr, 1u, RLX_AGENT); __syncthreads(); dst = __builtin_amdgcn_readfirstlane((int)F.MISC[16]); __syncthreads(); } while (0)
            int L; NEXT_ITEM(L);
            if (L < 3072) {
                ABlk cur = dil_item(F.ws, L); att::Seam<att::bf16> S; int par = 0;
                att::causal_swa_prime<1, att::bf16, att::bf16>(cur, F.ldsg, S);
                unsigned char* const wsp = F.ws; auto itf = [wsp](int l) { return dil_item(wsp, l); };
                for (;;) { int Ln; NEXT_ITEM(Ln); const bool last = Ln >= 3072; const int Lx = last ? L : Ln;
                    att::causal_swa_block<1, att::bf16, att::bf16>(cur, Lx, itf, par, F.ldsg, S);
                    if (last) break; L = Ln; cur = dil_item(F.ws, L); par ^= 1; }
            }
#undef NEXT_ITEM
        }
#ifdef DUP_CHAIN
        __syncthreads(); if ((int)blockIdx.x < 64) gla_chain_unit(F, blockIdx.x >> 4, (blockIdx.x >> 2) & 3, blockIdx.x & 3);
#endif
        if (BOTH(3)) GRID_BARX();
    }
    if (IN(4)) {
        { const int lane = tid_now() & 63; for (int t = gw; t < M; t += NGW) mix_row(F, t, lane); }
        ffn_weights<0>(F, 2 * FW_IG, FW_P9_LO, gw, NGW);
        if constexpr (FFN_I8) { ffn_weights<1>(F, 0, 2 * FW_IG, gw, NGW); GRID_BAR(); }
        ffn_weights<0>(F, 0, FW_P6_LO, gw, NGW);
        if (BOTH(4)) GRID_BARX(); }
    if (IN(5)) {
        pg8::Gemm g{(const bf16*)(F.ws + WS_MIX), (const bf16*)(F.ws + WS_WOUT), M, DM, DM}; pg8::StaticOrder S; S.init(M, DM, F.G, (int)blockIdx.x);
        pg8::EpiResid E{F.kin[0], nullptr, (bf16*)(F.ws + WS_XN), SS1, DM, nullptr};
        pg8::gemm_phase<pg8::EpiResid, pg8::StaticOrder, PG_ALIGN, PG_SP2>(F.lds, g, S, E);
#ifdef DUP_P5
        { pg8::EpiResid E2{F.kin[0], nullptr, (bf16*)(F.ws + WS_XN), nullptr, DM, nullptr}; pg8::gemm_phase<pg8::EpiResid, pg8::StaticOrder, PG_ALIGN, PG_SP2>(F.lds, g, S, E2); }
#endif
        if (BOTH(5)) GRID_BARX();
    }
    if (IN(6)) {
        DUPK(6,
        if ((int)blockIdx.x < 128 || F.G < 144) {
        pg8::Gemm g{(const bf16*)(F.ws + WS_XN), (const bf16*)(F.ws + WS_WXQ), M, XW, DM}; pg8::StaticOrder S; S.init(M, XW, F.G < 144 ? F.G : 128, (int)blockIdx.x);
        pg8::EpiScaleBf16 E{(bf16*)(F.ws + WS_XQ), XW, SS1, 1.0f / 4096.0f};
        pg8::gemm_phase<pg8::EpiScaleBf16, pg8::StaticOrder, PG_ALIGN, PG_SP2>(F.lds, g, S, E);
        }
        if ((int)blockIdx.x >= 128 || F.G < 144) {
        pg8::Gemm g{(const bf16*)(F.ws + WS_MEMN), (const bf16*)(F.ws + WS_WXKV), MROWS, 1024, DM}; pg8::StaticOrder S; S.init(MROWS, 1024, F.G < 144 ? F.G : F.G - 128, F.G < 144 ? (int)blockIdx.x : (int)blockIdx.x - 128);
        pg8::EpiScaleBf16 E{(bf16*)(F.ws + WS_XKV), 1024, nullptr, 0.f};
        pg8::gemm_phase<pg8::EpiScaleBf16, pg8::StaticOrder, PG_ALIGN, PG_SP2>(F.lds, g, S, E);
        }
        if (F.G >= 256) { if ((int)blockIdx.x >= 144) ffn_weights<0>(F, FW_P6_LO, FW_P6_HI, ((int)blockIdx.x - 144) * NWAVES + F.wave, (F.G - 144) * NWAVES); }
        else ffn_weights<0>(F, FW_P6_LO, FW_P6_HI, gw, NGW);
        )
        if (BOTH(6)) GRID_BARX();
    }
    if (IN(7)) {
        DUPK(7,
        if ((int)blockIdx.x < 256) {
            int L = blockIdx.x; ABlk cur = xat_item(F.ws, L); att::Seam<att::bf16> S; int par = 0;
            att::causal_swa_prime<0, att::bf16, att::bf16>(cur, F.ldsg, S);
            unsigned char* const wsp = F.ws; auto itf = [wsp](int l) { return xat_item(wsp, l); };
            for (;;) { const int Ln = L + F.G; const bool last = Ln >= 256; const int Lx = last ? L : Ln;
                att::causal_swa_block<0, att::bf16, att::bf16>(cur, Lx, itf, par, F.ldsg, S);
                if (last) break; L = Ln; cur = xat_item(F.ws, L); par ^= 1; }
        }
        )
        if (BOTH(7)) GRID_BARX();
    }
    if (IN(8)) {
        pg8::Gemm g{(const bf16*)(F.ws + WS_XO), (const bf16*)(F.ws + WS_WXO), M, DM, XW}; pg8::StaticOrder S; S.init(M, DM, F.G, (int)blockIdx.x);
        pg8::EpiResid E{nullptr, (const bf16*)(F.ws + WS_XN), (bf16*)(F.ws + WS_XN), SS2, DM, FFN_I8 ? (unsigned*)(F.ws + WS_CTL + CTL_AMAX) : nullptr};
        pg8::gemm_phase<pg8::EpiResid, pg8::StaticOrder, PG_ALIGN, PG_SP2>(F.lds, g, S, E);
        if constexpr (FFN_I8) { GRID_BAR(); const int lane = tid_now() & 63; for (int t = gw; t < M; t += NGW) quant_row(F, t, lane); }
        if (BOTH(8)) GRID_BARX();
    }
    if (IN(9)) {
        DUPK(9,
        typedef pg8::EpiGateUpT<FFN_I8 != 0> EpiGU;
        pg8::Gemm g{(const bf16*)(F.ws + (FFN_I8 ? WS_H2Q : WS_XN)), (const bf16*)(F.ws + WS_WGU), M, NGU, FFN_I8 ? DM / 2 : DM}; pg8::StaticOrder S; S.init(M, NGU, F.G, (int)blockIdx.x);
        float* GF = (float*)(F.ws + WS_HALO);
        EpiGU E{(bf16*)(F.ws + WS_ACT), DFF, SS2, 1.0f / 4096.0f, F.kin[18], F.kin[19], GF, GF + HALO_ONE / 4, GF + 2 * (HALO_ONE / 4), DFF, (LAS float*)(F.lds + 131072),
                (const unsigned*)(F.ws + WS_CTL + CTL_COLMAX), (const unsigned*)(F.ws + WS_CTL + CTL_AMAX)};
        pg8::gemm_phase<EpiGU, pg8::StaticOrder, PG_ALIGN, PG_SP2>(F.lds, g, S, E);
        if (F.G == 256) { if ((int)blockIdx.x >= 128) ffn_weights<0>(F, FW_P9_LO, FW_P9_HI, ((int)blockIdx.x - 128) * NWAVES + F.wave, 128 * NWAVES); }
        else ffn_weights<0>(F, FW_P9_LO, FW_P9_HI, gw, NGW);
        )
        if (BOTH(9)) GRID_BARX();
    }
    if (IN(10)) { DUPK(10, halo_fix(F);) if (BOTH(10)) GRID_BARX(); }
    if (IN(11)) {
        pg8::Gemm g{(const bf16*)(F.ws + WS_ACT), (const bf16*)(F.ws + WS_WDN), M, DM, DFF}; pg8::StaticOrder S; S.init(M, DM, F.G, (int)blockIdx.x);
        pg8::EpiResid E{nullptr, (const bf16*)(F.ws + WS_XN), (bf16*)(F.ws + WS_XN), SS3, DM, nullptr};
        pg8::gemm_phase<pg8::EpiResid, pg8::StaticOrder, PG_ALIGN, PG_SP2>(F.lds, g, S, E);
        if (BOTH(11)) GRID_BARX();
    }
    if (IN(12)) { DUPK(12, const int lane = tid_now() & 63; for (int t = gw; t < M; t += NGW) final_norm_row(F, t, lane);)
    }
#undef IN
#undef BOTH
#undef GRID_BAR
}

extern "C" void kernel_launch(void* const* d_in, const int* in_sizes, int n_in, void* d_out, int out_size, void* d_ws, size_t ws_size, hipStream_t stream) {
    static int grid = 0;
    if (grid == 0) {
        if (n_in != 22 || in_sizes[0] != M * DM || out_size != M * DM || ws_size < WS_END) { fprintf(stderr, "kernel_launch: unexpected shapes (n_in %d, in0 %d, out %d, ws %zu)\n", n_in, n_in > 0 ? in_sizes[0] : -1, out_size, ws_size); grid = -1; return; }
        int dev = 0, cus = 0, per_cu = 0;
        if (hipGetDevice(&dev) != hipSuccess || hipDeviceGetAttribute(&cus, hipDeviceAttributeMultiprocessorCount, dev) != hipSuccess) { grid = -1; return; }
        if (hipFuncSetAttribute((const void*)hybrid_fwd, hipFuncAttributeMaxDynamicSharedMemorySize, LDS_BYTES) != hipSuccess) { fprintf(stderr, "kernel_launch: hipFuncSetAttribute failed\n"); grid = -1; return; }
        if (hipOccupancyMaxActiveBlocksPerMultiprocessor(&per_cu, (const void*)hybrid_fwd, NWAVES * 64, LDS_BYTES) != hipSuccess || per_cu < 1) fprintf(stderr, "kernel_launch: occupancy query reports %d\n", per_cu);
        (void)hipGetLastError();
        grid = cus;
    }
    if (grid < 0) return;
    if (hipMemsetAsync((char*)d_ws + WS_CTL, 0, CTL_ZERO_BYTES, stream) != hipSuccess) return;
    Args a{};
    for (int i = 0; i < 22; ++i) a.in[i] = (const float*)d_in[i];
    a.out = (float*)d_out; a.ws = (unsigned char*)d_ws;
    for (int li = 0; li < N_LAUNCHES; ++li) {
        a.ph_lo = (N_LAUNCHES == 1) ? 0 : li; a.ph_hi = (N_LAUNCHES == 1) ? NPH : li + 1;
        hipLaunchKernelGGL(hybrid_fwd, dim3(grid), dim3(NWAVES * 64), LDS_BYTES, stream, a);
    }
}
```

```cpp
#include <hip/hip_runtime.h>
#include <hip/hip_bf16.h>
#include <cstdio>
#include <cstdint>
#include <cmath>
#include <type_traits>
#ifndef MK_N_LAUNCHES
#define MK_N_LAUNCHES 1
#endif
namespace pg8 {
#define PG8_LAS __attribute__((address_space(3)))
typedef unsigned short bf16_t;
typedef short bf16x8 __attribute__((ext_vector_type(8)));
typedef float f32x4 __attribute__((ext_vector_type(4)));
typedef unsigned u32x4 __attribute__((ext_vector_type(4)));
constexpr int BM = 256, BK = 64, HALF = 128, HTB = HALF * BK * 2  , STAGE_BYTES = 8 * HTB, NXCD = 8, WGM = 8;

__host__ __device__ __forceinline__ int lds_byte(int r, int c) { const int st = (r >> 4) * 2 + (c >> 5), rr = r & 15, cc = c & 31, ob = rr * 64 + cc * 2; return st * 1024 + (ob ^ (((ob >> 9) & 1) << 5)); }
__host__ __device__ __forceinline__ void stage_rc(int b, int& R, int& C) { const int st = b / 1024, sb = b % 1024, swz = sb ^ (((sb >> 9) & 1) << 5); R = (st >> 1) * 16 + swz / 64; C = (st & 1) * 32 + (swz % 64) / 2; }
__host__ __device__ __forceinline__ int perm32(int rho) { const int n = rho >> 4, i = rho & 15; return 8 * (i >> 2) + 4 * n + (i & 3); }

struct Unit { int pm, pn; };
struct Gemm { const bf16_t* A; const bf16_t* Bt; int M, N, K; };

struct StaticOrder {
    int nM, nN, nwg, G, c;
    __host__ __device__ void init(int M, int N, int G_, int c_) { nM = M / BM; nN = N / BM; nwg = nM * nN; G = G_; c = c_; }
    __host__ __device__ bool next(int i, Unit& u) const {
        const long L = (long)i * G + c; if (L >= nwg) return false;
        int wgid = (int)L; { const int q = nwg / NXCD, r = nwg % NXCD, xcd = wgid % NXCD, off = wgid / NXCD; wgid = (xcd < r ? xcd * (q + 1) : r * (q + 1) + (xcd - r) * q) + off; }
        const int nig = WGM * nN, gid = wgid / nig, fm = gid * WGM, gsz = (nM - fm) < WGM ? (nM - fm) : WGM;
        u.pm = fm + ((wgid % nig) % gsz); u.pn = (wgid % nig) / gsz; return true;
    }
    __device__ __forceinline__ void a_ready(const Unit&) const {}
    __device__ __forceinline__ void done(const Unit&) const {}
};

__device__ __forceinline__ unsigned cvt_pk_bf16(float lo, float hi) { unsigned r; asm volatile("v_cvt_pk_bf16_f32 %0, %1, %2" : "=v"(r) : "v"(lo), "v"(hi)); return r; }
typedef float f32x2 __attribute__((ext_vector_type(2)));
typedef unsigned u32x2 __attribute__((ext_vector_type(2)));
typedef int i32x4 __attribute__((ext_vector_type(4)));
typedef __bf16 bf16x2v __attribute__((ext_vector_type(2)));
__device__ __forceinline__ unsigned cvtpk_e(float lo, float hi) { f32x2 v = {lo, hi}; bf16x2v b = __builtin_convertvector(v, bf16x2v); return __builtin_bit_cast(unsigned, b); }
constexpr float RMS_EPS = 1e-6f;
constexpr float SS_SCALE = 1048576.0f;
__device__ __forceinline__ float rstd_of(const unsigned long long* ss, int row, float inv_n) { return 1.0f / sqrtf((float)ss[row] * (inv_n / SS_SCALE) + RMS_EPS); }

struct Seg { bf16_t* base; int ld; int col0; int pad; };
struct EpiProj {
    static constexpr bool PERM = true, PERMA = false, AFTER_DRAIN = false, PREFETCH = false, I8 = false; typedef f32x4 AccT; static constexpr int NST = 16;
    bf16_t *gq, *gk, *gv, *gr, *dqkv;
    int nv;
    __device__ __forceinline__ void operator()(const f32x4 (&acc)[2][2][4][2], const Unit& u, int wr, int wc, int fr, int fq) const {
        const int colt = u.pn * BM; const int row0 = u.pm * BM + wr * 64 + fr;
        if (colt < 4096 + nv) {
            bf16_t* base; int ld, c0;
            if (colt < 1024) { base = gq; ld = 1024; c0 = colt; } else if (colt < 2048) { base = gk; ld = 1024; c0 = colt - 1024; }
            else if (colt < 2048 + nv) { base = gv; ld = 2048; c0 = colt - 2048; } else { base = gr; ld = 2048; c0 = colt - 2048 - nv; }
            const int col0 = c0 + wc * 32 + 8 * fq;
#pragma unroll
            for (int ai = 0; ai < 2; ++ai)
#pragma unroll
                for (int m = 0; m < 4; ++m) { bf16_t* rowp = base + (size_t)(row0 + ai * HALF + m * 16) * ld + col0;
#pragma unroll
                    for (int bj = 0; bj < 2; ++bj) { const f32x4 v0 = acc[ai][bj][m][0], v1 = acc[ai][bj][m][1];
                        u32x4 w; w.x = cvt_pk_bf16(v0[0], v0[1]); w.y = cvt_pk_bf16(v0[2], v0[3]); w.z = cvt_pk_bf16(v1[0], v1[1]); w.w = cvt_pk_bf16(v1[2], v1[3]);
                        __builtin_nontemporal_store(w, (u32x4*)(rowp + bj * HALF)); } }
        } else {
            const int c = colt - 4096 - nv, ten = c >> 11, h0 = (c & 2047) >> 7;
            bf16_t* base = dqkv + (size_t)ten * ((size_t)16384 * 2048) + wc * 32 + 8 * fq;
#pragma unroll
            for (int ai = 0; ai < 2; ++ai)
#pragma unroll
                for (int m = 0; m < 4; ++m) { const int row = row0 + ai * HALF + m * 16, b = row >> 12, sq = row & 4095;
#pragma unroll
                    for (int bj = 0; bj < 2; ++bj) { const f32x4 v0 = acc[ai][bj][m][0], v1 = acc[ai][bj][m][1];
                        u32x4 w; w.x = cvt_pk_bf16(v0[0], v0[1]); w.y = cvt_pk_bf16(v0[2], v0[3]); w.z = cvt_pk_bf16(v1[0], v1[1]); w.w = cvt_pk_bf16(v1[2], v1[3]);
                        __builtin_nontemporal_store(w, (u32x4*)(base + ((size_t)((b * 16 + h0 + bj) * 4096 + sq)) * 128)); } }
        }
    }
};
struct EpiProjQ {
    static constexpr bool PERM = true, PERMA = false, AFTER_DRAIN = false, PREFETCH = false, I8 = true; typedef i32x4 AccT; static constexpr int NST = 16;
    bf16_t* dqkv; const float* rsc; const unsigned* cmax; bf16_t* gv; int nv;
    __device__ __forceinline__ void operator()(const i32x4 (&acc)[2][2][4][2], const Unit& u, int wr, int wc, int fr, int fq) const {
        const int c = u.pn * BM, cd = c - nv, ten = cd >> 11, h0 = (cd & 2047) >> 7; const int row0 = u.pm * BM + wr * 64 + fr;
        const bool isv = c < nv;
        bf16_t* base = isv ? gv + c + wc * 32 + 8 * fq : dqkv + (size_t)ten * ((size_t)16384 * 2048) + wc * 32 + 8 * fq;
        float cs[2][8];
#pragma unroll
        for (int bj = 0; bj < 2; ++bj) { const u32x4 m0 = *(const u32x4*)(cmax + c + bj * HALF + wc * 32 + 8 * fq), m1 = *(const u32x4*)(cmax + c + bj * HALF + wc * 32 + 8 * fq + 4);
            cs[bj][0] = __uint_as_float(m0.x) * (1.0f / 127.0f); cs[bj][1] = __uint_as_float(m0.y) * (1.0f / 127.0f); cs[bj][2] = __uint_as_float(m0.z) * (1.0f / 127.0f); cs[bj][3] = __uint_as_float(m0.w) * (1.0f / 127.0f);
            cs[bj][4] = __uint_as_float(m1.x) * (1.0f / 127.0f); cs[bj][5] = __uint_as_float(m1.y) * (1.0f / 127.0f); cs[bj][6] = __uint_as_float(m1.z) * (1.0f / 127.0f); cs[bj][7] = __uint_as_float(m1.w) * (1.0f / 127.0f); }
#pragma unroll
        for (int ai = 0; ai < 2; ++ai)
#pragma unroll
            for (int m = 0; m < 4; ++m) { const int row = row0 + ai * HALF + m * 16, b = row >> 12, sq = row & 4095; const float rs = rsc[row];
#pragma unroll
                for (int bj = 0; bj < 2; ++bj) { const i32x4 a0 = acc[ai][bj][m][0], a1 = acc[ai][bj][m][1];
                    u32x4 w; w.x = cvt_pk_bf16((float)a0[0] * (rs * cs[bj][0]), (float)a0[1] * (rs * cs[bj][1])); w.y = cvt_pk_bf16((float)a0[2] * (rs * cs[bj][2]), (float)a0[3] * (rs * cs[bj][3]));
                    w.z = cvt_pk_bf16((float)a1[0] * (rs * cs[bj][4]), (float)a1[1] * (rs * cs[bj][5])); w.w = cvt_pk_bf16((float)a1[2] * (rs * cs[bj][6]), (float)a1[3] * (rs * cs[bj][7]));
                    __builtin_nontemporal_store(w, (u32x4*)(isv ? base + (size_t)row * 2048 + bj * HALF : base + ((size_t)((b * 16 + h0 + bj) * 4096 + sq)) * 128)); } }
    }
};
struct EpiScaleBf16 {
    static constexpr bool PERM = true, PERMA = false, AFTER_DRAIN = false, PREFETCH = false, I8 = false; typedef f32x4 AccT; static constexpr int NST = 16;
    bf16_t* O; int ldc; const unsigned long long* ss; float inv_n;
    __device__ __forceinline__ void operator()(const f32x4 (&acc)[2][2][4][2], const Unit& u, int wr, int wc, int fr, int fq) const {
        const int row0 = u.pm * BM + wr * 64 + fr, col0 = u.pn * BM + wc * 32 + 8 * fq;
#pragma unroll
        for (int ai = 0; ai < 2; ++ai)
#pragma unroll
            for (int m = 0; m < 4; ++m) { const int row = row0 + ai * HALF + m * 16; const float rs = ss ? rstd_of(ss, row, inv_n) : 1.0f; bf16_t* rowp = O + (size_t)row * ldc + col0;
#pragma unroll
                for (int bj = 0; bj < 2; ++bj) { const f32x4 v0 = acc[ai][bj][m][0] * rs, v1 = acc[ai][bj][m][1] * rs;
                    u32x4 w; w.x = cvt_pk_bf16(v0[0], v0[1]); w.y = cvt_pk_bf16(v0[2], v0[3]); w.z = cvt_pk_bf16(v1[0], v1[1]); w.w = cvt_pk_bf16(v1[2], v1[3]);
                    *(u32x4*)(rowp + bj * HALF) = w; } }
    }
};
struct EpiResid {
    static constexpr bool PERM = true, PERMA = false, AFTER_DRAIN = false, PREFETCH = false, I8 = false; typedef f32x4 AccT; static constexpr int NST = 32;
    const float* base32; const bf16_t* base16; bf16_t* hb; unsigned long long* ss; int ldc; unsigned* amax;
    __device__ __forceinline__ void operator()(const f32x4 (&acc)[2][2][4][2], const Unit& u, int wr, int wc, int fr, int fq) const {
        const int row0 = u.pm * BM + wr * 64 + fr, col0 = u.pn * BM + wc * 32 + 8 * fq;
        f32x4 bc[2][2], bn[2][2]; u32x4 hc[2], hn[2];
#define EPR_LOAD(d32, d16, g) do { const size_t o_ = (size_t)(row0 + ((g) >> 2) * HALF + ((g) & 3) * 16) * ldc + col0; \
        if (base32) { d32[0][0] = __builtin_nontemporal_load((const f32x4*)(base32 + o_)); d32[0][1] = __builtin_nontemporal_load((const f32x4*)(base32 + o_ + 4)); d32[1][0] = __builtin_nontemporal_load((const f32x4*)(base32 + o_ + HALF)); d32[1][1] = __builtin_nontemporal_load((const f32x4*)(base32 + o_ + HALF + 4)); } \
        else { d16[0] = *(const u32x4*)(base16 + o_); d16[1] = *(const u32x4*)(base16 + o_ + HALF); } } while (0)
        EPR_LOAD(bc, hc, 0);
#pragma unroll
        for (int g = 0; g < 8; ++g) {
            const int ai = g >> 2, m = g & 3; const int row = row0 + ai * HALF + m * 16; const size_t off = (size_t)row * ldc + col0; float s = 0.f; float mx = 0.f;
            if (g < 7) EPR_LOAD(bn, hn, g + 1);
#pragma unroll
            for (int bj = 0; bj < 2; ++bj) {
                f32x4 b0, b1;
                if (base32) { b0 = bc[bj][0]; b1 = bc[bj][1]; }
                else { const u32x4 w = hc[bj]; b0 = (f32x4){__uint_as_float(w.x << 16), __uint_as_float(w.x & 0xffff0000u), __uint_as_float(w.y << 16), __uint_as_float(w.y & 0xffff0000u)};
                                              b1 = (f32x4){__uint_as_float(w.z << 16), __uint_as_float(w.z & 0xffff0000u), __uint_as_float(w.w << 16), __uint_as_float(w.w & 0xffff0000u)}; }
                const f32x4 v0 = acc[ai][bj][m][0] + b0, v1 = acc[ai][bj][m][1] + b1;
                s += (v0[0] * v0[0] + v0[1] * v0[1]) + (v0[2] * v0[2] + v0[3] * v0[3]) + (v1[0] * v1[0] + v1[1] * v1[1]) + (v1[2] * v1[2] + v1[3] * v1[3]);
                if (amax) { const f32x4 a0 = __builtin_elementwise_abs(v0), a1 = __builtin_elementwise_abs(v1); mx = fmaxf(mx, fmaxf(fmaxf(fmaxf(a0[0], a0[1]), fmaxf(a0[2], a0[3])), fmaxf(fmaxf(a1[0], a1[1]), fmaxf(a1[2], a1[3])))); }
                u32x4 w; w.x = cvt_pk_bf16(v0[0], v0[1]); w.y = cvt_pk_bf16(v0[2], v0[3]); w.z = cvt_pk_bf16(v1[0], v1[1]); w.w = cvt_pk_bf16(v1[2], v1[3]); *(u32x4*)(hb + off + bj * HALF) = w; }
            s += __shfl_xor(s, 16); s += __shfl_xor(s, 32);
            if (ss && fq == 0) atomicAdd(ss + row, (unsigned long long)(s * SS_SCALE + 0.5f));
            if (amax) { mx = fmaxf(mx, __shfl_xor(mx, 16)); mx = fmaxf(mx, __shfl_xor(mx, 32)); if (fq == 0) atomicMax(amax + row, __float_as_uint(mx)); }
#pragma unroll
            for (int bj = 0; bj < 2; ++bj) { bc[bj][0] = bn[bj][0]; bc[bj][1] = bn[bj][1]; hc[bj] = hn[bj]; }
            asm volatile("" ::: "memory");
        }
#undef EPR_LOAD
    }
};
template <bool Q> struct EpiGateUpT {
    static constexpr bool PERM = true, PERMA = true, AFTER_DRAIN = false, PREFETCH = true, I8 = Q; typedef typename std::conditional<Q, i32x4, f32x4>::type AccT; static constexpr int NST = 32;
    static constexpr int AUXN = 1024;
    static constexpr float NLOG2E = -1.4426950408889634f, NLN2 = -0.6931471805599453f;
    bf16_t* act; int ldc; const unsigned long long* ss; float inv_n; const float* cw; const float* cb; float* GF; float* UF; float* GL; int nff;
    PG8_LAS float* aux;
    const unsigned* colmax; const unsigned* amax;
    __device__ __forceinline__ float rowscale(unsigned long long s2, unsigned am) const { const float r = 1.0f / sqrtf((float)s2 * (inv_n / SS_SCALE) + RMS_EPS); return Q ? r * __uint_as_float(am) * (1.0f / 127.0f) : r; }
    __device__ __forceinline__ void prefetch(const Unit& u, int par) const {
        int tid = (int)threadIdx.x; asm volatile("" : "+v"(tid)); const int arr = tid >> 7, c = u.pn * HALF + (tid & 127);
        const float gs = Q ? __uint_as_float(colmax[c]) * (1.0f / 127.0f) : 1.0f;
        const float v = (arr < 3 ? cw[arr * nff + c] * gs : cb[c]) * NLOG2E;
        PG8_LAS float* a = aux + par * AUXN; a[tid] = v;
        if (tid < 128) a[512 + tid] = (Q ? __uint_as_float(colmax[nff + c]) * (1.0f / 127.0f) : 1.0f) * NLN2;
        if (tid < 256) { const int row = u.pm * BM + tid; a[768 + tid] = rowscale(ss[row], Q ? amax[row] : 0u); }
    }
    __device__ __forceinline__ void run(const AccT (&acc)[2][2][4][2], const Unit& u, int wr, int wc, int fr, int fq, int par, const Unit& nxt) const {
        int tid = (int)threadIdx.x; asm volatile("" : "+v"(tid)); const int arr = tid >> 7, cn = nxt.pn * HALF + (tid & 127);
        const float ncw = arr < 3 ? cw[arr * nff + cn] : cb[cn];
        const unsigned ncg = Q ? colmax[cn] : 0u, ncu = Q ? colmax[nff + cn] : 0u;
        const int nrow = nxt.pm * BM + (tid & 255);
        const unsigned long long nss = ss[nrow]; const unsigned nam = Q ? amax[nrow] : 0u;
        const PG8_LAS float* a = aux + par * AUXN;
        const int c0 = wc * 32 + 8 * fq;
        const int ch0 = u.pn * HALF + c0;
        f32x2 w0[4], w1[4], w2[4], bb[4], sl[4];
#pragma unroll
        for (int h4 = 0; h4 < 2; ++h4) { const f32x4 x0 = *(const PG8_LAS f32x4*)(a + c0 + 4 * h4), x1 = *(const PG8_LAS f32x4*)(a + 128 + c0 + 4 * h4), x2 = *(const PG8_LAS f32x4*)(a + 256 + c0 + 4 * h4), x3 = *(const PG8_LAS f32x4*)(a + 384 + c0 + 4 * h4);
            const f32x4 x4 = *(const PG8_LAS f32x4*)(a + 512 + c0 + 4 * h4);
#pragma unroll
            for (int q = 0; q < 2; ++q) { w0[2 * h4 + q] = (f32x2){x0[2 * q], x0[2 * q + 1]}; w1[2 * h4 + q] = (f32x2){x1[2 * q], x1[2 * q + 1]}; w2[2 * h4 + q] = (f32x2){x2[2 * q], x2[2 * q + 1]};
                bb[2 * h4 + q] = (f32x2){x3[2 * q], x3[2 * q + 1]}; sl[2 * h4 + q] = (f32x2){x4[2 * q], x4[2 * q + 1]}; } }
#pragma unroll
        for (int ai = 0; ai < 2; ++ai) {
            const int lrow0 = ai * HALF + wr * 64 + fr * 4;
            const int blk = (u.pm * BM + ai * HALF + wr * 64) >> 6;
            const f32x4 rs4 = *(const PG8_LAS f32x4*)(a + 768 + lrow0);
            bf16_t* arow = act + (size_t)(u.pm * BM + lrow0) * ldc + ch0;
            f32x2 g[4][4];
#pragma unroll
            for (int m = 0; m < 4; ++m)
#pragma unroll
                for (int p = 0; p < 4; ++p) g[m][p] = (f32x2){(float)acc[ai][0][m][p >> 1][2 * (p & 1)], (float)acc[ai][0][m][p >> 1][2 * (p & 1) + 1]} * rs4[m];
            f32x2 gm1[4], gm2[4];
#pragma unroll
            for (int p = 0; p < 4; ++p) {
                gm1[p] = (f32x2){__int_as_float(__builtin_amdgcn_update_dpp(0, __float_as_int(g[3][p][0]), 0x111, 0xf, 0xf, true)), __int_as_float(__builtin_amdgcn_update_dpp(0, __float_as_int(g[3][p][1]), 0x111, 0xf, 0xf, true))};
                gm2[p] = (f32x2){__int_as_float(__builtin_amdgcn_update_dpp(0, __float_as_int(g[2][p][0]), 0x111, 0xf, 0xf, true)), __int_as_float(__builtin_amdgcn_update_dpp(0, __float_as_int(g[2][p][1]), 0x111, 0xf, 0xf, true))}; }
#pragma unroll
            for (int m = 0; m < 4; ++m) {
                u32x4 w; f32x2 upv[4];
#pragma unroll
                for (int p = 0; p < 4; ++p) {
                    const f32x2 r1 = m >= 1 ? g[m >= 1 ? m - 1 : 0][p] : gm1[p], r2 = m >= 2 ? g[m >= 2 ? m - 2 : 0][p] : (m == 1 ? gm1[p] : gm2[p]);
                    const f32x2 y = bb[p] + w2[p] * g[m][p] + w1[p] * r1 + w0[p] * r2;
                    const f32x2 d = (f32x2){__builtin_amdgcn_exp2f(y[0]), __builtin_amdgcn_exp2f(y[1])} + 1.0f;
                    const f32x2 sg = {__builtin_amdgcn_rcpf(d[0]), __builtin_amdgcn_rcpf(d[1])};
                    upv[p] = (f32x2){(float)acc[ai][1][m][p >> 1][2 * (p & 1)], (float)acc[ai][1][m][p >> 1][2 * (p & 1) + 1]} * (sl[p] * rs4[m]);
                    const f32x2 av = y * sg * upv[p];
                    w[p] = cvtpk_e(av[0], av[1]);
                }
                if (m >= 2 || fr != 0) __builtin_nontemporal_store(w, (u32x4*)(arow + (size_t)m * ldc));
                if (m < 2 && fr == 0) { float* gp = GF + ((size_t)blk * 2 + m) * nff + ch0; float* upp = UF + ((size_t)blk * 2 + m) * nff + ch0;
                    *(f32x4*)gp = (f32x4){g[m][0][0], g[m][0][1], g[m][1][0], g[m][1][1]}; *(f32x4*)(gp + 4) = (f32x4){g[m][2][0], g[m][2][1], g[m][3][0], g[m][3][1]};
                    *(f32x4*)upp = (f32x4){upv[0][0], upv[0][1], upv[1][0], upv[1][1]}; *(f32x4*)(upp + 4) = (f32x4){upv[2][0], upv[2][1], upv[3][0], upv[3][1]}; }
                if (m >= 2 && fr == 15) { float* gp = GL + ((size_t)blk * 2 + (m - 2)) * nff + ch0;
                    *(f32x4*)gp = (f32x4){g[m][0][0], g[m][0][1], g[m][1][0], g[m][1][1]}; *(f32x4*)(gp + 4) = (f32x4){g[m][2][0], g[m][2][1], g[m][3][0], g[m][3][1]}; }
            }
        }
        PG8_LAS float* an = aux + (par ^ 1) * AUXN;
        an[tid] = (arr < 3 ? ncw * (Q ? __uint_as_float(ncg) * (1.0f / 127.0f) : 1.0f) : ncw) * NLOG2E;
        if (tid < 128) an[512 + tid] = (Q ? __uint_as_float(ncu) * (1.0f / 127.0f) : 1.0f) * NLN2;
        if (tid < 256) an[768 + tid] = rowscale(nss, nam);
    }
};
typedef EpiGateUpT<false> EpiGateUp;
typedef EpiGateUpT<true> EpiGateUpQ;
struct EpiNull {
    static constexpr bool PERM = true, PERMA = false, AFTER_DRAIN = false, PREFETCH = false, I8 = false; typedef f32x4 AccT; static constexpr int NST = 0;
    __device__ __forceinline__ void operator()(const f32x4 (&acc)[2][2][4][2], const Unit& u, int wr, int wc, int fr, int fq) const {
#pragma unroll
        for (int ai = 0; ai < 2; ++ai)
#pragma unroll
            for (int bj = 0; bj < 2; ++bj)
#pragma unroll
                for (int m = 0; m < 4; ++m)
#pragma unroll
                    for (int n = 0; n < 2; ++n) asm volatile("" :: "v"(acc[ai][bj][m][n]));
    }
};
template <bool I8> __device__ __forceinline__ auto pg8_mma(bf16x8 b, bf16x8 a, typename std::conditional<I8, i32x4, f32x4>::type c) {
    if constexpr (I8) return __builtin_amdgcn_mfma_i32_16x16x64_i8(__builtin_bit_cast(i32x4, b), __builtin_bit_cast(i32x4, a), c, 0, 0, 0);
    else return __builtin_amdgcn_mfma_f32_16x16x32_bf16(b, a, c, 0, 0, 0);
}
#ifndef PG_RELAXW
#define PG_RELAXW 1
#endif
template <class Epi, class Sched, bool ALIGN_EPI = false, bool SP2 = false>
__device__ __forceinline__ void gemm_phase(PG8_LAS unsigned char* lds, const Gemm g, const Sched& S, const Epi& E) {
    const int tid = threadIdx.x, wid = __builtin_amdgcn_readfirstlane(tid >> 6), lane = tid & 63, wr = wid >> 2, wc = wid & 3, fr = lane & 15, fq = lane >> 4;
    const int K = g.K, nt = K / BK;
    unsigned voffA[2], voffB[2];
#pragma unroll
    for (int i = 0; i < 2; ++i) { int R, C; stage_rc(tid * 16 + i * 8192, R, C); const int Rb = Epi::PERM ? ((R & ~31) + perm32(R & 31)) : R;
        const int Ra = Epi::PERMA ? ((R & 64) | ((R & 15) << 2) | ((R >> 4) & 3)) : R;
        voffA[i] = (unsigned)(Ra * K + C) * 2u; voffB[i] = (unsigned)(Rb * K + C) * 2u; }
    const size_t kstep = (size_t)(BK * 2);
    const size_t hstep = (size_t)HALF * K * 2;
    const size_t tstep = 2 * hstep;
    const unsigned ldsw = (unsigned)wid * 1024u;
    const int aoff = lds_byte(wr * 64 + fr, fq * 8), boff = lds_byte(wc * 32 + fr, fq * 8);
#define PG8_SA(b, h) (((b) * 2 + (h)) * HTB)
#define PG8_SB(b, h) ((4 + (b) * 2 + (h)) * HTB)
#define PG8_STAGE(bufoff, gbase, voff) do { _Pragma("unroll") for (int _i = 0; _i < 2; ++_i) \
        __builtin_amdgcn_global_load_lds((const unsigned*)((const char*)(gbase) + (voff)[_i]), (PG8_LAS unsigned*)(lds + (bufoff) + ldsw + _i * 8192), 16, 0, 0); } while (0)
#define PG8_LDA(dst, b, h) do { _Pragma("unroll") for (int m = 0; m < 4; ++m) _Pragma("unroll") for (int k = 0; k < 2; ++k) dst[m][k] = *(const PG8_LAS bf16x8*)(lds + PG8_SA(b, h) + aoff + m * 2048 + k * 1024); } while (0)
#define PG8_LDB(dst, b, h) do { _Pragma("unroll") for (int n = 0; n < 2; ++n) _Pragma("unroll") for (int k = 0; k < 2; ++k) dst[n][k] = *(const PG8_LAS bf16x8*)(lds + PG8_SB(b, h) + boff + n * 2048 + k * 1024); } while (0)
#define PG8_MMA(ai, bj, At, Bt) do { __builtin_amdgcn_s_setprio(1); _Pragma("unroll") for (int m = 0; m < 4; ++m) _Pragma("unroll") for (int n = 0; n < 2; ++n) _Pragma("unroll") for (int k = 0; k < 2; ++k) \
        acc[ai][bj][m][n] = pg8_mma<Epi::I8>(Bt[n][k], At[m][k], acc[ai][bj][m][n]); __builtin_amdgcn_s_setprio(0); } while (0)
#define PG8_WAIT_V(n) asm volatile("s_waitcnt vmcnt(" #n ")" ::: "memory")
#define PG8_WAIT_L(n) asm volatile("s_waitcnt lgkmcnt(" #n ")" ::: "memory")
#define PG8_WAIT_VR(rlx, n) asm volatile("s_waitcnt vmcnt(%1)\n\ts_cmp_lg_u32 %0, 0\n\ts_cbranch_scc1 .Lrw%=\n\ts_waitcnt vmcnt(8)\n.Lrw%=:" :: "s"(rlx), "n"(n) : "scc", "memory")
#define PG8_BAR __builtin_amdgcn_s_barrier()
#define PG8_SCHED __builtin_amdgcn_sched_barrier(0)
    Unit cur, nxt; int ui = 0;
    if (!S.next(0, cur)) return;
    typedef typename Epi::AccT AccT; AccT acc[2][2][4][2];
#pragma unroll
    for (int a = 0; a < 2; ++a)
#pragma unroll
        for (int b = 0; b < 2; ++b)
#pragma unroll
            for (int m = 0; m < 4; ++m)
#pragma unroll
                for (int n = 0; n < 2; ++n) acc[a][b][m][n] = AccT{};
    bf16x8 At[4][2], B0[2][2], B1[2][2];
    const char* cA = (const char*)g.A + (size_t)cur.pm * tstep; const char* cB = (const char*)g.Bt + (size_t)cur.pn * tstep;
    S.a_ready(cur);
    if constexpr (Epi::PREFETCH) E.prefetch(cur, 0);
    if constexpr (SP2) {
        PG8_STAGE(PG8_SB(0, 0), cB, voffB); PG8_STAGE(PG8_SB(0, 1), cB + hstep, voffB); PG8_STAGE(PG8_SA(0, 0), cA, voffA); PG8_STAGE(PG8_SA(0, 1), cA + hstep, voffA);
        if (wr == 1) PG8_BAR;
        PG8_WAIT_V(2); PG8_BAR;
        PG8_STAGE(PG8_SB(1, 0), cB + kstep, voffB); PG8_STAGE(PG8_SA(1, 0), cA + kstep, voffA); PG8_STAGE(PG8_SB(1, 1), cB + hstep + kstep, voffB);
        PG8_WAIT_V(6); PG8_BAR;
    } else {
        PG8_STAGE(PG8_SB(0, 0), cB, voffB); PG8_STAGE(PG8_SA(0, 0), cA, voffA); PG8_STAGE(PG8_SB(0, 1), cB + hstep, voffB); PG8_STAGE(PG8_SA(0, 1), cA + hstep, voffA);
        if (wr == 1) PG8_BAR;
        PG8_WAIT_V(4); PG8_BAR;
        PG8_STAGE(PG8_SB(1, 0), cB + kstep, voffB); PG8_STAGE(PG8_SA(1, 0), cA + kstep, voffA); PG8_STAGE(PG8_SB(1, 1), cB + hstep + kstep, voffB);
        PG8_WAIT_V(6); PG8_BAR;
    }
    for (;;) {
        const bool has_next = S.next(ui + 1, nxt);
        const char* nA = has_next ? (const char*)g.A + (size_t)nxt.pm * tstep : cA; const char* nB = has_next ? (const char*)g.Bt + (size_t)nxt.pn * tstep : cB;
        for (int t = 0; t < nt; t += 2) {
            const bool last = (t == nt - 2);
            const char* a1 = cA + (size_t)(t + 1) * kstep;
            const char* a2 = last ? nA : cA + (size_t)(t + 2) * kstep; const char* b2 = last ? nB : cB + (size_t)(t + 2) * kstep;
            const char* a3 = a2 + kstep; const char* b3 = b2 + kstep;
            if (last && has_next) S.a_ready(nxt);
            const int rl = __builtin_amdgcn_readfirstlane((PG_RELAXW && (t == 0) && (ui > 0)) ? 1 : 0);
            if constexpr (SP2) {
            PG8_LDB(B0, 0, 0); PG8_LDB(B1, 0, 1); PG8_SCHED; PG8_LDA(At, 0, 0); PG8_STAGE(PG8_SA(1, 1), a1 + hstep, voffA);
            PG8_WAIT_VR(rl, 8 + Epi::NST); PG8_WAIT_L(0); PG8_BAR; PG8_MMA(0, 0, At, B0); PG8_MMA(0, 1, At, B1); PG8_BAR; PG8_SCHED;
            PG8_LDA(At, 0, 1); PG8_STAGE(PG8_SB(0, 0), b2, voffB); PG8_STAGE(PG8_SB(0, 1), b2 + hstep, voffB); PG8_STAGE(PG8_SA(0, 0), a2, voffA);
            PG8_WAIT_VR(rl, 8 + Epi::NST); PG8_WAIT_L(0); PG8_BAR; PG8_MMA(1, 0, At, B0); PG8_MMA(1, 1, At, B1); PG8_BAR; PG8_SCHED;
            PG8_LDB(B0, 1, 0); PG8_LDB(B1, 1, 1); PG8_SCHED; PG8_LDA(At, 1, 0); PG8_STAGE(PG8_SA(0, 1), a2 + hstep, voffA);
            PG8_WAIT_V(8); PG8_WAIT_L(0); PG8_BAR; PG8_MMA(0, 0, At, B0); PG8_MMA(0, 1, At, B1); PG8_BAR; PG8_SCHED;
            PG8_LDA(At, 1, 1); PG8_STAGE(PG8_SB(1, 0), b3, voffB); PG8_STAGE(PG8_SB(1, 1), b3 + hstep, voffB); PG8_STAGE(PG8_SA(1, 0), a3, voffA);
            PG8_WAIT_V(8); PG8_WAIT_L(0); PG8_BAR; PG8_MMA(1, 0, At, B0); PG8_MMA(1, 1, At, B1); PG8_BAR; PG8_SCHED;
            } else {
            PG8_LDB(B0, 0, 0); PG8_SCHED; PG8_LDA(At, 0, 0); PG8_STAGE(PG8_SA(1, 1), a1 + hstep, voffA);
            PG8_WAIT_L(8); PG8_BAR; PG8_WAIT_L(0); PG8_MMA(0, 0, At, B0); PG8_BAR; PG8_SCHED;
            PG8_LDB(B1, 0, 1); PG8_STAGE(PG8_SB(0, 0), b2, voffB);
            PG8_BAR; PG8_WAIT_L(0); PG8_MMA(0, 1, At, B1); PG8_BAR;
            PG8_LDA(At, 0, 1); PG8_STAGE(PG8_SA(0, 0), a2, voffA);
            PG8_BAR; PG8_WAIT_L(0); PG8_MMA(1, 0, At, B0); PG8_BAR; PG8_SCHED;
            PG8_STAGE(PG8_SB(0, 1), b2 + hstep, voffB);
            PG8_WAIT_V(6); PG8_BAR; PG8_MMA(1, 1, At, B1); PG8_BAR;
            PG8_LDB(B0, 1, 0); PG8_SCHED; PG8_LDA(At, 1, 0); PG8_STAGE(PG8_SA(0, 1), a2 + hstep, voffA);
            PG8_WAIT_L(8); PG8_BAR; PG8_WAIT_L(0); PG8_MMA(0, 0, At, B0); PG8_BAR; PG8_SCHED;
            PG8_LDB(B1, 1, 1); PG8_STAGE(PG8_SB(1, 0), b3, voffB);
            PG8_BAR; PG8_WAIT_L(0); PG8_MMA(0, 1, At, B1); PG8_BAR;
            PG8_LDA(At, 1, 1); PG8_STAGE(PG8_SA(1, 0), a3, voffA);
            PG8_BAR; PG8_WAIT_L(0); PG8_MMA(1, 0, At, B0); PG8_BAR; PG8_SCHED;
            PG8_STAGE(PG8_SB(1, 1), b3 + hstep, voffB);
            PG8_WAIT_V(6); PG8_BAR; PG8_MMA(1, 1, At, B1); PG8_BAR;
            }
        }
        if constexpr (ALIGN_EPI) { if (wr == 0) PG8_BAR; }
        if constexpr (!Epi::AFTER_DRAIN) { if constexpr (Epi::PREFETCH) E.run(acc, cur, wr, wc, fr, fq, ui & 1, has_next ? nxt : cur); else E(acc, cur, wr, wc, fr, fq); S.done(cur); }
        if (!has_next) break;
#pragma unroll
        for (int a = 0; a < 2; ++a)
#pragma unroll
            for (int b = 0; b < 2; ++b)
#pragma unroll
                for (int m = 0; m < 4; ++m)
#pragma unroll
                    for (int n = 0; n < 2; ++n) acc[a][b][m][n] = AccT{};
        cur = nxt; cA = nA; cB = nB; ++ui;
        if constexpr (ALIGN_EPI) { if (wr == 1) PG8_BAR; }
    }
    PG8_WAIT_V(0);
    if constexpr (!ALIGN_EPI) { if (wr == 0) PG8_BAR; }
    PG8_BAR;
    if constexpr (Epi::AFTER_DRAIN) { E.fused(acc, cur, wr, wc, fr, fq, lds, wid, lane); S.done(cur); }
#undef PG8_SA
#undef PG8_SB
#undef PG8_STAGE
#undef PG8_LDA
#undef PG8_LDB
#undef PG8_MMA
#undef PG8_WAIT_V
#undef PG8_WAIT_L
#undef PG8_WAIT_VR
#undef PG8_BAR
#undef PG8_SCHED
}
}
namespace att {
constexpr int D = 128; constexpr float THR = 8.f; constexpr bool WSKIP = true;
constexpr float SCALE = 0.08838834764831845f;
constexpr int NW = 8, QBLK = 32, KVBLK = 64, QB = NW * QBLK;
constexpr int SHM_V = KVBLK * D * 2, SHM_K = KVBLK * D * 2;
constexpr int LDS_TAB = 2 * SHM_V + 2 * SHM_K + NW * 64 * 4, TAB_N = 328, TAB_OFF = 100, TAB_PITCH = 4 * TAB_N;
constexpr int LDS_BYTES = LDS_TAB + 2 * TAB_PITCH * 4;
using bf16 = __hip_bfloat16;
typedef short bf16x8 __attribute__((ext_vector_type(8)));
typedef short s16x4 __attribute__((ext_vector_type(4)));
typedef float f32x16 __attribute__((ext_vector_type(16)));
typedef float f32x4 __attribute__((ext_vector_type(4)));
typedef float f32x2 __attribute__((ext_vector_type(2)));
typedef unsigned u32x4 __attribute__((ext_vector_type(4)));
template <class A, class Bt> struct same_t { static constexpr bool v = false; };
template <class A> struct same_t<A, A> { static constexpr bool v = true; };

#define KSWZ(row, colB) ((row) * 256 + ((colB) ^ (((row) & 7) << 4)))
#define SBAR() __builtin_amdgcn_sched_barrier(0)
__device__ __forceinline__ int v_st(int k, int c) { const int kk = (k & ~0xC) | ((k & 4) << 1) | ((k & 8) >> 1); return ((kk >> 3) * 4 + (c >> 5)) * 512 + ((kk & 7) * 32 + (c & 31)) * 2; }
__device__ __forceinline__ int v_rd_base(int lane) { return ((lane & 3) << 3) | (((lane >> 2) & 3) << 6) | (((lane >> 4) & 1) << 5) | (((lane >> 5) & 1) << 8); }
constexpr int v_rd_off(int d0, int ks, int half) { return d0 * 512 + ks * 4096 + half * 2048; }
__device__ __forceinline__ int crow(int r, int hi) { return (r & 3) + 8 * (r >> 2) + 4 * hi; }
__device__ __forceinline__ unsigned cvtpk(float lo, float hi) {
    unsigned r; asm volatile("v_cvt_pk_bf16_f32 %0, %1, %2" : "=v"(r) : "v"(lo), "v"(hi)); return r;
}
__device__ __forceinline__ bf16x8 pack8(f32x4 a, f32x4 b) {
    u32x4 w = {cvtpk(a[0], a[1]), cvtpk(a[2], a[3]), cvtpk(b[0], b[1]), cvtpk(b[2], b[3])};
    return *reinterpret_cast<bf16x8*>(&w);
}
template <class T> __device__ __forceinline__ bf16x8 load8(const T* p) {
    if constexpr (same_t<T, float>::v) { return pack8(*(const f32x4*)p, *(const f32x4*)(p + 4)); }
    else { return *reinterpret_cast<const bf16x8*>(p); }
}
__device__ __forceinline__ void mask_tile(f32x16& p0, f32x16& p1, int dq, unsigned W) {
    const float NEG = -__builtin_inff();
#pragma unroll
    for (int r = 0; r < 16; ++r) {
        const int c = (r & 3) + 8 * (r >> 2);
        if ((unsigned)(dq - c) >= W) p0[r] = NEG;
        if ((unsigned)(dq - c - 32) >= W) p1[r] = NEG;
    }
}
__device__ __forceinline__ void bias_mask_tile(f32x16& p0, f32x16& p1, int dq, unsigned W, const float* tabu, bool needmask) {
    const float NEG = -__builtin_inff();
    const int sft = (4 - ((int)threadIdx.x & 3)) & 3;
    const float* t0 = tabu + (sft * (TAB_N - 1) + TAB_OFF + 128 - dq);
#pragma unroll
    for (int J = 0; J < 8; ++J) {
        const f32x4 b = *(const f32x4*)(t0 + 8 * J);
#pragma unroll
        for (int e = 0; e < 4; ++e) {
            const int r = 4 * (J & 3) + e; const int c = e + 8 * (J & 3) + (J >= 4 ? 32 : 0);
            float v = (J < 4 ? p0[r] : p1[r]) + b[e];
            if (needmask) { if ((unsigned)(dq - c) >= W) v = NEG; }
            if (J < 4) p0[r] = v; else p1[r] = v;
        }
        if ((J & 1) == 1) asm volatile("" ::: "memory");
    }
}
__device__ __forceinline__ void bias_fill(float* T, const float* bsrc, int tid) {
    asm volatile("" : "+v"(tid));
    if (tid < TAB_N) {
#pragma unroll
        for (int sf = 0; sf < 4; ++sf) { const int i = tid - TAB_OFF + sf; T[sf * TAB_N + tid] = (i >= 0 && i <= 128) ? bsrc[128 - i] : 0.f; }
    }
}
__device__ __forceinline__ void partialSM(f32x16& p0, f32x16& p1, float& m_reg, float& mn, float& alpha) {
    float pmax = p0[0]; for (int r = 1; r < 16; ++r) pmax = fmaxf(pmax, p0[r]); for (int r = 0; r < 16; ++r) pmax = fmaxf(pmax, p1[r]);
    { auto rr = __builtin_amdgcn_permlane32_swap(__float_as_uint(pmax), __float_as_uint(pmax), false, false);
      pmax = fmaxf(__uint_as_float(rr[0]), __uint_as_float(rr[1])); }
    constexpr float C2 = 1.4426950408889634f * SCALE;
    if (__builtin_expect(__all((pmax - m_reg) * SCALE <= THR), 1)) { mn = m_reg; alpha = 1.f; }
    else { mn = fmaxf(m_reg, pmax); alpha = __builtin_amdgcn_exp2f((m_reg - mn) * C2); m_reg = mn; }
    const float mnL = -mn * C2;
    for (int r = 0; r < 16; ++r) p0[r] = fmaf(p0[r], C2, mnL); for (int r = 0; r < 16; ++r) p1[r] = fmaf(p1[r], C2, mnL);
    for (int r = 0; r < 16; ++r) p0[r] = __builtin_amdgcn_exp2f(p0[r]);
}
__device__ __forceinline__ void finishSM(f32x16& p0, f32x16& p1, float alpha, float& l_reg, bf16x8& pa0, bf16x8& pa1, bf16x8& pa2, bf16x8& pa3) {
    for (int r = 0; r < 16; ++r) p1[r] = __builtin_amdgcn_exp2f(p1[r]);
    float ps = 0; for (int r = 0; r < 16; ++r) ps += p0[r]; for (int r = 0; r < 16; ++r) ps += p1[r];
    { auto rr = __builtin_amdgcn_permlane32_swap(__float_as_uint(ps), __float_as_uint(ps), false, false);
      ps = __uint_as_float(rr[0]) + __uint_as_float(rr[1]); }
    l_reg = l_reg * alpha + ps;
#define PK4(P, B_, OUT) do { unsigned a0 = cvtpk(P[B_+0], P[B_+1]), a1 = cvtpk(P[B_+2], P[B_+3]);                          \
        unsigned b0 = cvtpk(P[B_+4], P[B_+5]), b1 = cvtpk(P[B_+6], P[B_+7]);                                             \
        auto r0 = __builtin_amdgcn_permlane32_swap(a0, b0, false, false); auto r1 = __builtin_amdgcn_permlane32_swap(a1, b1, false, false); \
        u32x4 w = {r0[0], r1[0], r0[1], r1[1]}; OUT = *reinterpret_cast<bf16x8*>(&w); } while (0)
    PK4(p0, 0, pa0); PK4(p0, 8, pa1); PK4(p1, 0, pa2); PK4(p1, 8, pa3);
#undef PK4
}
template <int KB, bool SK>
__device__ __forceinline__ void qkt(f32x16& p0, f32x16& p1, const char* K_lds, int r32, int hi, const bf16x8* qr, bool act) {
    if (SK && !act) { const float NEG = -__builtin_inff();
#pragma unroll
        for (int r = 0; r < 16; ++r) { p0[r] = NEG; p1[r] = NEG; } return; }
    p0 = f32x16{}; p1 = f32x16{};
    const char* kb[4];
#pragma unroll
    for (int dd = 0; dd < 4; ++dd) kb[dd] = K_lds + KB * SHM_K + KSWZ(r32, (dd * 16 + hi * 8) * 2);
#pragma unroll
    for (int d0 = 0; d0 < 8; ++d0) { const char* a = kb[d0 & 3] + (d0 >> 2) * 128;
        bf16x8 b0 = *reinterpret_cast<const bf16x8*>(a);
        bf16x8 b1 = *reinterpret_cast<const bf16x8*>(a + 32 * 256);
        p0 = __builtin_amdgcn_mfma_f32_32x32x16_bf16(b0, qr[d0], p0, 0, 0, 0);
        p1 = __builtin_amdgcn_mfma_f32_32x32x16_bf16(b1, qr[d0], p1, 0, 0, 0); }
}
template <int VB, bool SK>
__device__ __forceinline__ void pv_tile(f32x16* o, int vb0, bf16x8 pa0, bf16x8 pa1, bf16x8 pa2, bf16x8 pa3, bool act) {
    if (SK && !act) return;
#define TRRD(dst, off) asm volatile("ds_read_b64_tr_b16 %0, %1 offset:%2" : "=&v"(dst) : "v"(vb0), "i"(off) : "memory")
#define PV_D0(d0) do { s16x4 l0, l1, l2, l3, h0, h1, h2, h3; constexpr int b_ = VB * SHM_V + v_rd_off(d0, 0, 0);     \
        TRRD(l0, b_); TRRD(h0, b_ + 2048); TRRD(l1, b_ + 4096); TRRD(h1, b_ + 6144); TRRD(l2, b_ + 8192); TRRD(h2, b_ + 10240); TRRD(l3, b_ + 12288); TRRD(h3, b_ + 14336); \
        asm volatile("s_waitcnt lgkmcnt(0)" ::: "memory"); SBAR();                 \
        o[d0] = __builtin_amdgcn_mfma_f32_32x32x16_bf16(pa0, (bf16x8){l0[0], l0[1], l0[2], l0[3], h0[0], h0[1], h0[2], h0[3]}, o[d0], 0, 0, 0);   \
        o[d0] = __builtin_amdgcn_mfma_f32_32x32x16_bf16(pa1, (bf16x8){l1[0], l1[1], l1[2], l1[3], h1[0], h1[1], h1[2], h1[3]}, o[d0], 0, 0, 0);   \
        o[d0] = __builtin_amdgcn_mfma_f32_32x32x16_bf16(pa2, (bf16x8){l2[0], l2[1], l2[2], l2[3], h2[0], h2[1], h2[2], h2[3]}, o[d0], 0, 0, 0);   \
        o[d0] = __builtin_amdgcn_mfma_f32_32x32x16_bf16(pa3, (bf16x8){l3[0], l3[1], l3[2], l3[3], h3[0], h3[1], h3[2], h3[3]}, o[d0], 0, 0, 0); } while (0)
    PV_D0(0); PV_D0(1); PV_D0(2); PV_D0(3);
#undef PV_D0
#undef TRRD
}

template <class TIn, class TOut> struct BlockRef { const TIn* Q; const TIn* K; const TIn* V; TOut* O; float* L; const float* bsrc; int P0, pq, pk, po, pl, skv, W; };
template <class TIn> struct Seam {
    bf16x8 qr[8];
    bf16x8 st_v0, st_v1, st_k0, st_k1; f32x4 sf0, sf1, sf2, sf3;
    f32x4 tq[16];
};
__device__ __forceinline__ int swa_jlo(int P0, int W) { const int lowk = P0 - W + 1; return lowk > 0 ? lowk / KVBLK : 0; }
#define ROW(p, pit, k0, rr) ((p) + (unsigned)(((k0) + (rr)) * (pit) + sc))
#define VMW() asm volatile("s_waitcnt vmcnt(0)" ::: "memory")
#define VMWN(n) asm volatile("s_waitcnt vmcnt(%0)" :: "i"(n) : "memory")
#define SLOAD_H(Kp, Vp, pit, k0) do { S.st_v0 = load8<TIn>(ROW(Vp, pit, k0, sr)); S.st_v1 = load8<TIn>(ROW(Vp, pit, k0, 32 + sr));              \
                         S.st_k0 = load8<TIn>(ROW(Kp, pit, k0, sr)); S.st_k1 = load8<TIn>(ROW(Kp, pit, k0, 32 + sr)); } while (0)
#define SWRITE_HK(bf) do { *(bf16x8*)(K_lds + (bf) * SHM_K + kws) = S.st_k0; *(bf16x8*)(K_lds + (bf) * SHM_K + kws + 32 * 256) = S.st_k1; } while (0)
#define SWRITE_HV(bf) do { *(bf16x8*)(V_lds + (bf) * SHM_V + vst0) = S.st_v0; *(bf16x8*)(V_lds + (bf) * SHM_V + vst1) = S.st_v1; } while (0)
#define SWRITE_H(bf) do { SWRITE_HV(bf); SWRITE_HK(bf); } while (0)
#define SLOAD_F(p, k0) do { S.sf0 = *(const f32x4*)ROW(p, D, k0, sr); S.sf1 = *(const f32x4*)(ROW(p, D, k0, sr) + 4);                \
                            S.sf2 = *(const f32x4*)ROW(p, D, k0, 32 + sr); S.sf3 = *(const f32x4*)(ROW(p, D, k0, 32 + sr) + 4); } while (0)
#define SWRITE_KF(bf) do { *(bf16x8*)(K_lds + (bf) * SHM_K + kws) = pack8(S.sf0, S.sf1); *(bf16x8*)(K_lds + (bf) * SHM_K + kws + 32 * 256) = pack8(S.sf2, S.sf3); } while (0)
#define SWRITE_VF(bf) do { *(bf16x8*)(V_lds + (bf) * SHM_V + vst0) = pack8(S.sf0, S.sf1); *(bf16x8*)(V_lds + (bf) * SHM_V + vst1) = pack8(S.sf2, S.sf3); } while (0)
template <int BIAS, class TIn, class TOut>
__device__ __forceinline__ void causal_swa_prime(const BlockRef<TIn, TOut>& cur, char* lds, Seam<TIn>& S) {
    const int W = cur.W;
    constexpr bool F32 = same_t<TIn, float>::v;
    const int tid = threadIdx.x, wid = __builtin_amdgcn_readfirstlane(tid >> 6), lane = tid & 63, r32 = lane & 31, hi = lane >> 5;
    const int sr = tid >> 4, sc = (tid & 15) * 8, kws = KSWZ(sr, sc * 2); char* K_lds = lds + 2 * SHM_V;
    const int kb0 = swa_jlo(cur.P0, W) * KVBLK;
    if (BIAS == 1 || BIAS == 3) bias_fill((float*)(lds + LDS_TAB), cur.bsrc, tid);
    for (int d0 = 0; d0 < 8; ++d0) S.qr[d0] = load8<TIn>(cur.Q + (unsigned)((wid * QBLK + r32) * cur.pq + d0 * 16 + hi * 8));
    if constexpr (F32) { SLOAD_F((const float*)cur.K, kb0); VMW(); SWRITE_KF(0); SBAR(); SLOAD_F((const float*)cur.V, kb0); }
    else { SLOAD_H(cur.K, cur.V, cur.pk, kb0); VMW(); SWRITE_HK(0); }
    __syncthreads();
}
template <int BIAS, class TIn, class TOut, class ItemFn>
__device__ __forceinline__ void causal_swa_block(const BlockRef<TIn, TOut>& cur, int Lnext, const ItemFn& itemfn, int par, char* lds, Seam<TIn>& S) {
    const int skv = cur.skv, W = cur.W;
    const float* tab = (const float*)(lds + LDS_TAB) + par * TAB_PITCH;
    constexpr bool F32 = same_t<TIn, float>::v;
    const int tid = threadIdx.x, wid = __builtin_amdgcn_readfirstlane(tid >> 6), lane = tid & 63, r32 = lane & 31, hi = lane >> 5;
    const int j_lo = swa_jlo(cur.P0, W);
    int j_hi = (cur.P0 + QB - 1) / KVBLK + 1; if (j_hi > skv / KVBLK) j_hi = skv / KVBLK;
    const int NT = j_hi - j_lo;
    const int qlo = cur.P0 + wid * QBLK, qm = qlo + r32 - 4 * hi;
    char* V_lds = lds; char* K_lds = lds + 2 * SHM_V;
    float* ws = (float*)(lds + 2 * SHM_V + 2 * SHM_K) + wid * 64; float* li_l = ws, * al_l = ws + 32;
    float m_reg = -1e30f, l_reg = 0; f32x16 o[4] = {};
    const int sr = tid >> 4, sc = (tid & 15) * 8, vst0 = v_st(sr, sc), vst1 = v_st(32 + sr, sc), kws = KSWZ(sr, sc * 2);
    const int vb0 = (int)(uintptr_t)V_lds + v_rd_base(lane);
    const TIn* Kh = cur.K; const TIn* Vh = cur.V;
#define RESC(a) do { if (__any((a) < 1.f)) { if (hi == 0) al_l[r32] = (a); asm volatile("s_waitcnt lgkmcnt(0)" ::: "memory");              \
                     for (int d_ = 0; d_ < 4; ++d_) for (int r = 0; r < 16; ++r) o[d_][r] *= al_l[crow(r, hi)]; } } while (0)
#define KBASE(t) ((j_lo + (t)) * KVBLK)
#define ACT(t) (KBASE(t) <= qlo + QBLK - 1 && KBASE(t) + KVBLK - 1 >= qlo - W + 1)
#define MASKT(P0_, P1_, t) do { const int kb_ = KBASE(t); if constexpr (BIAS == 1 || BIAS == 2) { if (!SK || ACT(t)) bias_mask_tile(P0_, P1_, qm - kb_, (unsigned)W, tab, kb_ + KVBLK - 1 > qlo || kb_ <= qlo + QBLK - 1 - W); } \
        else { if ((!SK || ACT(t)) && (kb_ + KVBLK - 1 > qlo || kb_ <= qlo + QBLK - 1 - W)) mask_tile(P0_, P1_, qm - kb_, (unsigned)W); } } while (0)
    constexpr int NQL = F32 ? 16 : 8;
    constexpr bool SK = WSKIP && !F32;
#define SEAM_K0() do { VMWN(NQL); if constexpr (F32) { SWRITE_KF(0); SBAR(); SLOAD_F((const float*)nxt.V, kbn); } else { SWRITE_HK(0); } SBAR(); } while (0)
    f32x16 pA0, pA1, pB0, pB1; float mnA, mnB, alA, alB; bf16x8 pa0, pa1, pa2, pa3;
    if constexpr (F32) { VMW(); SWRITE_VF(0); SBAR(); } else { SWRITE_HV(0); SBAR(); }
    if (NT > 1) { if constexpr (F32) SLOAD_F((const float*)Kh, KBASE(1)); else SLOAD_H(Kh, Vh, cur.pk, KBASE(1)); }
    SBAR(); qkt<0, SK>(pA0, pA1, K_lds, r32, hi, S.qr, ACT(0));
    if constexpr (F32) { if (NT > 1) { VMW(); SWRITE_KF(1); SBAR(); SLOAD_F((const float*)Vh, KBASE(1)); } }
    MASKT(pA0, pA1, 0); partialSM(pA0, pA1, m_reg, mnA, alA);
    if (NT > 1) { VMW(); if constexpr (F32) { SWRITE_VF(1); SBAR(); if (NT > 2) SLOAD_F((const float*)Kh, KBASE(2)); } else SWRITE_H(1); }
    __syncthreads();
#define HALF_STEP(PX0, PX1, mnX, alX, PY0, PY1, alY, t, KB, VB, SB) do {                                                      \
        SBAR(); qkt<KB, SK>(PX0, PX1, K_lds, r32, hi, S.qr, ACT(t));                                             \
        finishSM(PY0, PY1, alY, l_reg, pa0, pa1, pa2, pa3); SBAR();                                                           \
        if ((t) + 1 < NT) { if constexpr (F32) { VMW(); SWRITE_KF(SB); SBAR(); SLOAD_F((const float*)Vh, KBASE((t) + 1)); }  \
                            else { SLOAD_H(Kh, Vh, cur.pk, KBASE((t) + 1)); } SBAR(); }                                               \
        pv_tile<VB, SK>(o, vb0, pa0, pa1, pa2, pa3, ACT((t) - 1)); MASKT(PX0, PX1, (t)); partialSM(PX0, PX1, m_reg, mnX, alX);                                        \
        __syncthreads();                                                                                                      \
        if ((t) + 1 < NT) { VMW(); if constexpr (F32) { SWRITE_VF(SB); SBAR(); if ((t) + 2 < NT) SLOAD_F((const float*)Kh, KBASE((t) + 2)); } \
                            else { SWRITE_H(SB); } }                                                                          \
        RESC(alX); __syncthreads(); } while (0)
    for (int t = 1; t + 1 < NT; t += 2) {
        HALF_STEP(pB0, pB1, mnB, alB, pA0, pA1, alA, t, 1, 0, 0);
        HALF_STEP(pA0, pA1, mnA, alA, pB0, pB1, alB, t + 1, 0, 1, 1);
    }
    asm volatile("" : "+s"(Lnext));
    const BlockRef<TIn, TOut> nxt = itemfn(Lnext); const int kbn = swa_jlo(nxt.P0, nxt.W) * KVBLK;
    const bool even = (NT & 1) == 0;
    if (even) { SBAR(); qkt<1, SK>(pB0, pB1, K_lds, r32, hi, S.qr, ACT(NT - 1)); SBAR(); }
#define QROW(e) (nxt.Q + (size_t)(wid * QBLK + r32) * D + ((e) >> 1) * 16 + hi * 8 + ((e) & 1) * 4)
    if constexpr (F32) { SLOAD_F((const float*)nxt.K, kbn); SBAR();
#pragma unroll
        for (int e = 0; e < 8; ++e) S.tq[e] = *(const f32x4*)QROW(e); }
    else { SLOAD_H(nxt.K, nxt.V, nxt.pk, kbn); SBAR();
#pragma unroll
        for (int d0 = 0; d0 < 8; ++d0) S.qr[d0] = load8<TIn>(nxt.Q + (unsigned)((wid * QBLK + r32) * nxt.pq + d0 * 16 + hi * 8)); }
    SBAR();
    finishSM(pA0, pA1, alA, l_reg, pa0, pa1, pa2, pa3); SBAR();
    if constexpr (F32) {
#pragma unroll
        for (int e = 8; e < 16; ++e) S.tq[e] = *(const f32x4*)QROW(e); SBAR(); }
#undef QROW
    pv_tile<0, SK>(o, vb0, pa0, pa1, pa2, pa3, ACT(even ? NT - 2 : NT - 1));
    if (even) { MASKT(pB0, pB1, NT - 1); partialSM(pB0, pB1, m_reg, mnB, alB); __syncthreads(); RESC(alB);
        finishSM(pB0, pB1, alB, l_reg, pa0, pa1, pa2, pa3); SBAR(); pv_tile<1, SK>(o, vb0, pa0, pa1, pa2, pa3, ACT(NT - 1)); }
    SBAR(); SEAM_K0();
    if (hi == 0) li_l[r32] = l_reg; asm volatile("s_waitcnt lgkmcnt(0)" ::: "memory");
    float rli[16];
#pragma unroll
    for (int r = 0; r < 16; ++r) rli[r] = __builtin_amdgcn_rcpf(li_l[crow(r, hi)]);
    TOut* Ow = cur.O + (unsigned)((wid * QBLK) * cur.po); const int po = cur.po;
    if constexpr (BIAS == 1 || BIAS == 3) { if (hi == 0) { f32x2 ml = {m_reg * (1.4426950408889634f * SCALE), l_reg}; *(f32x2*)(cur.L + (unsigned)((wid * QBLK + r32) * cur.pl)) = ml; }
                          bias_fill((float*)(lds + LDS_TAB) + (par ^ 1) * TAB_PITCH, nxt.bsrc, tid); }
#pragma unroll
    for (int r = 0; r < 16; ++r) { const int orow = crow(r, hi);
#pragma unroll
        for (int d0 = 0; d0 < 4; ++d0) { const float v = o[d0][r] * rli[r];
            if constexpr (same_t<TOut, float>::v) { Ow[(unsigned)(orow * po + d0 * 32 + r32)] = v; }
            else { const float vn = __shfl_xor(v, 1);
                   if ((r32 & 1) == 0) *(unsigned*)(Ow + (unsigned)(orow * po + d0 * 32 + r32)) = cvtpk(v, vn); } } }
    if constexpr (F32) {
#pragma unroll
        for (int d0 = 0; d0 < 8; ++d0) S.qr[d0] = pack8(S.tq[2 * d0], S.tq[2 * d0 + 1]); }
    __syncthreads();
#undef RESC
#undef KBASE
#undef ACT
#undef MASKT
#undef SEAM_K0
#undef HALF_STEP
}
#undef ROW
#undef VMW
#undef VMWN
#undef SLOAD_H
#undef SWRITE_HK
#undef SWRITE_HV
#undef SWRITE_H
#undef SLOAD_F
#undef SWRITE_KF
#undef SWRITE_VF

}
constexpr int NWAVES = 8;
#ifndef MK_N_LAUNCHES
#define MK_N_LAUNCHES 1
#endif
constexpr int NPH = 13;
constexpr int N_LAUNCHES = MK_N_LAUNCHES;
static_assert(N_LAUNCHES == 1 || N_LAUNCHES == NPH, "MK_N_LAUNCHES is 1 or 13");

#ifndef GV_I8
#define GV_I8 1
#endif
#ifndef FFN_I8
#define FFN_I8 1
#endif
constexpr int NB = 4, SEQ = 4096, DM = 4096, M = NB * SEQ;
constexpr int MEMLEN = 256, MROWS = NB * MEMLEN;
constexpr int NIN = 12304, NPROJ = 12288;
constexpr int DFF = 11008, NGU = 2 * DFF;
constexpr int NB1 = GV_I8 ? 4096 : 6144, NQ1 = GV_I8 ? 8192 : 6144;
constexpr int XW = 512;
constexpr float RMS_EPS = 1e-6f;

constexpr size_t MiB = 1u << 20;
constexpr size_t WS_CTL = 0, CTL_ZERO_BYTES = 1 * MiB;
constexpr size_t WS_BT = 1 * MiB;
constexpr size_t WS_Q0K0 = 1 * MiB + 64 * 1024;
constexpr size_t WS_RSC1 = 1 * MiB + 128 * 1024;
constexpr size_t WS_XNQ = 780 * MiB;
constexpr size_t WS_WINQ = 2 * MiB + (size_t)6144 * 4096 * 2;
constexpr size_t WS_WIN = 2 * MiB;
constexpr size_t WS_WLR = 98 * MiB;
constexpr size_t WS_WOUT = 99 * MiB;
constexpr size_t WS_WXQ = 131 * MiB;
constexpr size_t WS_WXKV = 135 * MiB;
constexpr size_t WS_WXO = 143 * MiB;
constexpr size_t WS_MEMN = 147 * MiB;
constexpr size_t WS_XKV = 155 * MiB;
constexpr size_t WS_WGU = 160 * MiB;
constexpr size_t WS_WDN = 332 * MiB;
constexpr size_t WS_DQKV = 160 * MiB;
constexpr size_t WS_GK = 352 * MiB;
constexpr size_t WS_GQ = 384 * MiB;
constexpr size_t WS_XN = 418 * MiB;
constexpr size_t WS_MIX = 546 * MiB;
constexpr size_t WS_GV = 546 * MiB;
constexpr size_t WS_VT = 610 * MiB;
constexpr size_t WS_GR = 674 * MiB;
constexpr size_t WS_KET = 738 * MiB;
constexpr size_t WS_ATT = 770 * MiB;
constexpr size_t WS_DEC = 778 * MiB;
constexpr size_t WS_OC = 780 * MiB;
constexpr size_t WS_LSE = 972 * MiB;
constexpr size_t WS_ACT = 546 * MiB;
constexpr size_t WS_HALO = 890 * MiB;
constexpr size_t WS_XQ = 980 * MiB;
constexpr size_t WS_XO = 996 * MiB;
constexpr size_t WS_GQ2 = 1012 * MiB;
constexpr size_t WS_H2Q = 980 * MiB;
constexpr size_t WS_END = 1044 * MiB;
constexpr size_t HALO_ONE = (size_t)256 * 2 * DFF * 4;
static_assert(WS_HALO + 3 * HALO_ONE <= WS_XQ && WS_ACT + (size_t)M * DFF * 2 <= WS_HALO && WS_WDN + (size_t)DM * DFF * 2 <= WS_XN && WS_WGU + (size_t)NGU * DM * 2 <= WS_WDN, "d_ws map");
static_assert(WS_OC + (size_t)3 * M * 2048 * 2 <= WS_LSE && WS_LSE + (size_t)3 * M * 16 * 2 * 4 <= WS_XQ && WS_GQ + (size_t)M * 1024 * 2 <= WS_XN, "d_ws map 2");
constexpr int CW_QUEUE = 2048;
constexpr int CW_BAR = 4096;
constexpr size_t CTL_COLMAX = 704 * 1024;
constexpr size_t CTL_CMAX1 = 864 * 1024;
constexpr size_t CTL_AMAX = 800 * 1024;
constexpr size_t CTL_SS = 256 * 1024;

constexpr int LDS_BYTES = 147456;
constexpr int MISC_OFF = LDS_BYTES - 256;

#define GAS __attribute__((address_space(1)))
#define LAS __attribute__((address_space(3)))
typedef unsigned short bf16;
typedef unsigned v4u __attribute__((ext_vector_type(4)));
typedef unsigned v2u __attribute__((ext_vector_type(2)));
typedef float f32x4 __attribute__((ext_vector_type(4)));
typedef float f32x2 __attribute__((ext_vector_type(2)));
typedef float f32x16 __attribute__((ext_vector_type(16)));
typedef short bf16x8 __attribute__((ext_vector_type(8)));
typedef short s16x4 __attribute__((ext_vector_type(4)));
typedef short v4i16_t __attribute__((ext_vector_type(4)));
typedef GAS unsigned gu32;
#define RLX_AGENT __ATOMIC_RELAXED, __HIP_MEMORY_SCOPE_AGENT
#define LDS_WAIT() asm volatile("s_waitcnt lgkmcnt(0)" ::: "memory")
#define VM_WAIT() asm volatile("s_waitcnt vmcnt(0)" ::: "memory")
__device__ __forceinline__ unsigned f2bf(float f) { unsigned u = __builtin_bit_cast(unsigned, f); return (u + 0x7fffu + ((u >> 16) & 1u)) >> 16; }
__device__ __forceinline__ float bf2f(unsigned short b) { return __builtin_bit_cast(float, (unsigned)b << 16); }
__device__ __forceinline__ float bflo(unsigned w) { return __builtin_bit_cast(float, w << 16); }
__device__ __forceinline__ float bfhi(unsigned w) { return __builtin_bit_cast(float, w & 0xffff0000u); }
__device__ __forceinline__ unsigned q8x4(float a, float b, float c, float d, float inv) {
    const float MG = 12582912.0f;
    const unsigned ua = __builtin_bit_cast(unsigned, __builtin_amdgcn_fmed3f(__builtin_fmaf(a, inv, MG), MG - 127.0f, MG + 127.0f)), ub = __builtin_bit_cast(unsigned, __builtin_amdgcn_fmed3f(__builtin_fmaf(b, inv, MG), MG - 127.0f, MG + 127.0f));
    const unsigned uc = __builtin_bit_cast(unsigned, __builtin_amdgcn_fmed3f(__builtin_fmaf(c, inv, MG), MG - 127.0f, MG + 127.0f)), ud = __builtin_bit_cast(unsigned, __builtin_amdgcn_fmed3f(__builtin_fmaf(d, inv, MG), MG - 127.0f, MG + 127.0f));
    return __builtin_amdgcn_perm(ub, ua, 0x0c0c0400u) | __builtin_amdgcn_perm(ud, uc, 0x04000c0cu);
}
typedef __bf16 bf16x2_t __attribute__((ext_vector_type(2)));
__device__ __forceinline__ unsigned cvtpk_s(float lo, float hi) { f32x2 v = {lo, hi}; bf16x2_t b = __builtin_convertvector(v, bf16x2_t); return __builtin_bit_cast(unsigned, b); }
__device__ __forceinline__ unsigned pk2(float lo, float hi) { return cvtpk_s(lo, hi); }
__device__ __forceinline__ bf16x8 pack8f(float a0, float a1, float a2, float a3, float a4, float a5, float a6, float a7) {
    v4u w = {cvtpk_s(a0, a1), cvtpk_s(a2, a3), cvtpk_s(a4, a5), cvtpk_s(a6, a7)}; return __builtin_bit_cast(bf16x8, w); }
#define XB_TMO      128
#define XB_XCNT(j)  (256  + 64 * (j))
#define XB_XSUB(j)  (1280 + 64 * (j))
#define XB_XGEN(j)  (2304 + 64 * (j))
#define XB_TOP      3328
#define XB_TOPGEN   3392
#define XCD_BAR_WORDS 3456
#define XB_SPIN_CAP (1u << 18)

__device__ __forceinline__ unsigned xb_ld(unsigned* p)              { return __hip_atomic_load(p, __ATOMIC_RELAXED, __HIP_MEMORY_SCOPE_AGENT); }
__device__ __forceinline__ unsigned xb_add(unsigned* p, unsigned v) { return __hip_atomic_fetch_add(p, v, __ATOMIC_RELAXED, __HIP_MEMORY_SCOPE_AGENT); }
__device__ __forceinline__ unsigned xb_xcc_id() { return (unsigned)__builtin_amdgcn_s_getreg((3 << 11) | 20) & 0xFu; }
#define XB_SPIN(cond, bar) do { unsigned _sp = 0; while (cond) { __builtin_amdgcn_s_sleep(1); \
    if ((++_sp & 255u) == 0u) { if (xb_ld(&(bar)[XB_TMO])) break; if (_sp > XB_SPIN_CAP) { atomicAdd(&(bar)[XB_TMO], 1u); break; } } } } while (0)

struct XcdBarrier {
    unsigned* bar; unsigned x;
    volatile LAS unsigned* st;
};

__device__ __forceinline__ XcdBarrier xcd_barrier_post(unsigned* bar, volatile LAS unsigned* st) {
    XcdBarrier b; b.bar = bar; b.x = xb_xcc_id(); b.st = st;
    if (threadIdx.x == 0) (void)xb_add(&bar[XB_XCNT(b.x)], 1u);
    return b;
}
__device__ __forceinline__ void xcd_barrier_complete(unsigned* bar, unsigned x, unsigned& nloc, unsigned& nx) {
    const unsigned G = gridDim.x * gridDim.y * gridDim.z;
    unsigned sum, cnt, mine, sp = 0u;
    for (;;) {
        sum = 0u; cnt = 0u; mine = 0u;
#pragma unroll
        for (unsigned j = 0; j < 16; ++j) { const unsigned c = xb_ld(&bar[XB_XCNT(j)]); sum += c; cnt += (c > 0u) ? 1u : 0u; mine = (j == x) ? c : mine; }
        if (sum == G) break;
        __builtin_amdgcn_s_sleep(1);
        if ((++sp & 255u) == 0u) { if (xb_ld(&bar[XB_TMO])) break; if (sp > XB_SPIN_CAP) { atomicAdd(&bar[XB_TMO], 1u); break; } }
    }
    nloc = mine > 0u ? mine : 1u; nx = cnt > 0u ? cnt : 1u;
}

__device__ __forceinline__ void xcd_barrier(const XcdBarrier& b) {
    asm volatile("s_waitcnt vmcnt(0)" ::: "memory");
    __syncthreads();
    if (threadIdx.x == 0) {
        unsigned* bar = b.bar;
        __builtin_amdgcn_s_waitcnt(0);
        unsigned nloc = b.st[0], nx = b.st[1];
        if (nloc == 0u) { xcd_barrier_complete(bar, b.x, nloc, nx); b.st[0] = nloc; b.st[1] = nx; }
        const unsigned old = xb_add(&bar[XB_XSUB(b.x)], 1u);
        const unsigned gen = old / nloc;
        if (old + 1u == (gen + 1u) * nloc) {
            __builtin_amdgcn_fence(__ATOMIC_RELEASE, "agent");
            asm volatile("s_waitcnt vmcnt(0)" ::: "memory");
            const unsigned og = xb_add(&bar[XB_TOP], 1u);
            const unsigned tg = og / nx;
            if (og + 1u == (tg + 1u) * nx) xb_add(&bar[XB_TOPGEN], 1u);
            else XB_SPIN(xb_ld(&bar[XB_TOPGEN]) == tg, bar);
            __builtin_amdgcn_fence(__ATOMIC_ACQUIRE, "agent");
            xb_add(&bar[XB_XGEN(b.x)], 1u);
            asm volatile("s_waitcnt vmcnt(0)" ::: "memory");
        } else {
            XB_SPIN(xb_ld(&bar[XB_XGEN(b.x)]) == gen, bar);
            __builtin_amdgcn_fence(__ATOMIC_ACQUIRE, "agent");
            asm volatile("s_waitcnt vmcnt(0)" ::: "memory");
        }
    }
    __syncthreads();
}
struct Frame {
    LAS unsigned char* lds; char* ldsg;
    volatile LAS unsigned* MISC;
    gu32* ctl;
    int wave, vcu, G;
    unsigned char* ws;
    const float* const __attribute__((address_space(4)))* kin;
    float* out;
};
__device__ __forceinline__ int tid_now() { int t = (int)threadIdx.x; asm volatile("" : "+v"(t)); return t; }
#define WAVE_RED_(v, OP) do { \
    v = OP(v, __builtin_bit_cast(decltype(v), __builtin_amdgcn_update_dpp(0, __builtin_bit_cast(int, v), 0xB1, 0xf, 0xf, true))); \
    v = OP(v, __builtin_bit_cast(decltype(v), __builtin_amdgcn_update_dpp(0, __builtin_bit_cast(int, v), 0x4E, 0xf, 0xf, true))); \
    v = OP(v, __builtin_bit_cast(decltype(v), __builtin_amdgcn_update_dpp(0, __builtin_bit_cast(int, v), 0x124, 0xf, 0xf, true))); \
    v = OP(v, __builtin_bit_cast(decltype(v), __builtin_amdgcn_update_dpp(0, __builtin_bit_cast(int, v), 0x128, 0xf, 0xf, true))); \
    { auto rr_ = __builtin_amdgcn_permlane16_swap(__builtin_bit_cast(unsigned, v), __builtin_bit_cast(unsigned, v), false, false); v = OP(__builtin_bit_cast(decltype(v), rr_[0]), __builtin_bit_cast(decltype(v), rr_[1])); } \
    { auto rr_ = __builtin_amdgcn_permlane32_swap(__builtin_bit_cast(unsigned, v), __builtin_bit_cast(unsigned, v), false, false); v = OP(__builtin_bit_cast(decltype(v), rr_[0]), __builtin_bit_cast(decltype(v), rr_[1])); } } while (0)
#define WR_ADD_(a, b) ((a) + (b))
#define WR_MAXF_(a, b) fmaxf((a), (b))
#define WR_MAXU_(a, b) ((a) > (b) ? (a) : (b))
__device__ __forceinline__ float wave_sum(float v) {
    v += __int_as_float(__builtin_amdgcn_update_dpp(0, __float_as_int(v), 0xB1, 0xf, 0xf, true));
    v += __int_as_float(__builtin_amdgcn_update_dpp(0, __float_as_int(v), 0x4E, 0xf, 0xf, true));
    v += __int_as_float(__builtin_amdgcn_update_dpp(0, __float_as_int(v), 0x124, 0xf, 0xf, true));
    v += __int_as_float(__builtin_amdgcn_update_dpp(0, __float_as_int(v), 0x128, 0xf, 0xf, true));
    v += __shfl_xor(v, 16);
    { auto rr_ = __builtin_amdgcn_permlane32_swap(__float_as_uint(v), __float_as_uint(v), false, false); v = __uint_as_float(rr_[0]) + __uint_as_float(rr_[1]); }
    return v;
}
__device__ __forceinline__ float wave_maxf(float v) {
    v = fmaxf(v, __int_as_float(__builtin_amdgcn_update_dpp(0, __float_as_int(v), 0xB1, 0xf, 0xf, true)));
    v = fmaxf(v, __int_as_float(__builtin_amdgcn_update_dpp(0, __float_as_int(v), 0x4E, 0xf, 0xf, true)));
    v = fmaxf(v, __int_as_float(__builtin_amdgcn_update_dpp(0, __float_as_int(v), 0x124, 0xf, 0xf, true)));
    v = fmaxf(v, __int_as_float(__builtin_amdgcn_update_dpp(0, __float_as_int(v), 0x128, 0xf, 0xf, true)));
    v = fmaxf(v, __shfl_xor(v, 16));
    { auto rr_ = __builtin_amdgcn_permlane32_swap(__float_as_uint(v), __float_as_uint(v), false, false); v = fmaxf(__uint_as_float(rr_[0]), __uint_as_float(rr_[1])); }
    return v;
}
__device__ __forceinline__ unsigned wave_maxu(unsigned v) {
#define WMU_(ctrl) { const unsigned u_ = (unsigned)__builtin_amdgcn_update_dpp(0, (int)v, ctrl, 0xf, 0xf, true); v = v > u_ ? v : u_; }
    WMU_(0xB1) WMU_(0x4E) WMU_(0x124) WMU_(0x128)
#undef WMU_
    { const unsigned u_ = (unsigned)__shfl_xor((int)v, 16); v = v > u_ ? v : u_; }
    { auto rr_ = __builtin_amdgcn_permlane32_swap(v, v, false, false); v = rr_[0] > rr_[1] ? rr_[0] : rr_[1]; }
    return v;
}
__device__ const unsigned char kBucket[3][132] = {
 {0,1,2,3,4,5,6,7,8,9,10,11,12,13,14,15,16,16,16,16,16,16,17,17,17,17,17,17,17,17,18,18,18,18,18,18,18,18,18,18,19,19,19,19,19,19,19,19,19,19,19,19,19,19,20,20,20,20,20,20,20,20,20,20,20,20,20,20,20,20,20,20,20,21,21,21,21,21,21,21,21,21,21,21,21,21,21,21,21,21,21,21,21,21,21,21,21,21,21,22,22,22,22,22,22,22,22,22,22,22,22,22,22,22,22,22,22,22,22,22,22,22,22,22,22,22,22,22,22,0,0,0},
 {0,4,8,12,16,16,17,17,18,18,19,19,19,19,20,20,20,20,20,21,21,21,21,21,21,22,22,22,22,22,22,22,22,22,23,23,23,23,23,23,23,23,23,23,23,23,24,24,24,24,24,24,24,24,24,24,24,24,24,24,24,24,25,25,25,25,25,25,25,25,25,25,25,25,25,25,25,25,25,25,25,25,25,26,26,26,26,26,26,26,26,26,26,26,26,26,26,26,26,26,26,26,26,26,26,26,26,26,26,26,26,26,26,27,27,27,27,27,27,27,27,27,27,27,27,27,27,27,27,0,0,0},
 {0,16,18,19,20,21,21,22,22,23,23,23,24,24,24,24,25,25,25,25,25,26,26,26,26,26,26,26,26,27,27,27,27,27,27,27,27,27,27,28,28,28,28,28,28,28,28,28,28,28,28,28,29,29,29,29,29,29,29,29,29,29,29,29,29,29,29,29,29,29,30,30,30,30,30,30,30,30,30,30,30,30,30,30,30,30,30,30,30,30,30,30,30,30,30,31,31,31,31,31,31,31,31,31,31,31,31,31,31,31,31,31,31,31,31,31,31,31,31,31,31,31,31,31,31,31,31,31,31,0,0,0}};

#ifndef NT_LOADS
#define NT_LOADS 1
#endif
#if NT_LOADS
#define NTLD(p) __builtin_nontemporal_load(p)
#else
#define NTLD(p) (*(p))
#endif
constexpr int TR_SCR = 17408;
__device__ __forceinline__ void tr_item(const float* W, int ldw, bf16* WT, int ldt, int src_c0, int dst_r0, int nvalid, const float* gain, LAS float* scr, int kb, int lane) {
    const int k0 = 64 * kb, a = lane >> 4, c4 = 4 * (lane & 15);
#pragma unroll 8
    for (int i = 0; i < 16; ++i) { const int kk = 4 * i + a; f32x4 v = NTLD((const GAS f32x4*)(W + (size_t)(k0 + kk) * ldw + src_c0 + c4)); if (gain) v = v * gain[k0 + kk];
        LAS float* d = scr + kk * 65 + c4; d[0] = v.x; d[1] = v.y; d[2] = v.z; d[3] = v.w; }
    LDS_WAIT(); asm volatile("" ::: "memory");
    const int c = lane & 7;
#pragma unroll
    for (int j = 0; j < 8; ++j) { const int n = (lane >> 3) + 8 * j; const LAS float* s = scr + (8 * c) * 65 + n;
        v4u o; o.x = pk2(s[0 * 65], s[1 * 65]); o.y = pk2(s[2 * 65], s[3 * 65]); o.z = pk2(s[4 * 65], s[5 * 65]); o.w = pk2(s[6 * 65], s[7 * 65]);
        if (n < nvalid) *(GAS v4u*)(WT + (size_t)(dst_r0 + n) * ldt + k0 + 8 * c) = o; }
    LDS_WAIT(); asm volatile("" ::: "memory");
}
constexpr float CM_WIDEN = 1.0f;
__device__ __forceinline__ void absmax_item(const float* W, int ldw, int src_c0, const float* gain, unsigned* cmax, int kb, int lane) {
    const int k0 = 64 * kb, a = lane >> 4, c4 = 4 * (lane & 15);
    f32x4 m = {0.f, 0.f, 0.f, 0.f};
#pragma unroll 8
    for (int i = 0; i < 16; ++i) { const int kk = 4 * i + a; const f32x4 v = *(const GAS f32x4*)(W + (size_t)(k0 + kk) * ldw + src_c0 + c4) * (gain ? gain[k0 + kk] : 1.0f);
        m.x = fmaxf(m.x, fabsf(v.x)); m.y = fmaxf(m.y, fabsf(v.y)); m.z = fmaxf(m.z, fabsf(v.z)); m.w = fmaxf(m.w, fabsf(v.w)); }
#pragma unroll
    for (int o = 16; o < 64; o <<= 1) { m.x = fmaxf(m.x, __shfl_xor(m.x, o)); m.y = fmaxf(m.y, __shfl_xor(m.y, o)); m.z = fmaxf(m.z, __shfl_xor(m.z, o)); m.w = fmaxf(m.w, __shfl_xor(m.w, o)); }
    if (lane < 16) { unsigned* p = cmax + c4;   atomicMax(p, __float_as_uint(m.x)); atomicMax(p + 1, __float_as_uint(m.y)); atomicMax(p + 2, __float_as_uint(m.z)); atomicMax(p + 3, __float_as_uint(m.w)); }
}
__device__ __forceinline__ void quant_item(const float* W, int ldw, signed char* WQ, int ldq, int src_c0, int dst_r0, const float* gain, const unsigned* cmax, LAS float* scr, int kb, int lane) {
    const int k0 = 64 * kb, a = lane >> 4, c4 = 4 * (lane & 15);
#pragma unroll 8
    for (int i = 0; i < 16; ++i) { const int kk = 4 * i + a; const f32x4 v = NTLD((const GAS f32x4*)(W + (size_t)(k0 + kk) * ldw + src_c0 + c4)) * (gain ? gain[k0 + kk] : 1.0f);
        LAS float* d = scr + kk * 65 + c4; d[0] = v.x; d[1] = v.y; d[2] = v.z; d[3] = v.w; }
    LDS_WAIT(); asm volatile("" ::: "memory");
    const int c = lane & 3;
#pragma unroll
    for (int j = 0; j < 4; ++j) { const int n = (lane >> 2) + 16 * j; const LAS float* s = scr + (16 * c) * 65 + n;
        const float cm = __uint_as_float(cmax[n]) * CM_WIDEN; const float inv = cm > 0.f ? 127.0f / cm : 0.f;
        unsigned wq[4];
#pragma unroll
        for (int q = 0; q < 4; ++q) wq[q] = q8x4(s[(4 * q) * 65], s[(4 * q + 1) * 65], s[(4 * q + 2) * 65], s[(4 * q + 3) * 65], inv);
        v4u o = {wq[0], wq[1], wq[2], wq[3]};
        *(GAS v4u*)(WQ + (size_t)(dst_r0 + n) * ldq + k0 + 16 * c) = o; }
    LDS_WAIT(); asm volatile("" ::: "memory");
}

__device__ __forceinline__ void rms_row_to_bf16(const float* xrow, const float* g, bf16* orow, int lane, signed char* qrow = nullptr, float* qscale = nullptr) {
    const GAS f32x4* xr = (const GAS f32x4*)xrow + lane; const GAS f32x4* gr = (const GAS f32x4*)g + lane;
    f32x4 v[16]; float s = 0.f;
#pragma unroll
    for (int j = 0; j < 16; ++j) { v[j] = NTLD(xr + 64 * j); s += (v[j].x * v[j].x + v[j].y * v[j].y) + (v[j].z * v[j].z + v[j].w * v[j].w); }
    const float r = 1.0f / sqrtf(wave_sum(s) * (1.0f / 4096.0f) + RMS_EPS);
    GAS v2u* o8 = (GAS v2u*)orow + lane; float mx = 0.f;
#pragma unroll
    for (int j = 0; j < 16; ++j) { const f32x4 gg = gr[64 * j]; v[j] = (f32x4){v[j].x * r * gg.x, v[j].y * r * gg.y, v[j].z * r * gg.z, v[j].w * r * gg.w};
        v2u o; o.x = pk2(v[j].x, v[j].y); o.y = pk2(v[j].z, v[j].w); o8[64 * j] = o;
        mx = fmaxf(mx, fmaxf(fmaxf(fabsf(v[j].x), fabsf(v[j].y)), fmaxf(fabsf(v[j].z), fabsf(v[j].w)))); }
    if (qrow) {
        mx = wave_maxf(mx);
        const float inv = mx > 0.f ? 127.0f / mx : 0.f; GAS unsigned* q4 = (GAS unsigned*)qrow + lane;
#pragma unroll
        for (int j = 0; j < 16; ++j) q4[64 * j] = q8x4(v[j].x, v[j].y, v[j].z, v[j].w, inv);
        if (lane == 0) *qscale = mx * (1.0f / 127.0f);
    }
}

__device__ __forceinline__ void p0_first_token(Frame& F) {
    const int tid = tid_now(), lane = tid & 63, w = F.wave;
    LAS float* red = (LAS float*)F.lds;
    const float* x = F.kin[0]; const float* g = F.kin[3]; const float* W = F.kin[4];
    float* Q0K0 = (float*)(F.ws + WS_Q0K0);
    for (int cb = blockIdx.x; cb < 256; cb += F.G) {
        float xv[4][8]; float gg[8]; f32x4 w0[8], w1[8];
#pragma unroll
        for (int i = 0; i < 8; ++i) { gg[i] = g[tid + 512 * i]; const GAS f32x4* wp = (const GAS f32x4*)(W + (size_t)(tid + 512 * i) * NIN + 8 * cb); w0[i] = wp[0]; w1[i] = wp[1];
#pragma unroll
            for (int b = 0; b < 4; ++b) xv[b][i] = x[(size_t)b * SEQ * DM + tid + 512 * i]; }
        float acc[4][8], ss[4];
#pragma unroll
        for (int b = 0; b < 4; ++b) { ss[b] = 0.f;
#pragma unroll
            for (int c = 0; c < 8; ++c) acc[b][c] = 0.f; }
#pragma unroll
        for (int i = 0; i < 8; ++i) { const float wv[8] = {w0[i].x, w0[i].y, w0[i].z, w0[i].w, w1[i].x, w1[i].y, w1[i].z, w1[i].w};
#pragma unroll
            for (int b = 0; b < 4; ++b) { ss[b] += xv[b][i] * xv[b][i]; const float xg = xv[b][i] * gg[i];
#pragma unroll
                for (int c = 0; c < 8; ++c) acc[b][c] += xg * wv[c]; } }
#pragma unroll
        for (int b = 0; b < 4; ++b) { const float s2 = wave_sum(ss[b]); if (lane == 0) red[w * 40 + 32 + b] = s2;
#pragma unroll
            for (int c = 0; c < 8; ++c) { const float s = wave_sum(acc[b][c]); if (lane == 0) red[w * 40 + b * 8 + c] = s; } }
        __syncthreads();
        if (tid < 32) { float s = 0.f, q = 0.f;
#pragma unroll
            for (int k = 0; k < 8; ++k) { s += red[k * 40 + tid]; q += red[k * 40 + 32 + (tid >> 3)]; }
            Q0K0[(tid >> 3) * 2048 + 8 * cb + (tid & 7)] = s * (1.0f / sqrtf(q * (1.0f / 4096.0f) + RMS_EPS)); }
        __syncthreads();
    }
}
__device__ __forceinline__ int winq_src_col(int nb) { return GV_I8 ? (nb < 32 ? 2048 + 64 * nb : 6160 + 64 * (nb - 32)) : 6160 + 64 * nb; }
__device__ __forceinline__ void p0_prologue(Frame& F) {
    const int tid = tid_now(), lane = tid & 63;
    LAS float* scr = (LAS float*)(F.lds + F.wave * TR_SCR);
    const int gw = F.vcu * NWAVES + F.wave, NGW = F.G * NWAVES;
    bf16* Win = (bf16*)(F.ws + WS_WIN); bf16* Wlr = (bf16*)(F.ws + WS_WLR); bf16* Wout = (bf16*)(F.ws + WS_WOUT); bf16* Wxq = (bf16*)(F.ws + WS_WXQ); bf16* Wxkv = (bf16*)(F.ws + WS_WXKV); bf16* Wxo = (bf16*)(F.ws + WS_WXO);
    constexpr int NA = GV_I8 ? 2048 : 4096;
    constexpr int I_INA = 64 * (NA / 64), I_INB = 64 * (2048 / 64), I_INQ = 64 * (NQ1 / 64), I_LR = 64, I_OUT = 64 * 64, I_XQ = 64 * 8, I_XO = 8 * 64;
    constexpr int NIT = I_INA + I_INB + I_INQ + I_LR + I_OUT + 3 * I_XQ + I_XO;
    unsigned* cmax1 = (unsigned*)(F.ws + WS_CTL + CTL_CMAX1);
    for (int it = gw; it < NIT; it += NGW) {
        int r = it;
        if (r < I_INA) { const int nb = r % (NA / 64), kb = r / (NA / 64); tr_item(F.kin[4], NIN, Win, DM, 64 * nb, 64 * nb, 64, nullptr, scr, kb, lane); continue; } r -= I_INA;
        if (r < I_INB) { const int nb = r % 32, kb = r / 32; tr_item(F.kin[4], NIN, Win, DM, 4112 + 64 * nb, NA + 64 * nb, 64, nullptr, scr, kb, lane); continue; } r -= I_INB;
        if (r < I_INQ) { const int nb = r % (NQ1 / 64), kb = r / (NQ1 / 64); absmax_item(F.kin[4], NIN, winq_src_col(nb), nullptr, cmax1 + 64 * nb, kb, lane); continue; } r -= I_INQ;
        if (r < I_LR) { tr_item(F.kin[4], NIN, Wlr, DM, 4096, 0, 16, nullptr, scr, r, lane); continue; } r -= I_LR;
        if (r < I_OUT) { const int nb = r % 64, kb = r / 64; tr_item(F.kin[8], DM, Wout, DM, 64 * nb, 64 * nb, 64, nullptr, scr, kb, lane); continue; } r -= I_OUT;
        if (r < I_XQ) { const int nb = r % 8, kb = r / 8; tr_item(F.kin[11], XW, Wxq, DM, 64 * nb, 64 * nb, 64, F.kin[9], scr, kb, lane); continue; } r -= I_XQ;
        if (r < I_XQ) { const int nb = r % 8, kb = r / 8; tr_item(F.kin[12], XW, Wxkv, DM, 64 * nb, 64 * nb, 64, nullptr, scr, kb, lane); continue; } r -= I_XQ;
        if (r < I_XQ) { const int nb = r % 8, kb = r / 8; tr_item(F.kin[13], XW, Wxkv, DM, 64 * nb, 512 + 64 * nb, 64, nullptr, scr, kb, lane); continue; } r -= I_XQ;
        { const int nb = r % 64, kb = r / 64; tr_item(F.kin[14], DM, Wxo, XW, 64 * nb, 64 * nb, 64, nullptr, scr, kb, lane); }
    }
    bf16* XN = (bf16*)(F.ws + WS_XN); bf16* MEMN = (bf16*)(F.ws + WS_MEMN);
    for (int m = NGW - 1 - gw; m < M + MROWS; m += NGW) {
        if (m < M) rms_row_to_bf16(F.kin[0] + (size_t)m * DM, F.kin[3], XN + (size_t)m * DM, lane, (signed char*)(F.ws + WS_XNQ) + (size_t)m * DM, (float*)(F.ws + WS_RSC1) + m);
        else rms_row_to_bf16(F.kin[1] + (size_t)(m - M) * DM, F.kin[10], MEMN + (size_t)(m - M) * DM, lane);
    }
    float* BT = (float*)(F.ws + WS_BT);
    for (int i = blockIdx.x * 512 + tid; i < 3 * 16 * 132; i += F.G * 512) { const int rel = i % 132, h = (i / 132) % 16, cfg = i / (132 * 16);
        BT[i] = rel < 129 ? F.kin[2][kBucket[cfg][rel] * 16 + h] * 11.313708498984761f : 0.f; }
}
constexpr int FW_IG = 64 * (DFF / 64), FW_ID = (DFF / 64) * 64, FW_ALL = 2 * FW_IG + FW_ID;
#ifndef FW_P6N
#define FW_P6N 3584
#endif
constexpr int FW_P6_LO = 2 * FW_IG - (FW_P6N), FW_P6_HI = 2 * FW_IG;
#ifndef FW_P9N
#define FW_P9N 8448
#endif
#ifndef P9_GEMM_WGS
#define P9_GEMM_WGS 251
#endif
constexpr int FW_P9_LO = FW_ALL - (FW_P9N), FW_P9_HI = FW_ALL;
template <int MODE  >
__device__ __forceinline__ void ffn_weight_item(Frame& F, int r, LAS float* scr, int lane) {
    bf16* Wgu = (bf16*)(F.ws + WS_WGU); bf16* Wdn = (bf16*)(F.ws + WS_WDN); unsigned* cmax = (unsigned*)(F.ws + WS_CTL + CTL_COLMAX);
    if (r < 2 * FW_IG) { const int up = r >= FW_IG ? 1 : 0; const int rr = r - up * FW_IG; const int nb = rr % 172, kb = rr / 172, c0 = 64 * nb; const float* W = up ? F.kin[17] : F.kin[16];
        const int drow = 256 * (c0 >> 7) + 128 * up + (c0 & 127);
        if constexpr (MODE == 1) absmax_item(W, DFF, c0, F.kin[15], cmax + up * DFF + c0, kb, lane);
        else if constexpr (FFN_I8) quant_item(W, DFF, (signed char*)Wgu, DM, c0, drow, F.kin[15], cmax + up * DFF + c0, scr, kb, lane);
        else tr_item(W, DFF, Wgu, DM, c0, drow, 64, F.kin[15], scr, kb, lane);
        return; }
    if constexpr (MODE == 0) { r -= 2 * FW_IG; const int nb = r % 64, kb = r / 64; tr_item(F.kin[20], DM, Wdn, DFF, 64 * nb, 64 * nb, 64, nullptr, scr, kb, lane); }
}
template <int MODE> __device__ __forceinline__ void ffn_weights(Frame& F, int lo, int hi, int iw, int nw) {
    const int lane = tid_now() & 63; LAS float* scr = (LAS float*)(F.lds + F.wave * TR_SCR);
    for (int it = lo + iw; it < hi; it += nw) ffn_weight_item<MODE>(F, it, scr, lane);
}

__device__ __forceinline__ void p0_quant_win(Frame& F) {
    const int lane = tid_now() & 63; LAS float* scr = (LAS float*)(F.lds + F.wave * TR_SCR);
    const int gw = F.vcu * NWAVES + F.wave, NGW = F.G * NWAVES;
    const unsigned* cmax1 = (const unsigned*)(F.ws + WS_CTL + CTL_CMAX1);
    for (int r = gw; r < 64 * (NQ1 / 64); r += NGW) { const int nb = r % (NQ1 / 64), kb = r / (NQ1 / 64);
        quant_item(F.kin[4], NIN, (signed char*)(F.ws + WS_WINQ), DM, winq_src_col(nb), 64 * nb, nullptr, cmax1 + 64 * nb, scr, kb, lane); }
}
constexpr int PP = 520;
constexpr int PREP_GLR = 0, PREP_QM = 8192, PREP_KM = 8192 + 64 * PP * 2;
static_assert(PREP_KM + 64 * PP * 2 <= MISC_OFF, "prep LDS");
__device__ __forceinline__ void gla_prep_unit(Frame& F, int b, int n) {
    const int tid = tid_now(), lane = tid & 63, w = F.wave;
    const int t0 = b * SEQ + 64 * n;
    const bf16* XN = (const bf16*)(F.ws + WS_XN); const bf16* Wlr = (const bf16*)(F.ws + WS_WLR);
    const bf16* GQ = (const bf16*)(F.ws + WS_GQ); bf16* GQ2 = (bf16*)(F.ws + WS_GQ2); const bf16* GK = (const bf16*)(F.ws + WS_GK);
    bf16* KET = (bf16*)(F.ws + WS_KET); bf16* ATT = (bf16*)(F.ws + WS_ATT); float* DEC = (float*)(F.ws + WS_DEC);
    LAS float* glr = (LAS float*)(F.lds + PREP_GLR);
    LAS bf16* QMs = (LAS bf16*)(F.lds + PREP_QM); LAS bf16* KMs = (LAS bf16*)(F.lds + PREP_KM);
    {
        const int rg = w & 3, kh = w >> 2, rr = lane & 15, kg = lane >> 4;
        const bf16* ap = XN + (size_t)(t0 + 16 * rg + rr) * DM + kh * 2048 + 8 * kg; const bf16* bp = Wlr + (size_t)rr * DM + kh * 2048 + 8 * kg;
        f32x4 acc = {0.f, 0.f, 0.f, 0.f};
#pragma unroll 16
        for (int s = 0; s < 64; ++s) { const bf16x8 a = *(const GAS bf16x8*)(ap + 32 * s), bq = *(const GAS bf16x8*)(bp + 32 * s); acc = __builtin_amdgcn_mfma_f32_16x16x32_bf16(a, bq, acc, 0, 0, 0); }
#pragma unroll
        for (int i = 0; i < 4; ++i) glr[(kh * 64 + 16 * rg + 4 * kg + i) * 16 + rr] = acc[i];
    }
    __syncthreads();
    for (int i = tid; i < 1024; i += 512) glr[i] += glr[1024 + i];
    __syncthreads();
    const int cid = (b * 64 + n) * 4;
    for (int hp = 0; hp < 2; ++hp) {
        {
            const int col = hp * 512 + tid, h = col >> 8, dk = col & 255;
            float w2[16];
#pragma unroll
            for (int j = 0; j < 16; ++j) w2[j] = F.kin[5][j * 1024 + col];
            const float bg = F.kin[6][col];
            const bf16* qp = GQ + (size_t)t0 * 1024 + col; const bf16* kp = GK + (size_t)t0 * 1024 + col;
            typedef unsigned short us2_t __attribute__((ext_vector_type(2)));
            us2_t kv[32];
#pragma unroll
            for (int c2 = 0; c2 < 32; ++c2) { kv[c2].x = kp[(size_t)(2 * c2) * 1024]; kv[c2].y = kp[(size_t)(2 * c2 + 1) * 1024]; }
            float bc[64]; float run = 0.f;
#pragma unroll
            for (int c = 0; c < 64; ++c) {
                const LAS f32x4* gp = (const LAS f32x4*)(glr + c * 16); const f32x4 g0 = gp[0], g1 = gp[1], g2 = gp[2], g3 = gp[3];
                float za = bg, zb = 0.f;
                za = __builtin_fmaf(g0.x, w2[0], za); zb = __builtin_fmaf(g0.y, w2[1], zb); za = __builtin_fmaf(g0.z, w2[2], za); zb = __builtin_fmaf(g0.w, w2[3], zb);
                za = __builtin_fmaf(g1.x, w2[4], za); zb = __builtin_fmaf(g1.y, w2[5], zb); za = __builtin_fmaf(g1.z, w2[6], za); zb = __builtin_fmaf(g1.w, w2[7], zb);
                za = __builtin_fmaf(g2.x, w2[8], za); zb = __builtin_fmaf(g2.y, w2[9], zb); za = __builtin_fmaf(g2.z, w2[10], za); zb = __builtin_fmaf(g2.w, w2[11], zb);
                za = __builtin_fmaf(g3.x, w2[12], za); zb = __builtin_fmaf(g3.y, w2[13], zb); za = __builtin_fmaf(g3.z, w2[14], za); zb = __builtin_fmaf(g3.w, w2[15], zb);
                const float z = za + zb;
                const float ls = fminf(z, 0.f) - 0.6931471805599453f * __builtin_amdgcn_logf(1.0f + __builtin_amdgcn_exp2f(-1.4426950408889634f * fabsf(z)));
                run += ls * (1.0f / 16.0f); bc[c] = run;
            }
            const float blast = bc[63], bmid = bc[32]; const float Emid = __expf(bmid), Elm = __expf(blast - bmid);
            unsigned kep[32];
            bf16* qo = GQ2 + (size_t)t0 * 1024 + col;
#pragma unroll
            for (int c2 = 0; c2 < 32; ++c2) {
                const int c = 2 * c2;
                const float qa = bf2f(qp[(size_t)c * 1024]) * (1.0f / 16.0f), ka = bf2f(kv[c2].x);
                const float qb = bf2f(qp[(size_t)(c + 1) * 1024]) * (1.0f / 16.0f), kb = bf2f(kv[c2].y);
                const float Aa = __expf(bc[c] - bmid), Ab = __expf(bc[c + 1] - bmid), Ra = __builtin_amdgcn_rcpf(Aa), Rb = __builtin_amdgcn_rcpf(Ab);
                const unsigned qt = cvtpk_s(qa * (Aa * Emid), qb * (Ab * Emid));
                qo[(size_t)c * 1024] = (bf16)(qt & 0xffffu); qo[(size_t)(c + 1) * 1024] = (bf16)(qt >> 16);
                kep[c2] = cvtpk_s(ka * (Ra * Elm), kb * (Rb * Elm));
                const unsigned qm = cvtpk_s(qa * Aa, qb * Ab);
                const unsigned km = cvtpk_s(ka * Ra, kb * Rb);
                QMs[c * PP + tid] = (bf16)(qm & 0xffffu); QMs[(c + 1) * PP + tid] = (bf16)(qm >> 16);
                KMs[c * PP + tid] = (bf16)(km & 0xffffu); KMs[(c + 1) * PP + tid] = (bf16)(km >> 16);
            }
            bf16* kt = KET + ((size_t)(cid + h) * 256 + dk) * 64;
#pragma unroll
            for (int i = 0; i < 8; ++i) { v4u o = {kep[4 * i], kep[4 * i + 1], kep[4 * i + 2], kep[4 * i + 3]}; *(GAS v4u*)(kt + 8 * i) = o; }
            DEC[(size_t)(cid + h) * 256 + dk] = __expf(blast);
        }
        __syncthreads();
        {
            const int rr = lane & 15, kg = lane >> 4;
#pragma unroll
            for (int q4 = 0; q4 < 4; ++q4) {
                const int id = w * 4 + q4, hl = id >> 4, mt = (id >> 2) & 3, nt = id & 3;
                const LAS bf16* ap = KMs + (16 * mt + rr) * PP + hl * 256 + 8 * kg; const LAS bf16* bp = QMs + (16 * nt + rr) * PP + hl * 256 + 8 * kg;
                f32x4 acc = {0.f, 0.f, 0.f, 0.f};
#pragma unroll
                for (int s = 0; s < 8; ++s) { const bf16x8 a = *(const LAS bf16x8*)(ap + 32 * s), bq = *(const LAS bf16x8*)(bp + 32 * s); acc = __builtin_amdgcn_mfma_f32_16x16x32_bf16(a, bq, acc, 0, 0, 0); }
                const int c = 16 * nt + rr, cp0 = 16 * mt + 4 * kg;
                v2u o; o.x = pk2(cp0 <= c ? acc[0] : 0.f, cp0 + 1 <= c ? acc[1] : 0.f); o.y = pk2(cp0 + 2 <= c ? acc[2] : 0.f, cp0 + 3 <= c ? acc[3] : 0.f);
                *(GAS v2u*)(ATT + ((size_t)(cid + 2 * hp + hl) * 64 + c) * 64 + cp0) = o;
            }
        }
        __syncthreads();
    }
    if (n == 0 && w < 4) {
        const float* q0 = (const float*)(F.ws + WS_Q0K0) + b * 2048 + w * 256; const float* k0 = q0 + 1024; float s = 0.f;
#pragma unroll
        for (int i = 0; i < 4; ++i) s += q0[lane + 64 * i] * k0[lane + 64 * i];
        s = wave_sum(s) * (1.0f / 16.0f);
        if (lane == 0) ATT[(size_t)(cid + w) * 4096] = (bf16)f2bf(s);
    }
}

constexpr int CH_QT = 0, CH_QP = 528, CH_KE = 64 * CH_QP, CH_KP = 144, CH_AT = CH_KE + 256 * CH_KP, CH_DC = CH_AT + 64 * CH_KP, CH_VS = CH_DC + 1024, CH_END = CH_VS + 16384;
static_assert(CH_END <= MISC_OFF, "chain LDS");
__device__ __forceinline__ void gla_chain_unit(Frame& F, int b, int h, int qd) {
    const int tid = tid_now(), lane = tid & 63, w = F.wave, r32 = lane & 31, hi = lane >> 5;
    const bool helper = w >= 4; const int htid = tid - 256;
    const bf16* GQ = (const bf16*)(F.ws + WS_GQ2); const bf16* KET = (const bf16*)(F.ws + WS_KET); const bf16* ATT = (const bf16*)(F.ws + WS_ATT);
    const float* DEC = (const float*)(F.ws + WS_DEC); const bf16* GV = (const bf16*)(F.ws + WS_GV); bf16* ORAW = (bf16*)(F.ws + WS_XN);
    LAS unsigned char* L = F.lds;
    if (helper) {
        v4u st[23];
#define CH_LOADS(nn) do { const int ch_ = (b * 64 + (nn)) * 4 + h; const int t0_ = b * SEQ + 64 * (nn); \
            _Pragma("unroll") for (int i = 0; i < 8; ++i) { const int id = htid + 256 * i; st[i] = *(const GAS v4u*)(GQ + (size_t)(t0_ + (id >> 5)) * 1024 + h * 256 + 8 * (id & 31)); } \
            _Pragma("unroll") for (int i = 0; i < 8; ++i) { const int id = htid + 256 * i; st[8 + i] = *(const GAS v4u*)(KET + ((size_t)ch_ * 256 + (id >> 3)) * 64 + 8 * (id & 7)); } \
            _Pragma("unroll") for (int i = 0; i < 2; ++i) { const int id = htid + 256 * i; st[16 + i] = *(const GAS v4u*)(ATT + ((size_t)ch_ * 64 + (id >> 3)) * 64 + 8 * (id & 7)); } \
            _Pragma("unroll") for (int i = 0; i < 4; ++i) { const int id = htid + 256 * i; st[19 + i] = *(const GAS v4u*)(GV + (size_t)(t0_ + (id >> 4)) * 2048 + h * 512 + qd * 128 + 8 * (id & 15)); } \
            st[18] = *(const GAS v4u*)(DEC + (size_t)ch_ * 256 + 4 * (htid & 63)); } while (0)
        CH_LOADS(0);
        for (int n = 0; n < 64; ++n) {
#pragma unroll
            for (int i = 0; i < 8; ++i) { const int id = htid + 256 * i; *(LAS v4u*)(L + CH_QT + (id >> 5) * CH_QP + 16 * (id & 31)) = st[i]; }
#pragma unroll
            for (int i = 0; i < 8; ++i) { const int id = htid + 256 * i; *(LAS v4u*)(L + CH_KE + (id >> 3) * CH_KP + 16 * (id & 7)) = st[8 + i]; }
#pragma unroll
            for (int i = 0; i < 2; ++i) { const int id = htid + 256 * i; *(LAS v4u*)(L + CH_AT + (id >> 3) * CH_KP + 16 * (id & 7)) = st[16 + i]; }
#pragma unroll
            for (int i = 0; i < 4; ++i) { const int id = htid + 256 * i; *(LAS v4u*)(L + CH_VS + att::v_st(id >> 4, 8 * (id & 15))) = st[19 + i]; }
            if (htid < 64) *(LAS v4u*)(L + CH_DC + 16 * htid) = st[18];
            __syncthreads();
            if (n + 1 < 64) CH_LOADS(n + 1);
            __syncthreads();
        }
#undef CH_LOADS
    } else {
        f32x16 S[8];
#pragma unroll
        for (int i = 0; i < 8; ++i)
#pragma unroll
            for (int r = 0; r < 16; ++r) S[i][r] = 0.f;
        for (int n = 0; n < 64; ++n) {
            __syncthreads();
            const int t0 = b * SEQ + 64 * n;
            bf16x8 vc[4];
#pragma unroll
            for (int s = 0; s < 4; ++s) { const LAS unsigned char* vp = L + CH_VS + att::v_rd_base(lane) + w * 512 + s * 4096;
                const s16x4 lo = __builtin_bit_cast(s16x4, __builtin_amdgcn_ds_read_tr16_b64_v4i16((LAS v4i16_t*)vp)), hh = __builtin_bit_cast(s16x4, __builtin_amdgcn_ds_read_tr16_b64_v4i16((LAS v4i16_t*)(vp + 2048)));
                vc[s] = (bf16x8){lo[0], lo[1], lo[2], lo[3], hh[0], hh[1], hh[2], hh[3]}; }
            f32x16 O[2];
#pragma unroll
            for (int r = 0; r < 16; ++r) { O[0][r] = 0.f; O[1][r] = 0.f; }
#pragma unroll
            for (int mt = 0; mt < 8; ++mt)
#pragma unroll
                for (int sp = 0; sp < 2; ++sp) {
                    const bf16x8 bs = pack8f(S[mt][8 * sp], S[mt][8 * sp + 1], S[mt][8 * sp + 2], S[mt][8 * sp + 3], S[mt][8 * sp + 4], S[mt][8 * sp + 5], S[mt][8 * sp + 6], S[mt][8 * sp + 7]);
#pragma unroll
                    for (int mc = 0; mc < 2; ++mc) {
                        const LAS unsigned char* ap = L + CH_QT + (32 * mc + r32) * CH_QP + (32 * mt + 16 * sp + 4 * hi) * 2;
                        const s16x4 lo = *(const LAS s16x4*)ap, hh = *(const LAS s16x4*)(ap + 16);
                        const bf16x8 a = {lo[0], lo[1], lo[2], lo[3], hh[0], hh[1], hh[2], hh[3]};
                        O[mc] = __builtin_amdgcn_mfma_f32_32x32x16_bf16(a, bs, O[mc], 0, 0, 0);
                    }
                }
#pragma unroll
            for (int s = 0; s < 4; ++s)
#pragma unroll
                for (int mc = 0; mc < 2; ++mc) { const bf16x8 a = *(const LAS bf16x8*)(L + CH_AT + (32 * mc + r32) * CH_KP + (16 * s + 8 * hi) * 2); O[mc] = __builtin_amdgcn_mfma_f32_32x32x16_bf16(a, vc[s], O[mc], 0, 0, 0); }
            bf16* rowbase = ORAW + (size_t)t0 * 2048 + h * 512 + qd * 128 + 32 * w;
            const unsigned loff = (unsigned)(r32 + hi * 4 * 2048);
#pragma unroll
            for (int mc = 0; mc < 2; ++mc)
#pragma unroll
                for (int r = 0; r < 16; ++r) { const float v = O[mc][r], vn = __shfl_xor(v, 1);
                    if ((r32 & 1) == 0) *(unsigned*)(rowbase + (32 * mc + (r & 3) + 8 * (r >> 2)) * 2048 + loff) = cvtpk_s(v, vn); }
#pragma unroll
            for (int mt = 0; mt < 8; ++mt) {
#pragma unroll
                for (int j = 0; j < 4; ++j) { const f32x4 d4 = *(const LAS f32x4*)(L + CH_DC + (32 * mt + 8 * j + 4 * hi) * 4);
                    S[mt][4 * j] *= d4.x; S[mt][4 * j + 1] *= d4.y; S[mt][4 * j + 2] *= d4.z; S[mt][4 * j + 3] *= d4.w; }
#pragma unroll
                for (int s = 0; s < 4; ++s) { const bf16x8 a = *(const LAS bf16x8*)(L + CH_KE + (32 * mt + r32) * CH_KP + (16 * s + 8 * hi) * 2); S[mt] = __builtin_amdgcn_mfma_f32_32x32x16_bf16(a, vc[s], S[mt], 0, 0, 0); }
            }
            __syncthreads();
        }
    }
}

__device__ __forceinline__ void mix_row(Frame& F, int t, int lane) {
    const bf16* ORAW = (const bf16*)(F.ws + WS_XN); const bf16* GR = (const bf16*)(F.ws + WS_GR); const bf16* OC = (const bf16*)(F.ws + WS_OC); const float* LSE = (const float*)(F.ws + WS_LSE);
    bf16* MIX = (bf16*)(F.ws + WS_MIX);
#pragma unroll
    for (int h = 0; h < 4; ++h) {
        const v4u ow = *(const GAS v4u*)(ORAW + (size_t)t * 2048 + h * 512 + 8 * lane); const f32x4 o0 = {bflo(ow.x), bfhi(ow.x), bflo(ow.y), bfhi(ow.y)}, o1 = {bflo(ow.z), bfhi(ow.z), bflo(ow.w), bfhi(ow.w)};
        const float ss = wave_sum((o0.x * o0.x + o0.y * o0.y) + (o0.z * o0.z + o0.w * o0.w) + (o1.x * o1.x + o1.y * o1.y) + (o1.z * o1.z + o1.w * o1.w));
        const float r = __builtin_amdgcn_rsqf(ss * (1.0f / 512.0f) + RMS_EPS);
        const GAS f32x4* gp = (const GAS f32x4*)F.kin[7] + 2 * lane; const f32x4 g0 = gp[0], g1 = gp[1];
        const v4u gw = *(const GAS v4u*)(GR + (size_t)t * 2048 + h * 512 + 8 * lane);
        float y[8] = {o0.x * r * g0.x, o0.y * r * g0.y, o0.z * r * g0.z, o0.w * r * g0.w, o1.x * r * g1.x, o1.y * r * g1.y, o1.z * r * g1.z, o1.w * r * g1.w};
        const float gv[8] = {bflo(gw.x), bfhi(gw.x), bflo(gw.y), bfhi(gw.y), bflo(gw.z), bfhi(gw.z), bflo(gw.w), bfhi(gw.w)};
#pragma unroll
        for (int e = 0; e < 8; ++e) y[e] *= gv[e] * __builtin_amdgcn_rcpf(1.0f + __expf(-gv[e]));
        v4u o = {pk2(y[0], y[1]), pk2(y[2], y[3]), pk2(y[4], y[5]), pk2(y[6], y[7])};
        *(GAS v4u*)(MIX + (size_t)t * DM + h * 512 + 8 * lane) = o;
    }
    {
        const int hd = lane >> 2;
        float m2[3], l[3];
#pragma unroll
        for (int c = 0; c < 3; ++c) { const f32x2 v = *(const GAS f32x2*)(LSE + (((size_t)c * M + t) * 16 + hd) * 2); m2[c] = v.x; l[c] = v.y; }
        const float mx = fmaxf(m2[0], fmaxf(m2[1], m2[2]));
        float wgt[3]; float den = 0.f;
#pragma unroll
        for (int c = 0; c < 3; ++c) { wgt[c] = __builtin_amdgcn_exp2f(m2[c] - mx) * l[c]; den += wgt[c]; }
        const float rden = __builtin_amdgcn_rcpf(den);
        float acc[32];
#pragma unroll
        for (int e = 0; e < 32; ++e) acc[e] = 0.f;
#pragma unroll
        for (int c = 0; c < 3; ++c) { const float wc = wgt[c] * rden; const GAS v4u* p = (const GAS v4u*)(OC + (size_t)c * M * 2048 + ((size_t)((t >> 12) * 16 + hd) * SEQ + (t & 4095)) * 128 + 32 * (lane & 3));
#pragma unroll
            for (int q = 0; q < 4; ++q) { const v4u v = p[q];
                acc[8 * q + 0] += wc * bflo(v.x); acc[8 * q + 1] += wc * bfhi(v.x); acc[8 * q + 2] += wc * bflo(v.y); acc[8 * q + 3] += wc * bfhi(v.y);
                acc[8 * q + 4] += wc * bflo(v.z); acc[8 * q + 5] += wc * bfhi(v.z); acc[8 * q + 6] += wc * bflo(v.w); acc[8 * q + 7] += wc * bfhi(v.w); } }
        GAS v4u* op = (GAS v4u*)(MIX + (size_t)t * DM + 2048 + 32 * lane);
#pragma unroll
        for (int q = 0; q < 4; ++q) { v4u o = {pk2(acc[8 * q], acc[8 * q + 1]), pk2(acc[8 * q + 2], acc[8 * q + 3]), pk2(acc[8 * q + 4], acc[8 * q + 5]), pk2(acc[8 * q + 6], acc[8 * q + 7])}; op[q] = o; }
    }
}
__device__ __forceinline__ void halo_fix(Frame& F) {
    const int tid = tid_now();
    const float* GF = (const float*)(F.ws + WS_HALO); const float* UF = GF + HALO_ONE / 4; const float* GL = UF + HALO_ONE / 4;
    bf16* ACT = (bf16*)(F.ws + WS_ACT); const float* cw = F.kin[18]; const float* cb = F.kin[19]; const unsigned* colmax = (const unsigned*)(F.ws + WS_CTL + CTL_COLMAX);
    const int total = 256 * 2 * (DFF / 4);
    for (int i = blockIdx.x * 512 + tid; i < total; i += F.G * 512) {
        const int c4 = i % (DFF / 4), j = (i / (DFF / 4)) & 1, blk = i / (DFF / 2), ch = 4 * c4;
        const bool first = (blk & 63) == 0;
        const f32x4 g0 = *(const GAS f32x4*)(GF + ((size_t)blk * 2 + j) * DFF + ch), uu = *(const GAS f32x4*)(UF + ((size_t)blk * 2 + j) * DFF + ch);
        const f32x4 z = {0.f, 0.f, 0.f, 0.f};
        f32x4 g1, g2;
        if (j == 0) { g1 = first ? z : *(const GAS f32x4*)(GL + ((size_t)(blk - 1) * 2 + 1) * DFF + ch); g2 = first ? z : *(const GAS f32x4*)(GL + ((size_t)(blk - 1) * 2 + 0) * DFF + ch); }
        else { g1 = *(const GAS f32x4*)(GF + ((size_t)blk * 2 + 0) * DFF + ch); g2 = first ? z : *(const GAS f32x4*)(GL + ((size_t)(blk - 1) * 2 + 1) * DFF + ch); }
        const f32x4 w0 = *(const GAS f32x4*)(cw + ch), w1 = *(const GAS f32x4*)(cw + DFF + ch), w2 = *(const GAS f32x4*)(cw + 2 * DFF + ch), bb = *(const GAS f32x4*)(cb + ch);
        float a[4];
#pragma unroll
        for (int e = 0; e < 4; ++e) { const float sg = FFN_I8 ? __uint_as_float(colmax[ch + e]) * (1.0f / 127.0f) : 1.0f;
            const float y = bb[e] + sg * (w0[e] * g2[e] + w1[e] * g1[e] + w2[e] * g0[e]); a[e] = y * __builtin_amdgcn_rcpf(1.0f + __expf(-y)) * (uu[e] * -1.4426950408889634f); }
        v2u o = {pk2(a[0], a[1]), pk2(a[2], a[3])};
        *(GAS v2u*)(ACT + (size_t)(64 * blk + j) * DFF + ch) = o;
    }
}
__device__ __forceinline__ void final_norm_row(Frame& F, int t, int lane) {
    const GAS v4u* hr = (const GAS v4u*)((const bf16*)(F.ws + WS_XN) + (size_t)t * DM) + lane; GAS f32x4* xr = (GAS f32x4*)(F.out + (size_t)t * DM) + 2 * lane; const GAS f32x4* gr = (const GAS f32x4*)F.kin[21] + 2 * lane;
    v4u w[8]; float s = 0.f;
#pragma unroll
    for (int j = 0; j < 8; ++j) { w[j] = NTLD(hr + 64 * j);
        const float a0 = bflo(w[j].x), a1 = bfhi(w[j].x), a2 = bflo(w[j].y), a3 = bfhi(w[j].y), a4 = bflo(w[j].z), a5 = bfhi(w[j].z), a6 = bflo(w[j].w), a7 = bfhi(w[j].w);
        s += ((a0 * a0 + a1 * a1) + (a2 * a2 + a3 * a3)) + ((a4 * a4 + a5 * a5) + (a6 * a6 + a7 * a7)); }
    const float r = 1.0f / sqrtf(wave_sum(s) * (1.0f / 4096.0f) + RMS_EPS);
#pragma unroll
    for (int j = 0; j < 8; ++j) { const f32x4 g0 = gr[128 * j], g1 = gr[128 * j + 1];
        xr[128 * j] = (f32x4){bflo(w[j].x) * r * g0.x, bfhi(w[j].x) * r * g0.y, bflo(w[j].y) * r * g0.z, bfhi(w[j].y) * r * g0.w};
        xr[128 * j + 1] = (f32x4){bflo(w[j].z) * r * g1.x, bfhi(w[j].z) * r * g1.y, bflo(w[j].w) * r * g1.z, bfhi(w[j].w) * r * g1.w}; }
}

__device__ __forceinline__ void quant_row(Frame& F, int t, int lane) {
    unsigned* amax = (unsigned*)(F.ws + WS_CTL + CTL_AMAX);
    const GAS v4u* hr = (const GAS v4u*)((const bf16*)(F.ws + WS_XN) + (size_t)t * DM) + lane; GAS v2u* qr = (GAS v2u*)((signed char*)(F.ws + WS_H2Q) + (size_t)t * DM) + lane;
    v4u w[8]; unsigned mb = 0u;
#pragma unroll
    for (int j = 0; j < 8; ++j) { w[j] = hr[64 * j];
        const unsigned a0 = w[j].x & 0x7fff7fffu, a1 = w[j].y & 0x7fff7fffu, a2 = w[j].z & 0x7fff7fffu, a3 = w[j].w & 0x7fff7fffu;
        mb = max(mb, max(max(a0 & 0xffffu, a0 >> 16), max(a1 & 0xffffu, a1 >> 16))); mb = max(mb, max(max(a2 & 0xffffu, a2 >> 16), max(a3 & 0xffffu, a3 >> 16))); }
    mb = wave_maxu(mb);
    const float am = __uint_as_float(mb << 16); const float inv = am > 0.f ? 127.0f / am : 0.f;
    float s2 = 0.f;
#pragma unroll
    for (int j = 0; j < 8; ++j) { const float a0 = bflo(w[j].x), a1 = bfhi(w[j].x), a2 = bflo(w[j].y), a3 = bfhi(w[j].y), a4 = bflo(w[j].z), a5 = bfhi(w[j].z), a6 = bflo(w[j].w), a7 = bfhi(w[j].w);
        s2 += ((a0 * a0 + a1 * a1) + (a2 * a2 + a3 * a3)) + ((a4 * a4 + a5 * a5) + (a6 * a6 + a7 * a7)); }
    s2 = wave_sum(s2);
    if (lane == 0) { amax[t] = __float_as_uint(am); ((unsigned long long*)(F.ws + WS_CTL + CTL_SS))[(size_t)M + t] = (unsigned long long)(s2 * 1048576.0f + 0.5f); }
#pragma unroll
    for (int j = 0; j < 8; ++j) {
        qr[64 * j] = (v2u){q8x4(bflo(w[j].x), bfhi(w[j].x), bflo(w[j].y), bfhi(w[j].y), inv), q8x4(bflo(w[j].z), bfhi(w[j].z), bflo(w[j].w), bfhi(w[j].w), inv)}; }
}
typedef att::BlockRef<att::bf16, att::bf16> ABlk;
__device__ __forceinline__ ABlk dil_item(unsigned char* ws, int L) {
    const int bh = L / 48, rem = L - 48 * bh, cfg = rem >> 4, x = rem & 15, h = bh & 15, b = bh >> 4;
    const int d = cfg == 0 ? 1 : (cfg == 1 ? 4 : 16);
    const int r = cfg == 0 ? 0 : (cfg == 1 ? (x >> 2) : x), qb = cfg == 0 ? x : (cfg == 1 ? (x & 3) : 0);
    const att::bf16* DQ = (const att::bf16*)(ws + WS_DQKV); const att::bf16* DK = DQ + (size_t)M * 2048; const att::bf16* DV = DK + (size_t)M * 2048;
    const int sq = r + d * 256 * qb, tq = b * SEQ + sq; const size_t hb = (size_t)(b * 16 + h) * SEQ;
    ABlk R;
    R.Q = DQ + (hb + sq) * 128; R.K = DK + (hb + r) * 128; R.V = DV + (hb + r) * 128;
    R.O = (att::bf16*)(ws + WS_OC) + ((size_t)cfg * M * 2048) + (hb + sq) * 128;
    R.L = (float*)(ws + WS_LSE) + (((size_t)cfg * M + tq) * 16 + h) * 2;
    R.bsrc = (const float*)(ws + WS_BT) + (cfg * 16 + h) * 132;
    R.P0 = 256 * qb; R.pq = 128 * d; R.pk = 128 * d; R.po = 128 * d; R.pl = 32 * d; R.skv = SEQ / d; R.W = 129;
    return R;
}
__device__ __forceinline__ ABlk xat_item(unsigned char* ws, int L) {
    const int qb = L & 15, h = (L >> 4) & 3, b = L >> 6;
    const att::bf16* XQ = (const att::bf16*)(ws + WS_XQ); const att::bf16* XKV = (const att::bf16*)(ws + WS_XKV);
    ABlk R;
    R.Q = XQ + (size_t)(b * SEQ + 256 * qb) * XW + h * 128; R.K = XKV + (size_t)(b * MEMLEN) * 1024 + h * 128; R.V = R.K + 512;
    R.O = (att::bf16*)(ws + WS_XO) + (size_t)(b * SEQ + 256 * qb) * XW + h * 128; R.L = nullptr; R.bsrc = nullptr;
    R.P0 = 1 << 20; R.pq = XW; R.pk = 1024; R.po = XW; R.pl = 0; R.skv = MEMLEN; R.W = 1 << 30;
    return R;
}

#ifndef PG_ALIGN
#define PG_ALIGN true
#endif
#ifndef PG_SP2
#define PG_SP2 true
#endif
struct Args { const float* in[22]; float* out; unsigned char* ws; int ph_lo, ph_hi; };
__global__ void __launch_bounds__(NWAVES * 64, 2) hybrid_fwd(Args args) {
    extern __shared__ __attribute__((aligned(16))) unsigned char lds[];
    Frame F;
    F.lds = (LAS unsigned char*)lds; F.ldsg = (char*)lds;
    F.MISC = (volatile LAS unsigned*)(F.lds + MISC_OFF);
    F.wave = __builtin_amdgcn_readfirstlane((int)threadIdx.x >> 6);
    F.G = gridDim.x; { const int bx = blockIdx.x; F.vcu = (F.G % 8 == 0) ? (bx % 8) * (F.G / 8) + bx / 8 : bx; }
    F.ws = args.ws; F.ctl = (gu32*)(args.ws + WS_CTL); F.out = args.out;
    F.kin = (const float* const __attribute__((address_space(4)))*)__builtin_amdgcn_kernarg_segment_ptr();
    if (threadIdx.x < 64) F.MISC[threadIdx.x] = 0u;
    __syncthreads();
    XcdBarrier bar; bar.bar = (unsigned*)(F.ctl + CW_BAR); bar.x = 0; bar.st = nullptr;
    if (N_LAUNCHES == 1) bar = xcd_barrier_post((unsigned*)(F.ctl + CW_BAR), F.MISC + 8);
#define GRID_BAR() do { if (N_LAUNCHES == 1) xcd_barrier(bar); } while (0)
    const int lo = args.ph_lo, hi = args.ph_hi;
#ifndef PH_MASK
#define PH_MASK 0x1fff
#endif
#define IN(k) ((((PH_MASK) >> (k)) & 1) && lo <= (k) && (k) < hi)
#define BOTH(k) (IN(k) && IN((k) + 1))
#ifndef DUPMASK
#define DUPMASK 0
#endif
#ifndef XBAR
#define XBAR 0
#endif
#define DUPK(k, ...) { __VA_ARGS__ } if constexpr ((((DUPMASK) >> (k)) & 1) != 0) { __syncthreads(); { __VA_ARGS__ } }
#define GRID_BARX() do { GRID_BAR(); if constexpr (XBAR != 0) GRID_BAR(); } while (0)
    unsigned long long* SS1 = (unsigned long long*)(F.ws + WS_CTL + CTL_SS); unsigned long long* SS2 = SS1 + M; unsigned long long* SS3 = SS2 + M;
    const int gw = F.vcu * NWAVES + F.wave, NGW = F.G * NWAVES;

    if (IN(0)) { DUPK(0, p0_first_token(F); p0_prologue(F);) GRID_BAR(); p0_quant_win(F);
#ifdef DUP_P0FT
        __syncthreads(); p0_first_token(F); __syncthreads(); p0_first_token(F); __syncthreads(); p0_first_token(F); __syncthreads(); p0_first_token(F);
#endif
        if (BOTH(0)) GRID_BARX(); }
    if (IN(1)) {
        { pg8::Gemm g{(const bf16*)(F.ws + WS_XN), (const bf16*)(F.ws + WS_WIN), M, NB1, DM}; pg8::StaticOrder S; S.init(M, NB1, F.G, (int)blockIdx.x);
          pg8::EpiProj E{(bf16*)(F.ws + WS_GQ), (bf16*)(F.ws + WS_GK), (bf16*)(F.ws + WS_GV), (bf16*)(F.ws + WS_GR), (bf16*)(F.ws + WS_DQKV), GV_I8 ? 0 : 2048};
          pg8::gemm_phase<pg8::EpiProj, pg8::StaticOrder, PG_ALIGN, PG_SP2>(F.lds, g, S, E);
          { pg8::Gemm gq{(const bf16*)(F.ws + WS_XNQ), (const bf16*)(F.ws + WS_WINQ), M, NQ1, DM / 2}; pg8::StaticOrder Sq; Sq.init(M, NQ1, F.G, (int)blockIdx.x);
            pg8::EpiProjQ Eq{(bf16*)(F.ws + WS_DQKV), (const float*)(F.ws + WS_RSC1), (const unsigned*)(F.ws + WS_CTL + CTL_CMAX1), (bf16*)(F.ws + WS_GV), GV_I8 ? 2048 : 0};
            pg8::gemm_phase<pg8::EpiProjQ, pg8::StaticOrder, PG_ALIGN, PG_SP2>(F.lds, gq, Sq, Eq); }
#ifdef DUP_P1NULL
          { pg8::EpiNull E0{}; pg8::Gemm g2{(const bf16*)(F.ws + WS_XN), (const bf16*)(F.ws + WS_WIN), M, 3072, DM}; pg8::StaticOrder S2; S2.init(M, 3072, F.G, (int)blockIdx.x); pg8::gemm_phase<pg8::EpiNull, pg8::StaticOrder, PG_ALIGN, PG_SP2>(F.lds, g2, S2, E0); pg8::gemm_phase<pg8::EpiNull, pg8::StaticOrder, PG_ALIGN, PG_SP2>(F.lds, g2, S2, E0); pg8::gemm_phase<pg8::EpiNull, pg8::StaticOrder, PG_ALIGN, PG_SP2>(F.lds, g2, S2, E0); pg8::gemm_phase<pg8::EpiNull, pg8::StaticOrder, PG_ALIGN, PG_SP2>(F.lds, g2, S2, E0); }
#endif
          }
        if (BOTH(1)) GRID_BARX();
    }
    if (IN(2)) { DUPK(2, for (int u = blockIdx.x; u < NB * 64; u += F.G) gla_prep_unit(F, u >> 6, u & 63);) if (BOTH(2)) GRID_BARX(); }
    if (IN(3)) {
#ifdef PRE_ATT_VARIANT
        {
            gu32* qctr = F.ctl + CW_QUEUE + 64;
#define NEXT_ITEM(dst) do { if (tid_now() == 0) F.MISC[16] = __hip_atomic_fetch_add(qctr, 1u, RLX_AGENT); __syncthreads(); dst = __builtin_amdgcn_readfirstlane((int)F.MISC[16]); __syncthreads(); } while (0)
            int L; NEXT_ITEM(L);
            if (L < 3072) {
                ABlk cur = dil_item(F.ws, L); att::Seam<att::bf16> S; int par = 0;
                att::causal_swa_prime<PRE_ATT_VARIANT, att::bf16, att::bf16>(cur, F.ldsg, S);
                unsigned char* const wsp = F.ws; auto itf = [wsp](int l) { return dil_item(wsp, l); };
                for (;;) { int Ln; NEXT_ITEM(Ln); const bool last = Ln >= 3072; const int Lx = last ? L : Ln;
                    att::causal_swa_block<PRE_ATT_VARIANT, att::bf16, att::bf16>(cur, Lx, itf, par, F.ldsg, S);
                    if (last) break; L = Ln; cur = dil_item(F.ws, L); par ^= 1; }
            }
#undef NEXT_ITEM
            __syncthreads();
        }
#endif
        if ((int)blockIdx.x < 64) gla_chain_unit(F, blockIdx.x >> 4, (blockIdx.x >> 2) & 3, blockIdx.x & 3);
        {
            gu32* qctr = F.ctl + CW_QUEUE;
#define NEXT_ITEM(dst) do { if (tid_now() == 0) F.MISC[16] = __hip_atomic_fetch_add(qctr, 1u, RLX_AGENT); __syncthreads(); dst = __builtin_amdgcn_readfirstlane((int)F.MISC[16]); __syncthreads(); } while (0)
            int L; NEXT_ITEM(L);
            if (L < 3072) {
                ABlk cur = dil_item(F.ws, L); att::Seam<att::bf16> S; int par = 0;
                att::causal_swa_prime<1, att::bf16, att::bf16>(cur, F.ldsg, S);
                unsigned char* const wsp = F.ws; auto itf = [wsp](int l) { return dil_item(wsp, l); };
                for (;;) { int Ln; NEXT_ITEM(Ln); const bool last = Ln >= 3072; const int Lx = last ? L : Ln;
                    att::causal_swa_block<1, att::bf16, att::bf16>(cur, Lx, itf, par, F.ldsg, S);
                    if (last) break; L = Ln; cur = dil_item(F.ws, L); par ^= 1; }
            }
#undef NEXT_ITEM
        }
#ifdef DUP_CHAIN
        __syncthreads(); if ((int)blockIdx.x < 64) gla_chain_unit(F, blockIdx.x >> 4, (blockIdx.x >> 2) & 3, blockIdx.x & 3);
#endif
        if (BOTH(3)) GRID_BARX();
    }
    if (IN(4)) {
        { const int lane = tid_now() & 63; for (int t = gw; t < M; t += NGW) mix_row(F, t, lane); }
        ffn_weights<0>(F, 2 * FW_IG, FW_P9_LO, gw, NGW);
        if constexpr (FFN_I8) { ffn_weights<1>(F, 0, 2 * FW_IG, gw, NGW); GRID_BAR(); }
        ffn_weights<0>(F, 0, FW_P6_LO, gw, NGW);
        if (BOTH(4)) GRID_BARX(); }
    if (IN(5)) {
        pg8::Gemm g{(const bf16*)(F.ws + WS_MIX), (const bf16*)(F.ws + WS_WOUT), M, DM, DM}; pg8::StaticOrder S; S.init(M, DM, F.G, (int)blockIdx.x);
        pg8::EpiResid E{F.kin[0], nullptr, (bf16*)(F.ws + WS_XN), SS1, DM, nullptr};
        pg8::gemm_phase<pg8::EpiResid, pg8::StaticOrder, PG_ALIGN, PG_SP2>(F.lds, g, S, E);
#ifdef DUP_P5
        { pg8::EpiResid E2{F.kin[0], nullptr, (bf16*)(F.ws + WS_XN), nullptr, DM, nullptr}; pg8::gemm_phase<pg8::EpiResid, pg8::StaticOrder, PG_ALIGN, PG_SP2>(F.lds, g, S, E2); }
#endif
        if (BOTH(5)) GRID_BARX();
    }
    if (IN(6)) {
        DUPK(6,
        if ((int)blockIdx.x < 128 || F.G < 144) {
        pg8::Gemm g{(const bf16*)(F.ws + WS_XN), (const bf16*)(F.ws + WS_WXQ), M, XW, DM}; pg8::StaticOrder S; S.init(M, XW, F.G < 144 ? F.G : 128, (int)blockIdx.x);
        pg8::EpiScaleBf16 E{(bf16*)(F.ws + WS_XQ), XW, SS1, 1.0f / 4096.0f};
        pg8::gemm_phase<pg8::EpiScaleBf16, pg8::StaticOrder, PG_ALIGN, PG_SP2>(F.lds, g, S, E);
        }
        if ((int)blockIdx.x >= 128 || F.G < 144) {
        pg8::Gemm g{(const bf16*)(F.ws + WS_MEMN), (const bf16*)(F.ws + WS_WXKV), MROWS, 1024, DM}; pg8::StaticOrder S; S.init(MROWS, 1024, F.G < 144 ? F.G : F.G - 128, F.G < 144 ? (int)blockIdx.x : (int)blockIdx.x - 128);
        pg8::EpiScaleBf16 E{(bf16*)(F.ws + WS_XKV), 1024, nullptr, 0.f};
        pg8::gemm_phase<pg8::EpiScaleBf16, pg8::StaticOrder, PG_ALIGN, PG_SP2>(F.lds, g, S, E);
        }
        if (F.G >= 256) { if ((int)blockIdx.x >= 144) ffn_weights<0>(F, FW_P6_LO, FW_P6_HI, ((int)blockIdx.x - 144) * NWAVES + F.wave, (F.G - 144) * NWAVES); }
        else ffn_weights<0>(F, FW_P6_LO, FW_P6_HI, gw, NGW);
        )
        if (BOTH(6)) GRID_BARX();
    }
    if (IN(7)) {
        DUPK(7,
        if ((int)blockIdx.x < 256) {
            int L = blockIdx.x; ABlk cur = xat_item(F.ws, L); att::Seam<att::bf16> S; int par = 0;
            att::causal_swa_prime<0, att::bf16, att::bf16>(cur, F.ldsg, S);
            unsigned char* const wsp = F.ws; auto itf = [wsp](int l) { return xat_item(wsp, l); };
            for (;;) { const int Ln = L + F.G; const bool last = Ln >= 256; const int Lx = last ? L : Ln;
                att::causal_swa_block<0, att::bf16, att::bf16>(cur, Lx, itf, par, F.ldsg, S);
                if (last) break; L = Ln; cur = xat_item(F.ws, L); par ^= 1; }
        }
        )
        if (BOTH(7)) GRID_BARX();
    }
    if (IN(8)) {
        pg8::Gemm g{(const bf16*)(F.ws + WS_XO), (const bf16*)(F.ws + WS_WXO), M, DM, XW}; pg8::StaticOrder S; S.init(M, DM, F.G, (int)blockIdx.x);
        pg8::EpiResid E{nullptr, (const bf16*)(F.ws + WS_XN), (bf16*)(F.ws + WS_XN), FFN_I8 ? nullptr : SS2, DM, nullptr};
        pg8::gemm_phase<pg8::EpiResid, pg8::StaticOrder, PG_ALIGN, PG_SP2>(F.lds, g, S, E);
        if constexpr (FFN_I8) { GRID_BAR(); const int lane = tid_now() & 63; for (int t = gw; t < M; t += NGW) quant_row(F, t, lane); }
        if (BOTH(8)) GRID_BARX();
    }
    if (IN(9)) {
        DUPK(9,
        typedef pg8::EpiGateUpT<FFN_I8 != 0> EpiGU;
        pg8::Gemm g{(const bf16*)(F.ws + (FFN_I8 ? WS_H2Q : WS_XN)), (const bf16*)(F.ws + WS_WGU), M, NGU, FFN_I8 ? DM / 2 : DM};
        const int G9 = (F.G == 256 && P9_GEMM_WGS > 0) ? P9_GEMM_WGS : F.G;
        pg8::StaticOrder S; S.init(M, NGU, G9, (int)blockIdx.x);
        float* GF = (float*)(F.ws + WS_HALO);
        EpiGU E{(bf16*)(F.ws + WS_ACT), DFF, SS2, 1.0f / 4096.0f, F.kin[18], F.kin[19], GF, GF + HALO_ONE / 4, GF + 2 * (HALO_ONE / 4), DFF, (LAS float*)(F.lds + 131072),
                (const unsigned*)(F.ws + WS_CTL + CTL_COLMAX), (const unsigned*)(F.ws + WS_CTL + CTL_AMAX)};
        if ((int)blockIdx.x < G9) pg8::gemm_phase<EpiGU, pg8::StaticOrder, PG_ALIGN, PG_SP2>(F.lds, g, S, E);
        if (G9 < F.G) { if ((int)blockIdx.x >= G9) ffn_weights<0>(F, FW_P9_LO, FW_P9_HI, ((int)blockIdx.x - G9) * NWAVES + F.wave, (F.G - G9) * NWAVES); }
        else if (F.G == 256) { if ((int)blockIdx.x >= 128) ffn_weights<0>(F, FW_P9_LO, FW_P9_HI, ((int)blockIdx.x - 128) * NWAVES + F.wave, 128 * NWAVES); }
        else ffn_weights<0>(F, FW_P9_LO, FW_P9_HI, gw, NGW);
        )
        if (BOTH(9)) GRID_BARX();
    }
    if (IN(10)) { DUPK(10, halo_fix(F);) if (BOTH(10)) GRID_BARX(); }
    if (IN(11)) {
        pg8::Gemm g{(const bf16*)(F.ws + WS_ACT), (const bf16*)(F.ws + WS_WDN), M, DM, DFF}; pg8::StaticOrder S; S.init(M, DM, F.G, (int)blockIdx.x);
        pg8::EpiResid E{nullptr, (const bf16*)(F.ws + WS_XN), (bf16*)(F.ws + WS_XN), nullptr, DM, nullptr};
        pg8::gemm_phase<pg8::EpiResid, pg8::StaticOrder, PG_ALIGN, PG_SP2>(F.lds, g, S, E);
        if (BOTH(11)) GRID_BARX();
    }
    if (IN(12)) { DUPK(12, const int lane = tid_now() & 63; for (int t = gw; t < M; t += NGW) final_norm_row(F, t, lane);)
    }
#undef IN
#undef BOTH
#undef GRID_BAR
}

extern "C" void kernel_launch(void* const* d_in, const int* in_sizes, int n_in, void* d_out, int out_size, void* d_ws, size_t ws_size, hipStream_t stream) {
    static int grid = 0;
    if (grid == 0) {
        if (n_in != 22 || in_sizes[0] != M * DM || out_size != M * DM || ws_size < WS_END) { fprintf(stderr, "kernel_launch: unexpected shapes (n_in %d, in0 %d, out %d, ws %zu)\n", n_in, n_in > 0 ? in_sizes[0] : -1, out_size, ws_size); grid = -1; return; }
        int dev = 0, cus = 0, per_cu = 0;
        if (hipGetDevice(&dev) != hipSuccess || hipDeviceGetAttribute(&cus, hipDeviceAttributeMultiprocessorCount, dev) != hipSuccess) { grid = -1; return; }
        if (hipFuncSetAttribute((const void*)hybrid_fwd, hipFuncAttributeMaxDynamicSharedMemorySize, LDS_BYTES) != hipSuccess) { fprintf(stderr, "kernel_launch: hipFuncSetAttribute failed\n"); grid = -1; return; }
        if (hipOccupancyMaxActiveBlocksPerMultiprocessor(&per_cu, (const void*)hybrid_fwd, NWAVES * 64, LDS_BYTES) != hipSuccess || per_cu < 1) fprintf(stderr, "kernel_launch: occupancy query reports %d\n", per_cu);
        (void)hipGetLastError();
        grid = cus;
    }
    if (grid < 0) return;
    if (hipMemsetAsync((char*)d_ws + WS_CTL, 0, CTL_ZERO_BYTES, stream) != hipSuccess) return;
    Args a{};
    for (int i = 0; i < 22; ++i) a.in[i] = (const float*)d_in[i];
    a.out = (float*)d_out; a.ws = (unsigned char*)d_ws;
    for (int li = 0; li < N_LAUNCHES; ++li) {
        a.ph_lo = (N_LAUNCHES == 1) ? 0 : li; a.ph_hi = (N_LAUNCHES == 1) ? NPH : li + 1;
        hipLaunchKernelGGL(hybrid_fwd, dim3(grid), dim3(NWAVES * 64), LDS_BYTES, stream, a);
    }
}
```

```cpp
#include <hip/hip_runtime.h>
#include <hip/hip_bf16.h>
#include <cstdio>
#include <cstdint>
#include <cmath>
#include <type_traits>
#ifndef MK_N_LAUNCHES
#define MK_N_LAUNCHES 1
#endif
namespace pg8 {
#define PG8_LAS __attribute__((address_space(3)))
typedef unsigned short bf16_t;
typedef short bf16x8 __attribute__((ext_vector_type(8)));
typedef float f32x4 __attribute__((ext_vector_type(4)));
typedef unsigned u32x4 __attribute__((ext_vector_type(4)));
constexpr int BM = 256, BK = 64, HALF = 128, HTB = HALF * BK * 2  , STAGE_BYTES = 8 * HTB, NXCD = 8, WGM = 8;

__host__ __device__ __forceinline__ int lds_byte(int r, int c) { const int st = (r >> 4) * 2 + (c >> 5), rr = r & 15, cc = c & 31, ob = rr * 64 + cc * 2; return st * 1024 + (ob ^ (((ob >> 9) & 1) << 5)); }
__host__ __device__ __forceinline__ void stage_rc(int b, int& R, int& C) { const int st = b / 1024, sb = b % 1024, swz = sb ^ (((sb >> 9) & 1) << 5); R = (st >> 1) * 16 + swz / 64; C = (st & 1) * 32 + (swz % 64) / 2; }
__host__ __device__ __forceinline__ int perm32(int rho) { const int n = rho >> 4, i = rho & 15; return 8 * (i >> 2) + 4 * n + (i & 3); }

struct Unit { int pm, pn; };
struct Gemm { const bf16_t* A; const bf16_t* Bt; int M, N, K; };

struct StaticOrder {
    int nM, nN, nwg, G, c;
    __host__ __device__ void init(int M, int N, int G_, int c_) { nM = M / BM; nN = N / BM; nwg = nM * nN; G = G_; c = c_; }
    __host__ __device__ bool next(int i, Unit& u) const {
        const long L = (long)i * G + c; if (L >= nwg) return false;
        int wgid = (int)L; { const int q = nwg / NXCD, r = nwg % NXCD, xcd = wgid % NXCD, off = wgid / NXCD; wgid = (xcd < r ? xcd * (q + 1) : r * (q + 1) + (xcd - r) * q) + off; }
        const int nig = WGM * nN, gid = wgid / nig, fm = gid * WGM, gsz = (nM - fm) < WGM ? (nM - fm) : WGM;
        u.pm = fm + ((wgid % nig) % gsz); u.pn = (wgid % nig) / gsz; return true;
    }
    __device__ __forceinline__ void a_ready(const Unit&) const {}
    __device__ __forceinline__ void done(const Unit&) const {}
};

__device__ __forceinline__ unsigned cvt_pk_bf16(float lo, float hi) { unsigned r; asm volatile("v_cvt_pk_bf16_f32 %0, %1, %2" : "=v"(r) : "v"(lo), "v"(hi)); return r; }
typedef float f32x2 __attribute__((ext_vector_type(2)));
typedef unsigned u32x2 __attribute__((ext_vector_type(2)));
typedef int i32x4 __attribute__((ext_vector_type(4)));
typedef __bf16 bf16x2v __attribute__((ext_vector_type(2)));
__device__ __forceinline__ unsigned cvtpk_e(float lo, float hi) { f32x2 v = {lo, hi}; bf16x2v b = __builtin_convertvector(v, bf16x2v); return __builtin_bit_cast(unsigned, b); }
constexpr float RMS_EPS = 1e-6f;
constexpr float SS_SCALE = 1048576.0f;
__device__ __forceinline__ float rstd_of(const unsigned long long* ss, int row, float inv_n) { return 1.0f / sqrtf((float)ss[row] * (inv_n / SS_SCALE) + RMS_EPS); }

struct Seg { bf16_t* base; int ld; int col0; int pad; };
struct EpiProj {
    static constexpr bool PERM = true, PERMA = false, AFTER_DRAIN = false, PREFETCH = false, I8 = false; typedef f32x4 AccT; static constexpr int NST = 16;
    bf16_t *gq, *gk, *gv, *gr, *dqkv;
    int nv;
    __device__ __forceinline__ void operator()(const f32x4 (&acc)[2][2][4][2], const Unit& u, int wr, int wc, int fr, int fq) const {
        const int colt = u.pn * BM; const int row0 = u.pm * BM + wr * 64 + fr;
        if (colt < 4096 + nv) {
            bf16_t* base; int ld, c0;
            if (colt < 1024) { base = gq; ld = 1024; c0 = colt; } else if (colt < 2048) { base = gk; ld = 1024; c0 = colt - 1024; }
            else if (colt < 2048 + nv) { base = gv; ld = 2048; c0 = colt - 2048; } else { base = gr; ld = 2048; c0 = colt - 2048 - nv; }
            const int col0 = c0 + wc * 32 + 8 * fq;
#pragma unroll
            for (int ai = 0; ai < 2; ++ai)
#pragma unroll
                for (int m = 0; m < 4; ++m) { bf16_t* rowp = base + (size_t)(row0 + ai * HALF + m * 16) * ld + col0;
#pragma unroll
                    for (int bj = 0; bj < 2; ++bj) { const f32x4 v0 = acc[ai][bj][m][0], v1 = acc[ai][bj][m][1];
                        u32x4 w; w.x = cvt_pk_bf16(v0[0], v0[1]); w.y = cvt_pk_bf16(v0[2], v0[3]); w.z = cvt_pk_bf16(v1[0], v1[1]); w.w = cvt_pk_bf16(v1[2], v1[3]);
                        __builtin_nontemporal_store(w, (u32x4*)(rowp + bj * HALF)); } }
        } else {
            const int c = colt - 4096 - nv, ten = c >> 11, h0 = (c & 2047) >> 7;
            bf16_t* base = dqkv + (size_t)ten * ((size_t)16384 * 2048) + wc * 32 + 8 * fq;
#pragma unroll
            for (int ai = 0; ai < 2; ++ai)
#pragma unroll
                for (int m = 0; m < 4; ++m) { const int row = row0 + ai * HALF + m * 16, b = row >> 12, sq = row & 4095;
#pragma unroll
                    for (int bj = 0; bj < 2; ++bj) { const f32x4 v0 = acc[ai][bj][m][0], v1 = acc[ai][bj][m][1];
                        u32x4 w; w.x = cvt_pk_bf16(v0[0], v0[1]); w.y = cvt_pk_bf16(v0[2], v0[3]); w.z = cvt_pk_bf16(v1[0], v1[1]); w.w = cvt_pk_bf16(v1[2], v1[3]);
                        __builtin_nontemporal_store(w, (u32x4*)(base + ((size_t)((b * 16 + h0 + bj) * 4096 + sq)) * 128)); } }
        }
    }
};
struct EpiProjQ {
    static constexpr bool PERM = true, PERMA = false, AFTER_DRAIN = false, PREFETCH = false, I8 = true; typedef i32x4 AccT; static constexpr int NST = 16;
    bf16_t* dqkv; const float* rsc; const unsigned* cmax; bf16_t* gv; int nv;
    __device__ __forceinline__ void operator()(const i32x4 (&acc)[2][2][4][2], const Unit& u, int wr, int wc, int fr, int fq) const {
        const int c = u.pn * BM, cd = c - nv, ten = cd >> 11, h0 = (cd & 2047) >> 7; const int row0 = u.pm * BM + wr * 64 + fr;
        const bool isv = c < nv;
        bf16_t* base = isv ? gv + c + wc * 32 + 8 * fq : dqkv + (size_t)ten * ((size_t)16384 * 2048) + wc * 32 + 8 * fq;
        float cs[2][8];
#pragma unroll
        for (int bj = 0; bj < 2; ++bj) { const u32x4 m0 = *(const u32x4*)(cmax + c + bj * HALF + wc * 32 + 8 * fq), m1 = *(const u32x4*)(cmax + c + bj * HALF + wc * 32 + 8 * fq + 4);
            cs[bj][0] = __uint_as_float(m0.x) * (1.0f / 127.0f); cs[bj][1] = __uint_as_float(m0.y) * (1.0f / 127.0f); cs[bj][2] = __uint_as_float(m0.z) * (1.0f / 127.0f); cs[bj][3] = __uint_as_float(m0.w) * (1.0f / 127.0f);
            cs[bj][4] = __uint_as_float(m1.x) * (1.0f / 127.0f); cs[bj][5] = __uint_as_float(m1.y) * (1.0f / 127.0f); cs[bj][6] = __uint_as_float(m1.z) * (1.0f / 127.0f); cs[bj][7] = __uint_as_float(m1.w) * (1.0f / 127.0f); }
#pragma unroll
        for (int ai = 0; ai < 2; ++ai)
#pragma unroll
            for (int m = 0; m < 4; ++m) { const int row = row0 + ai * HALF + m * 16, b = row >> 12, sq = row & 4095; const float rs = rsc[row];
#pragma unroll
                for (int bj = 0; bj < 2; ++bj) { const i32x4 a0 = acc[ai][bj][m][0], a1 = acc[ai][bj][m][1];
                    u32x4 w; w.x = cvt_pk_bf16((float)a0[0] * (rs * cs[bj][0]), (float)a0[1] * (rs * cs[bj][1])); w.y = cvt_pk_bf16((float)a0[2] * (rs * cs[bj][2]), (float)a0[3] * (rs * cs[bj][3]));
                    w.z = cvt_pk_bf16((float)a1[0] * (rs * cs[bj][4]), (float)a1[1] * (rs * cs[bj][5])); w.w = cvt_pk_bf16((float)a1[2] * (rs * cs[bj][6]), (float)a1[3] * (rs * cs[bj][7]));
                    __builtin_nontemporal_store(w, (u32x4*)(isv ? base + (size_t)row * 2048 + bj * HALF : base + ((size_t)((b * 16 + h0 + bj) * 4096 + sq)) * 128)); } }
    }
};
struct EpiScaleBf16 {
    static constexpr bool PERM = true, PERMA = false, AFTER_DRAIN = false, PREFETCH = false, I8 = false; typedef f32x4 AccT; static constexpr int NST = 16;
    bf16_t* O; int ldc; const unsigned long long* ss; float inv_n;
    __device__ __forceinline__ void operator()(const f32x4 (&acc)[2][2][4][2], const Unit& u, int wr, int wc, int fr, int fq) const {
        const int row0 = u.pm * BM + wr * 64 + fr, col0 = u.pn * BM + wc * 32 + 8 * fq;
#pragma unroll
        for (int ai = 0; ai < 2; ++ai)
#pragma unroll
            for (int m = 0; m < 4; ++m) { const int row = row0 + ai * HALF + m * 16; const float rs = ss ? rstd_of(ss, row, inv_n) : 1.0f; bf16_t* rowp = O + (size_t)row * ldc + col0;
#pragma unroll
                for (int bj = 0; bj < 2; ++bj) { const f32x4 v0 = acc[ai][bj][m][0] * rs, v1 = acc[ai][bj][m][1] * rs;
                    u32x4 w; w.x = cvt_pk_bf16(v0[0], v0[1]); w.y = cvt_pk_bf16(v0[2], v0[3]); w.z = cvt_pk_bf16(v1[0], v1[1]); w.w = cvt_pk_bf16(v1[2], v1[3]);
                    *(u32x4*)(rowp + bj * HALF) = w; } }
    }
};
struct EpiResid {
    static constexpr bool PERM = true, PERMA = false, AFTER_DRAIN = false, PREFETCH = false, I8 = false; typedef f32x4 AccT; static constexpr int NST = 32;
    const float* base32; const bf16_t* base16; bf16_t* hb; unsigned long long* ss; int ldc; unsigned* amax;
    __device__ __forceinline__ void operator()(const f32x4 (&acc)[2][2][4][2], const Unit& u, int wr, int wc, int fr, int fq) const {
        const int row0 = u.pm * BM + wr * 64 + fr, col0 = u.pn * BM + wc * 32 + 8 * fq;
        f32x4 bc[2][2], bn[2][2]; u32x4 hc[2], hn[2];
#define EPR_LOAD(d32, d16, g) do { const size_t o_ = (size_t)(row0 + ((g) >> 2) * HALF + ((g) & 3) * 16) * ldc + col0; \
        if (base32) { d32[0][0] = __builtin_nontemporal_load((const f32x4*)(base32 + o_)); d32[0][1] = __builtin_nontemporal_load((const f32x4*)(base32 + o_ + 4)); d32[1][0] = __builtin_nontemporal_load((const f32x4*)(base32 + o_ + HALF)); d32[1][1] = __builtin_nontemporal_load((const f32x4*)(base32 + o_ + HALF + 4)); } \
        else { d16[0] = *(const u32x4*)(base16 + o_); d16[1] = *(const u32x4*)(base16 + o_ + HALF); } } while (0)
        EPR_LOAD(bc, hc, 0);
#pragma unroll
        for (int g = 0; g < 8; ++g) {
            const int ai = g >> 2, m = g & 3; const int row = row0 + ai * HALF + m * 16; const size_t off = (size_t)row * ldc + col0; float s = 0.f; float mx = 0.f;
            if (g < 7) EPR_LOAD(bn, hn, g + 1);
#pragma unroll
            for (int bj = 0; bj < 2; ++bj) {
                f32x4 b0, b1;
                if (base32) { b0 = bc[bj][0]; b1 = bc[bj][1]; }
                else { const u32x4 w = hc[bj]; b0 = (f32x4){__uint_as_float(w.x << 16), __uint_as_float(w.x & 0xffff0000u), __uint_as_float(w.y << 16), __uint_as_float(w.y & 0xffff0000u)};
                                              b1 = (f32x4){__uint_as_float(w.z << 16), __uint_as_float(w.z & 0xffff0000u), __uint_as_float(w.w << 16), __uint_as_float(w.w & 0xffff0000u)}; }
                const f32x4 v0 = acc[ai][bj][m][0] + b0, v1 = acc[ai][bj][m][1] + b1;
                s += (v0[0] * v0[0] + v0[1] * v0[1]) + (v0[2] * v0[2] + v0[3] * v0[3]) + (v1[0] * v1[0] + v1[1] * v1[1]) + (v1[2] * v1[2] + v1[3] * v1[3]);
                if (amax) { const f32x4 a0 = __builtin_elementwise_abs(v0), a1 = __builtin_elementwise_abs(v1); mx = fmaxf(mx, fmaxf(fmaxf(fmaxf(a0[0], a0[1]), fmaxf(a0[2], a0[3])), fmaxf(fmaxf(a1[0], a1[1]), fmaxf(a1[2], a1[3])))); }
                u32x4 w; w.x = cvt_pk_bf16(v0[0], v0[1]); w.y = cvt_pk_bf16(v0[2], v0[3]); w.z = cvt_pk_bf16(v1[0], v1[1]); w.w = cvt_pk_bf16(v1[2], v1[3]); *(u32x4*)(hb + off + bj * HALF) = w; }
            s += __shfl_xor(s, 16); s += __shfl_xor(s, 32);
            if (ss && fq == 0) atomicAdd(ss + row, (unsigned long long)(s * SS_SCALE + 0.5f));
            if (amax) { mx = fmaxf(mx, __shfl_xor(mx, 16)); mx = fmaxf(mx, __shfl_xor(mx, 32)); if (fq == 0) atomicMax(amax + row, __float_as_uint(mx)); }
#pragma unroll
            for (int bj = 0; bj < 2; ++bj) { bc[bj][0] = bn[bj][0]; bc[bj][1] = bn[bj][1]; hc[bj] = hn[bj]; }
            asm volatile("" ::: "memory");
        }
#undef EPR_LOAD
    }
};
template <bool Q> struct EpiGateUpT {
    static constexpr bool PERM = true, PERMA = true, AFTER_DRAIN = false, PREFETCH = true, I8 = Q; typedef typename std::conditional<Q, i32x4, f32x4>::type AccT; static constexpr int NST = 32;
    static constexpr int AUXN = 1024;
    static constexpr float NLOG2E = -1.4426950408889634f, NLN2 = -0.6931471805599453f;
    bf16_t* act; int ldc; const unsigned long long* ss; float inv_n; const float* cw; const float* cb; float* GF; float* UF; float* GL; int nff;
    PG8_LAS float* aux;
    const unsigned* colmax; const unsigned* amax;
    __device__ __forceinline__ float rowscale(unsigned long long s2, unsigned am) const { const float r = 1.0f / sqrtf((float)s2 * (inv_n / SS_SCALE) + RMS_EPS); return Q ? r * __uint_as_float(am) * (1.0f / 127.0f) : r; }
    __device__ __forceinline__ void prefetch(const Unit& u, int par) const {
        int tid = (int)threadIdx.x; asm volatile("" : "+v"(tid)); const int arr = tid >> 7, c = u.pn * HALF + (tid & 127);
        const float gs = Q ? __uint_as_float(colmax[c]) * (1.0f / 127.0f) : 1.0f;
        const float v = (arr < 3 ? cw[arr * nff + c] * gs : cb[c]) * NLOG2E;
        PG8_LAS float* a = aux + par * AUXN; a[tid] = v;
        if (tid < 128) a[512 + tid] = (Q ? __uint_as_float(colmax[nff + c]) * (1.0f / 127.0f) : 1.0f) * NLN2;
        if (tid < 256) { const int row = u.pm * BM + tid; a[768 + tid] = rowscale(ss[row], Q ? amax[row] : 0u); }
    }
    __device__ __forceinline__ void run(const AccT (&acc)[2][2][4][2], const Unit& u, int wr, int wc, int fr, int fq, int par, const Unit& nxt) const {
        int tid = (int)threadIdx.x; asm volatile("" : "+v"(tid)); const int arr = tid >> 7, cn = nxt.pn * HALF + (tid & 127);
        const float ncw = arr < 3 ? cw[arr * nff + cn] : cb[cn];
        const unsigned ncg = Q ? colmax[cn] : 0u, ncu = Q ? colmax[nff + cn] : 0u;
        const int nrow = nxt.pm * BM + (tid & 255);
        const unsigned long long nss = ss[nrow]; const unsigned nam = Q ? amax[nrow] : 0u;
        const PG8_LAS float* a = aux + par * AUXN;
        const int c0 = wc * 32 + 8 * fq;
        const int ch0 = u.pn * HALF + c0;
        f32x2 w0[4], w1[4], w2[4], bb[4], sl[4];
#pragma unroll
        for (int h4 = 0; h4 < 2; ++h4) { const f32x4 x0 = *(const PG8_LAS f32x4*)(a + c0 + 4 * h4), x1 = *(const PG8_LAS f32x4*)(a + 128 + c0 + 4 * h4), x2 = *(const PG8_LAS f32x4*)(a + 256 + c0 + 4 * h4), x3 = *(const PG8_LAS f32x4*)(a + 384 + c0 + 4 * h4);
            const f32x4 x4 = *(const PG8_LAS f32x4*)(a + 512 + c0 + 4 * h4);
#pragma unroll
            for (int q = 0; q < 2; ++q) { w0[2 * h4 + q] = (f32x2){x0[2 * q], x0[2 * q + 1]}; w1[2 * h4 + q] = (f32x2){x1[2 * q], x1[2 * q + 1]}; w2[2 * h4 + q] = (f32x2){x2[2 * q], x2[2 * q + 1]};
                bb[2 * h4 + q] = (f32x2){x3[2 * q], x3[2 * q + 1]}; sl[2 * h4 + q] = (f32x2){x4[2 * q], x4[2 * q + 1]}; } }
#pragma unroll
        for (int ai = 0; ai < 2; ++ai) {
            const int lrow0 = ai * HALF + wr * 64 + fr * 4;
            const int blk = (u.pm * BM + ai * HALF + wr * 64) >> 6;
            const f32x4 rs4 = *(const PG8_LAS f32x4*)(a + 768 + lrow0);
            bf16_t* arow = act + (size_t)(u.pm * BM + lrow0) * ldc + ch0;
            f32x2 g[4][4];
#pragma unroll
            for (int m = 0; m < 4; ++m)
#pragma unroll
                for (int p = 0; p < 4; ++p) g[m][p] = (f32x2){(float)acc[ai][0][m][p >> 1][2 * (p & 1)], (float)acc[ai][0][m][p >> 1][2 * (p & 1) + 1]} * rs4[m];
            f32x2 gm1[4], gm2[4];
#pragma unroll
            for (int p = 0; p < 4; ++p) {
                gm1[p] = (f32x2){__int_as_float(__builtin_amdgcn_update_dpp(0, __float_as_int(g[3][p][0]), 0x111, 0xf, 0xf, true)), __int_as_float(__builtin_amdgcn_update_dpp(0, __float_as_int(g[3][p][1]), 0x111, 0xf, 0xf, true))};
                gm2[p] = (f32x2){__int_as_float(__builtin_amdgcn_update_dpp(0, __float_as_int(g[2][p][0]), 0x111, 0xf, 0xf, true)), __int_as_float(__builtin_amdgcn_update_dpp(0, __float_as_int(g[2][p][1]), 0x111, 0xf, 0xf, true))}; }
#pragma unroll
            for (int m = 0; m < 4; ++m) {
                u32x4 w; f32x2 upv[4];
#pragma unroll
                for (int p = 0; p < 4; ++p) {
                    const f32x2 r1 = m >= 1 ? g[m >= 1 ? m - 1 : 0][p] : gm1[p], r2 = m >= 2 ? g[m >= 2 ? m - 2 : 0][p] : (m == 1 ? gm1[p] : gm2[p]);
                    const f32x2 y = bb[p] + w2[p] * g[m][p] + w1[p] * r1 + w0[p] * r2;
                    const f32x2 d = (f32x2){__builtin_amdgcn_exp2f(y[0]), __builtin_amdgcn_exp2f(y[1])} + 1.0f;
                    const f32x2 sg = {__builtin_amdgcn_rcpf(d[0]), __builtin_amdgcn_rcpf(d[1])};
                    upv[p] = (f32x2){(float)acc[ai][1][m][p >> 1][2 * (p & 1)], (float)acc[ai][1][m][p >> 1][2 * (p & 1) + 1]} * (sl[p] * rs4[m]);
                    const f32x2 av = y * sg * upv[p];
                    w[p] = cvtpk_e(av[0], av[1]);
                }
                if (m >= 2 || fr != 0) __builtin_nontemporal_store(w, (u32x4*)(arow + (size_t)m * ldc));
                if (m < 2 && fr == 0) { float* gp = GF + ((size_t)blk * 2 + m) * nff + ch0; float* upp = UF + ((size_t)blk * 2 + m) * nff + ch0;
                    *(f32x4*)gp = (f32x4){g[m][0][0], g[m][0][1], g[m][1][0], g[m][1][1]}; *(f32x4*)(gp + 4) = (f32x4){g[m][2][0], g[m][2][1], g[m][3][0], g[m][3][1]};
                    *(f32x4*)upp = (f32x4){upv[0][0], upv[0][1], upv[1][0], upv[1][1]}; *(f32x4*)(upp + 4) = (f32x4){upv[2][0], upv[2][1], upv[3][0], upv[3][1]}; }
                if (m >= 2 && fr == 15) { float* gp = GL + ((size_t)blk * 2 + (m - 2)) * nff + ch0;
                    *(f32x4*)gp = (f32x4){g[m][0][0], g[m][0][1], g[m][1][0], g[m][1][1]}; *(f32x4*)(gp + 4) = (f32x4){g[m][2][0], g[m][2][1], g[m][3][0], g[m][3][1]}; }
            }
        }
        PG8_LAS float* an = aux + (par ^ 1) * AUXN;
        an[tid] = (arr < 3 ? ncw * (Q ? __uint_as_float(ncg) * (1.0f / 127.0f) : 1.0f) : ncw) * NLOG2E;
        if (tid < 128) an[512 + tid] = (Q ? __uint_as_float(ncu) * (1.0f / 127.0f) : 1.0f) * NLN2;
        if (tid < 256) an[768 + tid] = rowscale(nss, nam);
    }
};
typedef EpiGateUpT<false> EpiGateUp;
typedef EpiGateUpT<true> EpiGateUpQ;
struct EpiNull {
    static constexpr bool PERM = true, PERMA = false, AFTER_DRAIN = false, PREFETCH = false, I8 = false; typedef f32x4 AccT; static constexpr int NST = 0;
    __device__ __forceinline__ void operator()(const f32x4 (&acc)[2][2][4][2], const Unit& u, int wr, int wc, int fr, int fq) const {
#pragma unroll
        for (int ai = 0; ai < 2; ++ai)
#pragma unroll
            for (int bj = 0; bj < 2; ++bj)
#pragma unroll
                for (int m = 0; m < 4; ++m)
#pragma unroll
                    for (int n = 0; n < 2; ++n) asm volatile("" :: "v"(acc[ai][bj][m][n]));
    }
};
template <bool I8> __device__ __forceinline__ auto pg8_mma(bf16x8 b, bf16x8 a, typename std::conditional<I8, i32x4, f32x4>::type c) {
    if constexpr (I8) return __builtin_amdgcn_mfma_i32_16x16x64_i8(__builtin_bit_cast(i32x4, b), __builtin_bit_cast(i32x4, a), c, 0, 0, 0);
    else return __builtin_amdgcn_mfma_f32_16x16x32_bf16(b, a, c, 0, 0, 0);
}
#ifndef PG_RELAXW
#define PG_RELAXW 1
#endif
template <class Epi, class Sched, bool ALIGN_EPI = false, bool SP2 = false>
__device__ __forceinline__ void gemm_phase(PG8_LAS unsigned char* lds, const Gemm g, const Sched& S, const Epi& E) {
    const int tid = threadIdx.x, wid = __builtin_amdgcn_readfirstlane(tid >> 6), lane = tid & 63, wr = wid >> 2, wc = wid & 3, fr = lane & 15, fq = lane >> 4;
    const int K = g.K, nt = K / BK;
    unsigned voffA[2], voffB[2];
#pragma unroll
    for (int i = 0; i < 2; ++i) { int R, C; stage_rc(tid * 16 + i * 8192, R, C); const int Rb = Epi::PERM ? ((R & ~31) + perm32(R & 31)) : R;
        const int Ra = Epi::PERMA ? ((R & 64) | ((R & 15) << 2) | ((R >> 4) & 3)) : R;
        voffA[i] = (unsigned)(Ra * K + C) * 2u; voffB[i] = (unsigned)(Rb * K + C) * 2u; }
    const size_t kstep = (size_t)(BK * 2);
    const size_t hstep = (size_t)HALF * K * 2;
    const size_t tstep = 2 * hstep;
    const unsigned ldsw = (unsigned)wid * 1024u;
    const int aoff = lds_byte(wr * 64 + fr, fq * 8), boff = lds_byte(wc * 32 + fr, fq * 8);
#define PG8_SA(b, h) (((b) * 2 + (h)) * HTB)
#define PG8_SB(b, h) ((4 + (b) * 2 + (h)) * HTB)
#define PG8_STAGE(bufoff, gbase, voff) do { _Pragma("unroll") for (int _i = 0; _i < 2; ++_i) \
        __builtin_amdgcn_global_load_lds((const unsigned*)((const char*)(gbase) + (voff)[_i]), (PG8_LAS unsigned*)(lds + (bufoff) + ldsw + _i * 8192), 16, 0, 0); } while (0)
#define PG8_LDA(dst, b, h) do { _Pragma("unroll") for (int m = 0; m < 4; ++m) _Pragma("unroll") for (int k = 0; k < 2; ++k) dst[m][k] = *(const PG8_LAS bf16x8*)(lds + PG8_SA(b, h) + aoff + m * 2048 + k * 1024); } while (0)
#define PG8_LDB(dst, b, h) do { _Pragma("unroll") for (int n = 0; n < 2; ++n) _Pragma("unroll") for (int k = 0; k < 2; ++k) dst[n][k] = *(const PG8_LAS bf16x8*)(lds + PG8_SB(b, h) + boff + n * 2048 + k * 1024); } while (0)
#define PG8_MMA(ai, bj, At, Bt) do { __builtin_amdgcn_s_setprio(1); _Pragma("unroll") for (int m = 0; m < 4; ++m) _Pragma("unroll") for (int n = 0; n < 2; ++n) _Pragma("unroll") for (int k = 0; k < 2; ++k) \
        acc[ai][bj][m][n] = pg8_mma<Epi::I8>(Bt[n][k], At[m][k], acc[ai][bj][m][n]); __builtin_amdgcn_s_setprio(0); } while (0)
#define PG8_WAIT_V(n) asm volatile("s_waitcnt vmcnt(" #n ")" ::: "memory")
#define PG8_WAIT_L(n) asm volatile("s_waitcnt lgkmcnt(" #n ")" ::: "memory")
#define PG8_WAIT_VR(rlx, n) asm volatile("s_waitcnt vmcnt(%1)\n\ts_cmp_lg_u32 %0, 0\n\ts_cbranch_scc1 .Lrw%=\n\ts_waitcnt vmcnt(8)\n.Lrw%=:" :: "s"(rlx), "n"(n) : "scc", "memory")
#define PG8_BAR __builtin_amdgcn_s_barrier()
#define PG8_SCHED __builtin_amdgcn_sched_barrier(0)
    Unit cur, nxt; int ui = 0;
    if (!S.next(0, cur)) return;
    typedef typename Epi::AccT AccT; AccT acc[2][2][4][2];
#pragma unroll
    for (int a = 0; a < 2; ++a)
#pragma unroll
        for (int b = 0; b < 2; ++b)
#pragma unroll
            for (int m = 0; m < 4; ++m)
#pragma unroll
                for (int n = 0; n < 2; ++n) acc[a][b][m][n] = AccT{};
    bf16x8 At[4][2], B0[2][2], B1[2][2];
    const char* cA = (const char*)g.A + (size_t)cur.pm * tstep; const char* cB = (const char*)g.Bt + (size_t)cur.pn * tstep;
    S.a_ready(cur);
    if constexpr (Epi::PREFETCH) E.prefetch(cur, 0);
    if constexpr (SP2) {
        PG8_STAGE(PG8_SB(0, 0), cB, voffB); PG8_STAGE(PG8_SB(0, 1), cB + hstep, voffB); PG8_STAGE(PG8_SA(0, 0), cA, voffA); PG8_STAGE(PG8_SA(0, 1), cA + hstep, voffA);
        if (wr == 1) PG8_BAR;
        PG8_WAIT_V(2); PG8_BAR;
        PG8_STAGE(PG8_SB(1, 0), cB + kstep, voffB); PG8_STAGE(PG8_SA(1, 0), cA + kstep, voffA); PG8_STAGE(PG8_SB(1, 1), cB + hstep + kstep, voffB);
        PG8_WAIT_V(6); PG8_BAR;
    } else {
        PG8_STAGE(PG8_SB(0, 0), cB, voffB); PG8_STAGE(PG8_SA(0, 0), cA, voffA); PG8_STAGE(PG8_SB(0, 1), cB + hstep, voffB); PG8_STAGE(PG8_SA(0, 1), cA + hstep, voffA);
        if (wr == 1) PG8_BAR;
        PG8_WAIT_V(4); PG8_BAR;
        PG8_STAGE(PG8_SB(1, 0), cB + kstep, voffB); PG8_STAGE(PG8_SA(1, 0), cA + kstep, voffA); PG8_STAGE(PG8_SB(1, 1), cB + hstep + kstep, voffB);
        PG8_WAIT_V(6); PG8_BAR;
    }
    for (;;) {
        const bool has_next = S.next(ui + 1, nxt);
        const char* nA = has_next ? (const char*)g.A + (size_t)nxt.pm * tstep : cA; const char* nB = has_next ? (const char*)g.Bt + (size_t)nxt.pn * tstep : cB;
        for (int t = 0; t < nt; t += 2) {
            const bool last = (t == nt - 2);
            const char* a1 = cA + (size_t)(t + 1) * kstep;
            const char* a2 = last ? nA : cA + (size_t)(t + 2) * kstep; const char* b2 = last ? nB : cB + (size_t)(t + 2) * kstep;
            const char* a3 = a2 + kstep; const char* b3 = b2 + kstep;
            if (last && has_next) S.a_ready(nxt);
            const int rl = __builtin_amdgcn_readfirstlane((PG_RELAXW && (t == 0) && (ui > 0)) ? 1 : 0);
            if constexpr (SP2) {
            PG8_LDB(B0, 0, 0); PG8_LDB(B1, 0, 1); PG8_SCHED; PG8_LDA(At, 0, 0); PG8_STAGE(PG8_SA(1, 1), a1 + hstep, voffA);
            PG8_WAIT_VR(rl, 8 + Epi::NST); PG8_WAIT_L(0); PG8_BAR; PG8_MMA(0, 0, At, B0); PG8_MMA(0, 1, At, B1); PG8_BAR; PG8_SCHED;
            PG8_LDA(At, 0, 1); PG8_STAGE(PG8_SB(0, 0), b2, voffB); PG8_STAGE(PG8_SB(0, 1), b2 + hstep, voffB); PG8_STAGE(PG8_SA(0, 0), a2, voffA);
            PG8_WAIT_VR(rl, 8 + Epi::NST); PG8_WAIT_L(0); PG8_BAR; PG8_MMA(1, 0, At, B0); PG8_MMA(1, 1, At, B1); PG8_BAR; PG8_SCHED;
            PG8_LDB(B0, 1, 0); PG8_LDB(B1, 1, 1); PG8_SCHED; PG8_LDA(At, 1, 0); PG8_STAGE(PG8_SA(0, 1), a2 + hstep, voffA);
            PG8_WAIT_V(8); PG8_WAIT_L(0); PG8_BAR; PG8_MMA(0, 0, At, B0); PG8_MMA(0, 1, At, B1); PG8_BAR; PG8_SCHED;
            PG8_LDA(At, 1, 1); PG8_STAGE(PG8_SB(1, 0), b3, voffB); PG8_STAGE(PG8_SB(1, 1), b3 + hstep, voffB); PG8_STAGE(PG8_SA(1, 0), a3, voffA);
            PG8_WAIT_V(8); PG8_WAIT_L(0); PG8_BAR; PG8_MMA(1, 0, At, B0); PG8_MMA(1, 1, At, B1); PG8_BAR; PG8_SCHED;
            } else {
            PG8_LDB(B0, 0, 0); PG8_SCHED; PG8_LDA(At, 0, 0); PG8_STAGE(PG8_SA(1, 1), a1 + hstep, voffA);
            PG8_WAIT_L(8); PG8_BAR; PG8_WAIT_L(0); PG8_MMA(0, 0, At, B0); PG8_BAR; PG8_SCHED;
            PG8_LDB(B1, 0, 1); PG8_STAGE(PG8_SB(0, 0), b2, voffB);
            PG8_BAR; PG8_WAIT_L(0); PG8_MMA(0, 1, At, B1); PG8_BAR;
            PG8_LDA(At, 0, 1); PG8_STAGE(PG8_SA(0, 0), a2, voffA);
            PG8_BAR; PG8_WAIT_L(0); PG8_MMA(1, 0, At, B0); PG8_BAR; PG8_SCHED;
            PG8_STAGE(PG8_SB(0, 1), b2 + hstep, voffB);
            PG8_WAIT_V(6); PG8_BAR; PG8_MMA(1, 1, At, B1); PG8_BAR;
            PG8_LDB(B0, 1, 0); PG8_SCHED; PG8_LDA(At, 1, 0); PG8_STAGE(PG8_SA(0, 1), a2 + hstep, voffA);
            PG8_WAIT_L(8); PG8_BAR; PG8_WAIT_L(0); PG8_MMA(0, 0, At, B0); PG8_BAR; PG8_SCHED;
            PG8_LDB(B1, 1, 1); PG8_STAGE(PG8_SB(1, 0), b3, voffB);
            PG8_BAR; PG8_WAIT_L(0); PG8_MMA(0, 1, At, B1); PG8_BAR;
            PG8_LDA(At, 1, 1); PG8_STAGE(PG8_SA(1, 0), a3, voffA);
            PG8_BAR; PG8_WAIT_L(0); PG8_MMA(1, 0, At, B0); PG8_BAR; PG8_SCHED;
            PG8_STAGE(PG8_SB(1, 1), b3 + hstep, voffB);
            PG8_WAIT_V(6); PG8_BAR; PG8_MMA(1, 1, At, B1); PG8_BAR;
            }
        }
        if constexpr (ALIGN_EPI) { if (wr == 0) PG8_BAR; }
        if constexpr (!Epi::AFTER_DRAIN) { if constexpr (Epi::PREFETCH) E.run(acc, cur, wr, wc, fr, fq, ui & 1, has_next ? nxt : cur); else E(acc, cur, wr, wc, fr, fq); S.done(cur); }
        if (!has_next) break;
#pragma unroll
        for (int a = 0; a < 2; ++a)
#pragma unroll
            for (int b = 0; b < 2; ++b)
#pragma unroll
                for (int m = 0; m < 4; ++m)
#pragma unroll
                    for (int n = 0; n < 2; ++n) acc[a][b][m][n] = AccT{};
        cur = nxt; cA = nA; cB = nB; ++ui;
        if constexpr (ALIGN_EPI) { if (wr == 1) PG8_BAR; }
    }
    PG8_WAIT_V(0);
    if constexpr (!ALIGN_EPI) { if (wr == 0) PG8_BAR; }
    PG8_BAR;
    if constexpr (Epi::AFTER_DRAIN) { E.fused(acc, cur, wr, wc, fr, fq, lds, wid, lane); S.done(cur); }
#undef PG8_SA
#undef PG8_SB
#undef PG8_STAGE
#undef PG8_LDA
#undef PG8_LDB
#undef PG8_MMA
#undef PG8_WAIT_V
#undef PG8_WAIT_L
#undef PG8_WAIT_VR
#undef PG8_BAR
#undef PG8_SCHED
}
}
namespace att {
constexpr int D = 128; constexpr float THR = 8.f; constexpr bool WSKIP = true;
constexpr float SCALE = 0.08838834764831845f;
constexpr int NW = 8, QBLK = 32, KVBLK = 64, QB = NW * QBLK;
constexpr int SHM_V = KVBLK * D * 2, SHM_K = KVBLK * D * 2;
constexpr int LDS_TAB = 2 * SHM_V + 2 * SHM_K + NW * 64 * 4, TAB_N = 328, TAB_OFF = 100, TAB_PITCH = 4 * TAB_N;
constexpr int LDS_BYTES = LDS_TAB + 2 * TAB_PITCH * 4;
using bf16 = __hip_bfloat16;
typedef short bf16x8 __attribute__((ext_vector_type(8)));
typedef short s16x4 __attribute__((ext_vector_type(4)));
typedef float f32x16 __attribute__((ext_vector_type(16)));
typedef float f32x4 __attribute__((ext_vector_type(4)));
typedef float f32x2 __attribute__((ext_vector_type(2)));
typedef unsigned u32x4 __attribute__((ext_vector_type(4)));
template <class A, class Bt> struct same_t { static constexpr bool v = false; };
template <class A> struct same_t<A, A> { static constexpr bool v = true; };

#define KSWZ(row, colB) ((row) * 256 + ((colB) ^ (((row) & 7) << 4)))
#define SBAR() __builtin_amdgcn_sched_barrier(0)
__device__ __forceinline__ int v_st(int k, int c) { const int kk = (k & ~0xC) | ((k & 4) << 1) | ((k & 8) >> 1); return ((kk >> 3) * 4 + (c >> 5)) * 512 + ((kk & 7) * 32 + (c & 31)) * 2; }
__device__ __forceinline__ int v_rd_base(int lane) { return ((lane & 3) << 3) | (((lane >> 2) & 3) << 6) | (((lane >> 4) & 1) << 5) | (((lane >> 5) & 1) << 8); }
constexpr int v_rd_off(int d0, int ks, int half) { return d0 * 512 + ks * 4096 + half * 2048; }
__device__ __forceinline__ int crow(int r, int hi) { return (r & 3) + 8 * (r >> 2) + 4 * hi; }
__device__ __forceinline__ unsigned cvtpk(float lo, float hi) {
    unsigned r; asm volatile("v_cvt_pk_bf16_f32 %0, %1, %2" : "=v"(r) : "v"(lo), "v"(hi)); return r;
}
__device__ __forceinline__ bf16x8 pack8(f32x4 a, f32x4 b) {
    u32x4 w = {cvtpk(a[0], a[1]), cvtpk(a[2], a[3]), cvtpk(b[0], b[1]), cvtpk(b[2], b[3])};
    return *reinterpret_cast<bf16x8*>(&w);
}
template <class T> __device__ __forceinline__ bf16x8 load8(const T* p) {
    if constexpr (same_t<T, float>::v) { return pack8(*(const f32x4*)p, *(const f32x4*)(p + 4)); }
    else { return *reinterpret_cast<const bf16x8*>(p); }
}
__device__ __forceinline__ void mask_tile(f32x16& p0, f32x16& p1, int dq, unsigned W) {
    const float NEG = -__builtin_inff();
#pragma unroll
    for (int r = 0; r < 16; ++r) {
        const int c = (r & 3) + 8 * (r >> 2);
        if ((unsigned)(dq - c) >= W) p0[r] = NEG;
        if ((unsigned)(dq - c - 32) >= W) p1[r] = NEG;
    }
}
__device__ __forceinline__ void bias_mask_tile(f32x16& p0, f32x16& p1, int dq, unsigned W, const float* tabu, bool needmask) {
    const float NEG = -__builtin_inff();
    const int sft = (4 - ((int)threadIdx.x & 3)) & 3;
    const float* t0 = tabu + (sft * (TAB_N - 1) + TAB_OFF + 128 - dq);
#pragma unroll
    for (int J = 0; J < 8; ++J) {
        const f32x4 b = *(const f32x4*)(t0 + 8 * J);
#pragma unroll
        for (int e = 0; e < 4; ++e) {
            const int r = 4 * (J & 3) + e; const int c = e + 8 * (J & 3) + (J >= 4 ? 32 : 0);
            float v = (J < 4 ? p0[r] : p1[r]) + b[e];
            if (needmask) { if ((unsigned)(dq - c) >= W) v = NEG; }
            if (J < 4) p0[r] = v; else p1[r] = v;
        }
        if ((J & 1) == 1) asm volatile("" ::: "memory");
    }
}
__device__ __forceinline__ void bias_fill(float* T, const float* bsrc, int tid) {
    asm volatile("" : "+v"(tid));
    if (tid < TAB_N) {
#pragma unroll
        for (int sf = 0; sf < 4; ++sf) { const int i = tid - TAB_OFF + sf; T[sf * TAB_N + tid] = (i >= 0 && i <= 128) ? bsrc[128 - i] : 0.f; }
    }
}
__device__ __forceinline__ void partialSM(f32x16& p0, f32x16& p1, float& m_reg, float& mn, float& alpha) {
    float pmax = p0[0]; for (int r = 1; r < 16; ++r) pmax = fmaxf(pmax, p0[r]); for (int r = 0; r < 16; ++r) pmax = fmaxf(pmax, p1[r]);
    { auto rr = __builtin_amdgcn_permlane32_swap(__float_as_uint(pmax), __float_as_uint(pmax), false, false);
      pmax = fmaxf(__uint_as_float(rr[0]), __uint_as_float(rr[1])); }
    constexpr float C2 = 1.4426950408889634f * SCALE;
    if (__builtin_expect(__all((pmax - m_reg) * SCALE <= THR), 1)) { mn = m_reg; alpha = 1.f; }
    else { mn = fmaxf(m_reg, pmax); alpha = __builtin_amdgcn_exp2f((m_reg - mn) * C2); m_reg = mn; }
    const float mnL = -mn * C2;
    for (int r = 0; r < 16; ++r) p0[r] = fmaf(p0[r], C2, mnL); for (int r = 0; r < 16; ++r) p1[r] = fmaf(p1[r], C2, mnL);
    for (int r = 0; r < 16; ++r) p0[r] = __builtin_amdgcn_exp2f(p0[r]);
}
__device__ __forceinline__ void finishSM(f32x16& p0, f32x16& p1, float alpha, float& l_reg, bf16x8& pa0, bf16x8& pa1, bf16x8& pa2, bf16x8& pa3) {
    for (int r = 0; r < 16; ++r) p1[r] = __builtin_amdgcn_exp2f(p1[r]);
    float ps = 0; for (int r = 0; r < 16; ++r) ps += p0[r]; for (int r = 0; r < 16; ++r) ps += p1[r];
    { auto rr = __builtin_amdgcn_permlane32_swap(__float_as_uint(ps), __float_as_uint(ps), false, false);
      ps = __uint_as_float(rr[0]) + __uint_as_float(rr[1]); }
    l_reg = l_reg * alpha + ps;
#define PK4(P, B_, OUT) do { unsigned a0 = cvtpk(P[B_+0], P[B_+1]), a1 = cvtpk(P[B_+2], P[B_+3]);                          \
        unsigned b0 = cvtpk(P[B_+4], P[B_+5]), b1 = cvtpk(P[B_+6], P[B_+7]);                                             \
        auto r0 = __builtin_amdgcn_permlane32_swap(a0, b0, false, false); auto r1 = __builtin_amdgcn_permlane32_swap(a1, b1, false, false); \
        u32x4 w = {r0[0], r1[0], r0[1], r1[1]}; OUT = *reinterpret_cast<bf16x8*>(&w); } while (0)
    PK4(p0, 0, pa0); PK4(p0, 8, pa1); PK4(p1, 0, pa2); PK4(p1, 8, pa3);
#undef PK4
}
template <int KB, bool SK>
__device__ __forceinline__ void qkt(f32x16& p0, f32x16& p1, const char* K_lds, int r32, int hi, const bf16x8* qr, bool act) {
    if (SK && !act) { const float NEG = -__builtin_inff();
#pragma unroll
        for (int r = 0; r < 16; ++r) { p0[r] = NEG; p1[r] = NEG; } return; }
    p0 = f32x16{}; p1 = f32x16{};
    const char* kb[4];
#pragma unroll
    for (int dd = 0; dd < 4; ++dd) kb[dd] = K_lds + KB * SHM_K + KSWZ(r32, (dd * 16 + hi * 8) * 2);
#pragma unroll
    for (int d0 = 0; d0 < 8; ++d0) { const char* a = kb[d0 & 3] + (d0 >> 2) * 128;
        bf16x8 b0 = *reinterpret_cast<const bf16x8*>(a);
        bf16x8 b1 = *reinterpret_cast<const bf16x8*>(a + 32 * 256);
        p0 = __builtin_amdgcn_mfma_f32_32x32x16_bf16(b0, qr[d0], p0, 0, 0, 0);
        p1 = __builtin_amdgcn_mfma_f32_32x32x16_bf16(b1, qr[d0], p1, 0, 0, 0); }
}
template <int VB, bool SK>
__device__ __forceinline__ void pv_tile(f32x16* o, int vb0, bf16x8 pa0, bf16x8 pa1, bf16x8 pa2, bf16x8 pa3, bool act) {
    if (SK && !act) return;
#define TRRD(dst, off) asm volatile("ds_read_b64_tr_b16 %0, %1 offset:%2" : "=&v"(dst) : "v"(vb0), "i"(off) : "memory")
#define PV_D0(d0) do { s16x4 l0, l1, l2, l3, h0, h1, h2, h3; constexpr int b_ = VB * SHM_V + v_rd_off(d0, 0, 0);     \
        TRRD(l0, b_); TRRD(h0, b_ + 2048); TRRD(l1, b_ + 4096); TRRD(h1, b_ + 6144); TRRD(l2, b_ + 8192); TRRD(h2, b_ + 10240); TRRD(l3, b_ + 12288); TRRD(h3, b_ + 14336); \
        asm volatile("s_waitcnt lgkmcnt(0)" ::: "memory"); SBAR();                 \
        o[d0] = __builtin_amdgcn_mfma_f32_32x32x16_bf16(pa0, (bf16x8){l0[0], l0[1], l0[2], l0[3], h0[0], h0[1], h0[2], h0[3]}, o[d0], 0, 0, 0);   \
        o[d0] = __builtin_amdgcn_mfma_f32_32x32x16_bf16(pa1, (bf16x8){l1[0], l1[1], l1[2], l1[3], h1[0], h1[1], h1[2], h1[3]}, o[d0], 0, 0, 0);   \
        o[d0] = __builtin_amdgcn_mfma_f32_32x32x16_bf16(pa2, (bf16x8){l2[0], l2[1], l2[2], l2[3], h2[0], h2[1], h2[2], h2[3]}, o[d0], 0, 0, 0);   \
        o[d0] = __builtin_amdgcn_mfma_f32_32x32x16_bf16(pa3, (bf16x8){l3[0], l3[1], l3[2], l3[3], h3[0], h3[1], h3[2], h3[3]}, o[d0], 0, 0, 0); } while (0)
    PV_D0(0); PV_D0(1); PV_D0(2); PV_D0(3);
#undef PV_D0
#undef TRRD
}

template <class TIn, class TOut> struct BlockRef { const TIn* Q; const TIn* K; const TIn* V; TOut* O; float* L; const float* bsrc; int P0, pq, pk, po, pl, skv, W; };
template <class TIn> struct Seam {
    bf16x8 qr[8];
    bf16x8 st_v0, st_v1, st_k0, st_k1; f32x4 sf0, sf1, sf2, sf3;
    f32x4 tq[16];
};
__device__ __forceinline__ int swa_jlo(int P0, int W) { const int lowk = P0 - W + 1; return lowk > 0 ? lowk / KVBLK : 0; }
#define ROW(p, pit, k0, rr) ((p) + (unsigned)(((k0) + (rr)) * (pit) + sc))
#define VMW() asm volatile("s_waitcnt vmcnt(0)" ::: "memory")
#define VMWN(n) asm volatile("s_waitcnt vmcnt(%0)" :: "i"(n) : "memory")
#define SLOAD_H(Kp, Vp, pit, k0) do { S.st_v0 = load8<TIn>(ROW(Vp, pit, k0, sr)); S.st_v1 = load8<TIn>(ROW(Vp, pit, k0, 32 + sr));              \
                         S.st_k0 = load8<TIn>(ROW(Kp, pit, k0, sr)); S.st_k1 = load8<TIn>(ROW(Kp, pit, k0, 32 + sr)); } while (0)
#define SWRITE_HK(bf) do { *(bf16x8*)(K_lds + (bf) * SHM_K + kws) = S.st_k0; *(bf16x8*)(K_lds + (bf) * SHM_K + kws + 32 * 256) = S.st_k1; } while (0)
#define SWRITE_HV(bf) do { *(bf16x8*)(V_lds + (bf) * SHM_V + vst0) = S.st_v0; *(bf16x8*)(V_lds + (bf) * SHM_V + vst1) = S.st_v1; } while (0)
#define SWRITE_H(bf) do { SWRITE_HV(bf); SWRITE_HK(bf); } while (0)
#define SLOAD_F(p, k0) do { S.sf0 = *(const f32x4*)ROW(p, D, k0, sr); S.sf1 = *(const f32x4*)(ROW(p, D, k0, sr) + 4);                \
                            S.sf2 = *(const f32x4*)ROW(p, D, k0, 32 + sr); S.sf3 = *(const f32x4*)(ROW(p, D, k0, 32 + sr) + 4); } while (0)
#define SWRITE_KF(bf) do { *(bf16x8*)(K_lds + (bf) * SHM_K + kws) = pack8(S.sf0, S.sf1); *(bf16x8*)(K_lds + (bf) * SHM_K + kws + 32 * 256) = pack8(S.sf2, S.sf3); } while (0)
#define SWRITE_VF(bf) do { *(bf16x8*)(V_lds + (bf) * SHM_V + vst0) = pack8(S.sf0, S.sf1); *(bf16x8*)(V_lds + (bf) * SHM_V + vst1) = pack8(S.sf2, S.sf3); } while (0)
template <int BIAS, class TIn, class TOut>
__device__ __forceinline__ void causal_swa_prime(const BlockRef<TIn, TOut>& cur, char* lds, Seam<TIn>& S) {
    const int W = cur.W;
    constexpr bool F32 = same_t<TIn, float>::v;
    const int tid = threadIdx.x, wid = __builtin_amdgcn_readfirstlane(tid >> 6), lane = tid & 63, r32 = lane & 31, hi = lane >> 5;
    const int sr = tid >> 4, sc = (tid & 15) * 8, kws = KSWZ(sr, sc * 2); char* K_lds = lds + 2 * SHM_V;
    const int kb0 = swa_jlo(cur.P0, W) * KVBLK;
    if (BIAS == 1 || BIAS == 3) bias_fill((float*)(lds + LDS_TAB), cur.bsrc, tid);
    for (int d0 = 0; d0 < 8; ++d0) S.qr[d0] = load8<TIn>(cur.Q + (unsigned)((wid * QBLK + r32) * cur.pq + d0 * 16 + hi * 8));
    if constexpr (F32) { SLOAD_F((const float*)cur.K, kb0); VMW(); SWRITE_KF(0); SBAR(); SLOAD_F((const float*)cur.V, kb0); }
    else { SLOAD_H(cur.K, cur.V, cur.pk, kb0); VMW(); SWRITE_HK(0); }
    __syncthreads();
}
template <int BIAS, class TIn, class TOut, class ItemFn>
__device__ __forceinline__ void causal_swa_block(const BlockRef<TIn, TOut>& cur, int Lnext, const ItemFn& itemfn, int par, char* lds, Seam<TIn>& S) {
    const int skv = cur.skv, W = cur.W;
    const float* tab = (const float*)(lds + LDS_TAB) + par * TAB_PITCH;
    constexpr bool F32 = same_t<TIn, float>::v;
    const int tid = threadIdx.x, wid = __builtin_amdgcn_readfirstlane(tid >> 6), lane = tid & 63, r32 = lane & 31, hi = lane >> 5;
    const int j_lo = swa_jlo(cur.P0, W);
    int j_hi = (cur.P0 + QB - 1) / KVBLK + 1; if (j_hi > skv / KVBLK) j_hi = skv / KVBLK;
    const int NT = j_hi - j_lo;
    const int qlo = cur.P0 + wid * QBLK, qm = qlo + r32 - 4 * hi;
    char* V_lds = lds; char* K_lds = lds + 2 * SHM_V;
    float* ws = (float*)(lds + 2 * SHM_V + 2 * SHM_K) + wid * 64; float* li_l = ws, * al_l = ws + 32;
    float m_reg = -1e30f, l_reg = 0; f32x16 o[4] = {};
    const int sr = tid >> 4, sc = (tid & 15) * 8, vst0 = v_st(sr, sc), vst1 = v_st(32 + sr, sc), kws = KSWZ(sr, sc * 2);
    const int vb0 = (int)(uintptr_t)V_lds + v_rd_base(lane);
    const TIn* Kh = cur.K; const TIn* Vh = cur.V;
#define RESC(a) do { if (__any((a) < 1.f)) { if (hi == 0) al_l[r32] = (a); asm volatile("s_waitcnt lgkmcnt(0)" ::: "memory");              \
                     for (int d_ = 0; d_ < 4; ++d_) for (int r = 0; r < 16; ++r) o[d_][r] *= al_l[crow(r, hi)]; } } while (0)
#define KBASE(t) ((j_lo + (t)) * KVBLK)
#define ACT(t) (KBASE(t) <= qlo + QBLK - 1 && KBASE(t) + KVBLK - 1 >= qlo - W + 1)
#define MASKT(P0_, P1_, t) do { const int kb_ = KBASE(t); if constexpr (BIAS == 1 || BIAS == 2) { if (!SK || ACT(t)) bias_mask_tile(P0_, P1_, qm - kb_, (unsigned)W, tab, kb_ + KVBLK - 1 > qlo || kb_ <= qlo + QBLK - 1 - W); } \
        else { if ((!SK || ACT(t)) && (kb_ + KVBLK - 1 > qlo || kb_ <= qlo + QBLK - 1 - W)) mask_tile(P0_, P1_, qm - kb_, (unsigned)W); } } while (0)
    constexpr int NQL = F32 ? 16 : 8;
    constexpr bool SK = WSKIP && !F32;
#define SEAM_K0() do { VMWN(NQL); if constexpr (F32) { SWRITE_KF(0); SBAR(); SLOAD_F((const float*)nxt.V, kbn); } else { SWRITE_HK(0); } SBAR(); } while (0)
    f32x16 pA0, pA1, pB0, pB1; float mnA, mnB, alA, alB; bf16x8 pa0, pa1, pa2, pa3;
    if constexpr (F32) { VMW(); SWRITE_VF(0); SBAR(); } else { SWRITE_HV(0); SBAR(); }
    if (NT > 1) { if constexpr (F32) SLOAD_F((const float*)Kh, KBASE(1)); else SLOAD_H(Kh, Vh, cur.pk, KBASE(1)); }
    SBAR(); qkt<0, SK>(pA0, pA1, K_lds, r32, hi, S.qr, ACT(0));
    if constexpr (F32) { if (NT > 1) { VMW(); SWRITE_KF(1); SBAR(); SLOAD_F((const float*)Vh, KBASE(1)); } }
    MASKT(pA0, pA1, 0); partialSM(pA0, pA1, m_reg, mnA, alA);
    if (NT > 1) { VMW(); if constexpr (F32) { SWRITE_VF(1); SBAR(); if (NT > 2) SLOAD_F((const float*)Kh, KBASE(2)); } else SWRITE_H(1); }
    __syncthreads();
#define HALF_STEP(PX0, PX1, mnX, alX, PY0, PY1, alY, t, KB, VB, SB) do {                                                      \
        SBAR(); qkt<KB, SK>(PX0, PX1, K_lds, r32, hi, S.qr, ACT(t));                                             \
        finishSM(PY0, PY1, alY, l_reg, pa0, pa1, pa2, pa3); SBAR();                                                           \
        if ((t) + 1 < NT) { if constexpr (F32) { VMW(); SWRITE_KF(SB); SBAR(); SLOAD_F((const float*)Vh, KBASE((t) + 1)); }  \
                            else { SLOAD_H(Kh, Vh, cur.pk, KBASE((t) + 1)); } SBAR(); }                                               \
        pv_tile<VB, SK>(o, vb0, pa0, pa1, pa2, pa3, ACT((t) - 1)); MASKT(PX0, PX1, (t)); partialSM(PX0, PX1, m_reg, mnX, alX);                                        \
        __syncthreads();                                                                                                      \
        if ((t) + 1 < NT) { VMW(); if constexpr (F32) { SWRITE_VF(SB); SBAR(); if ((t) + 2 < NT) SLOAD_F((const float*)Kh, KBASE((t) + 2)); } \
                            else { SWRITE_H(SB); } }                                                                          \
        RESC(alX); __syncthreads(); } while (0)
    for (int t = 1; t + 1 < NT; t += 2) {
        HALF_STEP(pB0, pB1, mnB, alB, pA0, pA1, alA, t, 1, 0, 0);
        HALF_STEP(pA0, pA1, mnA, alA, pB0, pB1, alB, t + 1, 0, 1, 1);
    }
    asm volatile("" : "+s"(Lnext));
    const BlockRef<TIn, TOut> nxt = itemfn(Lnext); const int kbn = swa_jlo(nxt.P0, nxt.W) * KVBLK;
    const bool even = (NT & 1) == 0;
    if (even) { SBAR(); qkt<1, SK>(pB0, pB1, K_lds, r32, hi, S.qr, ACT(NT - 1)); SBAR(); }
#define QROW(e) (nxt.Q + (size_t)(wid * QBLK + r32) * D + ((e) >> 1) * 16 + hi * 8 + ((e) & 1) * 4)
    if constexpr (F32) { SLOAD_F((const float*)nxt.K, kbn); SBAR();
#pragma unroll
        for (int e = 0; e < 8; ++e) S.tq[e] = *(const f32x4*)QROW(e); }
    else { SLOAD_H(nxt.K, nxt.V, nxt.pk, kbn); SBAR();
#pragma unroll
        for (int d0 = 0; d0 < 8; ++d0) S.qr[d0] = load8<TIn>(nxt.Q + (unsigned)((wid * QBLK + r32) * nxt.pq + d0 * 16 + hi * 8)); }
    SBAR();
    finishSM(pA0, pA1, alA, l_reg, pa0, pa1, pa2, pa3); SBAR();
    if constexpr (F32) {
#pragma unroll
        for (int e = 8; e < 16; ++e) S.tq[e] = *(const f32x4*)QROW(e); SBAR(); }
#undef QROW
    pv_tile<0, SK>(o, vb0, pa0, pa1, pa2, pa3, ACT(even ? NT - 2 : NT - 1));
    if (even) { MASKT(pB0, pB1, NT - 1); partialSM(pB0, pB1, m_reg, mnB, alB); __syncthreads(); RESC(alB);
        finishSM(pB0, pB1, alB, l_reg, pa0, pa1, pa2, pa3); SBAR(); pv_tile<1, SK>(o, vb0, pa0, pa1, pa2, pa3, ACT(NT - 1)); }
    SBAR(); SEAM_K0();
    if (hi == 0) li_l[r32] = l_reg; asm volatile("s_waitcnt lgkmcnt(0)" ::: "memory");
    float rli[16];
#pragma unroll
    for (int r = 0; r < 16; ++r) rli[r] = __builtin_amdgcn_rcpf(li_l[crow(r, hi)]);
    TOut* Ow = cur.O + (unsigned)((wid * QBLK) * cur.po); const int po = cur.po;
    if constexpr (BIAS == 1 || BIAS == 3) { if (hi == 0) { f32x2 ml = {m_reg * (1.4426950408889634f * SCALE), l_reg}; *(f32x2*)(cur.L + (unsigned)((wid * QBLK + r32) * cur.pl)) = ml; }
                          bias_fill((float*)(lds + LDS_TAB) + (par ^ 1) * TAB_PITCH, nxt.bsrc, tid); }
#pragma unroll
    for (int r = 0; r < 16; ++r) { const int orow = crow(r, hi);
#pragma unroll
        for (int d0 = 0; d0 < 4; ++d0) { const float v = o[d0][r] * rli[r];
            if constexpr (same_t<TOut, float>::v) { Ow[(unsigned)(orow * po + d0 * 32 + r32)] = v; }
            else { const float vn = __shfl_xor(v, 1);
                   if ((r32 & 1) == 0) *(unsigned*)(Ow + (unsigned)(orow * po + d0 * 32 + r32)) = cvtpk(v, vn); } } }
    if constexpr (F32) {
#pragma unroll
        for (int d0 = 0; d0 < 8; ++d0) S.qr[d0] = pack8(S.tq[2 * d0], S.tq[2 * d0 + 1]); }
    __syncthreads();
#undef RESC
#undef KBASE
#undef ACT
#undef MASKT
#undef SEAM_K0
#undef HALF_STEP
}
#undef ROW
#undef VMW
#undef VMWN
#undef SLOAD_H
#undef SWRITE_HK
#undef SWRITE_HV
#undef SWRITE_H
#undef SLOAD_F
#undef SWRITE_KF
#undef SWRITE_VF

}
constexpr int NWAVES = 8;
#ifndef MK_N_LAUNCHES
#define MK_N_LAUNCHES 1
#endif
constexpr int NPH = 13;
constexpr int N_LAUNCHES = MK_N_LAUNCHES;
static_assert(N_LAUNCHES == 1 || N_LAUNCHES == NPH, "MK_N_LAUNCHES is 1 or 13");

#ifndef GV_I8
#define GV_I8 1
#endif
#ifndef FFN_I8
#define FFN_I8 1
#endif
constexpr int NB = 4, SEQ = 4096, DM = 4096, M = NB * SEQ;
constexpr int MEMLEN = 256, MROWS = NB * MEMLEN;
constexpr int NIN = 12304, NPROJ = 12288;
constexpr int DFF = 11008, NGU = 2 * DFF;
constexpr int NB1 = GV_I8 ? 4096 : 6144, NQ1 = GV_I8 ? 8192 : 6144;
constexpr int XW = 512;
constexpr float RMS_EPS = 1e-6f;

constexpr size_t MiB = 1u << 20;
constexpr size_t WS_CTL = 0, CTL_ZERO_BYTES = 1 * MiB;
constexpr size_t WS_BT = 1 * MiB;
constexpr size_t WS_Q0K0 = 1 * MiB + 64 * 1024;
constexpr size_t WS_RSC1 = 1 * MiB + 128 * 1024;
constexpr size_t WS_XNQ = 780 * MiB;
constexpr size_t WS_WINQ = 2 * MiB + (size_t)6144 * 4096 * 2;
constexpr size_t WS_WIN = 2 * MiB;
constexpr size_t WS_WLR = 98 * MiB;
constexpr size_t WS_WOUT = 99 * MiB;
constexpr size_t WS_WXQ = 131 * MiB;
constexpr size_t WS_WXKV = 135 * MiB;
constexpr size_t WS_WXO = 143 * MiB;
constexpr size_t WS_MEMN = 147 * MiB;
constexpr size_t WS_XKV = 155 * MiB;
constexpr size_t WS_WGU = 160 * MiB;
constexpr size_t WS_WDN = 332 * MiB;
constexpr size_t WS_DQKV = 160 * MiB;
constexpr size_t WS_GK = 352 * MiB;
constexpr size_t WS_GQ = 384 * MiB;
constexpr size_t WS_XN = 418 * MiB;
constexpr size_t WS_MIX = 546 * MiB;
constexpr size_t WS_GV = 546 * MiB;
constexpr size_t WS_VT = 610 * MiB;
constexpr size_t WS_GR = 674 * MiB;
constexpr size_t WS_KET = 738 * MiB;
constexpr size_t WS_ATT = 770 * MiB;
constexpr size_t WS_DEC = 778 * MiB;
constexpr size_t WS_OC = 780 * MiB;
constexpr size_t WS_LSE = 972 * MiB;
constexpr size_t WS_ACT = 546 * MiB;
constexpr size_t WS_HALO = 890 * MiB;
constexpr size_t WS_XQ = 980 * MiB;
constexpr size_t WS_XO = 996 * MiB;
constexpr size_t WS_GQ2 = 1012 * MiB;
constexpr size_t WS_H2Q = 980 * MiB;
constexpr size_t WS_END = 1044 * MiB;
constexpr size_t HALO_ONE = (size_t)256 * 2 * DFF * 4;
static_assert(WS_HALO + 3 * HALO_ONE <= WS_XQ && WS_ACT + (size_t)M * DFF * 2 <= WS_HALO && WS_WDN + (size_t)DM * DFF * 2 <= WS_XN && WS_WGU + (size_t)NGU * DM * 2 <= WS_WDN, "d_ws map");
static_assert(WS_OC + (size_t)3 * M * 2048 * 2 <= WS_LSE && WS_LSE + (size_t)3 * M * 16 * 2 * 4 <= WS_XQ && WS_GQ + (size_t)M * 1024 * 2 <= WS_XN, "d_ws map 2");
constexpr int CW_QUEUE = 2048;
constexpr int CW_BAR = 4096;
constexpr size_t CTL_COLMAX = 704 * 1024;
constexpr size_t CTL_CMAX1 = 864 * 1024;
constexpr size_t CTL_AMAX = 800 * 1024;
constexpr size_t CTL_SS = 256 * 1024;

constexpr int LDS_BYTES = 147456;
constexpr int MISC_OFF = LDS_BYTES - 256;

#define GAS __attribute__((address_space(1)))
#define LAS __attribute__((address_space(3)))
typedef unsigned short bf16;
typedef unsigned v4u __attribute__((ext_vector_type(4)));
typedef unsigned v2u __attribute__((ext_vector_type(2)));
typedef float f32x4 __attribute__((ext_vector_type(4)));
typedef float f32x2 __attribute__((ext_vector_type(2)));
typedef float f32x16 __attribute__((ext_vector_type(16)));
typedef short bf16x8 __attribute__((ext_vector_type(8)));
typedef short s16x4 __attribute__((ext_vector_type(4)));
typedef short v4i16_t __attribute__((ext_vector_type(4)));
typedef GAS unsigned gu32;
#define RLX_AGENT __ATOMIC_RELAXED, __HIP_MEMORY_SCOPE_AGENT
#define LDS_WAIT() asm volatile("s_waitcnt lgkmcnt(0)" ::: "memory")
#define VM_WAIT() asm volatile("s_waitcnt vmcnt(0)" ::: "memory")
__device__ __forceinline__ unsigned f2bf(float f) { unsigned u = __builtin_bit_cast(unsigned, f); return (u + 0x7fffu + ((u >> 16) & 1u)) >> 16; }
__device__ __forceinline__ float bf2f(unsigned short b) { return __builtin_bit_cast(float, (unsigned)b << 16); }
__device__ __forceinline__ float bflo(unsigned w) { return __builtin_bit_cast(float, w << 16); }
__device__ __forceinline__ float bfhi(unsigned w) { return __builtin_bit_cast(float, w & 0xffff0000u); }
__device__ __forceinline__ unsigned q8x4(float a, float b, float c, float d, float inv) {
    const float MG = 12582912.0f;
    const unsigned ua = __builtin_bit_cast(unsigned, __builtin_amdgcn_fmed3f(__builtin_fmaf(a, inv, MG), MG - 127.0f, MG + 127.0f)), ub = __builtin_bit_cast(unsigned, __builtin_amdgcn_fmed3f(__builtin_fmaf(b, inv, MG), MG - 127.0f, MG + 127.0f));
    const unsigned uc = __builtin_bit_cast(unsigned, __builtin_amdgcn_fmed3f(__builtin_fmaf(c, inv, MG), MG - 127.0f, MG + 127.0f)), ud = __builtin_bit_cast(unsigned, __builtin_amdgcn_fmed3f(__builtin_fmaf(d, inv, MG), MG - 127.0f, MG + 127.0f));
    return __builtin_amdgcn_perm(ub, ua, 0x0c0c0400u) | __builtin_amdgcn_perm(ud, uc, 0x04000c0cu);
}
typedef __bf16 bf16x2_t __attribute__((ext_vector_type(2)));
__device__ __forceinline__ unsigned cvtpk_s(float lo, float hi) { f32x2 v = {lo, hi}; bf16x2_t b = __builtin_convertvector(v, bf16x2_t); return __builtin_bit_cast(unsigned, b); }
__device__ __forceinline__ unsigned pk2(float lo, float hi) { return cvtpk_s(lo, hi); }
__device__ __forceinline__ bf16x8 pack8f(float a0, float a1, float a2, float a3, float a4, float a5, float a6, float a7) {
    v4u w = {cvtpk_s(a0, a1), cvtpk_s(a2, a3), cvtpk_s(a4, a5), cvtpk_s(a6, a7)}; return __builtin_bit_cast(bf16x8, w); }
#define XB_TMO      128
#define XB_XCNT(j)  (256  + 64 * (j))
#define XB_XSUB(j)  (1280 + 64 * (j))
#define XB_XGEN(j)  (2304 + 64 * (j))
#define XB_TOP      3328
#define XB_TOPGEN   3392
#define XCD_BAR_WORDS 3456
#define XB_SPIN_CAP (1u << 18)

__device__ __forceinline__ unsigned xb_ld(unsigned* p)              { return __hip_atomic_load(p, __ATOMIC_RELAXED, __HIP_MEMORY_SCOPE_AGENT); }
__device__ __forceinline__ unsigned xb_add(unsigned* p, unsigned v) { return __hip_atomic_fetch_add(p, v, __ATOMIC_RELAXED, __HIP_MEMORY_SCOPE_AGENT); }
__device__ __forceinline__ unsigned xb_xcc_id() { return (unsigned)__builtin_amdgcn_s_getreg((3 << 11) | 20) & 0xFu; }
#define XB_SPIN(cond, bar) do { unsigned _sp = 0; while (cond) { __builtin_amdgcn_s_sleep(1); \
    if ((++_sp & 255u) == 0u) { if (xb_ld(&(bar)[XB_TMO])) break; if (_sp > XB_SPIN_CAP) { atomicAdd(&(bar)[XB_TMO], 1u); break; } } } } while (0)

struct XcdBarrier {
    unsigned* bar; unsigned x;
    volatile LAS unsigned* st;
};

__device__ __forceinline__ XcdBarrier xcd_barrier_post(unsigned* bar, volatile LAS unsigned* st) {
    XcdBarrier b; b.bar = bar; b.x = xb_xcc_id(); b.st = st;
    if (threadIdx.x == 0) (void)xb_add(&bar[XB_XCNT(b.x)], 1u);
    return b;
}
__device__ __forceinline__ void xcd_barrier_complete(unsigned* bar, unsigned x, unsigned& nloc, unsigned& nx) {
    const unsigned G = gridDim.x * gridDim.y * gridDim.z;
    unsigned sum, cnt, mine, sp = 0u;
    for (;;) {
        sum = 0u; cnt = 0u; mine = 0u;
#pragma unroll
        for (unsigned j = 0; j < 16; ++j) { const unsigned c = xb_ld(&bar[XB_XCNT(j)]); sum += c; cnt += (c > 0u) ? 1u : 0u; mine = (j == x) ? c : mine; }
        if (sum == G) break;
        __builtin_amdgcn_s_sleep(1);
        if ((++sp & 255u) == 0u) { if (xb_ld(&bar[XB_TMO])) break; if (sp > XB_SPIN_CAP) { atomicAdd(&bar[XB_TMO], 1u); break; } }
    }
    nloc = mine > 0u ? mine : 1u; nx = cnt > 0u ? cnt : 1u;
}

__device__ __forceinline__ void xcd_barrier(const XcdBarrier& b) {
    asm volatile("s_waitcnt vmcnt(0)" ::: "memory");
    __syncthreads();
    if (threadIdx.x == 0) {
        unsigned* bar = b.bar;
        __builtin_amdgcn_s_waitcnt(0);
        unsigned nloc = b.st[0], nx = b.st[1];
        if (nloc == 0u) { xcd_barrier_complete(bar, b.x, nloc, nx); b.st[0] = nloc; b.st[1] = nx; }
        const unsigned old = xb_add(&bar[XB_XSUB(b.x)], 1u);
        const unsigned gen = old / nloc;
        if (old + 1u == (gen + 1u) * nloc) {
            __builtin_amdgcn_fence(__ATOMIC_RELEASE, "agent");
            asm volatile("s_waitcnt vmcnt(0)" ::: "memory");
            const unsigned og = xb_add(&bar[XB_TOP], 1u);
            const unsigned tg = og / nx;
            if (og + 1u == (tg + 1u) * nx) xb_add(&bar[XB_TOPGEN], 1u);
            else XB_SPIN(xb_ld(&bar[XB_TOPGEN]) == tg, bar);
            __builtin_amdgcn_fence(__ATOMIC_ACQUIRE, "agent");
            xb_add(&bar[XB_XGEN(b.x)], 1u);
            asm volatile("s_waitcnt vmcnt(0)" ::: "memory");
        } else {
            XB_SPIN(xb_ld(&bar[XB_XGEN(b.x)]) == gen, bar);
            __builtin_amdgcn_fence(__ATOMIC_ACQUIRE, "agent");
            asm volatile("s_waitcnt vmcnt(0)" ::: "memory");
        }
    }
    __syncthreads();
}
struct Frame {
    LAS unsigned char* lds; char* ldsg;
    volatile LAS unsigned* MISC;
    gu32* ctl;
    int wave, vcu, G;
    unsigned char* ws;
    const float* const __attribute__((address_space(4)))* kin;
    float* out;
};
__device__ __forceinline__ int tid_now() { int t = (int)threadIdx.x; asm volatile("" : "+v"(t)); return t; }
#define WAVE_RED_(v, OP) do { \
    v = OP(v, __builtin_bit_cast(decltype(v), __builtin_amdgcn_update_dpp(0, __builtin_bit_cast(int, v), 0xB1, 0xf, 0xf, true))); \
    v = OP(v, __builtin_bit_cast(decltype(v), __builtin_amdgcn_update_dpp(0, __builtin_bit_cast(int, v), 0x4E, 0xf, 0xf, true))); \
    v = OP(v, __builtin_bit_cast(decltype(v), __builtin_amdgcn_update_dpp(0, __builtin_bit_cast(int, v), 0x124, 0xf, 0xf, true))); \
    v = OP(v, __builtin_bit_cast(decltype(v), __builtin_amdgcn_update_dpp(0, __builtin_bit_cast(int, v), 0x128, 0xf, 0xf, true))); \
    { auto rr_ = __builtin_amdgcn_permlane16_swap(__builtin_bit_cast(unsigned, v), __builtin_bit_cast(unsigned, v), false, false); v = OP(__builtin_bit_cast(decltype(v), rr_[0]), __builtin_bit_cast(decltype(v), rr_[1])); } \
    { auto rr_ = __builtin_amdgcn_permlane32_swap(__builtin_bit_cast(unsigned, v), __builtin_bit_cast(unsigned, v), false, false); v = OP(__builtin_bit_cast(decltype(v), rr_[0]), __builtin_bit_cast(decltype(v), rr_[1])); } } while (0)
#define WR_ADD_(a, b) ((a) + (b))
#define WR_MAXF_(a, b) fmaxf((a), (b))
#define WR_MAXU_(a, b) ((a) > (b) ? (a) : (b))
__device__ __forceinline__ float wave_sum(float v) {
    v += __int_as_float(__builtin_amdgcn_update_dpp(0, __float_as_int(v), 0xB1, 0xf, 0xf, true));
    v += __int_as_float(__builtin_amdgcn_update_dpp(0, __float_as_int(v), 0x4E, 0xf, 0xf, true));
    v += __int_as_float(__builtin_amdgcn_update_dpp(0, __float_as_int(v), 0x124, 0xf, 0xf, true));
    v += __int_as_float(__builtin_amdgcn_update_dpp(0, __float_as_int(v), 0x128, 0xf, 0xf, true));
    v += __shfl_xor(v, 16);
    { auto rr_ = __builtin_amdgcn_permlane32_swap(__float_as_uint(v), __float_as_uint(v), false, false); v = __uint_as_float(rr_[0]) + __uint_as_float(rr_[1]); }
    return v;
}
__device__ __forceinline__ float wave_maxf(float v) {
#pragma unroll
    for (int o = 1; o < 64; o <<= 1) v = fmaxf(v, __shfl_xor(v, o));
    return v;
}
__device__ __forceinline__ unsigned wave_maxu(unsigned v) {
#pragma unroll
    for (int o = 1; o < 64; o <<= 1) { const unsigned u = (unsigned)__shfl_xor((int)v, o); v = v > u ? v : u; }
    return v;
}
__device__ const unsigned char kBucket[3][132] = {
 {0,1,2,3,4,5,6,7,8,9,10,11,12,13,14,15,16,16,16,16,16,16,17,17,17,17,17,17,17,17,18,18,18,18,18,18,18,18,18,18,19,19,19,19,19,19,19,19,19,19,19,19,19,19,20,20,20,20,20,20,20,20,20,20,20,20,20,20,20,20,20,20,20,21,21,21,21,21,21,21,21,21,21,21,21,21,21,21,21,21,21,21,21,21,21,21,21,21,21,22,22,22,22,22,22,22,22,22,22,22,22,22,22,22,22,22,22,22,22,22,22,22,22,22,22,22,22,22,22,0,0,0},
 {0,4,8,12,16,16,17,17,18,18,19,19,19,19,20,20,20,20,20,21,21,21,21,21,21,22,22,22,22,22,22,22,22,22,23,23,23,23,23,23,23,23,23,23,23,23,24,24,24,24,24,24,24,24,24,24,24,24,24,24,24,24,25,25,25,25,25,25,25,25,25,25,25,25,25,25,25,25,25,25,25,25,25,26,26,26,26,26,26,26,26,26,26,26,26,26,26,26,26,26,26,26,26,26,26,26,26,26,26,26,26,26,26,27,27,27,27,27,27,27,27,27,27,27,27,27,27,27,27,0,0,0},
 {0,16,18,19,20,21,21,22,22,23,23,23,24,24,24,24,25,25,25,25,25,26,26,26,26,26,26,26,26,27,27,27,27,27,27,27,27,27,27,28,28,28,28,28,28,28,28,28,28,28,28,28,29,29,29,29,29,29,29,29,29,29,29,29,29,29,29,29,29,29,30,30,30,30,30,30,30,30,30,30,30,30,30,30,30,30,30,30,30,30,30,30,30,30,30,31,31,31,31,31,31,31,31,31,31,31,31,31,31,31,31,31,31,31,31,31,31,31,31,31,31,31,31,31,31,31,31,31,31,0,0,0}};

#ifndef NT_LOADS
#define NT_LOADS 1
#endif
#if NT_LOADS
#define NTLD(p) __builtin_nontemporal_load(p)
#else
#define NTLD(p) (*(p))
#endif
constexpr int TR_SCR = 17408;
__device__ __forceinline__ void tr_item(const float* W, int ldw, bf16* WT, int ldt, int src_c0, int dst_r0, int nvalid, const float* gain, LAS float* scr, int kb, int lane) {
    const int k0 = 64 * kb, a = lane >> 4, c4 = 4 * (lane & 15);
#pragma unroll 8
    for (int i = 0; i < 16; ++i) { const int kk = 4 * i + a; f32x4 v = NTLD((const GAS f32x4*)(W + (size_t)(k0 + kk) * ldw + src_c0 + c4)); if (gain) v = v * gain[k0 + kk];
        LAS float* d = scr + kk * 65 + c4; d[0] = v.x; d[1] = v.y; d[2] = v.z; d[3] = v.w; }
    LDS_WAIT(); asm volatile("" ::: "memory");
    const int c = lane & 7;
#pragma unroll
    for (int j = 0; j < 8; ++j) { const int n = (lane >> 3) + 8 * j; const LAS float* s = scr + (8 * c) * 65 + n;
        v4u o; o.x = pk2(s[0 * 65], s[1 * 65]); o.y = pk2(s[2 * 65], s[3 * 65]); o.z = pk2(s[4 * 65], s[5 * 65]); o.w = pk2(s[6 * 65], s[7 * 65]);
        if (n < nvalid) *(GAS v4u*)(WT + (size_t)(dst_r0 + n) * ldt + k0 + 8 * c) = o; }
    LDS_WAIT(); asm volatile("" ::: "memory");
}
constexpr float CM_WIDEN = 1.0f;
__device__ __forceinline__ void absmax_item(const float* W, int ldw, int src_c0, const float* gain, unsigned* cmax, int kb, int lane) {
    const int k0 = 64 * kb, a = lane >> 4, c4 = 4 * (lane & 15);
    f32x4 m = {0.f, 0.f, 0.f, 0.f};
#pragma unroll 8
    for (int i = 0; i < 16; ++i) { const int kk = 4 * i + a; const f32x4 v = *(const GAS f32x4*)(W + (size_t)(k0 + kk) * ldw + src_c0 + c4) * (gain ? gain[k0 + kk] : 1.0f);
        m.x = fmaxf(m.x, fabsf(v.x)); m.y = fmaxf(m.y, fabsf(v.y)); m.z = fmaxf(m.z, fabsf(v.z)); m.w = fmaxf(m.w, fabsf(v.w)); }
#pragma unroll
    for (int o = 16; o < 64; o <<= 1) { m.x = fmaxf(m.x, __shfl_xor(m.x, o)); m.y = fmaxf(m.y, __shfl_xor(m.y, o)); m.z = fmaxf(m.z, __shfl_xor(m.z, o)); m.w = fmaxf(m.w, __shfl_xor(m.w, o)); }
    if (lane < 16) { unsigned* p = cmax + c4;   atomicMax(p, __float_as_uint(m.x)); atomicMax(p + 1, __float_as_uint(m.y)); atomicMax(p + 2, __float_as_uint(m.z)); atomicMax(p + 3, __float_as_uint(m.w)); }
}
__device__ __forceinline__ void quant_item(const float* W, int ldw, signed char* WQ, int ldq, int src_c0, int dst_r0, const float* gain, const unsigned* cmax, LAS float* scr, int kb, int lane) {
    const int k0 = 64 * kb, a = lane >> 4, c4 = 4 * (lane & 15);
#pragma unroll 8
    for (int i = 0; i < 16; ++i) { const int kk = 4 * i + a; const f32x4 v = NTLD((const GAS f32x4*)(W + (size_t)(k0 + kk) * ldw + src_c0 + c4)) * (gain ? gain[k0 + kk] : 1.0f);
        LAS float* d = scr + kk * 65 + c4; d[0] = v.x; d[1] = v.y; d[2] = v.z; d[3] = v.w; }
    LDS_WAIT(); asm volatile("" ::: "memory");
    const int c = lane & 3;
#pragma unroll
    for (int j = 0; j < 4; ++j) { const int n = (lane >> 2) + 16 * j; const LAS float* s = scr + (16 * c) * 65 + n;
        const float cm = __uint_as_float(cmax[n]) * CM_WIDEN; const float inv = cm > 0.f ? 127.0f / cm : 0.f;
        unsigned wq[4];
#pragma unroll
        for (int q = 0; q < 4; ++q) wq[q] = q8x4(s[(4 * q) * 65], s[(4 * q + 1) * 65], s[(4 * q + 2) * 65], s[(4 * q + 3) * 65], inv);
        v4u o = {wq[0], wq[1], wq[2], wq[3]};
        *(GAS v4u*)(WQ + (size_t)(dst_r0 + n) * ldq + k0 + 16 * c) = o; }
    LDS_WAIT(); asm volatile("" ::: "memory");
}

__device__ __forceinline__ void rms_row_to_bf16(const float* xrow, const float* g, bf16* orow, int lane, signed char* qrow = nullptr, float* qscale = nullptr) {
    const GAS f32x4* xr = (const GAS f32x4*)xrow + lane; const GAS f32x4* gr = (const GAS f32x4*)g + lane;
    f32x4 v[16]; float s = 0.f;
#pragma unroll
    for (int j = 0; j < 16; ++j) { v[j] = NTLD(xr + 64 * j); s += (v[j].x * v[j].x + v[j].y * v[j].y) + (v[j].z * v[j].z + v[j].w * v[j].w); }
    const float r = 1.0f / sqrtf(wave_sum(s) * (1.0f / 4096.0f) + RMS_EPS);
    GAS v2u* o8 = (GAS v2u*)orow + lane; float mx = 0.f;
#pragma unroll
    for (int j = 0; j < 16; ++j) { const f32x4 gg = gr[64 * j]; v[j] = (f32x4){v[j].x * r * gg.x, v[j].y * r * gg.y, v[j].z * r * gg.z, v[j].w * r * gg.w};
        v2u o; o.x = pk2(v[j].x, v[j].y); o.y = pk2(v[j].z, v[j].w); o8[64 * j] = o;
        mx = fmaxf(mx, fmaxf(fmaxf(fabsf(v[j].x), fabsf(v[j].y)), fmaxf(fabsf(v[j].z), fabsf(v[j].w)))); }
    if (qrow) {
        mx = wave_maxf(mx);
        const float inv = mx > 0.f ? 127.0f / mx : 0.f; GAS unsigned* q4 = (GAS unsigned*)qrow + lane;
#pragma unroll
        for (int j = 0; j < 16; ++j) q4[64 * j] = q8x4(v[j].x, v[j].y, v[j].z, v[j].w, inv);
        if (lane == 0) *qscale = mx * (1.0f / 127.0f);
    }
}

__device__ __forceinline__ void p0_first_token(Frame& F) {
    const int tid = tid_now(), lane = tid & 63, w = F.wave;
    LAS float* red = (LAS float*)F.lds;
    const float* x = F.kin[0]; const float* g = F.kin[3]; const float* W = F.kin[4];
    float* Q0K0 = (float*)(F.ws + WS_Q0K0);
    for (int cb = blockIdx.x; cb < 256; cb += F.G) {
        float xv[4][8]; float gg[8]; f32x4 w0[8], w1[8];
#pragma unroll
        for (int i = 0; i < 8; ++i) { gg[i] = g[tid + 512 * i]; const GAS f32x4* wp = (const GAS f32x4*)(W + (size_t)(tid + 512 * i) * NIN + 8 * cb); w0[i] = wp[0]; w1[i] = wp[1];
#pragma unroll
            for (int b = 0; b < 4; ++b) xv[b][i] = x[(size_t)b * SEQ * DM + tid + 512 * i]; }
        float acc[4][8], ss[4];
#pragma unroll
        for (int b = 0; b < 4; ++b) { ss[b] = 0.f;
#pragma unroll
            for (int c = 0; c < 8; ++c) acc[b][c] = 0.f; }
#pragma unroll
        for (int i = 0; i < 8; ++i) { const float wv[8] = {w0[i].x, w0[i].y, w0[i].z, w0[i].w, w1[i].x, w1[i].y, w1[i].z, w1[i].w};
#pragma unroll
            for (int b = 0; b < 4; ++b) { ss[b] += xv[b][i] * xv[b][i]; const float xg = xv[b][i] * gg[i];
#pragma unroll
                for (int c = 0; c < 8; ++c) acc[b][c] += xg * wv[c]; } }
#pragma unroll
        for (int b = 0; b < 4; ++b) { const float s2 = wave_sum(ss[b]); if (lane == 0) red[w * 40 + 32 + b] = s2;
#pragma unroll
            for (int c = 0; c < 8; ++c) { const float s = wave_sum(acc[b][c]); if (lane == 0) red[w * 40 + b * 8 + c] = s; } }
        __syncthreads();
        if (tid < 32) { float s = 0.f, q = 0.f;
#pragma unroll
            for (int k = 0; k < 8; ++k) { s += red[k * 40 + tid]; q += red[k * 40 + 32 + (tid >> 3)]; }
            Q0K0[(tid >> 3) * 2048 + 8 * cb + (tid & 7)] = s * (1.0f / sqrtf(q * (1.0f / 4096.0f) + RMS_EPS)); }
        __syncthreads();
    }
}
__device__ __forceinline__ int winq_src_col(int nb) { return GV_I8 ? (nb < 32 ? 2048 + 64 * nb : 6160 + 64 * (nb - 32)) : 6160 + 64 * nb; }
__device__ __forceinline__ void p0_prologue(Frame& F) {
    const int tid = tid_now(), lane = tid & 63;
    LAS float* scr = (LAS float*)(F.lds + F.wave * TR_SCR);
    const int gw = F.vcu * NWAVES + F.wave, NGW = F.G * NWAVES;
    bf16* Win = (bf16*)(F.ws + WS_WIN); bf16* Wlr = (bf16*)(F.ws + WS_WLR); bf16* Wout = (bf16*)(F.ws + WS_WOUT); bf16* Wxq = (bf16*)(F.ws + WS_WXQ); bf16* Wxkv = (bf16*)(F.ws + WS_WXKV); bf16* Wxo = (bf16*)(F.ws + WS_WXO);
    constexpr int NA = GV_I8 ? 2048 : 4096;
    constexpr int I_INA = 64 * (NA / 64), I_INB = 64 * (2048 / 64), I_INQ = 64 * (NQ1 / 64), I_LR = 64, I_OUT = 64 * 64, I_XQ = 64 * 8, I_XO = 8 * 64;
    constexpr int NIT = I_INA + I_INB + I_INQ + I_LR + I_OUT + 3 * I_XQ + I_XO;
    unsigned* cmax1 = (unsigned*)(F.ws + WS_CTL + CTL_CMAX1);
    for (int it = gw; it < NIT; it += NGW) {
        int r = it;
        if (r < I_INA) { const int nb = r % (NA / 64), kb = r / (NA / 64); tr_item(F.kin[4], NIN, Win, DM, 64 * nb, 64 * nb, 64, nullptr, scr, kb, lane); continue; } r -= I_INA;
        if (r < I_INB) { const int nb = r % 32, kb = r / 32; tr_item(F.kin[4], NIN, Win, DM, 4112 + 64 * nb, NA + 64 * nb, 64, nullptr, scr, kb, lane); continue; } r -= I_INB;
        if (r < I_INQ) { const int nb = r % (NQ1 / 64), kb = r / (NQ1 / 64); absmax_item(F.kin[4], NIN, winq_src_col(nb), nullptr, cmax1 + 64 * nb, kb, lane); continue; } r -= I_INQ;
        if (r < I_LR) { tr_item(F.kin[4], NIN, Wlr, DM, 4096, 0, 16, nullptr, scr, r, lane); continue; } r -= I_LR;
        if (r < I_OUT) { const int nb = r % 64, kb = r / 64; tr_item(F.kin[8], DM, Wout, DM, 64 * nb, 64 * nb, 64, nullptr, scr, kb, lane); continue; } r -= I_OUT;
        if (r < I_XQ) { const int nb = r % 8, kb = r / 8; tr_item(F.kin[11], XW, Wxq, DM, 64 * nb, 64 * nb, 64, F.kin[9], scr, kb, lane); continue; } r -= I_XQ;
        if (r < I_XQ) { const int nb = r % 8, kb = r / 8; tr_item(F.kin[12], XW, Wxkv, DM, 64 * nb, 64 * nb, 64, nullptr, scr, kb, lane); continue; } r -= I_XQ;
        if (r < I_XQ) { const int nb = r % 8, kb = r / 8; tr_item(F.kin[13], XW, Wxkv, DM, 64 * nb, 512 + 64 * nb, 64, nullptr, scr, kb, lane); continue; } r -= I_XQ;
        { const int nb = r % 64, kb = r / 64; tr_item(F.kin[14], DM, Wxo, XW, 64 * nb, 64 * nb, 64, nullptr, scr, kb, lane); }
    }
    bf16* XN = (bf16*)(F.ws + WS_XN); bf16* MEMN = (bf16*)(F.ws + WS_MEMN);
    for (int m = NGW - 1 - gw; m < M + MROWS; m += NGW) {
        if (m < M) rms_row_to_bf16(F.kin[0] + (size_t)m * DM, F.kin[3], XN + (size_t)m * DM, lane, (signed char*)(F.ws + WS_XNQ) + (size_t)m * DM, (float*)(F.ws + WS_RSC1) + m);
        else rms_row_to_bf16(F.kin[1] + (size_t)(m - M) * DM, F.kin[10], MEMN + (size_t)(m - M) * DM, lane);
    }
    float* BT = (float*)(F.ws + WS_BT);
    for (int i = blockIdx.x * 512 + tid; i < 3 * 16 * 132; i += F.G * 512) { const int rel = i % 132, h = (i / 132) % 16, cfg = i / (132 * 16);
        BT[i] = rel < 129 ? F.kin[2][kBucket[cfg][rel] * 16 + h] * 11.313708498984761f : 0.f; }
}
constexpr int FW_IG = 64 * (DFF / 64), FW_ID = (DFF / 64) * 64, FW_ALL = 2 * FW_IG + FW_ID;
#ifndef FW_P6N
#define FW_P6N 3584
#endif
constexpr int FW_P6_LO = 2 * FW_IG - (FW_P6N), FW_P6_HI = 2 * FW_IG;
#ifndef FW_P9N
#define FW_P9N 8448
#endif
#ifndef P9_GEMM_WGS
#define P9_GEMM_WGS 251
#endif
constexpr int FW_P9_LO = FW_ALL - (FW_P9N), FW_P9_HI = FW_ALL;
template <int MODE  >
__device__ __forceinline__ void ffn_weight_item(Frame& F, int r, LAS float* scr, int lane) {
    bf16* Wgu = (bf16*)(F.ws + WS_WGU); bf16* Wdn = (bf16*)(F.ws + WS_WDN); unsigned* cmax = (unsigned*)(F.ws + WS_CTL + CTL_COLMAX);
    if (r < 2 * FW_IG) { const int up = r >= FW_IG ? 1 : 0; const int rr = r - up * FW_IG; const int nb = rr % 172, kb = rr / 172, c0 = 64 * nb; const float* W = up ? F.kin[17] : F.kin[16];
        const int drow = 256 * (c0 >> 7) + 128 * up + (c0 & 127);
        if constexpr (MODE == 1) absmax_item(W, DFF, c0, F.kin[15], cmax + up * DFF + c0, kb, lane);
        else if constexpr (FFN_I8) quant_item(W, DFF, (signed char*)Wgu, DM, c0, drow, F.kin[15], cmax + up * DFF + c0, scr, kb, lane);
        else tr_item(W, DFF, Wgu, DM, c0, drow, 64, F.kin[15], scr, kb, lane);
        return; }
    if constexpr (MODE == 0) { r -= 2 * FW_IG; const int nb = r % 64, kb = r / 64; tr_item(F.kin[20], DM, Wdn, DFF, 64 * nb, 64 * nb, 64, nullptr, scr, kb, lane); }
}
template <int MODE> __device__ __forceinline__ void ffn_weights(Frame& F, int lo, int hi, int iw, int nw) {
    const int lane = tid_now() & 63; LAS float* scr = (LAS float*)(F.lds + F.wave * TR_SCR);
    for (int it = lo + iw; it < hi; it += nw) ffn_weight_item<MODE>(F, it, scr, lane);
}

__device__ __forceinline__ void p0_quant_win(Frame& F) {
    const int lane = tid_now() & 63; LAS float* scr = (LAS float*)(F.lds + F.wave * TR_SCR);
    const int gw = F.vcu * NWAVES + F.wave, NGW = F.G * NWAVES;
    const unsigned* cmax1 = (const unsigned*)(F.ws + WS_CTL + CTL_CMAX1);
    for (int r = gw; r < 64 * (NQ1 / 64); r += NGW) { const int nb = r % (NQ1 / 64), kb = r / (NQ1 / 64);
        quant_item(F.kin[4], NIN, (signed char*)(F.ws + WS_WINQ), DM, winq_src_col(nb), 64 * nb, nullptr, cmax1 + 64 * nb, scr, kb, lane); }
}
#ifndef QPRE
#define QPRE 8
#endif
constexpr int PP = 520;
constexpr int PREP_GLR = 0, PREP_QM = 8192, PREP_KM = 8192 + 64 * PP * 2;
static_assert(PREP_KM + 64 * PP * 2 <= MISC_OFF, "prep LDS");
__device__ __forceinline__ void gla_prep_unit(Frame& F, int b, int n) {
    const int tid = tid_now(), lane = tid & 63, w = F.wave;
    const int t0 = b * SEQ + 64 * n;
    const bf16* XN = (const bf16*)(F.ws + WS_XN); const bf16* Wlr = (const bf16*)(F.ws + WS_WLR);
    const bf16* GQ = (const bf16*)(F.ws + WS_GQ); bf16* GQ2 = (bf16*)(F.ws + WS_GQ2); const bf16* GK = (const bf16*)(F.ws + WS_GK);
    bf16* KET = (bf16*)(F.ws + WS_KET); bf16* ATT = (bf16*)(F.ws + WS_ATT); float* DEC = (float*)(F.ws + WS_DEC);
    LAS float* glr = (LAS float*)(F.lds + PREP_GLR);
    LAS bf16* QMs = (LAS bf16*)(F.lds + PREP_QM); LAS bf16* KMs = (LAS bf16*)(F.lds + PREP_KM);
    {
        const int rg = w & 3, kh = w >> 2, rr = lane & 15, kg = lane >> 4;
        const bf16* ap = XN + (size_t)(t0 + 16 * rg + rr) * DM + kh * 2048 + 8 * kg; const bf16* bp = Wlr + (size_t)rr * DM + kh * 2048 + 8 * kg;
        f32x4 acc = {0.f, 0.f, 0.f, 0.f};
#pragma unroll 16
        for (int s = 0; s < 64; ++s) { const bf16x8 a = *(const GAS bf16x8*)(ap + 32 * s), bq = *(const GAS bf16x8*)(bp + 32 * s); acc = __builtin_amdgcn_mfma_f32_16x16x32_bf16(a, bq, acc, 0, 0, 0); }
#pragma unroll
        for (int i = 0; i < 4; ++i) glr[(kh * 64 + 16 * rg + 4 * kg + i) * 16 + rr] = acc[i];
    }
    __syncthreads();
    for (int i = tid; i < 1024; i += 512) glr[i] += glr[1024 + i];
    __syncthreads();
    const int cid = (b * 64 + n) * 4;
    for (int hp = 0; hp < 2; ++hp) {
        {
            const int col = hp * 512 + tid, h = col >> 8, dk = col & 255;
            float w2[16];
#pragma unroll
            for (int j = 0; j < 16; ++j) w2[j] = F.kin[5][j * 1024 + col];
            const float bg = F.kin[6][col];
            const bf16* qp = GQ + (size_t)t0 * 1024 + col; const bf16* kp = GK + (size_t)t0 * 1024 + col;
            typedef unsigned short us2_t __attribute__((ext_vector_type(2)));
            us2_t kv[32];
#pragma unroll
            for (int c2 = 0; c2 < 32; ++c2) { kv[c2].x = kp[(size_t)(2 * c2) * 1024]; kv[c2].y = kp[(size_t)(2 * c2 + 1) * 1024]; }
            us2_t qv[QPRE];
#pragma unroll
            for (int c2 = 0; c2 < QPRE; ++c2) { qv[c2].x = qp[(size_t)(2 * c2) * 1024]; qv[c2].y = qp[(size_t)(2 * c2 + 1) * 1024]; }
            float bc[64]; float run = 0.f;
#pragma unroll
            for (int c = 0; c < 64; ++c) {
                const LAS f32x4* gp = (const LAS f32x4*)(glr + c * 16); const f32x4 g0 = gp[0], g1 = gp[1], g2 = gp[2], g3 = gp[3];
                float za = bg, zb = 0.f;
                za = __builtin_fmaf(g0.x, w2[0], za); zb = __builtin_fmaf(g0.y, w2[1], zb); za = __builtin_fmaf(g0.z, w2[2], za); zb = __builtin_fmaf(g0.w, w2[3], zb);
                za = __builtin_fmaf(g1.x, w2[4], za); zb = __builtin_fmaf(g1.y, w2[5], zb); za = __builtin_fmaf(g1.z, w2[6], za); zb = __builtin_fmaf(g1.w, w2[7], zb);
                za = __builtin_fmaf(g2.x, w2[8], za); zb = __builtin_fmaf(g2.y, w2[9], zb); za = __builtin_fmaf(g2.z, w2[10], za); zb = __builtin_fmaf(g2.w, w2[11], zb);
                za = __builtin_fmaf(g3.x, w2[12], za); zb = __builtin_fmaf(g3.y, w2[13], zb); za = __builtin_fmaf(g3.z, w2[14], za); zb = __builtin_fmaf(g3.w, w2[15], zb);
                const float z = za + zb;
                const float ls = fminf(z, 0.f) - 0.6931471805599453f * __builtin_amdgcn_logf(1.0f + __builtin_amdgcn_exp2f(-1.4426950408889634f * fabsf(z)));
                run += ls * (1.0f / 16.0f); bc[c] = run;
            }
            const float blast = bc[63], bmid = bc[32]; const float Emid = __expf(bmid), Elm = __expf(blast - bmid);
            unsigned kep[32];
            bf16* qo = GQ2 + (size_t)t0 * 1024 + col;
#pragma unroll
            for (int c2 = 0; c2 < 32; ++c2) {
                const int c = 2 * c2;
                const float qa = bf2f(c2 < QPRE ? qv[c2 < QPRE ? c2 : 0].x : qp[(size_t)c * 1024]) * (1.0f / 16.0f), ka = bf2f(kv[c2].x);
                const float qb = bf2f(c2 < QPRE ? qv[c2 < QPRE ? c2 : 0].y : qp[(size_t)(c + 1) * 1024]) * (1.0f / 16.0f), kb = bf2f(kv[c2].y);
                const float Aa = __expf(bc[c] - bmid), Ab = __expf(bc[c + 1] - bmid), Ra = __builtin_amdgcn_rcpf(Aa), Rb = __builtin_amdgcn_rcpf(Ab);
                const unsigned qt = cvtpk_s(qa * (Aa * Emid), qb * (Ab * Emid));
                qo[(size_t)c * 1024] = (bf16)(qt & 0xffffu); qo[(size_t)(c + 1) * 1024] = (bf16)(qt >> 16);
                kep[c2] = cvtpk_s(ka * (Ra * Elm), kb * (Rb * Elm));
                const unsigned qm = cvtpk_s(qa * Aa, qb * Ab);
                const unsigned km = cvtpk_s(ka * Ra, kb * Rb);
                QMs[c * PP + tid] = (bf16)(qm & 0xffffu); QMs[(c + 1) * PP + tid] = (bf16)(qm >> 16);
                KMs[c * PP + tid] = (bf16)(km & 0xffffu); KMs[(c + 1) * PP + tid] = (bf16)(km >> 16);
            }
            bf16* kt = KET + ((size_t)(cid + h) * 256 + dk) * 64;
#pragma unroll
            for (int i = 0; i < 8; ++i) { v4u o = {kep[4 * i], kep[4 * i + 1], kep[4 * i + 2], kep[4 * i + 3]}; *(GAS v4u*)(kt + 8 * i) = o; }
            DEC[(size_t)(cid + h) * 256 + dk] = __expf(blast);
        }
        __syncthreads();
        {
            const int rr = lane & 15, kg = lane >> 4;
#pragma unroll
            for (int q4 = 0; q4 < 4; ++q4) {
                const int id = w * 4 + q4, hl = id >> 4, mt = (id >> 2) & 3, nt = id & 3;
                const LAS bf16* ap = KMs + (16 * mt + rr) * PP + hl * 256 + 8 * kg; const LAS bf16* bp = QMs + (16 * nt + rr) * PP + hl * 256 + 8 * kg;
                f32x4 acc = {0.f, 0.f, 0.f, 0.f};
#pragma unroll
                for (int s = 0; s < 8; ++s) { const bf16x8 a = *(const LAS bf16x8*)(ap + 32 * s), bq = *(const LAS bf16x8*)(bp + 32 * s); acc = __builtin_amdgcn_mfma_f32_16x16x32_bf16(a, bq, acc, 0, 0, 0); }
                const int c = 16 * nt + rr, cp0 = 16 * mt + 4 * kg;
                v2u o; o.x = pk2(cp0 <= c ? acc[0] : 0.f, cp0 + 1 <= c ? acc[1] : 0.f); o.y = pk2(cp0 + 2 <= c ? acc[2] : 0.f, cp0 + 3 <= c ? acc[3] : 0.f);
                *(GAS v2u*)(ATT + ((size_t)(cid + 2 * hp + hl) * 64 + c) * 64 + cp0) = o;
            }
        }
        __syncthreads();
    }
    if (n == 0 && w < 4) {
        const float* q0 = (const float*)(F.ws + WS_Q0K0) + b * 2048 + w * 256; const float* k0 = q0 + 1024; float s = 0.f;
#pragma unroll
        for (int i = 0; i < 4; ++i) s += q0[lane + 64 * i] * k0[lane + 64 * i];
        s = wave_sum(s) * (1.0f / 16.0f);
        if (lane == 0) ATT[(size_t)(cid + w) * 4096] = (bf16)f2bf(s);
    }
}

constexpr int CH_QT = 0, CH_QP = 528, CH_KE = 64 * CH_QP, CH_KP = 144, CH_AT = CH_KE + 256 * CH_KP, CH_DC = CH_AT + 64 * CH_KP, CH_VS = CH_DC + 1024, CH_END = CH_VS + 16384;
static_assert(CH_END <= MISC_OFF, "chain LDS");
__device__ __forceinline__ void gla_chain_unit(Frame& F, int b, int h, int qd) {
    const int tid = tid_now(), lane = tid & 63, w = F.wave, r32 = lane & 31, hi = lane >> 5;
    const bool helper = w >= 4; const int htid = tid - 256;
    const bf16* GQ = (const bf16*)(F.ws + WS_GQ2); const bf16* KET = (const bf16*)(F.ws + WS_KET); const bf16* ATT = (const bf16*)(F.ws + WS_ATT);
    const float* DEC = (const float*)(F.ws + WS_DEC); const bf16* GV = (const bf16*)(F.ws + WS_GV); bf16* ORAW = (bf16*)(F.ws + WS_XN);
    LAS unsigned char* L = F.lds;
    if (helper) {
        v4u st[23];
#define CH_LOADS(nn) do { const int ch_ = (b * 64 + (nn)) * 4 + h; const int t0_ = b * SEQ + 64 * (nn); \
            _Pragma("unroll") for (int i = 0; i < 8; ++i) { const int id = htid + 256 * i; st[i] = *(const GAS v4u*)(GQ + (size_t)(t0_ + (id >> 5)) * 1024 + h * 256 + 8 * (id & 31)); } \
            _Pragma("unroll") for (int i = 0; i < 8; ++i) { const int id = htid + 256 * i; st[8 + i] = *(const GAS v4u*)(KET + ((size_t)ch_ * 256 + (id >> 3)) * 64 + 8 * (id & 7)); } \
            _Pragma("unroll") for (int i = 0; i < 2; ++i) { const int id = htid + 256 * i; st[16 + i] = *(const GAS v4u*)(ATT + ((size_t)ch_ * 64 + (id >> 3)) * 64 + 8 * (id & 7)); } \
            _Pragma("unroll") for (int i = 0; i < 4; ++i) { const int id = htid + 256 * i; st[19 + i] = *(const GAS v4u*)(GV + (size_t)(t0_ + (id >> 4)) * 2048 + h * 512 + qd * 128 + 8 * (id & 15)); } \
            st[18] = *(const GAS v4u*)(DEC + (size_t)ch_ * 256 + 4 * (htid & 63)); } while (0)
        CH_LOADS(0);
        for (int n = 0; n < 64; ++n) {
#pragma unroll
            for (int i = 0; i < 8; ++i) { const int id = htid + 256 * i; *(LAS v4u*)(L + CH_QT + (id >> 5) * CH_QP + 16 * (id & 31)) = st[i]; }
#pragma unroll
            for (int i = 0; i < 8; ++i) { const int id = htid + 256 * i; *(LAS v4u*)(L + CH_KE + (id >> 3) * CH_KP + 16 * (id & 7)) = st[8 + i]; }
#pragma unroll
            for (int i = 0; i < 2; ++i) { const int id = htid + 256 * i; *(LAS v4u*)(L + CH_AT + (id >> 3) * CH_KP + 16 * (id & 7)) = st[16 + i]; }
#pragma unroll
            for (int i = 0; i < 4; ++i) { const int id = htid + 256 * i; *(LAS v4u*)(L + CH_VS + att::v_st(id >> 4, 8 * (id & 15))) = st[19 + i]; }
            if (htid < 64) *(LAS v4u*)(L + CH_DC + 16 * htid) = st[18];
            __syncthreads();
            if (n + 1 < 64) CH_LOADS(n + 1);
            __syncthreads();
        }
#undef CH_LOADS
    } else {
        f32x16 S[8];
#pragma unroll
        for (int i = 0; i < 8; ++i)
#pragma unroll
            for (int r = 0; r < 16; ++r) S[i][r] = 0.f;
        for (int n = 0; n < 64; ++n) {
            __syncthreads();
            const int t0 = b * SEQ + 64 * n;
            bf16x8 vc[4];
#pragma unroll
            for (int s = 0; s < 4; ++s) { const LAS unsigned char* vp = L + CH_VS + att::v_rd_base(lane) + w * 512 + s * 4096;
                const s16x4 lo = __builtin_bit_cast(s16x4, __builtin_amdgcn_ds_read_tr16_b64_v4i16((LAS v4i16_t*)vp)), hh = __builtin_bit_cast(s16x4, __builtin_amdgcn_ds_read_tr16_b64_v4i16((LAS v4i16_t*)(vp + 2048)));
                vc[s] = (bf16x8){lo[0], lo[1], lo[2], lo[3], hh[0], hh[1], hh[2], hh[3]}; }
            f32x16 O[2];
#pragma unroll
            for (int r = 0; r < 16; ++r) { O[0][r] = 0.f; O[1][r] = 0.f; }
#pragma unroll
            for (int mt = 0; mt < 8; ++mt)
#pragma unroll
                for (int sp = 0; sp < 2; ++sp) {
                    const bf16x8 bs = pack8f(S[mt][8 * sp], S[mt][8 * sp + 1], S[mt][8 * sp + 2], S[mt][8 * sp + 3], S[mt][8 * sp + 4], S[mt][8 * sp + 5], S[mt][8 * sp + 6], S[mt][8 * sp + 7]);
#pragma unroll
                    for (int mc = 0; mc < 2; ++mc) {
                        const LAS unsigned char* ap = L + CH_QT + (32 * mc + r32) * CH_QP + (32 * mt + 16 * sp + 4 * hi) * 2;
                        const s16x4 lo = *(const LAS s16x4*)ap, hh = *(const LAS s16x4*)(ap + 16);
                        const bf16x8 a = {lo[0], lo[1], lo[2], lo[3], hh[0], hh[1], hh[2], hh[3]};
                        O[mc] = __builtin_amdgcn_mfma_f32_32x32x16_bf16(a, bs, O[mc], 0, 0, 0);
                    }
                }
#pragma unroll
            for (int s = 0; s < 4; ++s)
#pragma unroll
                for (int mc = 0; mc < 2; ++mc) { const bf16x8 a = *(const LAS bf16x8*)(L + CH_AT + (32 * mc + r32) * CH_KP + (16 * s + 8 * hi) * 2); O[mc] = __builtin_amdgcn_mfma_f32_32x32x16_bf16(a, vc[s], O[mc], 0, 0, 0); }
            bf16* rowbase = ORAW + (size_t)t0 * 2048 + h * 512 + qd * 128 + 32 * w;
            const unsigned loff = (unsigned)(r32 + hi * 4 * 2048);
#pragma unroll
            for (int mc = 0; mc < 2; ++mc)
#pragma unroll
                for (int r = 0; r < 16; ++r) { const float v = O[mc][r], vn = __shfl_xor(v, 1);
                    if ((r32 & 1) == 0) *(unsigned*)(rowbase + (32 * mc + (r & 3) + 8 * (r >> 2)) * 2048 + loff) = cvtpk_s(v, vn); }
#pragma unroll
            for (int mt = 0; mt < 8; ++mt) {
#pragma unroll
                for (int j = 0; j < 4; ++j) { const f32x4 d4 = *(const LAS f32x4*)(L + CH_DC + (32 * mt + 8 * j + 4 * hi) * 4);
                    S[mt][4 * j] *= d4.x; S[mt][4 * j + 1] *= d4.y; S[mt][4 * j + 2] *= d4.z; S[mt][4 * j + 3] *= d4.w; }
#pragma unroll
                for (int s = 0; s < 4; ++s) { const bf16x8 a = *(const LAS bf16x8*)(L + CH_KE + (32 * mt + r32) * CH_KP + (16 * s + 8 * hi) * 2); S[mt] = __builtin_amdgcn_mfma_f32_32x32x16_bf16(a, vc[s], S[mt], 0, 0, 0); }
            }
            __syncthreads();
        }
    }
}

__device__ __forceinline__ void mix_row(Frame& F, int t, int lane) {
    const bf16* ORAW = (const bf16*)(F.ws + WS_XN); const bf16* GR = (const bf16*)(F.ws + WS_GR); const bf16* OC = (const bf16*)(F.ws + WS_OC); const float* LSE = (const float*)(F.ws + WS_LSE);
    bf16* MIX = (bf16*)(F.ws + WS_MIX);
#pragma unroll
    for (int h = 0; h < 4; ++h) {
        const v4u ow = *(const GAS v4u*)(ORAW + (size_t)t * 2048 + h * 512 + 8 * lane); const f32x4 o0 = {bflo(ow.x), bfhi(ow.x), bflo(ow.y), bfhi(ow.y)}, o1 = {bflo(ow.z), bfhi(ow.z), bflo(ow.w), bfhi(ow.w)};
        const float ss = wave_sum((o0.x * o0.x + o0.y * o0.y) + (o0.z * o0.z + o0.w * o0.w) + (o1.x * o1.x + o1.y * o1.y) + (o1.z * o1.z + o1.w * o1.w));
        const float r = __builtin_amdgcn_rsqf(ss * (1.0f / 512.0f) + RMS_EPS);
        const GAS f32x4* gp = (const GAS f32x4*)F.kin[7] + 2 * lane; const f32x4 g0 = gp[0], g1 = gp[1];
        const v4u gw = *(const GAS v4u*)(GR + (size_t)t * 2048 + h * 512 + 8 * lane);
        float y[8] = {o0.x * r * g0.x, o0.y * r * g0.y, o0.z * r * g0.z, o0.w * r * g0.w, o1.x * r * g1.x, o1.y * r * g1.y, o1.z * r * g1.z, o1.w * r * g1.w};
        const float gv[8] = {bflo(gw.x), bfhi(gw.x), bflo(gw.y), bfhi(gw.y), bflo(gw.z), bfhi(gw.z), bflo(gw.w), bfhi(gw.w)};
#pragma unroll
        for (int e = 0; e < 8; ++e) y[e] *= gv[e] * __builtin_amdgcn_rcpf(1.0f + __expf(-gv[e]));
        v4u o = {pk2(y[0], y[1]), pk2(y[2], y[3]), pk2(y[4], y[5]), pk2(y[6], y[7])};
        *(GAS v4u*)(MIX + (size_t)t * DM + h * 512 + 8 * lane) = o;
    }
    {
        const int hd = lane >> 2;
        float m2[3], l[3];
#pragma unroll
        for (int c = 0; c < 3; ++c) { const f32x2 v = *(const GAS f32x2*)(LSE + (((size_t)c * M + t) * 16 + hd) * 2); m2[c] = v.x; l[c] = v.y; }
        const float mx = fmaxf(m2[0], fmaxf(m2[1], m2[2]));
        float wgt[3]; float den = 0.f;
#pragma unroll
        for (int c = 0; c < 3; ++c) { wgt[c] = __builtin_amdgcn_exp2f(m2[c] - mx) * l[c]; den += wgt[c]; }
        const float rden = __builtin_amdgcn_rcpf(den);
        float acc[32];
#pragma unroll
        for (int e = 0; e < 32; ++e) acc[e] = 0.f;
#pragma unroll
        for (int c = 0; c < 3; ++c) { const float wc = wgt[c] * rden; const GAS v4u* p = (const GAS v4u*)(OC + (size_t)c * M * 2048 + ((size_t)((t >> 12) * 16 + hd) * SEQ + (t & 4095)) * 128 + 32 * (lane & 3));
#pragma unroll
            for (int q = 0; q < 4; ++q) { const v4u v = p[q];
                acc[8 * q + 0] += wc * bflo(v.x); acc[8 * q + 1] += wc * bfhi(v.x); acc[8 * q + 2] += wc * bflo(v.y); acc[8 * q + 3] += wc * bfhi(v.y);
                acc[8 * q + 4] += wc * bflo(v.z); acc[8 * q + 5] += wc * bfhi(v.z); acc[8 * q + 6] += wc * bflo(v.w); acc[8 * q + 7] += wc * bfhi(v.w); } }
        GAS v4u* op = (GAS v4u*)(MIX + (size_t)t * DM + 2048 + 32 * lane);
#pragma unroll
        for (int q = 0; q < 4; ++q) { v4u o = {pk2(acc[8 * q], acc[8 * q + 1]), pk2(acc[8 * q + 2], acc[8 * q + 3]), pk2(acc[8 * q + 4], acc[8 * q + 5]), pk2(acc[8 * q + 6], acc[8 * q + 7])}; op[q] = o; }
    }
}
__device__ __forceinline__ void halo_fix(Frame& F) {
    const int tid = tid_now();
    const float* GF = (const float*)(F.ws + WS_HALO); const float* UF = GF + HALO_ONE / 4; const float* GL = UF + HALO_ONE / 4;
    bf16* ACT = (bf16*)(F.ws + WS_ACT); const float* cw = F.kin[18]; const float* cb = F.kin[19]; const unsigned* colmax = (const unsigned*)(F.ws + WS_CTL + CTL_COLMAX);
    const int total = 256 * 2 * (DFF / 4);
    for (int i = blockIdx.x * 512 + tid; i < total; i += F.G * 512) {
        const int c4 = i % (DFF / 4), j = (i / (DFF / 4)) & 1, blk = i / (DFF / 2), ch = 4 * c4;
        const bool first = (blk & 63) == 0;
        const f32x4 g0 = *(const GAS f32x4*)(GF + ((size_t)blk * 2 + j) * DFF + ch), uu = *(const GAS f32x4*)(UF + ((size_t)blk * 2 + j) * DFF + ch);
        const f32x4 z = {0.f, 0.f, 0.f, 0.f};
        f32x4 g1, g2;
        if (j == 0) { g1 = first ? z : *(const GAS f32x4*)(GL + ((size_t)(blk - 1) * 2 + 1) * DFF + ch); g2 = first ? z : *(const GAS f32x4*)(GL + ((size_t)(blk - 1) * 2 + 0) * DFF + ch); }
        else { g1 = *(const GAS f32x4*)(GF + ((size_t)blk * 2 + 0) * DFF + ch); g2 = first ? z : *(const GAS f32x4*)(GL + ((size_t)(blk - 1) * 2 + 1) * DFF + ch); }
        const f32x4 w0 = *(const GAS f32x4*)(cw + ch), w1 = *(const GAS f32x4*)(cw + DFF + ch), w2 = *(const GAS f32x4*)(cw + 2 * DFF + ch), bb = *(const GAS f32x4*)(cb + ch);
        float a[4];
#pragma unroll
        for (int e = 0; e < 4; ++e) { const float sg = FFN_I8 ? __uint_as_float(colmax[ch + e]) * (1.0f / 127.0f) : 1.0f;
            const float y = bb[e] + sg * (w0[e] * g2[e] + w1[e] * g1[e] + w2[e] * g0[e]); a[e] = y / (1.0f + __expf(-y)) * (uu[e] * -1.4426950408889634f); }
        v2u o = {pk2(a[0], a[1]), pk2(a[2], a[3])};
        *(GAS v2u*)(ACT + (size_t)(64 * blk + j) * DFF + ch) = o;
    }
}
__device__ __forceinline__ void final_norm_row(Frame& F, int t, int lane) {
    const GAS v4u* hr = (const GAS v4u*)((const bf16*)(F.ws + WS_XN) + (size_t)t * DM) + lane; GAS f32x4* xr = (GAS f32x4*)(F.out + (size_t)t * DM) + 2 * lane; const GAS f32x4* gr = (const GAS f32x4*)F.kin[21] + 2 * lane;
    v4u w[8]; float s = 0.f;
#pragma unroll
    for (int j = 0; j < 8; ++j) { w[j] = NTLD(hr + 64 * j);
        const float a0 = bflo(w[j].x), a1 = bfhi(w[j].x), a2 = bflo(w[j].y), a3 = bfhi(w[j].y), a4 = bflo(w[j].z), a5 = bfhi(w[j].z), a6 = bflo(w[j].w), a7 = bfhi(w[j].w);
        s += ((a0 * a0 + a1 * a1) + (a2 * a2 + a3 * a3)) + ((a4 * a4 + a5 * a5) + (a6 * a6 + a7 * a7)); }
    const float r = 1.0f / sqrtf(wave_sum(s) * (1.0f / 4096.0f) + RMS_EPS);
#pragma unroll
    for (int j = 0; j < 8; ++j) { const f32x4 g0 = gr[128 * j], g1 = gr[128 * j + 1];
        xr[128 * j] = (f32x4){bflo(w[j].x) * r * g0.x, bfhi(w[j].x) * r * g0.y, bflo(w[j].y) * r * g0.z, bfhi(w[j].y) * r * g0.w};
        xr[128 * j + 1] = (f32x4){bflo(w[j].z) * r * g1.x, bfhi(w[j].z) * r * g1.y, bflo(w[j].w) * r * g1.z, bfhi(w[j].w) * r * g1.w}; }
}

__device__ __forceinline__ void quant_row(Frame& F, int t, int lane) {
    unsigned* amax = (unsigned*)(F.ws + WS_CTL + CTL_AMAX);
    const GAS v4u* hr = (const GAS v4u*)((const bf16*)(F.ws + WS_XN) + (size_t)t * DM) + lane; GAS v2u* qr = (GAS v2u*)((signed char*)(F.ws + WS_H2Q) + (size_t)t * DM) + lane;
    v4u w[8]; unsigned mb = 0u;
#pragma unroll
    for (int j = 0; j < 8; ++j) { w[j] = hr[64 * j];
        const unsigned a0 = w[j].x & 0x7fff7fffu, a1 = w[j].y & 0x7fff7fffu, a2 = w[j].z & 0x7fff7fffu, a3 = w[j].w & 0x7fff7fffu;
        mb = max(mb, max(max(a0 & 0xffffu, a0 >> 16), max(a1 & 0xffffu, a1 >> 16))); mb = max(mb, max(max(a2 & 0xffffu, a2 >> 16), max(a3 & 0xffffu, a3 >> 16))); }
    mb = wave_maxu(mb);
    const float am = __uint_as_float(mb << 16); const float inv = am > 0.f ? 127.0f / am : 0.f;
    float s2 = 0.f;
#pragma unroll
    for (int j = 0; j < 8; ++j) { const float a0 = bflo(w[j].x), a1 = bfhi(w[j].x), a2 = bflo(w[j].y), a3 = bfhi(w[j].y), a4 = bflo(w[j].z), a5 = bfhi(w[j].z), a6 = bflo(w[j].w), a7 = bfhi(w[j].w);
        s2 += ((a0 * a0 + a1 * a1) + (a2 * a2 + a3 * a3)) + ((a4 * a4 + a5 * a5) + (a6 * a6 + a7 * a7)); }
    s2 = wave_sum(s2);
    if (lane == 0) { amax[t] = __float_as_uint(am); ((unsigned long long*)(F.ws + WS_CTL + CTL_SS))[(size_t)M + t] = (unsigned long long)(s2 * 1048576.0f + 0.5f); }
#pragma unroll
    for (int j = 0; j < 8; ++j) {
        qr[64 * j] = (v2u){q8x4(bflo(w[j].x), bfhi(w[j].x), bflo(w[j].y), bfhi(w[j].y), inv), q8x4(bflo(w[j].z), bfhi(w[j].z), bflo(w[j].w), bfhi(w[j].w), inv)}; }
}
typedef att::BlockRef<att::bf16, att::bf16> ABlk;
__device__ __forceinline__ ABlk dil_item(unsigned char* ws, int L) {
    const int bh = L / 48, rem = L - 48 * bh, cfg = rem >> 4, x = rem & 15, h = bh & 15, b = bh >> 4;
    const int d = cfg == 0 ? 1 : (cfg == 1 ? 4 : 16);
    const int r = cfg == 0 ? 0 : (cfg == 1 ? (x >> 2) : x), qb = cfg == 0 ? x : (cfg == 1 ? (x & 3) : 0);
    const att::bf16* DQ = (const att::bf16*)(ws + WS_DQKV); const att::bf16* DK = DQ + (size_t)M * 2048; const att::bf16* DV = DK + (size_t)M * 2048;
    const int sq = r + d * 256 * qb, tq = b * SEQ + sq; const size_t hb = (size_t)(b * 16 + h) * SEQ;
    ABlk R;
    R.Q = DQ + (hb + sq) * 128; R.K = DK + (hb + r) * 128; R.V = DV + (hb + r) * 128;
    R.O = (att::bf16*)(ws + WS_OC) + ((size_t)cfg * M * 2048) + (hb + sq) * 128;
    R.L = (float*)(ws + WS_LSE) + (((size_t)cfg * M + tq) * 16 + h) * 2;
    R.bsrc = (const float*)(ws + WS_BT) + (cfg * 16 + h) * 132;
    R.P0 = 256 * qb; R.pq = 128 * d; R.pk = 128 * d; R.po = 128 * d; R.pl = 32 * d; R.skv = SEQ / d; R.W = 129;
    return R;
}
__device__ __forceinline__ ABlk xat_item(unsigned char* ws, int L) {
    const int qb = L & 15, h = (L >> 4) & 3, b = L >> 6;
    const att::bf16* XQ = (const att::bf16*)(ws + WS_XQ); const att::bf16* XKV = (const att::bf16*)(ws + WS_XKV);
    ABlk R;
    R.Q = XQ + (size_t)(b * SEQ + 256 * qb) * XW + h * 128; R.K = XKV + (size_t)(b * MEMLEN) * 1024 + h * 128; R.V = R.K + 512;
    R.O = (att::bf16*)(ws + WS_XO) + (size_t)(b * SEQ + 256 * qb) * XW + h * 128; R.L = nullptr; R.bsrc = nullptr;
    R.P0 = 1 << 20; R.pq = XW; R.pk = 1024; R.po = XW; R.pl = 0; R.skv = MEMLEN; R.W = 1 << 30;
    return R;
}

#ifndef PG_ALIGN
#define PG_ALIGN true
#endif
#ifndef PG_SP2
#define PG_SP2 true
#endif
struct Args { const float* in[22]; float* out; unsigned char* ws; int ph_lo, ph_hi; };
__global__ void __launch_bounds__(NWAVES * 64, 2) hybrid_fwd(Args args) {
    extern __shared__ __attribute__((aligned(16))) unsigned char lds[];
    Frame F;
    F.lds = (LAS unsigned char*)lds; F.ldsg = (char*)lds;
    F.MISC = (volatile LAS unsigned*)(F.lds + MISC_OFF);
    F.wave = __builtin_amdgcn_readfirstlane((int)threadIdx.x >> 6);
    F.G = gridDim.x; { const int bx = blockIdx.x; F.vcu = (F.G % 8 == 0) ? (bx % 8) * (F.G / 8) + bx / 8 : bx; }
    F.ws = args.ws; F.ctl = (gu32*)(args.ws + WS_CTL); F.out = args.out;
    F.kin = (const float* const __attribute__((address_space(4)))*)__builtin_amdgcn_kernarg_segment_ptr();
    if (threadIdx.x < 64) F.MISC[threadIdx.x] = 0u;
    __syncthreads();
    XcdBarrier bar; bar.bar = (unsigned*)(F.ctl + CW_BAR); bar.x = 0; bar.st = nullptr;
    if (N_LAUNCHES == 1) bar = xcd_barrier_post((unsigned*)(F.ctl + CW_BAR), F.MISC + 8);
#define GRID_BAR() do { if (N_LAUNCHES == 1) xcd_barrier(bar); } while (0)
    const int lo = args.ph_lo, hi = args.ph_hi;
#ifndef PH_MASK
#define PH_MASK 0x1fff
#endif
#define IN(k) ((((PH_MASK) >> (k)) & 1) && lo <= (k) && (k) < hi)
#define BOTH(k) (IN(k) && IN((k) + 1))
#ifndef DUPMASK
#define DUPMASK 0
#endif
#ifndef XBAR
#define XBAR 0
#endif
#define DUPK(k, ...) { __VA_ARGS__ } if constexpr ((((DUPMASK) >> (k)) & 1) != 0) { __syncthreads(); { __VA_ARGS__ } }
#define GRID_BARX() do { GRID_BAR(); if constexpr (XBAR != 0) GRID_BAR(); } while (0)
    unsigned long long* SS1 = (unsigned long long*)(F.ws + WS_CTL + CTL_SS); unsigned long long* SS2 = SS1 + M; unsigned long long* SS3 = SS2 + M;
    const int gw = F.vcu * NWAVES + F.wave, NGW = F.G * NWAVES;

    if (IN(0)) { DUPK(0, p0_first_token(F); p0_prologue(F);) GRID_BAR(); p0_quant_win(F);
#ifdef DUP_P0FT
        __syncthreads(); p0_first_token(F); __syncthreads(); p0_first_token(F); __syncthreads(); p0_first_token(F); __syncthreads(); p0_first_token(F);
#endif
        if (BOTH(0)) GRID_BARX(); }
    if (IN(1)) {
        { pg8::Gemm g{(const bf16*)(F.ws + WS_XN), (const bf16*)(F.ws + WS_WIN), M, NB1, DM}; pg8::StaticOrder S; S.init(M, NB1, F.G, (int)blockIdx.x);
          pg8::EpiProj E{(bf16*)(F.ws + WS_GQ), (bf16*)(F.ws + WS_GK), (bf16*)(F.ws + WS_GV), (bf16*)(F.ws + WS_GR), (bf16*)(F.ws + WS_DQKV), GV_I8 ? 0 : 2048};
          pg8::gemm_phase<pg8::EpiProj, pg8::StaticOrder, PG_ALIGN, PG_SP2>(F.lds, g, S, E);
          { pg8::Gemm gq{(const bf16*)(F.ws + WS_XNQ), (const bf16*)(F.ws + WS_WINQ), M, NQ1, DM / 2}; pg8::StaticOrder Sq; Sq.init(M, NQ1, F.G, (int)blockIdx.x);
            pg8::EpiProjQ Eq{(bf16*)(F.ws + WS_DQKV), (const float*)(F.ws + WS_RSC1), (const unsigned*)(F.ws + WS_CTL + CTL_CMAX1), (bf16*)(F.ws + WS_GV), GV_I8 ? 2048 : 0};
            pg8::gemm_phase<pg8::EpiProjQ, pg8::StaticOrder, PG_ALIGN, PG_SP2>(F.lds, gq, Sq, Eq); }
#ifdef DUP_P1NULL
          { pg8::EpiNull E0{}; pg8::Gemm g2{(const bf16*)(F.ws + WS_XN), (const bf16*)(F.ws + WS_WIN), M, 3072, DM}; pg8::StaticOrder S2; S2.init(M, 3072, F.G, (int)blockIdx.x); pg8::gemm_phase<pg8::EpiNull, pg8::StaticOrder, PG_ALIGN, PG_SP2>(F.lds, g2, S2, E0); pg8::gemm_phase<pg8::EpiNull, pg8::StaticOrder, PG_ALIGN, PG_SP2>(F.lds, g2, S2, E0); pg8::gemm_phase<pg8::EpiNull, pg8::StaticOrder, PG_ALIGN, PG_SP2>(F.lds, g2, S2, E0); pg8::gemm_phase<pg8::EpiNull, pg8::StaticOrder, PG_ALIGN, PG_SP2>(F.lds, g2, S2, E0); }
#endif
          }
        if (BOTH(1)) GRID_BARX();
    }
    if (IN(2)) { DUPK(2, for (int u = blockIdx.x; u < NB * 64; u += F.G) gla_prep_unit(F, u >> 6, u & 63);) if (BOTH(2)) GRID_BARX(); }
    if (IN(3)) {
#ifdef PRE_ATT_VARIANT
        {
            gu32* qctr = F.ctl + CW_QUEUE + 64;
#define NEXT_ITEM(dst) do { if (tid_now() == 0) F.MISC[16] = __hip_atomic_fetch_add(qctr, 1u, RLX_AGENT); __syncthreads(); dst = __builtin_amdgcn_readfirstlane((int)F.MISC[16]); __syncthreads(); } while (0)
            int L; NEXT_ITEM(L);
            if (L < 3072) {
                ABlk cur = dil_item(F.ws, L); att::Seam<att::bf16> S; int par = 0;
                att::causal_swa_prime<PRE_ATT_VARIANT, att::bf16, att::bf16>(cur, F.ldsg, S);
                unsigned char* const wsp = F.ws; auto itf = [wsp](int l) { return dil_item(wsp, l); };
                for (;;) { int Ln; NEXT_ITEM(Ln); const bool last = Ln >= 3072; const int Lx = last ? L : Ln;
                    att::causal_swa_block<PRE_ATT_VARIANT, att::bf16, att::bf16>(cur, Lx, itf, par, F.ldsg, S);
                    if (last) break; L = Ln; cur = dil_item(F.ws, L); par ^= 1; }
            }
#undef NEXT_ITEM
            __syncthreads();
        }
#endif
        if ((int)blockIdx.x < 64) gla_chain_unit(F, blockIdx.x >> 4, (blockIdx.x >> 2) & 3, blockIdx.x & 3);
        {
            gu32* qctr = F.ctl + CW_QUEUE;
#define NEXT_ITEM(dst) do { if (tid_now() == 0) F.MISC[16] = __hip_atomic_fetch_add(qctr, 1u, RLX_AGENT); __syncthreads(); dst = __builtin_amdgcn_readfirstlane((int)F.MISC[16]); __syncthreads(); } while (0)
            int L; NEXT_ITEM(L);
            if (L < 3072) {
                ABlk cur = dil_item(F.ws, L); att::Seam<att::bf16> S; int par = 0;
                att::causal_swa_prime<1, att::bf16, att::bf16>(cur, F.ldsg, S);
                unsigned char* const wsp = F.ws; auto itf = [wsp](int l) { return dil_item(wsp, l); };
                for (;;) { int Ln; NEXT_ITEM(Ln); const bool last = Ln >= 3072; const int Lx = last ? L : Ln;
                    att::causal_swa_block<1, att::bf16, att::bf16>(cur, Lx, itf, par, F.ldsg, S);
                    if (last) break; L = Ln; cur = dil_item(F.ws, L); par ^= 1; }
            }
#undef NEXT_ITEM
        }
#ifdef DUP_CHAIN
        __syncthreads(); if ((int)blockIdx.x < 64) gla_chain_unit(F, blockIdx.x >> 4, (blockIdx.x >> 2) & 3, blockIdx.x & 3);
#endif
        if (BOTH(3)) GRID_BARX();
    }
    if (IN(4)) {
        { const int lane = tid_now() & 63; for (int t = gw; t < M; t += NGW) mix_row(F, t, lane); }
        ffn_weights<0>(F, 2 * FW_IG, FW_P9_LO, gw, NGW);
        if constexpr (FFN_I8) { ffn_weights<1>(F, 0, 2 * FW_IG, gw, NGW); GRID_BAR(); }
        ffn_weights<0>(F, 0, FW_P6_LO, gw, NGW);
        if (BOTH(4)) GRID_BARX(); }
    if (IN(5)) {
        pg8::Gemm g{(const bf16*)(F.ws + WS_MIX), (const bf16*)(F.ws + WS_WOUT), M, DM, DM}; pg8::StaticOrder S; S.init(M, DM, F.G, (int)blockIdx.x);
        pg8::EpiResid E{F.kin[0], nullptr, (bf16*)(F.ws + WS_XN), SS1, DM, nullptr};
        pg8::gemm_phase<pg8::EpiResid, pg8::StaticOrder, PG_ALIGN, PG_SP2>(F.lds, g, S, E);
#ifdef DUP_P5
        { pg8::EpiResid E2{F.kin[0], nullptr, (bf16*)(F.ws + WS_XN), nullptr, DM, nullptr}; pg8::gemm_phase<pg8::EpiResid, pg8::StaticOrder, PG_ALIGN, PG_SP2>(F.lds, g, S, E2); }
#endif
        if (BOTH(5)) GRID_BARX();
    }
    if (IN(6)) {
        DUPK(6,
        if ((int)blockIdx.x < 128 || F.G < 144) {
        pg8::Gemm g{(const bf16*)(F.ws + WS_XN), (const bf16*)(F.ws + WS_WXQ), M, XW, DM}; pg8::StaticOrder S; S.init(M, XW, F.G < 144 ? F.G : 128, (int)blockIdx.x);
        pg8::EpiScaleBf16 E{(bf16*)(F.ws + WS_XQ), XW, SS1, 1.0f / 4096.0f};
        pg8::gemm_phase<pg8::EpiScaleBf16, pg8::StaticOrder, PG_ALIGN, PG_SP2>(F.lds, g, S, E);
        }
        if ((int)blockIdx.x >= 128 || F.G < 144) {
        pg8::Gemm g{(const bf16*)(F.ws + WS_MEMN), (const bf16*)(F.ws + WS_WXKV), MROWS, 1024, DM}; pg8::StaticOrder S; S.init(MROWS, 1024, F.G < 144 ? F.G : F.G - 128, F.G < 144 ? (int)blockIdx.x : (int)blockIdx.x - 128);
        pg8::EpiScaleBf16 E{(bf16*)(F.ws + WS_XKV), 1024, nullptr, 0.f};
        pg8::gemm_phase<pg8::EpiScaleBf16, pg8::StaticOrder, PG_ALIGN, PG_SP2>(F.lds, g, S, E);
        }
        if (F.G >= 256) { if ((int)blockIdx.x >= 144) ffn_weights<0>(F, FW_P6_LO, FW_P6_HI, ((int)blockIdx.x - 144) * NWAVES + F.wave, (F.G - 144) * NWAVES); }
        else ffn_weights<0>(F, FW_P6_LO, FW_P6_HI, gw, NGW);
        )
        if (BOTH(6)) GRID_BARX();
    }
    if (IN(7)) {
        DUPK(7,
        if ((int)blockIdx.x < 256) {
            int L = blockIdx.x; ABlk cur = xat_item(F.ws, L); att::Seam<att::bf16> S; int par = 0;
            att::causal_swa_prime<0, att::bf16, att::bf16>(cur, F.ldsg, S);
            unsigned char* const wsp = F.ws; auto itf = [wsp](int l) { return xat_item(wsp, l); };
            for (;;) { const int Ln = L + F.G; const bool last = Ln >= 256; const int Lx = last ? L : Ln;
                att::causal_swa_block<0, att::bf16, att::bf16>(cur, Lx, itf, par, F.ldsg, S);
                if (last) break; L = Ln; cur = xat_item(F.ws, L); par ^= 1; }
        }
        )
        if (BOTH(7)) GRID_BARX();
    }
    if (IN(8)) {
        pg8::Gemm g{(const bf16*)(F.ws + WS_XO), (const bf16*)(F.ws + WS_WXO), M, DM, XW}; pg8::StaticOrder S; S.init(M, DM, F.G, (int)blockIdx.x);
        pg8::EpiResid E{nullptr, (const bf16*)(F.ws + WS_XN), (bf16*)(F.ws + WS_XN), FFN_I8 ? nullptr : SS2, DM, nullptr};
        pg8::gemm_phase<pg8::EpiResid, pg8::StaticOrder, PG_ALIGN, PG_SP2>(F.lds, g, S, E);
        if constexpr (FFN_I8) { GRID_BAR(); const int lane = tid_now() & 63; for (int t = gw; t < M; t += NGW) quant_row(F, t, lane); }
        if (BOTH(8)) GRID_BARX();
    }
    if (IN(9)) {
        DUPK(9,
        typedef pg8::EpiGateUpT<FFN_I8 != 0> EpiGU;
        pg8::Gemm g{(const bf16*)(F.ws + (FFN_I8 ? WS_H2Q : WS_XN)), (const bf16*)(F.ws + WS_WGU), M, NGU, FFN_I8 ? DM / 2 : DM};
        const int G9 = (F.G == 256 && P9_GEMM_WGS > 0) ? P9_GEMM_WGS : F.G;
        pg8::StaticOrder S; S.init(M, NGU, G9, (int)blockIdx.x);
        float* GF = (float*)(F.ws + WS_HALO);
        EpiGU E{(bf16*)(F.ws + WS_ACT), DFF, SS2, 1.0f / 4096.0f, F.kin[18], F.kin[19], GF, GF + HALO_ONE / 4, GF + 2 * (HALO_ONE / 4), DFF, (LAS float*)(F.lds + 131072),
                (const unsigned*)(F.ws + WS_CTL + CTL_COLMAX), (const unsigned*)(F.ws + WS_CTL + CTL_AMAX)};
        if ((int)blockIdx.x < G9) pg8::gemm_phase<EpiGU, pg8::StaticOrder, PG_ALIGN, PG_SP2>(F.lds, g, S, E);
        if (G9 < F.G) { if ((int)blockIdx.x >= G9) ffn_weights<0>(F, FW_P9_LO, FW_P9_HI, ((int)blockIdx.x - G9) * NWAVES + F.wave, (F.G - G9) * NWAVES); }
        else if (F.G == 256) { if ((int)blockIdx.x >= 128) ffn_weights<0>(F, FW_P9_LO, FW_P9_HI, ((int)blockIdx.x - 128) * NWAVES + F.wave, 128 * NWAVES); }
        else ffn_weights<0>(F, FW_P9_LO, FW_P9_HI, gw, NGW);
        )
        if (BOTH(9)) GRID_BARX();
    }
    if (IN(10)) { DUPK(10, halo_fix(F);) if (BOTH(10)) GRID_BARX(); }
    if (IN(11)) {
        pg8::Gemm g{(const bf16*)(F.ws + WS_ACT), (const bf16*)(F.ws + WS_WDN), M, DM, DFF}; pg8::StaticOrder S; S.init(M, DM, F.G, (int)blockIdx.x);
        pg8::EpiResid E{nullptr, (const bf16*)(F.ws + WS_XN), (bf16*)(F.ws + WS_XN), nullptr, DM, nullptr};
        pg8::gemm_phase<pg8::EpiResid, pg8::StaticOrder, PG_ALIGN, PG_SP2>(F.lds, g, S, E);
        if (BOTH(11)) GRID_BARX();
    }
    if (IN(12)) { DUPK(12, const int lane = tid_now() & 63; for (int t = gw; t < M; t += NGW) final_norm_row(F, t, lane);)
    }
#undef IN
#undef BOTH
#undef GRID_BAR
}

extern "C" void kernel_launch(void* const* d_in, const int* in_sizes, int n_in, void* d_out, int out_size, void* d_ws, size_t ws_size, hipStream_t stream) {
    static int grid = 0;
    if (grid == 0) {
        if (n_in != 22 || in_sizes[0] != M * DM || out_size != M * DM || ws_size < WS_END) { fprintf(stderr, "kernel_launch: unexpected shapes (n_in %d, in0 %d, out %d, ws %zu)\n", n_in, n_in > 0 ? in_sizes[0] : -1, out_size, ws_size); grid = -1; return; }
        int dev = 0, cus = 0, per_cu = 0;
        if (hipGetDevice(&dev) != hipSuccess || hipDeviceGetAttribute(&cus, hipDeviceAttributeMultiprocessorCount, dev) != hipSuccess) { grid = -1; return; }
        if (hipFuncSetAttribute((const void*)hybrid_fwd, hipFuncAttributeMaxDynamicSharedMemorySize, LDS_BYTES) != hipSuccess) { fprintf(stderr, "kernel_launch: hipFuncSetAttribute failed\n"); grid = -1; return; }
        if (hipOccupancyMaxActiveBlocksPerMultiprocessor(&per_cu, (const void*)hybrid_fwd, NWAVES * 64, LDS_BYTES) != hipSuccess || per_cu < 1) fprintf(stderr, "kernel_launch: occupancy query reports %d\n", per_cu);
        (void)hipGetLastError();
        grid = cus;
    }
    if (grid < 0) return;
    if (hipMemsetAsync((char*)d_ws + WS_CTL, 0, CTL_ZERO_BYTES, stream) != hipSuccess) return;
    Args a{};
    for (int i = 0; i < 22; ++i) a.in[i] = (const float*)d_in[i];
    a.out = (float*)d_out; a.ws = (unsigned char*)d_ws;
    for (int li = 0; li < N_LAUNCHES; ++li) {
        a.ph_lo = (N_LAUNCHES == 1) ? 0 : li; a.ph_hi = (N_LAUNCHES == 1) ? NPH : li + 1;
        hipLaunchKernelGGL(hybrid_fwd, dim3(grid), dim3(NWAVES * 64), LDS_BYTES, stream, a);
    }
}
```

```cpp
#include <hip/hip_runtime.h>
#include <hip/hip_bf16.h>
#include <cstdio>
#include <cstdint>
#include <cmath>
#include <type_traits>
#ifndef MK_N_LAUNCHES
#define MK_N_LAUNCHES 1
#endif
namespace pg8 {
#define PG8_LAS __attribute__((address_space(3)))
typedef unsigned short bf16_t;
typedef short bf16x8 __attribute__((ext_vector_type(8)));
typedef float f32x4 __attribute__((ext_vector_type(4)));
typedef unsigned u32x4 __attribute__((ext_vector_type(4)));
constexpr int BM = 256, BK = 64, HALF = 128, HTB = HALF * BK * 2  , STAGE_BYTES = 8 * HTB, NXCD = 8, WGM = 8;

__host__ __device__ __forceinline__ int lds_byte(int r, int c) { const int st = (r >> 4) * 2 + (c >> 5), rr = r & 15, cc = c & 31, ob = rr * 64 + cc * 2; return st * 1024 + (ob ^ (((ob >> 9) & 1) << 5)); }
__host__ __device__ __forceinline__ void stage_rc(int b, int& R, int& C) { const int st = b / 1024, sb = b % 1024, swz = sb ^ (((sb >> 9) & 1) << 5); R = (st >> 1) * 16 + swz / 64; C = (st & 1) * 32 + (swz % 64) / 2; }
__host__ __device__ __forceinline__ int perm32(int rho) { const int n = rho >> 4, i = rho & 15; return 8 * (i >> 2) + 4 * n + (i & 3); }

struct Unit { int pm, pn; };
struct Gemm { const bf16_t* A; const bf16_t* Bt; int M, N, K; };

struct StaticOrder {
    int nM, nN, nwg, G, c;
    __host__ __device__ void init(int M, int N, int G_, int c_) { nM = M / BM; nN = N / BM; nwg = nM * nN; G = G_; c = c_; }
    __host__ __device__ bool next(int i, Unit& u) const {
        const long L = (long)i * G + c; if (L >= nwg) return false;
        int wgid = (int)L; { const int q = nwg / NXCD, r = nwg % NXCD, xcd = wgid % NXCD, off = wgid / NXCD; wgid = (xcd < r ? xcd * (q + 1) : r * (q + 1) + (xcd - r) * q) + off; }
        const int nig = WGM * nN, gid = wgid / nig, fm = gid * WGM, gsz = (nM - fm) < WGM ? (nM - fm) : WGM;
        u.pm = fm + ((wgid % nig) % gsz); u.pn = (wgid % nig) / gsz; return true;
    }
    __device__ __forceinline__ void a_ready(const Unit&) const {}
    __device__ __forceinline__ void done(const Unit&) const {}
};

__device__ __forceinline__ unsigned cvt_pk_bf16(float lo, float hi) { unsigned r; asm volatile("v_cvt_pk_bf16_f32 %0, %1, %2" : "=v"(r) : "v"(lo), "v"(hi)); return r; }
typedef float f32x2 __attribute__((ext_vector_type(2)));
typedef unsigned u32x2 __attribute__((ext_vector_type(2)));
typedef int i32x4 __attribute__((ext_vector_type(4)));
typedef __bf16 bf16x2v __attribute__((ext_vector_type(2)));
__device__ __forceinline__ unsigned cvtpk_e(float lo, float hi) { f32x2 v = {lo, hi}; bf16x2v b = __builtin_convertvector(v, bf16x2v); return __builtin_bit_cast(unsigned, b); }
constexpr float RMS_EPS = 1e-6f;
constexpr float SS_SCALE = 1048576.0f;
__device__ __forceinline__ float rstd_of(const unsigned long long* ss, int row, float inv_n) { return 1.0f / sqrtf((float)ss[row] * (inv_n / SS_SCALE) + RMS_EPS); }

struct Seg { bf16_t* base; int ld; int col0; int pad; };
struct EpiProj {
    static constexpr bool PERM = true, PERMA = false, AFTER_DRAIN = false, PREFETCH = false, I8 = false; typedef f32x4 AccT; static constexpr int NST = 16;
    bf16_t *gq, *gk, *gv, *gr, *dqkv;
    int nv;
    __device__ __forceinline__ void operator()(const f32x4 (&acc)[2][2][4][2], const Unit& u, int wr, int wc, int fr, int fq) const {
        const int colt = u.pn * BM; const int row0 = u.pm * BM + wr * 64 + fr;
        if (colt < 4096 + nv) {
            bf16_t* base; int ld, c0;
            if (colt < 1024) { base = gq; ld = 1024; c0 = colt; } else if (colt < 2048) { base = gk; ld = 1024; c0 = colt - 1024; }
            else if (colt < 2048 + nv) { base = gv; ld = 2048; c0 = colt - 2048; } else { base = gr; ld = 2048; c0 = colt - 2048 - nv; }
            const int col0 = c0 + wc * 32 + 8 * fq;
#pragma unroll
            for (int ai = 0; ai < 2; ++ai)
#pragma unroll
                for (int m = 0; m < 4; ++m) { bf16_t* rowp = base + (size_t)(row0 + ai * HALF + m * 16) * ld + col0;
#pragma unroll
                    for (int bj = 0; bj < 2; ++bj) { const f32x4 v0 = acc[ai][bj][m][0], v1 = acc[ai][bj][m][1];
                        u32x4 w; w.x = cvt_pk_bf16(v0[0], v0[1]); w.y = cvt_pk_bf16(v0[2], v0[3]); w.z = cvt_pk_bf16(v1[0], v1[1]); w.w = cvt_pk_bf16(v1[2], v1[3]);
                        __builtin_nontemporal_store(w, (u32x4*)(rowp + bj * HALF)); } }
        } else {
            const int c = colt - 4096 - nv, ten = c >> 11, h0 = (c & 2047) >> 7;
            bf16_t* base = dqkv + (size_t)ten * ((size_t)16384 * 2048) + wc * 32 + 8 * fq;
#pragma unroll
            for (int ai = 0; ai < 2; ++ai)
#pragma unroll
                for (int m = 0; m < 4; ++m) { const int row = row0 + ai * HALF + m * 16, b = row >> 12, sq = row & 4095;
#pragma unroll
                    for (int bj = 0; bj < 2; ++bj) { const f32x4 v0 = acc[ai][bj][m][0], v1 = acc[ai][bj][m][1];
                        u32x4 w; w.x = cvt_pk_bf16(v0[0], v0[1]); w.y = cvt_pk_bf16(v0[2], v0[3]); w.z = cvt_pk_bf16(v1[0], v1[1]); w.w = cvt_pk_bf16(v1[2], v1[3]);
                        __builtin_nontemporal_store(w, (u32x4*)(base + ((size_t)((b * 16 + h0 + bj) * 4096 + sq)) * 128)); } }
        }
    }
};
struct EpiProjQ {
    static constexpr bool PERM = true, PERMA = false, AFTER_DRAIN = false, PREFETCH = false, I8 = true; typedef i32x4 AccT; static constexpr int NST = 16;
    bf16_t* dqkv; const float* rsc; const unsigned* cmax; bf16_t* gv; int nv;
    __device__ __forceinline__ void operator()(const i32x4 (&acc)[2][2][4][2], const Unit& u, int wr, int wc, int fr, int fq) const {
        const int c = u.pn * BM, cd = c - nv, ten = cd >> 11, h0 = (cd & 2047) >> 7; const int row0 = u.pm * BM + wr * 64 + fr;
        const bool isv = c < nv;
        bf16_t* base = isv ? gv + c + wc * 32 + 8 * fq : dqkv + (size_t)ten * ((size_t)16384 * 2048) + wc * 32 + 8 * fq;
        float cs[2][8];
#pragma unroll
        for (int bj = 0; bj < 2; ++bj) { const u32x4 m0 = *(const u32x4*)(cmax + c + bj * HALF + wc * 32 + 8 * fq), m1 = *(const u32x4*)(cmax + c + bj * HALF + wc * 32 + 8 * fq + 4);
            cs[bj][0] = __uint_as_float(m0.x) * (1.0f / 127.0f); cs[bj][1] = __uint_as_float(m0.y) * (1.0f / 127.0f); cs[bj][2] = __uint_as_float(m0.z) * (1.0f / 127.0f); cs[bj][3] = __uint_as_float(m0.w) * (1.0f / 127.0f);
            cs[bj][4] = __uint_as_float(m1.x) * (1.0f / 127.0f); cs[bj][5] = __uint_as_float(m1.y) * (1.0f / 127.0f); cs[bj][6] = __uint_as_float(m1.z) * (1.0f / 127.0f); cs[bj][7] = __uint_as_float(m1.w) * (1.0f / 127.0f); }
#pragma unroll
        for (int ai = 0; ai < 2; ++ai)
#pragma unroll
            for (int m = 0; m < 4; ++m) { const int row = row0 + ai * HALF + m * 16, b = row >> 12, sq = row & 4095; const float rs = rsc[row];
#pragma unroll
                for (int bj = 0; bj < 2; ++bj) { const i32x4 a0 = acc[ai][bj][m][0], a1 = acc[ai][bj][m][1];
                    u32x4 w; w.x = cvt_pk_bf16((float)a0[0] * (rs * cs[bj][0]), (float)a0[1] * (rs * cs[bj][1])); w.y = cvt_pk_bf16((float)a0[2] * (rs * cs[bj][2]), (float)a0[3] * (rs * cs[bj][3]));
                    w.z = cvt_pk_bf16((float)a1[0] * (rs * cs[bj][4]), (float)a1[1] * (rs * cs[bj][5])); w.w = cvt_pk_bf16((float)a1[2] * (rs * cs[bj][6]), (float)a1[3] * (rs * cs[bj][7]));
                    __builtin_nontemporal_store(w, (u32x4*)(isv ? base + (size_t)row * 2048 + bj * HALF : base + ((size_t)((b * 16 + h0 + bj) * 4096 + sq)) * 128)); } }
    }
};
struct EpiScaleBf16 {
    static constexpr bool PERM = true, PERMA = false, AFTER_DRAIN = false, PREFETCH = false, I8 = false; typedef f32x4 AccT; static constexpr int NST = 16;
    bf16_t* O; int ldc; const unsigned long long* ss; float inv_n;
    __device__ __forceinline__ void operator()(const f32x4 (&acc)[2][2][4][2], const Unit& u, int wr, int wc, int fr, int fq) const {
        const int row0 = u.pm * BM + wr * 64 + fr, col0 = u.pn * BM + wc * 32 + 8 * fq;
#pragma unroll
        for (int ai = 0; ai < 2; ++ai)
#pragma unroll
            for (int m = 0; m < 4; ++m) { const int row = row0 + ai * HALF + m * 16; const float rs = ss ? rstd_of(ss, row, inv_n) : 1.0f; bf16_t* rowp = O + (size_t)row * ldc + col0;
#pragma unroll
                for (int bj = 0; bj < 2; ++bj) { const f32x4 v0 = acc[ai][bj][m][0] * rs, v1 = acc[ai][bj][m][1] * rs;
                    u32x4 w; w.x = cvt_pk_bf16(v0[0], v0[1]); w.y = cvt_pk_bf16(v0[2], v0[3]); w.z = cvt_pk_bf16(v1[0], v1[1]); w.w = cvt_pk_bf16(v1[2], v1[3]);
                    *(u32x4*)(rowp + bj * HALF) = w; } }
    }
};
struct EpiResid {
    static constexpr bool PERM = true, PERMA = false, AFTER_DRAIN = false, PREFETCH = false, I8 = false; typedef f32x4 AccT; static constexpr int NST = 32;
    const float* base32; const bf16_t* base16; bf16_t* hb; unsigned long long* ss; int ldc; unsigned* amax;
    __device__ __forceinline__ void operator()(const f32x4 (&acc)[2][2][4][2], const Unit& u, int wr, int wc, int fr, int fq) const {
        const int row0 = u.pm * BM + wr * 64 + fr, col0 = u.pn * BM + wc * 32 + 8 * fq;
        f32x4 bc[2][2], bn[2][2]; u32x4 hc[2], hn[2];
#define EPR_LOAD(d32, d16, g) do { const size_t o_ = (size_t)(row0 + ((g) >> 2) * HALF + ((g) & 3) * 16) * ldc + col0; \
        if (base32) { d32[0][0] = __builtin_nontemporal_load((const f32x4*)(base32 + o_)); d32[0][1] = __builtin_nontemporal_load((const f32x4*)(base32 + o_ + 4)); d32[1][0] = __builtin_nontemporal_load((const f32x4*)(base32 + o_ + HALF)); d32[1][1] = __builtin_nontemporal_load((const f32x4*)(base32 + o_ + HALF + 4)); } \
        else { d16[0] = *(const u32x4*)(base16 + o_); d16[1] = *(const u32x4*)(base16 + o_ + HALF); } } while (0)
        EPR_LOAD(bc, hc, 0);
#pragma unroll
        for (int g = 0; g < 8; ++g) {
            const int ai = g >> 2, m = g & 3; const int row = row0 + ai * HALF + m * 16; const size_t off = (size_t)row * ldc + col0; float s = 0.f; float mx = 0.f;
            if (g < 7) EPR_LOAD(bn, hn, g + 1);
#pragma unroll
            for (int bj = 0; bj < 2; ++bj) {
                f32x4 b0, b1;
                if (base32) { b0 = bc[bj][0]; b1 = bc[bj][1]; }
                else { const u32x4 w = hc[bj]; b0 = (f32x4){__uint_as_float(w.x << 16), __uint_as_float(w.x & 0xffff0000u), __uint_as_float(w.y << 16), __uint_as_float(w.y & 0xffff0000u)};
                                              b1 = (f32x4){__uint_as_float(w.z << 16), __uint_as_float(w.z & 0xffff0000u), __uint_as_float(w.w << 16), __uint_as_float(w.w & 0xffff0000u)}; }
                const f32x4 v0 = acc[ai][bj][m][0] + b0, v1 = acc[ai][bj][m][1] + b1;
                s += (v0[0] * v0[0] + v0[1] * v0[1]) + (v0[2] * v0[2] + v0[3] * v0[3]) + (v1[0] * v1[0] + v1[1] * v1[1]) + (v1[2] * v1[2] + v1[3] * v1[3]);
                if (amax) { const f32x4 a0 = __builtin_elementwise_abs(v0), a1 = __builtin_elementwise_abs(v1); mx = fmaxf(mx, fmaxf(fmaxf(fmaxf(a0[0], a0[1]), fmaxf(a0[2], a0[3])), fmaxf(fmaxf(a1[0], a1[1]), fmaxf(a1[2], a1[3])))); }
                u32x4 w; w.x = cvt_pk_bf16(v0[0], v0[1]); w.y = cvt_pk_bf16(v0[2], v0[3]); w.z = cvt_pk_bf16(v1[0], v1[1]); w.w = cvt_pk_bf16(v1[2], v1[3]); *(u32x4*)(hb + off + bj * HALF) = w; }
            s += __shfl_xor(s, 16); s += __shfl_xor(s, 32);
            if (ss && fq == 0) atomicAdd(ss + row, (unsigned long long)(s * SS_SCALE + 0.5f));
            if (amax) { mx = fmaxf(mx, __shfl_xor(mx, 16)); mx = fmaxf(mx, __shfl_xor(mx, 32)); if (fq == 0) atomicMax(amax + row, __float_as_uint(mx)); }
#pragma unroll
            for (int bj = 0; bj < 2; ++bj) { bc[bj][0] = bn[bj][0]; bc[bj][1] = bn[bj][1]; hc[bj] = hn[bj]; }
            asm volatile("" ::: "memory");
        }
#undef EPR_LOAD
    }
};
template <bool Q> struct EpiGateUpT {
    static constexpr bool PERM = true, PERMA = true, AFTER_DRAIN = false, PREFETCH = true, I8 = Q; typedef typename std::conditional<Q, i32x4, f32x4>::type AccT; static constexpr int NST = 32;
    static constexpr int AUXN = 1024;
    static constexpr float NLOG2E = -1.4426950408889634f, NLN2 = -0.6931471805599453f;
    bf16_t* act; int ldc; const unsigned long long* ss; float inv_n; const float* cw; const float* cb; float* GF; float* UF; float* GL; int nff;
    PG8_LAS float* aux;
    const unsigned* colmax; const unsigned* amax;
    __device__ __forceinline__ float rowscale(unsigned long long s2, unsigned am) const { const float r = 1.0f / sqrtf((float)s2 * (inv_n / SS_SCALE) + RMS_EPS); return Q ? r * __uint_as_float(am) * (1.0f / 127.0f) : r; }
    __device__ __forceinline__ void prefetch(const Unit& u, int par) const {
        int tid = (int)threadIdx.x; asm volatile("" : "+v"(tid)); const int arr = tid >> 7, c = u.pn * HALF + (tid & 127);
        const float gs = Q ? __uint_as_float(colmax[c]) * (1.0f / 127.0f) : 1.0f;
        const float v = (arr < 3 ? cw[arr * nff + c] * gs : cb[c]) * NLOG2E;
        PG8_LAS float* a = aux + par * AUXN; a[tid] = v;
        if (tid < 128) a[512 + tid] = (Q ? __uint_as_float(colmax[nff + c]) * (1.0f / 127.0f) : 1.0f) * NLN2;
        if (tid < 256) { const int row = u.pm * BM + tid; a[768 + tid] = rowscale(ss[row], Q ? amax[row] : 0u); }
    }
    __device__ __forceinline__ void run(const AccT (&acc)[2][2][4][2], const Unit& u, int wr, int wc, int fr, int fq, int par, const Unit& nxt) const {
        int tid = (int)threadIdx.x; asm volatile("" : "+v"(tid)); const int arr = tid >> 7, cn = nxt.pn * HALF + (tid & 127);
        const float ncw = arr < 3 ? cw[arr * nff + cn] : cb[cn];
        const unsigned ncg = Q ? colmax[cn] : 0u, ncu = Q ? colmax[nff + cn] : 0u;
        const int nrow = nxt.pm * BM + (tid & 255);
        const unsigned long long nss = ss[nrow]; const unsigned nam = Q ? amax[nrow] : 0u;
        const PG8_LAS float* a = aux + par * AUXN;
        const int c0 = wc * 32 + 8 * fq;
        const int ch0 = u.pn * HALF + c0;
        f32x2 w0[4], w1[4], w2[4], bb[4], sl[4];
#pragma unroll
        for (int h4 = 0; h4 < 2; ++h4) { const f32x4 x0 = *(const PG8_LAS f32x4*)(a + c0 + 4 * h4), x1 = *(const PG8_LAS f32x4*)(a + 128 + c0 + 4 * h4), x2 = *(const PG8_LAS f32x4*)(a + 256 + c0 + 4 * h4), x3 = *(const PG8_LAS f32x4*)(a + 384 + c0 + 4 * h4);
            const f32x4 x4 = *(const PG8_LAS f32x4*)(a + 512 + c0 + 4 * h4);
#pragma unroll
            for (int q = 0; q < 2; ++q) { w0[2 * h4 + q] = (f32x2){x0[2 * q], x0[2 * q + 1]}; w1[2 * h4 + q] = (f32x2){x1[2 * q], x1[2 * q + 1]}; w2[2 * h4 + q] = (f32x2){x2[2 * q], x2[2 * q + 1]};
                bb[2 * h4 + q] = (f32x2){x3[2 * q], x3[2 * q + 1]}; sl[2 * h4 + q] = (f32x2){x4[2 * q], x4[2 * q + 1]}; } }
#pragma unroll
        for (int ai = 0; ai < 2; ++ai) {
            const int lrow0 = ai * HALF + wr * 64 + fr * 4;
            const int blk = (u.pm * BM + ai * HALF + wr * 64) >> 6;
            const f32x4 rs4 = *(const PG8_LAS f32x4*)(a + 768 + lrow0);
            bf16_t* arow = act + (size_t)(u.pm * BM + lrow0) * ldc + ch0;
            f32x2 g[4][4];
#pragma unroll
            for (int m = 0; m < 4; ++m)
#pragma unroll
                for (int p = 0; p < 4; ++p) g[m][p] = (f32x2){(float)acc[ai][0][m][p >> 1][2 * (p & 1)], (float)acc[ai][0][m][p >> 1][2 * (p & 1) + 1]} * rs4[m];
            f32x2 gm1[4], gm2[4];
#pragma unroll
            for (int p = 0; p < 4; ++p) {
                gm1[p] = (f32x2){__int_as_float(__builtin_amdgcn_update_dpp(0, __float_as_int(g[3][p][0]), 0x111, 0xf, 0xf, true)), __int_as_float(__builtin_amdgcn_update_dpp(0, __float_as_int(g[3][p][1]), 0x111, 0xf, 0xf, true))};
                gm2[p] = (f32x2){__int_as_float(__builtin_amdgcn_update_dpp(0, __float_as_int(g[2][p][0]), 0x111, 0xf, 0xf, true)), __int_as_float(__builtin_amdgcn_update_dpp(0, __float_as_int(g[2][p][1]), 0x111, 0xf, 0xf, true))}; }
#pragma unroll
            for (int m = 0; m < 4; ++m) {
                u32x4 w; f32x2 upv[4];
#pragma unroll
                for (int p = 0; p < 4; ++p) {
                    const f32x2 r1 = m >= 1 ? g[m >= 1 ? m - 1 : 0][p] : gm1[p], r2 = m >= 2 ? g[m >= 2 ? m - 2 : 0][p] : (m == 1 ? gm1[p] : gm2[p]);
                    const f32x2 y = bb[p] + w2[p] * g[m][p] + w1[p] * r1 + w0[p] * r2;
                    const f32x2 d = (f32x2){__builtin_amdgcn_exp2f(y[0]), __builtin_amdgcn_exp2f(y[1])} + 1.0f;
                    const f32x2 sg = {__builtin_amdgcn_rcpf(d[0]), __builtin_amdgcn_rcpf(d[1])};
                    upv[p] = (f32x2){(float)acc[ai][1][m][p >> 1][2 * (p & 1)], (float)acc[ai][1][m][p >> 1][2 * (p & 1) + 1]} * (sl[p] * rs4[m]);
                    const f32x2 av = y * sg * upv[p];
                    w[p] = cvtpk_e(av[0], av[1]);
                }
                if (m >= 2 || fr != 0) __builtin_nontemporal_store(w, (u32x4*)(arow + (size_t)m * ldc));
                if (m < 2 && fr == 0) { float* gp = GF + ((size_t)blk * 2 + m) * nff + ch0; float* upp = UF + ((size_t)blk * 2 + m) * nff + ch0;
                    *(f32x4*)gp = (f32x4){g[m][0][0], g[m][0][1], g[m][1][0], g[m][1][1]}; *(f32x4*)(gp + 4) = (f32x4){g[m][2][0], g[m][2][1], g[m][3][0], g[m][3][1]};
                    *(f32x4*)upp = (f32x4){upv[0][0], upv[0][1], upv[1][0], upv[1][1]}; *(f32x4*)(upp + 4) = (f32x4){upv[2][0], upv[2][1], upv[3][0], upv[3][1]}; }
                if (m >= 2 && fr == 15) { float* gp = GL + ((size_t)blk * 2 + (m - 2)) * nff + ch0;
                    *(f32x4*)gp = (f32x4){g[m][0][0], g[m][0][1], g[m][1][0], g[m][1][1]}; *(f32x4*)(gp + 4) = (f32x4){g[m][2][0], g[m][2][1], g[m][3][0], g[m][3][1]}; }
            }
        }
        PG8_LAS float* an = aux + (par ^ 1) * AUXN;
        an[tid] = (arr < 3 ? ncw * (Q ? __uint_as_float(ncg) * (1.0f / 127.0f) : 1.0f) : ncw) * NLOG2E;
        if (tid < 128) an[512 + tid] = (Q ? __uint_as_float(ncu) * (1.0f / 127.0f) : 1.0f) * NLN2;
        if (tid < 256) an[768 + tid] = rowscale(nss, nam);
    }
};
typedef EpiGateUpT<false> EpiGateUp;
typedef EpiGateUpT<true> EpiGateUpQ;
struct EpiNull {
    static constexpr bool PERM = true, PERMA = false, AFTER_DRAIN = false, PREFETCH = false, I8 = false; typedef f32x4 AccT; static constexpr int NST = 0;
    __device__ __forceinline__ void operator()(const f32x4 (&acc)[2][2][4][2], const Unit& u, int wr, int wc, int fr, int fq) const {
#pragma unroll
        for (int ai = 0; ai < 2; ++ai)
#pragma unroll
            for (int bj = 0; bj < 2; ++bj)
#pragma unroll
                for (int m = 0; m < 4; ++m)
#pragma unroll
                    for (int n = 0; n < 2; ++n) asm volatile("" :: "v"(acc[ai][bj][m][n]));
    }
};
template <class AccT> __device__ __forceinline__ AccT pg8_zero4() {
    typedef unsigned long long u64x2_t __attribute__((ext_vector_type(2)));
    u64x2_t z; unsigned long long lo, hi;
    asm volatile("v_mov_b64 %0, 0" : "=v"(lo)); asm volatile("v_mov_b64 %0, 0" : "=v"(hi));
    z.x = lo; z.y = hi; return __builtin_bit_cast(AccT, z);
}
template <bool I8> __device__ __forceinline__ auto pg8_mma(bf16x8 b, bf16x8 a, typename std::conditional<I8, i32x4, f32x4>::type c) {
    if constexpr (I8) return __builtin_amdgcn_mfma_i32_16x16x64_i8(__builtin_bit_cast(i32x4, b), __builtin_bit_cast(i32x4, a), c, 0, 0, 0);
    else return __builtin_amdgcn_mfma_f32_16x16x32_bf16(b, a, c, 0, 0, 0);
}
#ifndef PG_RELAXW
#define PG_RELAXW 1
#endif
template <class Epi, class Sched, bool ALIGN_EPI = false, bool SP2 = false>
__device__ __forceinline__ void gemm_phase(PG8_LAS unsigned char* lds, const Gemm g, const Sched& S, const Epi& E) {
    const int tid = threadIdx.x, wid = __builtin_amdgcn_readfirstlane(tid >> 6), lane = tid & 63, wr = wid >> 2, wc = wid & 3, fr = lane & 15, fq = lane >> 4;
    const int K = g.K, nt = K / BK;
    unsigned voffA[2], voffB[2];
#pragma unroll
    for (int i = 0; i < 2; ++i) { int R, C; stage_rc(tid * 16 + i * 8192, R, C); const int Rb = Epi::PERM ? ((R & ~31) + perm32(R & 31)) : R;
        const int Ra = Epi::PERMA ? ((R & 64) | ((R & 15) << 2) | ((R >> 4) & 3)) : R;
        voffA[i] = (unsigned)(Ra * K + C) * 2u; voffB[i] = (unsigned)(Rb * K + C) * 2u; }
    const size_t kstep = (size_t)(BK * 2);
    const size_t hstep = (size_t)HALF * K * 2;
    const size_t tstep = 2 * hstep;
    const unsigned ldsw = (unsigned)wid * 1024u;
    const int aoff = lds_byte(wr * 64 + fr, fq * 8), boff = lds_byte(wc * 32 + fr, fq * 8);
#define PG8_SA(b, h) (((b) * 2 + (h)) * HTB)
#define PG8_SB(b, h) ((4 + (b) * 2 + (h)) * HTB)
#define PG8_STAGE(bufoff, gbase, voff) do { _Pragma("unroll") for (int _i = 0; _i < 2; ++_i) \
        __builtin_amdgcn_global_load_lds((const unsigned*)((const char*)(gbase) + (voff)[_i]), (PG8_LAS unsigned*)(lds + (bufoff) + ldsw + _i * 8192), 16, 0, 0); } while (0)
#define PG8_LDA(dst, b, h) do { _Pragma("unroll") for (int m = 0; m < 4; ++m) _Pragma("unroll") for (int k = 0; k < 2; ++k) dst[m][k] = *(const PG8_LAS bf16x8*)(lds + PG8_SA(b, h) + aoff + m * 2048 + k * 1024); } while (0)
#define PG8_LDB(dst, b, h) do { _Pragma("unroll") for (int n = 0; n < 2; ++n) _Pragma("unroll") for (int k = 0; k < 2; ++k) dst[n][k] = *(const PG8_LAS bf16x8*)(lds + PG8_SB(b, h) + boff + n * 2048 + k * 1024); } while (0)
#define PG8_MMA(ai, bj, At, Bt) do { __builtin_amdgcn_s_setprio(1); _Pragma("unroll") for (int m = 0; m < 4; ++m) _Pragma("unroll") for (int n = 0; n < 2; ++n) _Pragma("unroll") for (int k = 0; k < 2; ++k) \
        acc[ai][bj][m][n] = pg8_mma<Epi::I8>(Bt[n][k], At[m][k], acc[ai][bj][m][n]); __builtin_amdgcn_s_setprio(0); } while (0)
#define PG8_WAIT_V(n) asm volatile("s_waitcnt vmcnt(" #n ")" ::: "memory")
#define PG8_WAIT_L(n) asm volatile("s_waitcnt lgkmcnt(" #n ")" ::: "memory")
#define PG8_WAIT_VR(rlx, n) asm volatile("s_waitcnt vmcnt(%1)\n\ts_cmp_lg_u32 %0, 0\n\ts_cbranch_scc1 .Lrw%=\n\ts_waitcnt vmcnt(8)\n.Lrw%=:" :: "s"(rlx), "n"(n) : "scc", "memory")
#define PG8_BAR __builtin_amdgcn_s_barrier()
#define PG8_SCHED __builtin_amdgcn_sched_barrier(0)
    Unit cur, nxt; int ui = 0;
    if (!S.next(0, cur)) return;
    typedef typename Epi::AccT AccT; AccT acc[2][2][4][2];
#pragma unroll
    for (int a = 0; a < 2; ++a)
#pragma unroll
        for (int b = 0; b < 2; ++b)
#pragma unroll
            for (int m = 0; m < 4; ++m)
#pragma unroll
                for (int n = 0; n < 2; ++n) acc[a][b][m][n] = pg8_zero4<AccT>();
    bf16x8 At[4][2], B0[2][2], B1[2][2];
    const char* cA = (const char*)g.A + (size_t)cur.pm * tstep; const char* cB = (const char*)g.Bt + (size_t)cur.pn * tstep;
    S.a_ready(cur);
    if constexpr (Epi::PREFETCH) E.prefetch(cur, 0);
    if constexpr (SP2) {
        PG8_STAGE(PG8_SB(0, 0), cB, voffB); PG8_STAGE(PG8_SB(0, 1), cB + hstep, voffB); PG8_STAGE(PG8_SA(0, 0), cA, voffA); PG8_STAGE(PG8_SA(0, 1), cA + hstep, voffA);
        if (wr == 1) PG8_BAR;
        PG8_WAIT_V(2); PG8_BAR;
        PG8_STAGE(PG8_SB(1, 0), cB + kstep, voffB); PG8_STAGE(PG8_SA(1, 0), cA + kstep, voffA); PG8_STAGE(PG8_SB(1, 1), cB + hstep + kstep, voffB);
        PG8_WAIT_V(6); PG8_BAR;
    } else {
        PG8_STAGE(PG8_SB(0, 0), cB, voffB); PG8_STAGE(PG8_SA(0, 0), cA, voffA); PG8_STAGE(PG8_SB(0, 1), cB + hstep, voffB); PG8_STAGE(PG8_SA(0, 1), cA + hstep, voffA);
        if (wr == 1) PG8_BAR;
        PG8_WAIT_V(4); PG8_BAR;
        PG8_STAGE(PG8_SB(1, 0), cB + kstep, voffB); PG8_STAGE(PG8_SA(1, 0), cA + kstep, voffA); PG8_STAGE(PG8_SB(1, 1), cB + hstep + kstep, voffB);
        PG8_WAIT_V(6); PG8_BAR;
    }
    for (;;) {
        const bool has_next = S.next(ui + 1, nxt);
        const char* nA = has_next ? (const char*)g.A + (size_t)nxt.pm * tstep : cA; const char* nB = has_next ? (const char*)g.Bt + (size_t)nxt.pn * tstep : cB;
        for (int t = 0; t < nt; t += 2) {
            const bool last = (t == nt - 2);
            const char* a1 = cA + (size_t)(t + 1) * kstep;
            const char* a2 = last ? nA : cA + (size_t)(t + 2) * kstep; const char* b2 = last ? nB : cB + (size_t)(t + 2) * kstep;
            const char* a3 = a2 + kstep; const char* b3 = b2 + kstep;
            if (last && has_next) S.a_ready(nxt);
            const int rl = __builtin_amdgcn_readfirstlane((PG_RELAXW && (t == 0) && (ui > 0)) ? 1 : 0);
            if constexpr (SP2) {
            PG8_LDB(B0, 0, 0); PG8_LDB(B1, 0, 1); PG8_SCHED; PG8_LDA(At, 0, 0); PG8_STAGE(PG8_SA(1, 1), a1 + hstep, voffA);
            PG8_WAIT_VR(rl, 8 + Epi::NST); PG8_WAIT_L(0); PG8_BAR; PG8_MMA(0, 0, At, B0); PG8_MMA(0, 1, At, B1); PG8_BAR; PG8_SCHED;
            PG8_LDA(At, 0, 1); PG8_STAGE(PG8_SB(0, 0), b2, voffB); PG8_STAGE(PG8_SB(0, 1), b2 + hstep, voffB); PG8_STAGE(PG8_SA(0, 0), a2, voffA);
            PG8_WAIT_VR(rl, 8 + Epi::NST); PG8_WAIT_L(0); PG8_BAR; PG8_MMA(1, 0, At, B0); PG8_MMA(1, 1, At, B1); PG8_BAR; PG8_SCHED;
            PG8_LDB(B0, 1, 0); PG8_LDB(B1, 1, 1); PG8_SCHED; PG8_LDA(At, 1, 0); PG8_STAGE(PG8_SA(0, 1), a2 + hstep, voffA);
            PG8_WAIT_V(8); PG8_WAIT_L(0); PG8_BAR; PG8_MMA(0, 0, At, B0); PG8_MMA(0, 1, At, B1); PG8_BAR; PG8_SCHED;
            PG8_LDA(At, 1, 1); PG8_STAGE(PG8_SB(1, 0), b3, voffB); PG8_STAGE(PG8_SB(1, 1), b3 + hstep, voffB); PG8_STAGE(PG8_SA(1, 0), a3, voffA);
            PG8_WAIT_V(8); PG8_WAIT_L(0); PG8_BAR; PG8_MMA(1, 0, At, B0); PG8_MMA(1, 1, At, B1); PG8_BAR; PG8_SCHED;
            } else {
            PG8_LDB(B0, 0, 0); PG8_SCHED; PG8_LDA(At, 0, 0); PG8_STAGE(PG8_SA(1, 1), a1 + hstep, voffA);
            PG8_WAIT_L(8); PG8_BAR; PG8_WAIT_L(0); PG8_MMA(0, 0, At, B0); PG8_BAR; PG8_SCHED;
            PG8_LDB(B1, 0, 1); PG8_STAGE(PG8_SB(0, 0), b2, voffB);
            PG8_BAR; PG8_WAIT_L(0); PG8_MMA(0, 1, At, B1); PG8_BAR;
            PG8_LDA(At, 0, 1); PG8_STAGE(PG8_SA(0, 0), a2, voffA);
            PG8_BAR; PG8_WAIT_L(0); PG8_MMA(1, 0, At, B0); PG8_BAR; PG8_SCHED;
            PG8_STAGE(PG8_SB(0, 1), b2 + hstep, voffB);
            PG8_WAIT_V(6); PG8_BAR; PG8_MMA(1, 1, At, B1); PG8_BAR;
            PG8_LDB(B0, 1, 0); PG8_SCHED; PG8_LDA(At, 1, 0); PG8_STAGE(PG8_SA(0, 1), a2 + hstep, voffA);
            PG8_WAIT_L(8); PG8_BAR; PG8_WAIT_L(0); PG8_MMA(0, 0, At, B0); PG8_BAR; PG8_SCHED;
            PG8_LDB(B1, 1, 1); PG8_STAGE(PG8_SB(1, 0), b3, voffB);
            PG8_BAR; PG8_WAIT_L(0); PG8_MMA(0, 1, At, B1); PG8_BAR;
            PG8_LDA(At, 1, 1); PG8_STAGE(PG8_SA(1, 0), a3, voffA);
            PG8_BAR; PG8_WAIT_L(0); PG8_MMA(1, 0, At, B0); PG8_BAR; PG8_SCHED;
            PG8_STAGE(PG8_SB(1, 1), b3 + hstep, voffB);
            PG8_WAIT_V(6); PG8_BAR; PG8_MMA(1, 1, At, B1); PG8_BAR;
            }
        }
        if constexpr (ALIGN_EPI) { if (wr == 0) PG8_BAR; }
        if constexpr (!Epi::AFTER_DRAIN) { if constexpr (Epi::PREFETCH) E.run(acc, cur, wr, wc, fr, fq, ui & 1, has_next ? nxt : cur); else E(acc, cur, wr, wc, fr, fq); S.done(cur); }
        if (!has_next) break;
#pragma unroll
        for (int a = 0; a < 2; ++a)
#pragma unroll
            for (int b = 0; b < 2; ++b)
#pragma unroll
                for (int m = 0; m < 4; ++m)
#pragma unroll
                    for (int n = 0; n < 2; ++n) acc[a][b][m][n] = pg8_zero4<AccT>();
        cur = nxt; cA = nA; cB = nB; ++ui;
        if constexpr (ALIGN_EPI) { if (wr == 1) PG8_BAR; }
    }
    PG8_WAIT_V(0);
    if constexpr (!ALIGN_EPI) { if (wr == 0) PG8_BAR; }
    PG8_BAR;
    if constexpr (Epi::AFTER_DRAIN) { E.fused(acc, cur, wr, wc, fr, fq, lds, wid, lane); S.done(cur); }
#undef PG8_SA
#undef PG8_SB
#undef PG8_STAGE
#undef PG8_LDA
#undef PG8_LDB
#undef PG8_MMA
#undef PG8_WAIT_V
#undef PG8_WAIT_L
#undef PG8_WAIT_VR
#undef PG8_BAR
#undef PG8_SCHED
}
}
namespace att {
constexpr int D = 128; constexpr float THR = 8.f; constexpr bool WSKIP = true;
constexpr float SCALE = 0.08838834764831845f;
constexpr int NW = 8, QBLK = 32, KVBLK = 64, QB = NW * QBLK;
constexpr int SHM_V = KVBLK * D * 2, SHM_K = KVBLK * D * 2;
constexpr int LDS_TAB = 2 * SHM_V + 2 * SHM_K + NW * 64 * 4, TAB_N = 328, TAB_OFF = 100, TAB_PITCH = 4 * TAB_N;
constexpr int LDS_BYTES = LDS_TAB + 2 * TAB_PITCH * 4;
using bf16 = __hip_bfloat16;
typedef short bf16x8 __attribute__((ext_vector_type(8)));
typedef short s16x4 __attribute__((ext_vector_type(4)));
typedef float f32x16 __attribute__((ext_vector_type(16)));
typedef float f32x4 __attribute__((ext_vector_type(4)));
typedef float f32x2 __attribute__((ext_vector_type(2)));
typedef unsigned u32x4 __attribute__((ext_vector_type(4)));
template <class A, class Bt> struct same_t { static constexpr bool v = false; };
template <class A> struct same_t<A, A> { static constexpr bool v = true; };

#define KSWZ(row, colB) ((row) * 256 + ((colB) ^ (((row) & 7) << 4)))
#define SBAR() __builtin_amdgcn_sched_barrier(0)
__device__ __forceinline__ int v_st(int k, int c) { const int kk = (k & ~0xC) | ((k & 4) << 1) | ((k & 8) >> 1); return ((kk >> 3) * 4 + (c >> 5)) * 512 + ((kk & 7) * 32 + (c & 31)) * 2; }
__device__ __forceinline__ int v_rd_base(int lane) { return ((lane & 3) << 3) | (((lane >> 2) & 3) << 6) | (((lane >> 4) & 1) << 5) | (((lane >> 5) & 1) << 8); }
constexpr int v_rd_off(int d0, int ks, int half) { return d0 * 512 + ks * 4096 + half * 2048; }
__device__ __forceinline__ int crow(int r, int hi) { return (r & 3) + 8 * (r >> 2) + 4 * hi; }
__device__ __forceinline__ unsigned cvtpk(float lo, float hi) {
    unsigned r; asm volatile("v_cvt_pk_bf16_f32 %0, %1, %2" : "=v"(r) : "v"(lo), "v"(hi)); return r;
}
__device__ __forceinline__ bf16x8 pack8(f32x4 a, f32x4 b) {
    u32x4 w = {cvtpk(a[0], a[1]), cvtpk(a[2], a[3]), cvtpk(b[0], b[1]), cvtpk(b[2], b[3])};
    return *reinterpret_cast<bf16x8*>(&w);
}
template <class T> __device__ __forceinline__ bf16x8 load8(const T* p) {
    if constexpr (same_t<T, float>::v) { return pack8(*(const f32x4*)p, *(const f32x4*)(p + 4)); }
    else { return *reinterpret_cast<const bf16x8*>(p); }
}
__device__ __forceinline__ void mask_tile(f32x16& p0, f32x16& p1, int dq, unsigned W) {
    const float NEG = -__builtin_inff();
#pragma unroll
    for (int r = 0; r < 16; ++r) {
        const int c = (r & 3) + 8 * (r >> 2);
        if ((unsigned)(dq - c) >= W) p0[r] = NEG;
        if ((unsigned)(dq - c - 32) >= W) p1[r] = NEG;
    }
}
__device__ __forceinline__ void bias_mask_tile(f32x16& p0, f32x16& p1, int dq, unsigned W, const float* tabu, bool needmask) {
    const float NEG = -__builtin_inff();
    const int sft = (4 - ((int)threadIdx.x & 3)) & 3;
    const float* t0 = tabu + (sft * (TAB_N - 1) + TAB_OFF + 128 - dq);
#pragma unroll
    for (int J = 0; J < 8; ++J) {
        const f32x4 b = *(const f32x4*)(t0 + 8 * J);
#pragma unroll
        for (int e = 0; e < 4; ++e) {
            const int r = 4 * (J & 3) + e; const int c = e + 8 * (J & 3) + (J >= 4 ? 32 : 0);
            float v = (J < 4 ? p0[r] : p1[r]) + b[e];
            if (needmask) { if ((unsigned)(dq - c) >= W) v = NEG; }
            if (J < 4) p0[r] = v; else p1[r] = v;
        }
        if ((J & 1) == 1) asm volatile("" ::: "memory");
    }
}
__device__ __forceinline__ void bias_fill(float* T, const float* bsrc, int tid) {
    asm volatile("" : "+v"(tid));
    if (tid < TAB_N) {
#pragma unroll
        for (int sf = 0; sf < 4; ++sf) { const int i = tid - TAB_OFF + sf; T[sf * TAB_N + tid] = (i >= 0 && i <= 128) ? bsrc[128 - i] : 0.f; }
    }
}
__device__ __forceinline__ void partialSM(f32x16& p0, f32x16& p1, float& m_reg, float& mn, float& alpha) {
    float pmax = p0[0]; for (int r = 1; r < 16; ++r) pmax = fmaxf(pmax, p0[r]); for (int r = 0; r < 16; ++r) pmax = fmaxf(pmax, p1[r]);
    { auto rr = __builtin_amdgcn_permlane32_swap(__float_as_uint(pmax), __float_as_uint(pmax), false, false);
      pmax = fmaxf(__uint_as_float(rr[0]), __uint_as_float(rr[1])); }
    constexpr float C2 = 1.4426950408889634f * SCALE;
    if (__builtin_expect(__all((pmax - m_reg) * SCALE <= THR), 1)) { mn = m_reg; alpha = 1.f; }
    else { mn = fmaxf(m_reg, pmax); alpha = __builtin_amdgcn_exp2f((m_reg - mn) * C2); m_reg = mn; }
    const float mnL = -mn * C2;
    for (int r = 0; r < 16; ++r) p0[r] = fmaf(p0[r], C2, mnL); for (int r = 0; r < 16; ++r) p1[r] = fmaf(p1[r], C2, mnL);
    for (int r = 0; r < 16; ++r) p0[r] = __builtin_amdgcn_exp2f(p0[r]);
}
__device__ __forceinline__ void finishSM(f32x16& p0, f32x16& p1, float alpha, float& l_reg, bf16x8& pa0, bf16x8& pa1, bf16x8& pa2, bf16x8& pa3) {
    for (int r = 0; r < 16; ++r) p1[r] = __builtin_amdgcn_exp2f(p1[r]);
    float ps = 0; for (int r = 0; r < 16; ++r) ps += p0[r]; for (int r = 0; r < 16; ++r) ps += p1[r];
    { auto rr = __builtin_amdgcn_permlane32_swap(__float_as_uint(ps), __float_as_uint(ps), false, false);
      ps = __uint_as_float(rr[0]) + __uint_as_float(rr[1]); }
    l_reg = l_reg * alpha + ps;
#define PK4(P, B_, OUT) do { unsigned a0 = cvtpk(P[B_+0], P[B_+1]), a1 = cvtpk(P[B_+2], P[B_+3]);                          \
        unsigned b0 = cvtpk(P[B_+4], P[B_+5]), b1 = cvtpk(P[B_+6], P[B_+7]);                                             \
        auto r0 = __builtin_amdgcn_permlane32_swap(a0, b0, false, false); auto r1 = __builtin_amdgcn_permlane32_swap(a1, b1, false, false); \
        u32x4 w = {r0[0], r1[0], r0[1], r1[1]}; OUT = *reinterpret_cast<bf16x8*>(&w); } while (0)
    PK4(p0, 0, pa0); PK4(p0, 8, pa1); PK4(p1, 0, pa2); PK4(p1, 8, pa3);
#undef PK4
}
template <int KB, bool SK>
__device__ __forceinline__ void qkt(f32x16& p0, f32x16& p1, const char* K_lds, int r32, int hi, const bf16x8* qr, bool act) {
    if (SK && !act) { const float NEG = -__builtin_inff();
#pragma unroll
        for (int r = 0; r < 16; ++r) { p0[r] = NEG; p1[r] = NEG; } return; }
    p0 = f32x16{}; p1 = f32x16{};
    const char* kb[4];
#pragma unroll
    for (int dd = 0; dd < 4; ++dd) kb[dd] = K_lds + KB * SHM_K + KSWZ(r32, (dd * 16 + hi * 8) * 2);
#pragma unroll
    for (int d0 = 0; d0 < 8; ++d0) { const char* a = kb[d0 & 3] + (d0 >> 2) * 128;
        bf16x8 b0 = *reinterpret_cast<const bf16x8*>(a);
        bf16x8 b1 = *reinterpret_cast<const bf16x8*>(a + 32 * 256);
        p0 = __builtin_amdgcn_mfma_f32_32x32x16_bf16(b0, qr[d0], p0, 0, 0, 0);
        p1 = __builtin_amdgcn_mfma_f32_32x32x16_bf16(b1, qr[d0], p1, 0, 0, 0); }
}
template <int VB, bool SK>
__device__ __forceinline__ void pv_tile(f32x16* o, int vb0, bf16x8 pa0, bf16x8 pa1, bf16x8 pa2, bf16x8 pa3, bool act) {
    if (SK && !act) return;
#define TRRD(dst, off) asm volatile("ds_read_b64_tr_b16 %0, %1 offset:%2" : "=&v"(dst) : "v"(vb0), "i"(off) : "memory")
#define PV_D0(d0) do { s16x4 l0, l1, l2, l3, h0, h1, h2, h3; constexpr int b_ = VB * SHM_V + v_rd_off(d0, 0, 0);     \
        TRRD(l0, b_); TRRD(h0, b_ + 2048); TRRD(l1, b_ + 4096); TRRD(h1, b_ + 6144); TRRD(l2, b_ + 8192); TRRD(h2, b_ + 10240); TRRD(l3, b_ + 12288); TRRD(h3, b_ + 14336); \
        asm volatile("s_waitcnt lgkmcnt(0)" ::: "memory"); SBAR();                 \
        o[d0] = __builtin_amdgcn_mfma_f32_32x32x16_bf16(pa0, (bf16x8){l0[0], l0[1], l0[2], l0[3], h0[0], h0[1], h0[2], h0[3]}, o[d0], 0, 0, 0);   \
        o[d0] = __builtin_amdgcn_mfma_f32_32x32x16_bf16(pa1, (bf16x8){l1[0], l1[1], l1[2], l1[3], h1[0], h1[1], h1[2], h1[3]}, o[d0], 0, 0, 0);   \
        o[d0] = __builtin_amdgcn_mfma_f32_32x32x16_bf16(pa2, (bf16x8){l2[0], l2[1], l2[2], l2[3], h2[0], h2[1], h2[2], h2[3]}, o[d0], 0, 0, 0);   \
        o[d0] = __builtin_amdgcn_mfma_f32_32x32x16_bf16(pa3, (bf16x8){l3[0], l3[1], l3[2], l3[3], h3[0], h3[1], h3[2], h3[3]}, o[d0], 0, 0, 0); } while (0)
    PV_D0(0); PV_D0(1); PV_D0(2); PV_D0(3);
#undef PV_D0
#undef TRRD
}

template <class TIn, class TOut> struct BlockRef { const TIn* Q; const TIn* K; const TIn* V; TOut* O; float* L; const float* bsrc; int P0, pq, pk, po, pl, skv, W; };
template <class TIn> struct Seam {
    bf16x8 qr[8];
    bf16x8 st_v0, st_v1, st_k0, st_k1; f32x4 sf0, sf1, sf2, sf3;
    f32x4 tq[16];
};
__device__ __forceinline__ int swa_jlo(int P0, int W) { const int lowk = P0 - W + 1; return lowk > 0 ? lowk / KVBLK : 0; }
#define ROW(p, pit, k0, rr) ((p) + (unsigned)(((k0) + (rr)) * (pit) + sc))
#define VMW() asm volatile("s_waitcnt vmcnt(0)" ::: "memory")
#define VMWN(n) asm volatile("s_waitcnt vmcnt(%0)" :: "i"(n) : "memory")
#define SLOAD_H(Kp, Vp, pit, k0) do { S.st_v0 = load8<TIn>(ROW(Vp, pit, k0, sr)); S.st_v1 = load8<TIn>(ROW(Vp, pit, k0, 32 + sr));              \
                         S.st_k0 = load8<TIn>(ROW(Kp, pit, k0, sr)); S.st_k1 = load8<TIn>(ROW(Kp, pit, k0, 32 + sr)); } while (0)
#define SWRITE_HK(bf) do { *(bf16x8*)(K_lds + (bf) * SHM_K + kws) = S.st_k0; *(bf16x8*)(K_lds + (bf) * SHM_K + kws + 32 * 256) = S.st_k1; } while (0)
#define SWRITE_HV(bf) do { *(bf16x8*)(V_lds + (bf) * SHM_V + vst0) = S.st_v0; *(bf16x8*)(V_lds + (bf) * SHM_V + vst1) = S.st_v1; } while (0)
#define SWRITE_H(bf) do { SWRITE_HV(bf); SWRITE_HK(bf); } while (0)
#define SLOAD_F(p, k0) do { S.sf0 = *(const f32x4*)ROW(p, D, k0, sr); S.sf1 = *(const f32x4*)(ROW(p, D, k0, sr) + 4);                \
                            S.sf2 = *(const f32x4*)ROW(p, D, k0, 32 + sr); S.sf3 = *(const f32x4*)(ROW(p, D, k0, 32 + sr) + 4); } while (0)
#define SWRITE_KF(bf) do { *(bf16x8*)(K_lds + (bf) * SHM_K + kws) = pack8(S.sf0, S.sf1); *(bf16x8*)(K_lds + (bf) * SHM_K + kws + 32 * 256) = pack8(S.sf2, S.sf3); } while (0)
#define SWRITE_VF(bf) do { *(bf16x8*)(V_lds + (bf) * SHM_V + vst0) = pack8(S.sf0, S.sf1); *(bf16x8*)(V_lds + (bf) * SHM_V + vst1) = pack8(S.sf2, S.sf3); } while (0)
template <int BIAS, class TIn, class TOut>
__device__ __forceinline__ void causal_swa_prime(const BlockRef<TIn, TOut>& cur, char* lds, Seam<TIn>& S) {
    const int W = cur.W;
    constexpr bool F32 = same_t<TIn, float>::v;
    const int tid = threadIdx.x, wid = __builtin_amdgcn_readfirstlane(tid >> 6), lane = tid & 63, r32 = lane & 31, hi = lane >> 5;
    const int sr = tid >> 4, sc = (tid & 15) * 8, kws = KSWZ(sr, sc * 2); char* K_lds = lds + 2 * SHM_V;
    const int kb0 = swa_jlo(cur.P0, W) * KVBLK;
    if (BIAS == 1 || BIAS == 3) bias_fill((float*)(lds + LDS_TAB), cur.bsrc, tid);
    for (int d0 = 0; d0 < 8; ++d0) S.qr[d0] = load8<TIn>(cur.Q + (unsigned)((wid * QBLK + r32) * cur.pq + d0 * 16 + hi * 8));
    if constexpr (F32) { SLOAD_F((const float*)cur.K, kb0); VMW(); SWRITE_KF(0); SBAR(); SLOAD_F((const float*)cur.V, kb0); }
    else { SLOAD_H(cur.K, cur.V, cur.pk, kb0); VMW(); SWRITE_HK(0); }
    __syncthreads();
}
template <int BIAS, class TIn, class TOut, class ItemFn>
__device__ __forceinline__ void causal_swa_block(const BlockRef<TIn, TOut>& cur, int Lnext, const ItemFn& itemfn, int par, char* lds, Seam<TIn>& S) {
    const int skv = cur.skv, W = cur.W;
    const float* tab = (const float*)(lds + LDS_TAB) + par * TAB_PITCH;
    constexpr bool F32 = same_t<TIn, float>::v;
    const int tid = threadIdx.x, wid = __builtin_amdgcn_readfirstlane(tid >> 6), lane = tid & 63, r32 = lane & 31, hi = lane >> 5;
    const int j_lo = swa_jlo(cur.P0, W);
    int j_hi = (cur.P0 + QB - 1) / KVBLK + 1; if (j_hi > skv / KVBLK) j_hi = skv / KVBLK;
    const int NT = j_hi - j_lo;
    const int qlo = cur.P0 + wid * QBLK, qm = qlo + r32 - 4 * hi;
    char* V_lds = lds; char* K_lds = lds + 2 * SHM_V;
    float* ws = (float*)(lds + 2 * SHM_V + 2 * SHM_K) + wid * 64; float* li_l = ws, * al_l = ws + 32;
    float m_reg = -1e30f, l_reg = 0; f32x16 o[4] = {};
    const int sr = tid >> 4, sc = (tid & 15) * 8, vst0 = v_st(sr, sc), vst1 = v_st(32 + sr, sc), kws = KSWZ(sr, sc * 2);
    const int vb0 = (int)(uintptr_t)V_lds + v_rd_base(lane);
    const TIn* Kh = cur.K; const TIn* Vh = cur.V;
#define RESC(a) do { if (__any((a) < 1.f)) { if (hi == 0) al_l[r32] = (a); asm volatile("s_waitcnt lgkmcnt(0)" ::: "memory");              \
                     for (int d_ = 0; d_ < 4; ++d_) for (int r = 0; r < 16; ++r) o[d_][r] *= al_l[crow(r, hi)]; } } while (0)
#define KBASE(t) ((j_lo + (t)) * KVBLK)
#define ACT(t) (KBASE(t) <= qlo + QBLK - 1 && KBASE(t) + KVBLK - 1 >= qlo - W + 1)
#define MASKT(P0_, P1_, t) do { const int kb_ = KBASE(t); if constexpr (BIAS == 1 || BIAS == 2) { if (!SK || ACT(t)) bias_mask_tile(P0_, P1_, qm - kb_, (unsigned)W, tab, kb_ + KVBLK - 1 > qlo || kb_ <= qlo + QBLK - 1 - W); } \
        else { if ((!SK || ACT(t)) && (kb_ + KVBLK - 1 > qlo || kb_ <= qlo + QBLK - 1 - W)) mask_tile(P0_, P1_, qm - kb_, (unsigned)W); } } while (0)
    constexpr int NQL = F32 ? 16 : 8;
    constexpr bool SK = WSKIP && !F32;
#define SEAM_K0() do { VMWN(NQL); if constexpr (F32) { SWRITE_KF(0); SBAR(); SLOAD_F((const float*)nxt.V, kbn); } else { SWRITE_HK(0); } SBAR(); } while (0)
    f32x16 pA0, pA1, pB0, pB1; float mnA, mnB, alA, alB; bf16x8 pa0, pa1, pa2, pa3;
    if constexpr (F32) { VMW(); SWRITE_VF(0); SBAR(); } else { SWRITE_HV(0); SBAR(); }
    if (NT > 1) { if constexpr (F32) SLOAD_F((const float*)Kh, KBASE(1)); else SLOAD_H(Kh, Vh, cur.pk, KBASE(1)); }
    SBAR(); qkt<0, SK>(pA0, pA1, K_lds, r32, hi, S.qr, ACT(0));
    if constexpr (F32) { if (NT > 1) { VMW(); SWRITE_KF(1); SBAR(); SLOAD_F((const float*)Vh, KBASE(1)); } }
    MASKT(pA0, pA1, 0); partialSM(pA0, pA1, m_reg, mnA, alA);
    if (NT > 1) { VMW(); if constexpr (F32) { SWRITE_VF(1); SBAR(); if (NT > 2) SLOAD_F((const float*)Kh, KBASE(2)); } else SWRITE_H(1); }
    __syncthreads();
#define HALF_STEP(PX0, PX1, mnX, alX, PY0, PY1, alY, t, KB, VB, SB) do {                                                      \
        SBAR(); qkt<KB, SK>(PX0, PX1, K_lds, r32, hi, S.qr, ACT(t));                                             \
        finishSM(PY0, PY1, alY, l_reg, pa0, pa1, pa2, pa3); SBAR();                                                           \
        if ((t) + 1 < NT) { if constexpr (F32) { VMW(); SWRITE_KF(SB); SBAR(); SLOAD_F((const float*)Vh, KBASE((t) + 1)); }  \
                            else { SLOAD_H(Kh, Vh, cur.pk, KBASE((t) + 1)); } SBAR(); }                                               \
        pv_tile<VB, SK>(o, vb0, pa0, pa1, pa2, pa3, ACT((t) - 1)); MASKT(PX0, PX1, (t)); partialSM(PX0, PX1, m_reg, mnX, alX);                                        \
        __syncthreads();                                                                                                      \
        if ((t) + 1 < NT) { VMW(); if constexpr (F32) { SWRITE_VF(SB); SBAR(); if ((t) + 2 < NT) SLOAD_F((const float*)Kh, KBASE((t) + 2)); } \
                            else { SWRITE_H(SB); } }                                                                          \
        RESC(alX); __syncthreads(); } while (0)
    for (int t = 1; t + 1 < NT; t += 2) {
        HALF_STEP(pB0, pB1, mnB, alB, pA0, pA1, alA, t, 1, 0, 0);
        HALF_STEP(pA0, pA1, mnA, alA, pB0, pB1, alB, t + 1, 0, 1, 1);
    }
    asm volatile("" : "+s"(Lnext));
    const BlockRef<TIn, TOut> nxt = itemfn(Lnext); const int kbn = swa_jlo(nxt.P0, nxt.W) * KVBLK;
    const bool even = (NT & 1) == 0;
    if (even) { SBAR(); qkt<1, SK>(pB0, pB1, K_lds, r32, hi, S.qr, ACT(NT - 1)); SBAR(); }
#define QROW(e) (nxt.Q + (size_t)(wid * QBLK + r32) * D + ((e) >> 1) * 16 + hi * 8 + ((e) & 1) * 4)
    if constexpr (F32) { SLOAD_F((const float*)nxt.K, kbn); SBAR();
#pragma unroll
        for (int e = 0; e < 8; ++e) S.tq[e] = *(const f32x4*)QROW(e); }
    else { SLOAD_H(nxt.K, nxt.V, nxt.pk, kbn); SBAR();
#pragma unroll
        for (int d0 = 0; d0 < 8; ++d0) S.qr[d0] = load8<TIn>(nxt.Q + (unsigned)((wid * QBLK + r32) * nxt.pq + d0 * 16 + hi * 8)); }
    SBAR();
    finishSM(pA0, pA1, alA, l_reg, pa0, pa1, pa2, pa3); SBAR();
    if constexpr (F32) {
#pragma unroll
        for (int e = 8; e < 16; ++e) S.tq[e] = *(const f32x4*)QROW(e); SBAR(); }
#undef QROW
    pv_tile<0, SK>(o, vb0, pa0, pa1, pa2, pa3, ACT(even ? NT - 2 : NT - 1));
    if (even) { MASKT(pB0, pB1, NT - 1); partialSM(pB0, pB1, m_reg, mnB, alB); __syncthreads(); RESC(alB);
        finishSM(pB0, pB1, alB, l_reg, pa0, pa1, pa2, pa3); SBAR(); pv_tile<1, SK>(o, vb0, pa0, pa1, pa2, pa3, ACT(NT - 1)); }
    SBAR(); SEAM_K0();
    if (hi == 0) li_l[r32] = l_reg; asm volatile("s_waitcnt lgkmcnt(0)" ::: "memory");
    float rli[16];
#pragma unroll
    for (int r = 0; r < 16; ++r) rli[r] = __builtin_amdgcn_rcpf(li_l[crow(r, hi)]);
    TOut* Ow = cur.O + (unsigned)((wid * QBLK) * cur.po); const int po = cur.po;
    if constexpr (BIAS == 1 || BIAS == 3) { if (hi == 0) { f32x2 ml = {m_reg * (1.4426950408889634f * SCALE), l_reg}; *(f32x2*)(cur.L + (unsigned)((wid * QBLK + r32) * cur.pl)) = ml; }
                          bias_fill((float*)(lds + LDS_TAB) + (par ^ 1) * TAB_PITCH, nxt.bsrc, tid); }
#pragma unroll
    for (int r = 0; r < 16; ++r) { const int orow = crow(r, hi);
#pragma unroll
        for (int d0 = 0; d0 < 4; ++d0) { const float v = o[d0][r] * rli[r];
            if constexpr (same_t<TOut, float>::v) { Ow[(unsigned)(orow * po + d0 * 32 + r32)] = v; }
            else { const float vn = __shfl_xor(v, 1);
                   if ((r32 & 1) == 0) *(unsigned*)(Ow + (unsigned)(orow * po + d0 * 32 + r32)) = cvtpk(v, vn); } } }
    if constexpr (F32) {
#pragma unroll
        for (int d0 = 0; d0 < 8; ++d0) S.qr[d0] = pack8(S.tq[2 * d0], S.tq[2 * d0 + 1]); }
    __syncthreads();
#undef RESC
#undef KBASE
#undef ACT
#undef MASKT
#undef SEAM_K0
#undef HALF_STEP
}
#undef ROW
#undef VMW
#undef VMWN
#undef SLOAD_H
#undef SWRITE_HK
#undef SWRITE_HV
#undef SWRITE_H
#undef SLOAD_F
#undef SWRITE_KF
#undef SWRITE_VF

}
constexpr int NWAVES = 8;
#ifndef MK_N_LAUNCHES
#define MK_N_LAUNCHES 1
#endif
constexpr int NPH = 13;
constexpr int N_LAUNCHES = MK_N_LAUNCHES;
static_assert(N_LAUNCHES == 1 || N_LAUNCHES == NPH, "MK_N_LAUNCHES is 1 or 13");

#ifndef GV_I8
#define GV_I8 1
#endif
#ifndef FFN_I8
#define FFN_I8 1
#endif
constexpr int NB = 4, SEQ = 4096, DM = 4096, M = NB * SEQ;
constexpr int MEMLEN = 256, MROWS = NB * MEMLEN;
constexpr int NIN = 12304, NPROJ = 12288;
constexpr int DFF = 11008, NGU = 2 * DFF;
constexpr int NB1 = GV_I8 ? 4096 : 6144, NQ1 = GV_I8 ? 8192 : 6144;
constexpr int XW = 512;
constexpr float RMS_EPS = 1e-6f;

constexpr size_t MiB = 1u << 20;
constexpr size_t WS_CTL = 0, CTL_ZERO_BYTES = 1 * MiB;
constexpr size_t WS_BT = 1 * MiB;
constexpr size_t WS_Q0K0 = 1 * MiB + 64 * 1024;
constexpr size_t WS_RSC1 = 1 * MiB + 128 * 1024;
constexpr size_t WS_XNQ = 780 * MiB;
constexpr size_t WS_WINQ = 2 * MiB + (size_t)6144 * 4096 * 2;
constexpr size_t WS_WIN = 2 * MiB;
constexpr size_t WS_WLR = 98 * MiB;
constexpr size_t WS_WOUT = 99 * MiB;
constexpr size_t WS_WXQ = 131 * MiB;
constexpr size_t WS_WXKV = 135 * MiB;
constexpr size_t WS_WXO = 143 * MiB;
constexpr size_t WS_MEMN = 147 * MiB;
constexpr size_t WS_XKV = 155 * MiB;
constexpr size_t WS_WGU = 160 * MiB;
constexpr size_t WS_WDN = 332 * MiB;
constexpr size_t WS_DQKV = 160 * MiB;
constexpr size_t WS_GK = 352 * MiB;
constexpr size_t WS_GQ = 384 * MiB;
constexpr size_t WS_XN = 418 * MiB;
constexpr size_t WS_MIX = 546 * MiB;
constexpr size_t WS_GV = 546 * MiB;
constexpr size_t WS_VT = 610 * MiB;
constexpr size_t WS_GR = 674 * MiB;
constexpr size_t WS_KET = 738 * MiB;
constexpr size_t WS_ATT = 770 * MiB;
constexpr size_t WS_DEC = 778 * MiB;
constexpr size_t WS_OC = 780 * MiB;
constexpr size_t WS_LSE = 972 * MiB;
constexpr size_t WS_ACT = 546 * MiB;
constexpr size_t WS_HALO = 890 * MiB;
constexpr size_t WS_XQ = 980 * MiB;
constexpr size_t WS_XO = 996 * MiB;
constexpr size_t WS_GQ2 = 1012 * MiB;
constexpr size_t WS_H2Q = 980 * MiB;
constexpr size_t WS_END = 1044 * MiB;
constexpr size_t HALO_ONE = (size_t)256 * 2 * DFF * 4;
static_assert(WS_HALO + 3 * HALO_ONE <= WS_XQ && WS_ACT + (size_t)M * DFF * 2 <= WS_HALO && WS_WDN + (size_t)DM * DFF * 2 <= WS_XN && WS_WGU + (size_t)NGU * DM * 2 <= WS_WDN, "d_ws map");
static_assert(WS_OC + (size_t)3 * M * 2048 * 2 <= WS_LSE && WS_LSE + (size_t)3 * M * 16 * 2 * 4 <= WS_XQ && WS_GQ + (size_t)M * 1024 * 2 <= WS_XN, "d_ws map 2");
constexpr int CW_QUEUE = 2048;
constexpr int CW_BAR = 4096;
constexpr size_t CTL_COLMAX = 704 * 1024;
constexpr size_t CTL_CMAX1 = 864 * 1024;
constexpr size_t CTL_AMAX = 800 * 1024;
constexpr size_t CTL_SS = 256 * 1024;

constexpr int LDS_BYTES = 147456;
constexpr int MISC_OFF = LDS_BYTES - 256;

#define GAS __attribute__((address_space(1)))
#define LAS __attribute__((address_space(3)))
typedef unsigned short bf16;
typedef unsigned v4u __attribute__((ext_vector_type(4)));
typedef unsigned v2u __attribute__((ext_vector_type(2)));
typedef float f32x4 __attribute__((ext_vector_type(4)));
typedef float f32x2 __attribute__((ext_vector_type(2)));
typedef float f32x16 __attribute__((ext_vector_type(16)));
typedef short bf16x8 __attribute__((ext_vector_type(8)));
typedef short s16x4 __attribute__((ext_vector_type(4)));
typedef short v4i16_t __attribute__((ext_vector_type(4)));
typedef GAS unsigned gu32;
#define RLX_AGENT __ATOMIC_RELAXED, __HIP_MEMORY_SCOPE_AGENT
#define LDS_WAIT() asm volatile("s_waitcnt lgkmcnt(0)" ::: "memory")
#define VM_WAIT() asm volatile("s_waitcnt vmcnt(0)" ::: "memory")
__device__ __forceinline__ unsigned f2bf(float f) { unsigned u = __builtin_bit_cast(unsigned, f); return (u + 0x7fffu + ((u >> 16) & 1u)) >> 16; }
__device__ __forceinline__ float bf2f(unsigned short b) { return __builtin_bit_cast(float, (unsigned)b << 16); }
__device__ __forceinline__ float bflo(unsigned w) { return __builtin_bit_cast(float, w << 16); }
__device__ __forceinline__ float bfhi(unsigned w) { return __builtin_bit_cast(float, w & 0xffff0000u); }
__device__ __forceinline__ unsigned q8x4(float a, float b, float c, float d, float inv) {
    const float MG = 12582912.0f;
    const unsigned ua = __builtin_bit_cast(unsigned, __builtin_amdgcn_fmed3f(__builtin_fmaf(a, inv, MG), MG - 127.0f, MG + 127.0f)), ub = __builtin_bit_cast(unsigned, __builtin_amdgcn_fmed3f(__builtin_fmaf(b, inv, MG), MG - 127.0f, MG + 127.0f));
    const unsigned uc = __builtin_bit_cast(unsigned, __builtin_amdgcn_fmed3f(__builtin_fmaf(c, inv, MG), MG - 127.0f, MG + 127.0f)), ud = __builtin_bit_cast(unsigned, __builtin_amdgcn_fmed3f(__builtin_fmaf(d, inv, MG), MG - 127.0f, MG + 127.0f));
    return __builtin_amdgcn_perm(ub, ua, 0x0c0c0400u) | __builtin_amdgcn_perm(ud, uc, 0x04000c0cu);
}
typedef __bf16 bf16x2_t __attribute__((ext_vector_type(2)));
__device__ __forceinline__ unsigned cvtpk_s(float lo, float hi) { f32x2 v = {lo, hi}; bf16x2_t b = __builtin_convertvector(v, bf16x2_t); return __builtin_bit_cast(unsigned, b); }
__device__ __forceinline__ unsigned pk2(float lo, float hi) { return cvtpk_s(lo, hi); }
__device__ __forceinline__ bf16x8 pack8f(float a0, float a1, float a2, float a3, float a4, float a5, float a6, float a7) {
    v4u w = {cvtpk_s(a0, a1), cvtpk_s(a2, a3), cvtpk_s(a4, a5), cvtpk_s(a6, a7)}; return __builtin_bit_cast(bf16x8, w); }
#define XB_TMO      128
#define XB_XCNT(j)  (256  + 64 * (j))
#define XB_XSUB(j)  (1280 + 64 * (j))
#define XB_XGEN(j)  (2304 + 64 * (j))
#define XB_TOP      3328
#define XB_TOPGEN   3392
#define XCD_BAR_WORDS 3456
#define XB_SPIN_CAP (1u << 18)

__device__ __forceinline__ unsigned xb_ld(unsigned* p)              { return __hip_atomic_load(p, __ATOMIC_RELAXED, __HIP_MEMORY_SCOPE_AGENT); }
__device__ __forceinline__ unsigned xb_add(unsigned* p, unsigned v) { return __hip_atomic_fetch_add(p, v, __ATOMIC_RELAXED, __HIP_MEMORY_SCOPE_AGENT); }
__device__ __forceinline__ unsigned xb_xcc_id() { return (unsigned)__builtin_amdgcn_s_getreg((3 << 11) | 20) & 0xFu; }
#define XB_SPIN(cond, bar) do { unsigned _sp = 0; while (cond) { __builtin_amdgcn_s_sleep(1); \
    if ((++_sp & 255u) == 0u) { if (xb_ld(&(bar)[XB_TMO])) break; if (_sp > XB_SPIN_CAP) { atomicAdd(&(bar)[XB_TMO], 1u); break; } } } } while (0)

struct XcdBarrier {
    unsigned* bar; unsigned x;
    volatile LAS unsigned* st;
};

__device__ __forceinline__ XcdBarrier xcd_barrier_post(unsigned* bar, volatile LAS unsigned* st) {
    XcdBarrier b; b.bar = bar; b.x = xb_xcc_id(); b.st = st;
    if (threadIdx.x == 0) (void)xb_add(&bar[XB_XCNT(b.x)], 1u);
    return b;
}
__device__ __forceinline__ void xcd_barrier_complete(unsigned* bar, unsigned x, unsigned& nloc, unsigned& nx) {
    const unsigned G = gridDim.x * gridDim.y * gridDim.z;
    unsigned sum, cnt, mine, sp = 0u;
    for (;;) {
        sum = 0u; cnt = 0u; mine = 0u;
#pragma unroll
        for (unsigned j = 0; j < 16; ++j) { const unsigned c = xb_ld(&bar[XB_XCNT(j)]); sum += c; cnt += (c > 0u) ? 1u : 0u; mine = (j == x) ? c : mine; }
        if (sum == G) break;
        __builtin_amdgcn_s_sleep(1);
        if ((++sp & 255u) == 0u) { if (xb_ld(&bar[XB_TMO])) break; if (sp > XB_SPIN_CAP) { atomicAdd(&bar[XB_TMO], 1u); break; } }
    }
    nloc = mine > 0u ? mine : 1u; nx = cnt > 0u ? cnt : 1u;
}

__device__ __forceinline__ void xcd_barrier(const XcdBarrier& b) {
    asm volatile("s_waitcnt vmcnt(0)" ::: "memory");
    __syncthreads();
    if (threadIdx.x == 0) {
        unsigned* bar = b.bar;
        __builtin_amdgcn_s_waitcnt(0);
        unsigned nloc = b.st[0], nx = b.st[1];
        if (nloc == 0u) { xcd_barrier_complete(bar, b.x, nloc, nx); b.st[0] = nloc; b.st[1] = nx; }
        const unsigned old = xb_add(&bar[XB_XSUB(b.x)], 1u);
        const unsigned gen = old / nloc;
        if (old + 1u == (gen + 1u) * nloc) {
            __builtin_amdgcn_fence(__ATOMIC_RELEASE, "agent");
            asm volatile("s_waitcnt vmcnt(0)" ::: "memory");
            const unsigned og = xb_add(&bar[XB_TOP], 1u);
            const unsigned tg = og / nx;
            if (og + 1u == (tg + 1u) * nx) xb_add(&bar[XB_TOPGEN], 1u);
            else XB_SPIN(xb_ld(&bar[XB_TOPGEN]) == tg, bar);
            __builtin_amdgcn_fence(__ATOMIC_ACQUIRE, "agent");
            xb_add(&bar[XB_XGEN(b.x)], 1u);
            asm volatile("s_waitcnt vmcnt(0)" ::: "memory");
        } else {
            XB_SPIN(xb_ld(&bar[XB_XGEN(b.x)]) == gen, bar);
            __builtin_amdgcn_fence(__ATOMIC_ACQUIRE, "agent");
            asm volatile("s_waitcnt vmcnt(0)" ::: "memory");
        }
    }
    __syncthreads();
}
struct Frame {
    LAS unsigned char* lds; char* ldsg;
    volatile LAS unsigned* MISC;
    gu32* ctl;
    int wave, vcu, G;
    unsigned char* ws;
    const float* const __attribute__((address_space(4)))* kin;
    float* out;
};
__device__ __forceinline__ int tid_now() { int t = (int)threadIdx.x; asm volatile("" : "+v"(t)); return t; }
#define WAVE_RED_(v, OP) do { \
    v = OP(v, __builtin_bit_cast(decltype(v), __builtin_amdgcn_update_dpp(0, __builtin_bit_cast(int, v), 0xB1, 0xf, 0xf, true))); \
    v = OP(v, __builtin_bit_cast(decltype(v), __builtin_amdgcn_update_dpp(0, __builtin_bit_cast(int, v), 0x4E, 0xf, 0xf, true))); \
    v = OP(v, __builtin_bit_cast(decltype(v), __builtin_amdgcn_update_dpp(0, __builtin_bit_cast(int, v), 0x124, 0xf, 0xf, true))); \
    v = OP(v, __builtin_bit_cast(decltype(v), __builtin_amdgcn_update_dpp(0, __builtin_bit_cast(int, v), 0x128, 0xf, 0xf, true))); \
    { auto rr_ = __builtin_amdgcn_permlane16_swap(__builtin_bit_cast(unsigned, v), __builtin_bit_cast(unsigned, v), false, false); v = OP(__builtin_bit_cast(decltype(v), rr_[0]), __builtin_bit_cast(decltype(v), rr_[1])); } \
    { auto rr_ = __builtin_amdgcn_permlane32_swap(__builtin_bit_cast(unsigned, v), __builtin_bit_cast(unsigned, v), false, false); v = OP(__builtin_bit_cast(decltype(v), rr_[0]), __builtin_bit_cast(decltype(v), rr_[1])); } } while (0)
#define WR_ADD_(a, b) ((a) + (b))
#define WR_MAXF_(a, b) fmaxf((a), (b))
#define WR_MAXU_(a, b) ((a) > (b) ? (a) : (b))
__device__ __forceinline__ float wave_sum(float v) {
    v += __int_as_float(__builtin_amdgcn_update_dpp(0, __float_as_int(v), 0xB1, 0xf, 0xf, true));
    v += __int_as_float(__builtin_amdgcn_update_dpp(0, __float_as_int(v), 0x4E, 0xf, 0xf, true));
    v += __int_as_float(__builtin_amdgcn_update_dpp(0, __float_as_int(v), 0x124, 0xf, 0xf, true));
    v += __int_as_float(__builtin_amdgcn_update_dpp(0, __float_as_int(v), 0x128, 0xf, 0xf, true));
    v += __shfl_xor(v, 16);
    { auto rr_ = __builtin_amdgcn_permlane32_swap(__float_as_uint(v), __float_as_uint(v), false, false); v = __uint_as_float(rr_[0]) + __uint_as_float(rr_[1]); }
    return v;
}
__device__ __forceinline__ float wave_maxf(float v) {
#pragma unroll
    for (int o = 1; o < 64; o <<= 1) v = fmaxf(v, __shfl_xor(v, o));
    return v;
}
__device__ __forceinline__ unsigned wave_maxu(unsigned v) {
#pragma unroll
    for (int o = 1; o < 64; o <<= 1) { const unsigned u = (unsigned)__shfl_xor((int)v, o); v = v > u ? v : u; }
    return v;
}
__device__ const unsigned char kBucket[3][132] = {
 {0,1,2,3,4,5,6,7,8,9,10,11,12,13,14,15,16,16,16,16,16,16,17,17,17,17,17,17,17,17,18,18,18,18,18,18,18,18,18,18,19,19,19,19,19,19,19,19,19,19,19,19,19,19,20,20,20,20,20,20,20,20,20,20,20,20,20,20,20,20,20,20,20,21,21,21,21,21,21,21,21,21,21,21,21,21,21,21,21,21,21,21,21,21,21,21,21,21,21,22,22,22,22,22,22,22,22,22,22,22,22,22,22,22,22,22,22,22,22,22,22,22,22,22,22,22,22,22,22,0,0,0},
 {0,4,8,12,16,16,17,17,18,18,19,19,19,19,20,20,20,20,20,21,21,21,21,21,21,22,22,22,22,22,22,22,22,22,23,23,23,23,23,23,23,23,23,23,23,23,24,24,24,24,24,24,24,24,24,24,24,24,24,24,24,24,25,25,25,25,25,25,25,25,25,25,25,25,25,25,25,25,25,25,25,25,25,26,26,26,26,26,26,26,26,26,26,26,26,26,26,26,26,26,26,26,26,26,26,26,26,26,26,26,26,26,26,27,27,27,27,27,27,27,27,27,27,27,27,27,27,27,27,0,0,0},
 {0,16,18,19,20,21,21,22,22,23,23,23,24,24,24,24,25,25,25,25,25,26,26,26,26,26,26,26,26,27,27,27,27,27,27,27,27,27,27,28,28,28,28,28,28,28,28,28,28,28,28,28,29,29,29,29,29,29,29,29,29,29,29,29,29,29,29,29,29,29,30,30,30,30,30,30,30,30,30,30,30,30,30,30,30,30,30,30,30,30,30,30,30,30,30,31,31,31,31,31,31,31,31,31,31,31,31,31,31,31,31,31,31,31,31,31,31,31,31,31,31,31,31,31,31,31,31,31,31,0,0,0}};

#ifndef NT_LOADS
#define NT_LOADS 1
#endif
#if NT_LOADS
#define NTLD(p) __builtin_nontemporal_load(p)
#else
#define NTLD(p) (*(p))
#endif
constexpr int TR_SCR = 17408;
__device__ __forceinline__ void tr_item(const float* W, int ldw, bf16* WT, int ldt, int src_c0, int dst_r0, int nvalid, const float* gain, LAS float* scr, int kb, int lane) {
    const int k0 = 64 * kb, a = lane >> 4, c4 = 4 * (lane & 15);
#pragma unroll 8
    for (int i = 0; i < 16; ++i) { const int kk = 4 * i + a; f32x4 v = NTLD((const GAS f32x4*)(W + (size_t)(k0 + kk) * ldw + src_c0 + c4)); if (gain) v = v * gain[k0 + kk];
        LAS float* d = scr + kk * 65 + c4; d[0] = v.x; d[1] = v.y; d[2] = v.z; d[3] = v.w; }
    LDS_WAIT(); asm volatile("" ::: "memory");
    const int c = lane & 7;
#pragma unroll
    for (int j = 0; j < 8; ++j) { const int n = (lane >> 3) + 8 * j; const LAS float* s = scr + (8 * c) * 65 + n;
        v4u o; o.x = pk2(s[0 * 65], s[1 * 65]); o.y = pk2(s[2 * 65], s[3 * 65]); o.z = pk2(s[4 * 65], s[5 * 65]); o.w = pk2(s[6 * 65], s[7 * 65]);
        if (n < nvalid) *(GAS v4u*)(WT + (size_t)(dst_r0 + n) * ldt + k0 + 8 * c) = o; }
    LDS_WAIT(); asm volatile("" ::: "memory");
}
constexpr float CM_WIDEN = 1.0f;
__device__ __forceinline__ void absmax_item(const float* W, int ldw, int src_c0, const float* gain, unsigned* cmax, int kb, int lane) {
    const int k0 = 64 * kb, a = lane >> 4, c4 = 4 * (lane & 15);
    f32x4 m = {0.f, 0.f, 0.f, 0.f};
#pragma unroll 8
    for (int i = 0; i < 16; ++i) { const int kk = 4 * i + a; const f32x4 v = *(const GAS f32x4*)(W + (size_t)(k0 + kk) * ldw + src_c0 + c4) * (gain ? gain[k0 + kk] : 1.0f);
        m.x = fmaxf(m.x, fabsf(v.x)); m.y = fmaxf(m.y, fabsf(v.y)); m.z = fmaxf(m.z, fabsf(v.z)); m.w = fmaxf(m.w, fabsf(v.w)); }
#pragma unroll
    for (int o = 16; o < 64; o <<= 1) { m.x = fmaxf(m.x, __shfl_xor(m.x, o)); m.y = fmaxf(m.y, __shfl_xor(m.y, o)); m.z = fmaxf(m.z, __shfl_xor(m.z, o)); m.w = fmaxf(m.w, __shfl_xor(m.w, o)); }
    if (lane < 16) { unsigned* p = cmax + c4;   atomicMax(p, __float_as_uint(m.x)); atomicMax(p + 1, __float_as_uint(m.y)); atomicMax(p + 2, __float_as_uint(m.z)); atomicMax(p + 3, __float_as_uint(m.w)); }
}
__device__ __forceinline__ void quant_item(const float* W, int ldw, signed char* WQ, int ldq, int src_c0, int dst_r0, const float* gain, const unsigned* cmax, LAS float* scr, int kb, int lane) {
    const int k0 = 64 * kb, a = lane >> 4, c4 = 4 * (lane & 15);
#pragma unroll 8
    for (int i = 0; i < 16; ++i) { const int kk = 4 * i + a; const f32x4 v = NTLD((const GAS f32x4*)(W + (size_t)(k0 + kk) * ldw + src_c0 + c4)) * (gain ? gain[k0 + kk] : 1.0f);
        LAS float* d = scr + kk * 65 + c4; d[0] = v.x; d[1] = v.y; d[2] = v.z; d[3] = v.w; }
    LDS_WAIT(); asm volatile("" ::: "memory");
    const int c = lane & 3;
#pragma unroll
    for (int j = 0; j < 4; ++j) { const int n = (lane >> 2) + 16 * j; const LAS float* s = scr + (16 * c) * 65 + n;
        const float cm = __uint_as_float(cmax[n]) * CM_WIDEN; const float inv = cm > 0.f ? 127.0f / cm : 0.f;
        unsigned wq[4];
#pragma unroll
        for (int q = 0; q < 4; ++q) wq[q] = q8x4(s[(4 * q) * 65], s[(4 * q + 1) * 65], s[(4 * q + 2) * 65], s[(4 * q + 3) * 65], inv);
        v4u o = {wq[0], wq[1], wq[2], wq[3]};
        *(GAS v4u*)(WQ + (size_t)(dst_r0 + n) * ldq + k0 + 16 * c) = o; }
    LDS_WAIT(); asm volatile("" ::: "memory");
}

__device__ __forceinline__ void rms_row_to_bf16(const float* xrow, const float* g, bf16* orow, int lane, signed char* qrow = nullptr, float* qscale = nullptr) {
    const GAS f32x4* xr = (const GAS f32x4*)xrow + lane; const GAS f32x4* gr = (const GAS f32x4*)g + lane;
    f32x4 v[16]; float s = 0.f;
#pragma unroll
    for (int j = 0; j < 16; ++j) { v[j] = NTLD(xr + 64 * j); s += (v[j].x * v[j].x + v[j].y * v[j].y) + (v[j].z * v[j].z + v[j].w * v[j].w); }
    const float r = 1.0f / sqrtf(wave_sum(s) * (1.0f / 4096.0f) + RMS_EPS);
    GAS v2u* o8 = (GAS v2u*)orow + lane; float mx = 0.f;
#pragma unroll
    for (int j = 0; j < 16; ++j) { const f32x4 gg = gr[64 * j]; v[j] = (f32x4){v[j].x * r * gg.x, v[j].y * r * gg.y, v[j].z * r * gg.z, v[j].w * r * gg.w};
        v2u o; o.x = pk2(v[j].x, v[j].y); o.y = pk2(v[j].z, v[j].w); o8[64 * j] = o;
        mx = fmaxf(mx, fmaxf(fmaxf(fabsf(v[j].x), fabsf(v[j].y)), fmaxf(fabsf(v[j].z), fabsf(v[j].w)))); }
    if (qrow) {
        mx = wave_maxf(mx);
        const float inv = mx > 0.f ? 127.0f / mx : 0.f; GAS unsigned* q4 = (GAS unsigned*)qrow + lane;
#pragma unroll
        for (int j = 0; j < 16; ++j) q4[64 * j] = q8x4(v[j].x, v[j].y, v[j].z, v[j].w, inv);
        if (lane == 0) *qscale = mx * (1.0f / 127.0f);
    }
}

__device__ __forceinline__ void p0_first_token(Frame& F) {
    const int tid = tid_now(), lane = tid & 63, w = F.wave;
    LAS float* red = (LAS float*)F.lds;
    const float* x = F.kin[0]; const float* g = F.kin[3]; const float* W = F.kin[4];
    float* Q0K0 = (float*)(F.ws + WS_Q0K0);
    for (int cb = blockIdx.x; cb < 256; cb += F.G) {
        float xv[4][8]; float gg[8]; f32x4 w0[8], w1[8];
#pragma unroll
        for (int i = 0; i < 8; ++i) { gg[i] = g[tid + 512 * i]; const GAS f32x4* wp = (const GAS f32x4*)(W + (size_t)(tid + 512 * i) * NIN + 8 * cb); w0[i] = wp[0]; w1[i] = wp[1];
#pragma unroll
            for (int b = 0; b < 4; ++b) xv[b][i] = x[(size_t)b * SEQ * DM + tid + 512 * i]; }
        float acc[4][8], ss[4];
#pragma unroll
        for (int b = 0; b < 4; ++b) { ss[b] = 0.f;
#pragma unroll
            for (int c = 0; c < 8; ++c) acc[b][c] = 0.f; }
#pragma unroll
        for (int i = 0; i < 8; ++i) { const float wv[8] = {w0[i].x, w0[i].y, w0[i].z, w0[i].w, w1[i].x, w1[i].y, w1[i].z, w1[i].w};
#pragma unroll
            for (int b = 0; b < 4; ++b) { ss[b] += xv[b][i] * xv[b][i]; const float xg = xv[b][i] * gg[i];
#pragma unroll
                for (int c = 0; c < 8; ++c) acc[b][c] += xg * wv[c]; } }
#pragma unroll
        for (int b = 0; b < 4; ++b) { const float s2 = wave_sum(ss[b]); if (lane == 0) red[w * 40 + 32 + b] = s2;
#pragma unroll
            for (int c = 0; c < 8; ++c) { const float s = wave_sum(acc[b][c]); if (lane == 0) red[w * 40 + b * 8 + c] = s; } }
        __syncthreads();
        if (tid < 32) { float s = 0.f, q = 0.f;
#pragma unroll
            for (int k = 0; k < 8; ++k) { s += red[k * 40 + tid]; q += red[k * 40 + 32 + (tid >> 3)]; }
            Q0K0[(tid >> 3) * 2048 + 8 * cb + (tid & 7)] = s * (1.0f / sqrtf(q * (1.0f / 4096.0f) + RMS_EPS)); }
        __syncthreads();
    }
}
__device__ __forceinline__ int winq_src_col(int nb) { return GV_I8 ? (nb < 32 ? 2048 + 64 * nb : 6160 + 64 * (nb - 32)) : 6160 + 64 * nb; }
__device__ __forceinline__ void p0_prologue(Frame& F) {
    const int tid = tid_now(), lane = tid & 63;
    LAS float* scr = (LAS float*)(F.lds + F.wave * TR_SCR);
    const int gw = F.vcu * NWAVES + F.wave, NGW = F.G * NWAVES;
    bf16* Win = (bf16*)(F.ws + WS_WIN); bf16* Wlr = (bf16*)(F.ws + WS_WLR); bf16* Wout = (bf16*)(F.ws + WS_WOUT); bf16* Wxq = (bf16*)(F.ws + WS_WXQ); bf16* Wxkv = (bf16*)(F.ws + WS_WXKV); bf16* Wxo = (bf16*)(F.ws + WS_WXO);
    constexpr int NA = GV_I8 ? 2048 : 4096;
    constexpr int I_INA = 64 * (NA / 64), I_INB = 64 * (2048 / 64), I_INQ = 64 * (NQ1 / 64), I_LR = 64, I_OUT = 64 * 64, I_XQ = 64 * 8, I_XO = 8 * 64;
    constexpr int NIT = I_INA + I_INB + I_INQ + I_LR + I_OUT + 3 * I_XQ + I_XO;
    unsigned* cmax1 = (unsigned*)(F.ws + WS_CTL + CTL_CMAX1);
    for (int it = gw; it < NIT; it += NGW) {
        int r = it;
        if (r < I_INA) { const int nb = r % (NA / 64), kb = r / (NA / 64); tr_item(F.kin[4], NIN, Win, DM, 64 * nb, 64 * nb, 64, nullptr, scr, kb, lane); continue; } r -= I_INA;
        if (r < I_INB) { const int nb = r % 32, kb = r / 32; tr_item(F.kin[4], NIN, Win, DM, 4112 + 64 * nb, NA + 64 * nb, 64, nullptr, scr, kb, lane); continue; } r -= I_INB;
        if (r < I_INQ) { const int nb = r % (NQ1 / 64), kb = r / (NQ1 / 64); absmax_item(F.kin[4], NIN, winq_src_col(nb), nullptr, cmax1 + 64 * nb, kb, lane); continue; } r -= I_INQ;
        if (r < I_LR) { tr_item(F.kin[4], NIN, Wlr, DM, 4096, 0, 16, nullptr, scr, r, lane); continue; } r -= I_LR;
        if (r < I_OUT) { const int nb = r % 64, kb = r / 64; tr_item(F.kin[8], DM, Wout, DM, 64 * nb, 64 * nb, 64, nullptr, scr, kb, lane); continue; } r -= I_OUT;
        if (r < I_XQ) { const int nb = r % 8, kb = r / 8; tr_item(F.kin[11], XW, Wxq, DM, 64 * nb, 64 * nb, 64, F.kin[9], scr, kb, lane); continue; } r -= I_XQ;
        if (r < I_XQ) { const int nb = r % 8, kb = r / 8; tr_item(F.kin[12], XW, Wxkv, DM, 64 * nb, 64 * nb, 64, nullptr, scr, kb, lane); continue; } r -= I_XQ;
        if (r < I_XQ) { const int nb = r % 8, kb = r / 8; tr_item(F.kin[13], XW, Wxkv, DM, 64 * nb, 512 + 64 * nb, 64, nullptr, scr, kb, lane); continue; } r -= I_XQ;
        { const int nb = r % 64, kb = r / 64; tr_item(F.kin[14], DM, Wxo, XW, 64 * nb, 64 * nb, 64, nullptr, scr, kb, lane); }
    }
    bf16* XN = (bf16*)(F.ws + WS_XN); bf16* MEMN = (bf16*)(F.ws + WS_MEMN);
    for (int m = NGW - 1 - gw; m < M + MROWS; m += NGW) {
        if (m < M) rms_row_to_bf16(F.kin[0] + (size_t)m * DM, F.kin[3], XN + (size_t)m * DM, lane, (signed char*)(F.ws + WS_XNQ) + (size_t)m * DM, (float*)(F.ws + WS_RSC1) + m);
        else rms_row_to_bf16(F.kin[1] + (size_t)(m - M) * DM, F.kin[10], MEMN + (size_t)(m - M) * DM, lane);
    }
    float* BT = (float*)(F.ws + WS_BT);
    for (int i = blockIdx.x * 512 + tid; i < 3 * 16 * 132; i += F.G * 512) { const int rel = i % 132, h = (i / 132) % 16, cfg = i / (132 * 16);
        BT[i] = rel < 129 ? F.kin[2][kBucket[cfg][rel] * 16 + h] * 11.313708498984761f : 0.f; }
}
constexpr int FW_IG = 64 * (DFF / 64), FW_ID = (DFF / 64) * 64, FW_ALL = 2 * FW_IG + FW_ID;
#ifndef FW_P6N
#define FW_P6N 3584
#endif
constexpr int FW_P6_LO = 2 * FW_IG - (FW_P6N), FW_P6_HI = 2 * FW_IG;
#ifndef FW_P9N
#define FW_P9N 8448
#endif
#ifndef P9_GEMM_WGS
#define P9_GEMM_WGS 251
#endif
constexpr int FW_P9_LO = FW_ALL - (FW_P9N), FW_P9_HI = FW_ALL;
template <int MODE  >
__device__ __forceinline__ void ffn_weight_item(Frame& F, int r, LAS float* scr, int lane) {
    bf16* Wgu = (bf16*)(F.ws + WS_WGU); bf16* Wdn = (bf16*)(F.ws + WS_WDN); unsigned* cmax = (unsigned*)(F.ws + WS_CTL + CTL_COLMAX);
    if (r < 2 * FW_IG) { const int up = r >= FW_IG ? 1 : 0; const int rr = r - up * FW_IG; const int nb = rr % 172, kb = rr / 172, c0 = 64 * nb; const float* W = up ? F.kin[17] : F.kin[16];
        const int drow = 256 * (c0 >> 7) + 128 * up + (c0 & 127);
        if constexpr (MODE == 1) absmax_item(W, DFF, c0, F.kin[15], cmax + up * DFF + c0, kb, lane);
        else if constexpr (FFN_I8) quant_item(W, DFF, (signed char*)Wgu, DM, c0, drow, F.kin[15], cmax + up * DFF + c0, scr, kb, lane);
        else tr_item(W, DFF, Wgu, DM, c0, drow, 64, F.kin[15], scr, kb, lane);
        return; }
    if constexpr (MODE == 0) { r -= 2 * FW_IG; const int nb = r % 64, kb = r / 64; tr_item(F.kin[20], DM, Wdn, DFF, 64 * nb, 64 * nb, 64, nullptr, scr, kb, lane); }
}
template <int MODE> __device__ __forceinline__ void ffn_weights(Frame& F, int lo, int hi, int iw, int nw) {
    const int lane = tid_now() & 63; LAS float* scr = (LAS float*)(F.lds + F.wave * TR_SCR);
    for (int it = lo + iw; it < hi; it += nw) ffn_weight_item<MODE>(F, it, scr, lane);
}

__device__ __forceinline__ void p0_quant_win(Frame& F) {
    const int lane = tid_now() & 63; LAS float* scr = (LAS float*)(F.lds + F.wave * TR_SCR);
    const int gw = F.vcu * NWAVES + F.wave, NGW = F.G * NWAVES;
    const unsigned* cmax1 = (const unsigned*)(F.ws + WS_CTL + CTL_CMAX1);
    for (int r = gw; r < 64 * (NQ1 / 64); r += NGW) { const int nb = r % (NQ1 / 64), kb = r / (NQ1 / 64);
        quant_item(F.kin[4], NIN, (signed char*)(F.ws + WS_WINQ), DM, winq_src_col(nb), 64 * nb, nullptr, cmax1 + 64 * nb, scr, kb, lane); }
}
constexpr int PP = 520;
constexpr int PREP_GLR = 0, PREP_QM = 8192, PREP_KM = 8192 + 64 * PP * 2;
static_assert(PREP_KM + 64 * PP * 2 <= MISC_OFF, "prep LDS");
__device__ __forceinline__ void gla_prep_unit(Frame& F, int b, int n) {
    const int tid = tid_now(), lane = tid & 63, w = F.wave;
    const int t0 = b * SEQ + 64 * n;
    const bf16* XN = (const bf16*)(F.ws + WS_XN); const bf16* Wlr = (const bf16*)(F.ws + WS_WLR);
    const bf16* GQ = (const bf16*)(F.ws + WS_GQ); bf16* GQ2 = (bf16*)(F.ws + WS_GQ2); const bf16* GK = (const bf16*)(F.ws + WS_GK);
    bf16* KET = (bf16*)(F.ws + WS_KET); bf16* ATT = (bf16*)(F.ws + WS_ATT); float* DEC = (float*)(F.ws + WS_DEC);
    LAS float* glr = (LAS float*)(F.lds + PREP_GLR);
    LAS bf16* QMs = (LAS bf16*)(F.lds + PREP_QM); LAS bf16* KMs = (LAS bf16*)(F.lds + PREP_KM);
    {
        const int rg = w & 3, kh = w >> 2, rr = lane & 15, kg = lane >> 4;
        const bf16* ap = XN + (size_t)(t0 + 16 * rg + rr) * DM + kh * 2048 + 8 * kg; const bf16* bp = Wlr + (size_t)rr * DM + kh * 2048 + 8 * kg;
        f32x4 acc = {0.f, 0.f, 0.f, 0.f};
#pragma unroll 16
        for (int s = 0; s < 64; ++s) { const bf16x8 a = *(const GAS bf16x8*)(ap + 32 * s), bq = *(const GAS bf16x8*)(bp + 32 * s); acc = __builtin_amdgcn_mfma_f32_16x16x32_bf16(a, bq, acc, 0, 0, 0); }
#pragma unroll
        for (int i = 0; i < 4; ++i) glr[(kh * 64 + 16 * rg + 4 * kg + i) * 16 + rr] = acc[i];
    }
    __syncthreads();
    for (int i = tid; i < 1024; i += 512) glr[i] += glr[1024 + i];
    __syncthreads();
    const int cid = (b * 64 + n) * 4;
    for (int hp = 0; hp < 2; ++hp) {
        {
            const int col = hp * 512 + tid, h = col >> 8, dk = col & 255;
            float w2[16];
#pragma unroll
            for (int j = 0; j < 16; ++j) w2[j] = F.kin[5][j * 1024 + col];
            const float bg = F.kin[6][col];
            const bf16* qp = GQ + (size_t)t0 * 1024 + col; const bf16* kp = GK + (size_t)t0 * 1024 + col;
            typedef unsigned short us2_t __attribute__((ext_vector_type(2)));
            us2_t kv[32];
#pragma unroll
            for (int c2 = 0; c2 < 32; ++c2) { kv[c2].x = kp[(size_t)(2 * c2) * 1024]; kv[c2].y = kp[(size_t)(2 * c2 + 1) * 1024]; }
            float bc[64]; float run = 0.f;
#pragma unroll
            for (int c = 0; c < 64; ++c) {
                const LAS f32x4* gp = (const LAS f32x4*)(glr + c * 16); const f32x4 g0 = gp[0], g1 = gp[1], g2 = gp[2], g3 = gp[3];
                float za = bg, zb = 0.f;
                za = __builtin_fmaf(g0.x, w2[0], za); zb = __builtin_fmaf(g0.y, w2[1], zb); za = __builtin_fmaf(g0.z, w2[2], za); zb = __builtin_fmaf(g0.w, w2[3], zb);
                za = __builtin_fmaf(g1.x, w2[4], za); zb = __builtin_fmaf(g1.y, w2[5], zb); za = __builtin_fmaf(g1.z, w2[6], za); zb = __builtin_fmaf(g1.w, w2[7], zb);
                za = __builtin_fmaf(g2.x, w2[8], za); zb = __builtin_fmaf(g2.y, w2[9], zb); za = __builtin_fmaf(g2.z, w2[10], za); zb = __builtin_fmaf(g2.w, w2[11], zb);
                za = __builtin_fmaf(g3.x, w2[12], za); zb = __builtin_fmaf(g3.y, w2[13], zb); za = __builtin_fmaf(g3.z, w2[14], za); zb = __builtin_fmaf(g3.w, w2[15], zb);
                const float z = za + zb;
                const float ls = fminf(z, 0.f) - 0.6931471805599453f * __builtin_amdgcn_logf(1.0f + __builtin_amdgcn_exp2f(-1.4426950408889634f * fabsf(z)));
                run += ls * (1.0f / 16.0f); bc[c] = run;
            }
            const float blast = bc[63], bmid = bc[32]; const float Emid = __expf(bmid), Elm = __expf(blast - bmid);
            unsigned kep[32];
            bf16* qo = GQ2 + (size_t)t0 * 1024 + col;
#pragma unroll
            for (int c2 = 0; c2 < 32; ++c2) {
                const int c = 2 * c2;
                const float qa = bf2f(qp[(size_t)c * 1024]) * (1.0f / 16.0f), ka = bf2f(kv[c2].x);
                const float qb = bf2f(qp[(size_t)(c + 1) * 1024]) * (1.0f / 16.0f), kb = bf2f(kv[c2].y);
                const float Aa = __expf(bc[c] - bmid), Ab = __expf(bc[c + 1] - bmid), Ra = __builtin_amdgcn_rcpf(Aa), Rb = __builtin_amdgcn_rcpf(Ab);
                const unsigned qt = cvtpk_s(qa * (Aa * Emid), qb * (Ab * Emid));
                qo[(size_t)c * 1024] = (bf16)(qt & 0xffffu); qo[(size_t)(c + 1) * 1024] = (bf16)(qt >> 16);
                kep[c2] = cvtpk_s(ka * (Ra * Elm), kb * (Rb * Elm));
                const unsigned qm = cvtpk_s(qa * Aa, qb * Ab);
                const unsigned km = cvtpk_s(ka * Ra, kb * Rb);
                QMs[c * PP + tid] = (bf16)(qm & 0xffffu); QMs[(c + 1) * PP + tid] = (bf16)(qm >> 16);
                KMs[c * PP + tid] = (bf16)(km & 0xffffu); KMs[(c + 1) * PP + tid] = (bf16)(km >> 16);
            }
            bf16* kt = KET + ((size_t)(cid + h) * 256 + dk) * 64;
#pragma unroll
            for (int i = 0; i < 8; ++i) { v4u o = {kep[4 * i], kep[4 * i + 1], kep[4 * i + 2], kep[4 * i + 3]}; *(GAS v4u*)(kt + 8 * i) = o; }
            DEC[(size_t)(cid + h) * 256 + dk] = __expf(blast);
        }
        __syncthreads();
        {
            const int rr = lane & 15, kg = lane >> 4;
#pragma unroll
            for (int q4 = 0; q4 < 4; ++q4) {
                const int id = w * 4 + q4, hl = id >> 4, mt = (id >> 2) & 3, nt = id & 3;
                const LAS bf16* ap = KMs + (16 * mt + rr) * PP + hl * 256 + 8 * kg; const LAS bf16* bp = QMs + (16 * nt + rr) * PP + hl * 256 + 8 * kg;
                f32x4 acc = {0.f, 0.f, 0.f, 0.f};
#pragma unroll
                for (int s = 0; s < 8; ++s) { const bf16x8 a = *(const LAS bf16x8*)(ap + 32 * s), bq = *(const LAS bf16x8*)(bp + 32 * s); acc = __builtin_amdgcn_mfma_f32_16x16x32_bf16(a, bq, acc, 0, 0, 0); }
                const int c = 16 * nt + rr, cp0 = 16 * mt + 4 * kg;
                v2u o; o.x = pk2(cp0 <= c ? acc[0] : 0.f, cp0 + 1 <= c ? acc[1] : 0.f); o.y = pk2(cp0 + 2 <= c ? acc[2] : 0.f, cp0 + 3 <= c ? acc[3] : 0.f);
                *(GAS v2u*)(ATT + ((size_t)(cid + 2 * hp + hl) * 64 + c) * 64 + cp0) = o;
            }
        }
        __syncthreads();
    }
    if (n == 0 && w < 4) {
        const float* q0 = (const float*)(F.ws + WS_Q0K0) + b * 2048 + w * 256; const float* k0 = q0 + 1024; float s = 0.f;
#pragma unroll
        for (int i = 0; i < 4; ++i) s += q0[lane + 64 * i] * k0[lane + 64 * i];
        s = wave_sum(s) * (1.0f / 16.0f);
        if (lane == 0) ATT[(size_t)(cid + w) * 4096] = (bf16)f2bf(s);
    }
}

constexpr int CH_QT = 0, CH_QP = 528, CH_KE = 64 * CH_QP, CH_KP = 144, CH_AT = CH_KE + 256 * CH_KP, CH_DC = CH_AT + 64 * CH_KP, CH_VS = CH_DC + 1024, CH_END = CH_VS + 16384;
static_assert(CH_END <= MISC_OFF, "chain LDS");
__device__ __forceinline__ void gla_chain_unit(Frame& F, int b, int h, int qd) {
    const int tid = tid_now(), lane = tid & 63, w = F.wave, r32 = lane & 31, hi = lane >> 5;
    const bool helper = w >= 4; const int htid = tid - 256;
    const bf16* GQ = (const bf16*)(F.ws + WS_GQ2); const bf16* KET = (const bf16*)(F.ws + WS_KET); const bf16* ATT = (const bf16*)(F.ws + WS_ATT);
    const float* DEC = (const float*)(F.ws + WS_DEC); const bf16* GV = (const bf16*)(F.ws + WS_GV); bf16* ORAW = (bf16*)(F.ws + WS_XN);
    LAS unsigned char* L = F.lds;
    if (helper) {
        v4u st[23];
#define CH_LOADS(nn) do { const int ch_ = (b * 64 + (nn)) * 4 + h; const int t0_ = b * SEQ + 64 * (nn); \
            _Pragma("unroll") for (int i = 0; i < 8; ++i) { const int id = htid + 256 * i; st[i] = *(const GAS v4u*)(GQ + (size_t)(t0_ + (id >> 5)) * 1024 + h * 256 + 8 * (id & 31)); } \
            _Pragma("unroll") for (int i = 0; i < 8; ++i) { const int id = htid + 256 * i; st[8 + i] = *(const GAS v4u*)(KET + ((size_t)ch_ * 256 + (id >> 3)) * 64 + 8 * (id & 7)); } \
            _Pragma("unroll") for (int i = 0; i < 2; ++i) { const int id = htid + 256 * i; st[16 + i] = *(const GAS v4u*)(ATT + ((size_t)ch_ * 64 + (id >> 3)) * 64 + 8 * (id & 7)); } \
            _Pragma("unroll") for (int i = 0; i < 4; ++i) { const int id = htid + 256 * i; st[19 + i] = *(const GAS v4u*)(GV + (size_t)(t0_ + (id >> 4)) * 2048 + h * 512 + qd * 128 + 8 * (id & 15)); } \
            st[18] = *(const GAS v4u*)(DEC + (size_t)ch_ * 256 + 4 * (htid & 63)); } while (0)
        CH_LOADS(0);
        for (int n = 0; n < 64; ++n) {
#pragma unroll
            for (int i = 0; i < 8; ++i) { const int id = htid + 256 * i; *(LAS v4u*)(L + CH_QT + (id >> 5) * CH_QP + 16 * (id & 31)) = st[i]; }
#pragma unroll
            for (int i = 0; i < 8; ++i) { const int id = htid + 256 * i; *(LAS v4u*)(L + CH_KE + (id >> 3) * CH_KP + 16 * (id & 7)) = st[8 + i]; }
#pragma unroll
            for (int i = 0; i < 2; ++i) { const int id = htid + 256 * i; *(LAS v4u*)(L + CH_AT + (id >> 3) * CH_KP + 16 * (id & 7)) = st[16 + i]; }
#pragma unroll
            for (int i = 0; i < 4; ++i) { const int id = htid + 256 * i; *(LAS v4u*)(L + CH_VS + att::v_st(id >> 4, 8 * (id & 15))) = st[19 + i]; }
            if (htid < 64) *(LAS v4u*)(L + CH_DC + 16 * htid) = st[18];
            __syncthreads();
            if (n + 1 < 64) CH_LOADS(n + 1);
            __syncthreads();
        }
#undef CH_LOADS
    } else {
        f32x16 S[8];
#pragma unroll
        for (int i = 0; i < 8; ++i)
#pragma unroll
            for (int r = 0; r < 16; ++r) S[i][r] = 0.f;
        for (int n = 0; n < 64; ++n) {
            __syncthreads();
            const int t0 = b * SEQ + 64 * n;
            bf16x8 vc[4];
#pragma unroll
            for (int s = 0; s < 4; ++s) { const LAS unsigned char* vp = L + CH_VS + att::v_rd_base(lane) + w * 512 + s * 4096;
                const s16x4 lo = __builtin_bit_cast(s16x4, __builtin_amdgcn_ds_read_tr16_b64_v4i16((LAS v4i16_t*)vp)), hh = __builtin_bit_cast(s16x4, __builtin_amdgcn_ds_read_tr16_b64_v4i16((LAS v4i16_t*)(vp + 2048)));
                vc[s] = (bf16x8){lo[0], lo[1], lo[2], lo[3], hh[0], hh[1], hh[2], hh[3]}; }
            f32x16 O[2];
#pragma unroll
            for (int r = 0; r < 16; ++r) { O[0][r] = 0.f; O[1][r] = 0.f; }
#pragma unroll
            for (int mt = 0; mt < 8; ++mt)
#pragma unroll
                for (int sp = 0; sp < 2; ++sp) {
                    const bf16x8 bs = pack8f(S[mt][8 * sp], S[mt][8 * sp + 1], S[mt][8 * sp + 2], S[mt][8 * sp + 3], S[mt][8 * sp + 4], S[mt][8 * sp + 5], S[mt][8 * sp + 6], S[mt][8 * sp + 7]);
#pragma unroll
                    for (int mc = 0; mc < 2; ++mc) {
                        const LAS unsigned char* ap = L + CH_QT + (32 * mc + r32) * CH_QP + (32 * mt + 16 * sp + 4 * hi) * 2;
                        const s16x4 lo = *(const LAS s16x4*)ap, hh = *(const LAS s16x4*)(ap + 16);
                        const bf16x8 a = {lo[0], lo[1], lo[2], lo[3], hh[0], hh[1], hh[2], hh[3]};
                        O[mc] = __builtin_amdgcn_mfma_f32_32x32x16_bf16(a, bs, O[mc], 0, 0, 0);
                    }
                }
#pragma unroll
            for (int s = 0; s < 4; ++s)
#pragma unroll
                for (int mc = 0; mc < 2; ++mc) { const bf16x8 a = *(const LAS bf16x8*)(L + CH_AT + (32 * mc + r32) * CH_KP + (16 * s + 8 * hi) * 2); O[mc] = __builtin_amdgcn_mfma_f32_32x32x16_bf16(a, vc[s], O[mc], 0, 0, 0); }
            bf16* rowbase = ORAW + (size_t)t0 * 2048 + h * 512 + qd * 128 + 32 * w;
            const unsigned loff = (unsigned)(r32 + hi * 4 * 2048);
#pragma unroll
            for (int mc = 0; mc < 2; ++mc)
#pragma unroll
                for (int r = 0; r < 16; ++r) { const float v = O[mc][r], vn = __shfl_xor(v, 1);
                    if ((r32 & 1) == 0) *(unsigned*)(rowbase + (32 * mc + (r & 3) + 8 * (r >> 2)) * 2048 + loff) = cvtpk_s(v, vn); }
#pragma unroll
            for (int mt = 0; mt < 8; ++mt) {
#pragma unroll
                for (int j = 0; j < 4; ++j) { const f32x4 d4 = *(const LAS f32x4*)(L + CH_DC + (32 * mt + 8 * j + 4 * hi) * 4);
                    S[mt][4 * j] *= d4.x; S[mt][4 * j + 1] *= d4.y; S[mt][4 * j + 2] *= d4.z; S[mt][4 * j + 3] *= d4.w; }
#pragma unroll
                for (int s = 0; s < 4; ++s) { const bf16x8 a = *(const LAS bf16x8*)(L + CH_KE + (32 * mt + r32) * CH_KP + (16 * s + 8 * hi) * 2); S[mt] = __builtin_amdgcn_mfma_f32_32x32x16_bf16(a, vc[s], S[mt], 0, 0, 0); }
            }
            __syncthreads();
        }
    }
}

__device__ __forceinline__ void mix_row(Frame& F, int t, int lane) {
    const bf16* ORAW = (const bf16*)(F.ws + WS_XN); const bf16* GR = (const bf16*)(F.ws + WS_GR); const bf16* OC = (const bf16*)(F.ws + WS_OC); const float* LSE = (const float*)(F.ws + WS_LSE);
    bf16* MIX = (bf16*)(F.ws + WS_MIX);
#pragma unroll
    for (int h = 0; h < 4; ++h) {
        const v4u ow = *(const GAS v4u*)(ORAW + (size_t)t * 2048 + h * 512 + 8 * lane); const f32x4 o0 = {bflo(ow.x), bfhi(ow.x), bflo(ow.y), bfhi(ow.y)}, o1 = {bflo(ow.z), bfhi(ow.z), bflo(ow.w), bfhi(ow.w)};
        const float ss = wave_sum((o0.x * o0.x + o0.y * o0.y) + (o0.z * o0.z + o0.w * o0.w) + (o1.x * o1.x + o1.y * o1.y) + (o1.z * o1.z + o1.w * o1.w));
        const float r = __builtin_amdgcn_rsqf(ss * (1.0f / 512.0f) + RMS_EPS);
        const GAS f32x4* gp = (const GAS f32x4*)F.kin[7] + 2 * lane; const f32x4 g0 = gp[0], g1 = gp[1];
        const v4u gw = *(const GAS v4u*)(GR + (size_t)t * 2048 + h * 512 + 8 * lane);
        float y[8] = {o0.x * r * g0.x, o0.y * r * g0.y, o0.z * r * g0.z, o0.w * r * g0.w, o1.x * r * g1.x, o1.y * r * g1.y, o1.z * r * g1.z, o1.w * r * g1.w};
        const float gv[8] = {bflo(gw.x), bfhi(gw.x), bflo(gw.y), bfhi(gw.y), bflo(gw.z), bfhi(gw.z), bflo(gw.w), bfhi(gw.w)};
#pragma unroll
        for (int e = 0; e < 8; ++e) y[e] *= gv[e] * __builtin_amdgcn_rcpf(1.0f + __expf(-gv[e]));
        v4u o = {pk2(y[0], y[1]), pk2(y[2], y[3]), pk2(y[4], y[5]), pk2(y[6], y[7])};
        *(GAS v4u*)(MIX + (size_t)t * DM + h * 512 + 8 * lane) = o;
    }
    {
        const int hd = lane >> 2;
        float m2[3], l[3];
#pragma unroll
        for (int c = 0; c < 3; ++c) { const f32x2 v = *(const GAS f32x2*)(LSE + (((size_t)c * M + t) * 16 + hd) * 2); m2[c] = v.x; l[c] = v.y; }
        const float mx = fmaxf(m2[0], fmaxf(m2[1], m2[2]));
        float wgt[3]; float den = 0.f;
#pragma unroll
        for (int c = 0; c < 3; ++c) { wgt[c] = __builtin_amdgcn_exp2f(m2[c] - mx) * l[c]; den += wgt[c]; }
        const float rden = __builtin_amdgcn_rcpf(den);
        float acc[32];
#pragma unroll
        for (int e = 0; e < 32; ++e) acc[e] = 0.f;
#pragma unroll
        for (int c = 0; c < 3; ++c) { const float wc = wgt[c] * rden; const GAS v4u* p = (const GAS v4u*)(OC + (size_t)c * M * 2048 + ((size_t)((t >> 12) * 16 + hd) * SEQ + (t & 4095)) * 128 + 32 * (lane & 3));
#pragma unroll
            for (int q = 0; q < 4; ++q) { const v4u v = p[q];
                acc[8 * q + 0] += wc * bflo(v.x); acc[8 * q + 1] += wc * bfhi(v.x); acc[8 * q + 2] += wc * bflo(v.y); acc[8 * q + 3] += wc * bfhi(v.y);
                acc[8 * q + 4] += wc * bflo(v.z); acc[8 * q + 5] += wc * bfhi(v.z); acc[8 * q + 6] += wc * bflo(v.w); acc[8 * q + 7] += wc * bfhi(v.w); } }
        GAS v4u* op = (GAS v4u*)(MIX + (size_t)t * DM + 2048 + 32 * lane);
#pragma unroll
        for (int q = 0; q < 4; ++q) { v4u o = {pk2(acc[8 * q], acc[8 * q + 1]), pk2(acc[8 * q + 2], acc[8 * q + 3]), pk2(acc[8 * q + 4], acc[8 * q + 5]), pk2(acc[8 * q + 6], acc[8 * q + 7])}; op[q] = o; }
    }
}
__device__ __forceinline__ void halo_fix(Frame& F) {
    const int tid = tid_now();
    const float* GF = (const float*)(F.ws + WS_HALO); const float* UF = GF + HALO_ONE / 4; const float* GL = UF + HALO_ONE / 4;
    bf16* ACT = (bf16*)(F.ws + WS_ACT); const float* cw = F.kin[18]; const float* cb = F.kin[19]; const unsigned* colmax = (const unsigned*)(F.ws + WS_CTL + CTL_COLMAX);
    const int total = 256 * 2 * (DFF / 4);
    for (int i = blockIdx.x * 512 + tid; i < total; i += F.G * 512) {
        const int c4 = i % (DFF / 4), j = (i / (DFF / 4)) & 1, blk = i / (DFF / 2), ch = 4 * c4;
        const bool first = (blk & 63) == 0;
        const f32x4 g0 = *(const GAS f32x4*)(GF + ((size_t)blk * 2 + j) * DFF + ch), uu = *(const GAS f32x4*)(UF + ((size_t)blk * 2 + j) * DFF + ch);
        const f32x4 z = {0.f, 0.f, 0.f, 0.f};
        f32x4 g1, g2;
        if (j == 0) { g1 = first ? z : *(const GAS f32x4*)(GL + ((size_t)(blk - 1) * 2 + 1) * DFF + ch); g2 = first ? z : *(const GAS f32x4*)(GL + ((size_t)(blk - 1) * 2 + 0) * DFF + ch); }
        else { g1 = *(const GAS f32x4*)(GF + ((size_t)blk * 2 + 0) * DFF + ch); g2 = first ? z : *(const GAS f32x4*)(GL + ((size_t)(blk - 1) * 2 + 1) * DFF + ch); }
        const f32x4 w0 = *(const GAS f32x4*)(cw + ch), w1 = *(const GAS f32x4*)(cw + DFF + ch), w2 = *(const GAS f32x4*)(cw + 2 * DFF + ch), bb = *(const GAS f32x4*)(cb + ch);
        float a[4];
#pragma unroll
        for (int e = 0; e < 4; ++e) { const float sg = FFN_I8 ? __uint_as_float(colmax[ch + e]) * (1.0f / 127.0f) : 1.0f;
            const float y = bb[e] + sg * (w0[e] * g2[e] + w1[e] * g1[e] + w2[e] * g0[e]); a[e] = y / (1.0f + __expf(-y)) * (uu[e] * -1.4426950408889634f); }
        v2u o = {pk2(a[0], a[1]), pk2(a[2], a[3])};
        *(GAS v2u*)(ACT + (size_t)(64 * blk + j) * DFF + ch) = o;
    }
}
__device__ __forceinline__ void final_norm_row(Frame& F, int t, int lane) {
    const GAS v4u* hr = (const GAS v4u*)((const bf16*)(F.ws + WS_XN) + (size_t)t * DM) + lane; GAS f32x4* xr = (GAS f32x4*)(F.out + (size_t)t * DM) + 2 * lane; const GAS f32x4* gr = (const GAS f32x4*)F.kin[21] + 2 * lane;
    v4u w[8]; float s = 0.f;
#pragma unroll
    for (int j = 0; j < 8; ++j) { w[j] = NTLD(hr + 64 * j);
        const float a0 = bflo(w[j].x), a1 = bfhi(w[j].x), a2 = bflo(w[j].y), a3 = bfhi(w[j].y), a4 = bflo(w[j].z), a5 = bfhi(w[j].z), a6 = bflo(w[j].w), a7 = bfhi(w[j].w);
        s += ((a0 * a0 + a1 * a1) + (a2 * a2 + a3 * a3)) + ((a4 * a4 + a5 * a5) + (a6 * a6 + a7 * a7)); }
    const float r = 1.0f / sqrtf(wave_sum(s) * (1.0f / 4096.0f) + RMS_EPS);
#pragma unroll
    for (int j = 0; j < 8; ++j) { const f32x4 g0 = gr[128 * j], g1 = gr[128 * j + 1];
        xr[128 * j] = (f32x4){bflo(w[j].x) * r * g0.x, bfhi(w[j].x) * r * g0.y, bflo(w[j].y) * r * g0.z, bfhi(w[j].y) * r * g0.w};
        xr[128 * j + 1] = (f32x4){bflo(w[j].z) * r * g1.x, bfhi(w[j].z) * r * g1.y, bflo(w[j].w) * r * g1.z, bfhi(w[j].w) * r * g1.w}; }
}

__device__ __forceinline__ void quant_row(Frame& F, int t, int lane) {
    unsigned* amax = (unsigned*)(F.ws + WS_CTL + CTL_AMAX);
    const GAS v4u* hr = (const GAS v4u*)((const bf16*)(F.ws + WS_XN) + (size_t)t * DM) + lane; GAS v2u* qr = (GAS v2u*)((signed char*)(F.ws + WS_H2Q) + (size_t)t * DM) + lane;
    v4u w[8]; unsigned mb = 0u;
#pragma unroll
    for (int j = 0; j < 8; ++j) { w[j] = hr[64 * j];
        const unsigned a0 = w[j].x & 0x7fff7fffu, a1 = w[j].y & 0x7fff7fffu, a2 = w[j].z & 0x7fff7fffu, a3 = w[j].w & 0x7fff7fffu;
        mb = max(mb, max(max(a0 & 0xffffu, a0 >> 16), max(a1 & 0xffffu, a1 >> 16))); mb = max(mb, max(max(a2 & 0xffffu, a2 >> 16), max(a3 & 0xffffu, a3 >> 16))); }
    mb = wave_maxu(mb);
    const float am = __uint_as_float(mb << 16); const float inv = am > 0.f ? 127.0f / am : 0.f;
    float s2 = 0.f;
#pragma unroll
    for (int j = 0; j < 8; ++j) { const float a0 = bflo(w[j].x), a1 = bfhi(w[j].x), a2 = bflo(w[j].y), a3 = bfhi(w[j].y), a4 = bflo(w[j].z), a5 = bfhi(w[j].z), a6 = bflo(w[j].w), a7 = bfhi(w[j].w);
        s2 += ((a0 * a0 + a1 * a1) + (a2 * a2 + a3 * a3)) + ((a4 * a4 + a5 * a5) + (a6 * a6 + a7 * a7)); }
    s2 = wave_sum(s2);
    if (lane == 0) { amax[t] = __float_as_uint(am); ((unsigned long long*)(F.ws + WS_CTL + CTL_SS))[(size_t)M + t] = (unsigned long long)(s2 * 1048576.0f + 0.5f); }
#pragma unroll
    for (int j = 0; j < 8; ++j) {
        qr[64 * j] = (v2u){q8x4(bflo(w[j].x), bfhi(w[j].x), bflo(w[j].y), bfhi(w[j].y), inv), q8x4(bflo(w[j].z), bfhi(w[j].z), bflo(w[j].w), bfhi(w[j].w), inv)}; }
}
typedef att::BlockRef<att::bf16, att::bf16> ABlk;
__device__ __forceinline__ ABlk dil_item(unsigned char* ws, int L) {
    const int bh = L / 48, rem = L - 48 * bh, cfg = rem >> 4, x = rem & 15, h = bh & 15, b = bh >> 4;
    const int d = cfg == 0 ? 1 : (cfg == 1 ? 4 : 16);
    const int r = cfg == 0 ? 0 : (cfg == 1 ? (x >> 2) : x), qb = cfg == 0 ? x : (cfg == 1 ? (x & 3) : 0);
    const att::bf16* DQ = (const att::bf16*)(ws + WS_DQKV); const att::bf16* DK = DQ + (size_t)M * 2048; const att::bf16* DV = DK + (size_t)M * 2048;
    const int sq = r + d * 256 * qb, tq = b * SEQ + sq; const size_t hb = (size_t)(b * 16 + h) * SEQ;
    ABlk R;
    R.Q = DQ + (hb + sq) * 128; R.K = DK + (hb + r) * 128; R.V = DV + (hb + r) * 128;
    R.O = (att::bf16*)(ws + WS_OC) + ((size_t)cfg * M * 2048) + (hb + sq) * 128;
    R.L = (float*)(ws + WS_LSE) + (((size_t)cfg * M + tq) * 16 + h) * 2;
    R.bsrc = (const float*)(ws + WS_BT) + (cfg * 16 + h) * 132;
    R.P0 = 256 * qb; R.pq = 128 * d; R.pk = 128 * d; R.po = 128 * d; R.pl = 32 * d; R.skv = SEQ / d; R.W = 129;
    return R;
}
__device__ __forceinline__ ABlk xat_item(unsigned char* ws, int L) {
    const int qb = L & 15, h = (L >> 4) & 3, b = L >> 6;
    const att::bf16* XQ = (const att::bf16*)(ws + WS_XQ); const att::bf16* XKV = (const att::bf16*)(ws + WS_XKV);
    ABlk R;
    R.Q = XQ + (size_t)(b * SEQ + 256 * qb) * XW + h * 128; R.K = XKV + (size_t)(b * MEMLEN) * 1024 + h * 128; R.V = R.K + 512;
    R.O = (att::bf16*)(ws + WS_XO) + (size_t)(b * SEQ + 256 * qb) * XW + h * 128; R.L = nullptr; R.bsrc = nullptr;
    R.P0 = 1 << 20; R.pq = XW; R.pk = 1024; R.po = XW; R.pl = 0; R.skv = MEMLEN; R.W = 1 << 30;
    return R;
}

#ifndef PG_ALIGN
#define PG_ALIGN true
#endif
#ifndef PG_SP2
#define PG_SP2 true
#endif
struct Args { const float* in[22]; float* out; unsigned char* ws; int ph_lo, ph_hi; };
__global__ void __launch_bounds__(NWAVES * 64, 2) hybrid_fwd(Args args) {
    extern __shared__ __attribute__((aligned(16))) unsigned char lds[];
    Frame F;
    F.lds = (LAS unsigned char*)lds; F.ldsg = (char*)lds;
    F.MISC = (volatile LAS unsigned*)(F.lds + MISC_OFF);
    F.wave = __builtin_amdgcn_readfirstlane((int)threadIdx.x >> 6);
    F.G = gridDim.x; { const int bx = blockIdx.x; F.vcu = (F.G % 8 == 0) ? (bx % 8) * (F.G / 8) + bx / 8 : bx; }
    F.ws = args.ws; F.ctl = (gu32*)(args.ws + WS_CTL); F.out = args.out;
    F.kin = (const float* const __attribute__((address_space(4)))*)__builtin_amdgcn_kernarg_segment_ptr();
    if (threadIdx.x < 64) F.MISC[threadIdx.x] = 0u;
    __syncthreads();
    XcdBarrier bar; bar.bar = (unsigned*)(F.ctl + CW_BAR); bar.x = 0; bar.st = nullptr;
    if (N_LAUNCHES == 1) bar = xcd_barrier_post((unsigned*)(F.ctl + CW_BAR), F.MISC + 8);
#define GRID_BAR() do { if (N_LAUNCHES == 1) xcd_barrier(bar); } while (0)
    const int lo = args.ph_lo, hi = args.ph_hi;
#ifndef PH_MASK
#define PH_MASK 0x1fff
#endif
#define IN(k) ((((PH_MASK) >> (k)) & 1) && lo <= (k) && (k) < hi)
#define BOTH(k) (IN(k) && IN((k) + 1))
#ifndef DUPMASK
#define DUPMASK 0
#endif
#ifndef XBAR
#define XBAR 0
#endif
#define DUPK(k, ...) { __VA_ARGS__ } if constexpr ((((DUPMASK) >> (k)) & 1) != 0) { __syncthreads(); { __VA_ARGS__ } }
#define GRID_BARX() do { GRID_BAR(); if constexpr (XBAR != 0) GRID_BAR(); } while (0)
    unsigned long long* SS1 = (unsigned long long*)(F.ws + WS_CTL + CTL_SS); unsigned long long* SS2 = SS1 + M; unsigned long long* SS3 = SS2 + M;
    const int gw = F.vcu * NWAVES + F.wave, NGW = F.G * NWAVES;

    if (IN(0)) { DUPK(0, p0_first_token(F); p0_prologue(F);) GRID_BAR(); p0_quant_win(F);
#ifdef DUP_P0FT
        __syncthreads(); p0_first_token(F); __syncthreads(); p0_first_token(F); __syncthreads(); p0_first_token(F); __syncthreads(); p0_first_token(F);
#endif
        if (BOTH(0)) GRID_BARX(); }
    if (IN(1)) {
        { pg8::Gemm g{(const bf16*)(F.ws + WS_XN), (const bf16*)(F.ws + WS_WIN), M, NB1, DM}; pg8::StaticOrder S; S.init(M, NB1, F.G, (int)blockIdx.x);
          pg8::EpiProj E{(bf16*)(F.ws + WS_GQ), (bf16*)(F.ws + WS_GK), (bf16*)(F.ws + WS_GV), (bf16*)(F.ws + WS_GR), (bf16*)(F.ws + WS_DQKV), GV_I8 ? 0 : 2048};
          pg8::gemm_phase<pg8::EpiProj, pg8::StaticOrder, PG_ALIGN, PG_SP2>(F.lds, g, S, E);
          { pg8::Gemm gq{(const bf16*)(F.ws + WS_XNQ), (const bf16*)(F.ws + WS_WINQ), M, NQ1, DM / 2}; pg8::StaticOrder Sq; Sq.init(M, NQ1, F.G, (int)blockIdx.x);
            pg8::EpiProjQ Eq{(bf16*)(F.ws + WS_DQKV), (const float*)(F.ws + WS_RSC1), (const unsigned*)(F.ws + WS_CTL + CTL_CMAX1), (bf16*)(F.ws + WS_GV), GV_I8 ? 2048 : 0};
            pg8::gemm_phase<pg8::EpiProjQ, pg8::StaticOrder, PG_ALIGN, PG_SP2>(F.lds, gq, Sq, Eq); }
#ifdef DUP_P1NULL
          { pg8::EpiNull E0{}; pg8::Gemm g2{(const bf16*)(F.ws + WS_XN), (const bf16*)(F.ws + WS_WIN), M, 3072, DM}; pg8::StaticOrder S2; S2.init(M, 3072, F.G, (int)blockIdx.x); pg8::gemm_phase<pg8::EpiNull, pg8::StaticOrder, PG_ALIGN, PG_SP2>(F.lds, g2, S2, E0); pg8::gemm_phase<pg8::EpiNull, pg8::StaticOrder, PG_ALIGN, PG_SP2>(F.lds, g2, S2, E0); pg8::gemm_phase<pg8::EpiNull, pg8::StaticOrder, PG_ALIGN, PG_SP2>(F.lds, g2, S2, E0); pg8::gemm_phase<pg8::EpiNull, pg8::StaticOrder, PG_ALIGN, PG_SP2>(F.lds, g2, S2, E0); }
#endif
          }
        if (BOTH(1)) GRID_BARX();
    }
    if (IN(2)) { DUPK(2, for (int u = blockIdx.x; u < NB * 64; u += F.G) gla_prep_unit(F, u >> 6, u & 63);) if (BOTH(2)) GRID_BARX(); }
    if (IN(3)) {
#ifdef PRE_ATT_VARIANT
        {
            gu32* qctr = F.ctl + CW_QUEUE + 64;
#define NEXT_ITEM(dst) do { if (tid_now() == 0) F.MISC[16] = __hip_atomic_fetch_add(qctr, 1u, RLX_AGENT); __syncthreads(); dst = __builtin_amdgcn_readfirstlane((int)F.MISC[16]); __syncthreads(); } while (0)
            int L; NEXT_ITEM(L);
            if (L < 3072) {
                ABlk cur = dil_item(F.ws, L); att::Seam<att::bf16> S; int par = 0;
                att::causal_swa_prime<PRE_ATT_VARIANT, att::bf16, att::bf16>(cur, F.ldsg, S);
                unsigned char* const wsp = F.ws; auto itf = [wsp](int l) { return dil_item(wsp, l); };
                for (;;) { int Ln; NEXT_ITEM(Ln); const bool last = Ln >= 3072; const int Lx = last ? L : Ln;
                    att::causal_swa_block<PRE_ATT_VARIANT, att::bf16, att::bf16>(cur, Lx, itf, par, F.ldsg, S);
                    if (last) break; L = Ln; cur = dil_item(F.ws, L); par ^= 1; }
            }
#undef NEXT_ITEM
            __syncthreads();
        }
#endif
        if ((int)blockIdx.x < 64) gla_chain_unit(F, blockIdx.x >> 4, (blockIdx.x >> 2) & 3, blockIdx.x & 3);
        {
            gu32* qctr = F.ctl + CW_QUEUE;
#define NEXT_ITEM(dst) do { if (tid_now() == 0) F.MISC[16] = __hip_atomic_fetch_add(qctr, 1u, RLX_AGENT); __syncthreads(); dst = __builtin_amdgcn_readfirstlane((int)F.MISC[16]); __syncthreads(); } while (0)
            int L; NEXT_ITEM(L);
            if (L < 3072) {
                ABlk cur = dil_item(F.ws, L); att::Seam<att::bf16> S; int par = 0;
                att::causal_swa_prime<1, att::bf16, att::bf16>(cur, F.ldsg, S);
                unsigned char* const wsp = F.ws; auto itf = [wsp](int l) { return dil_item(wsp, l); };
                for (;;) { int Ln; NEXT_ITEM(Ln); const bool last = Ln >= 3072; const int Lx = last ? L : Ln;
                    att::causal_swa_block<1, att::bf16, att::bf16>(cur, Lx, itf, par, F.ldsg, S);
                    if (last) break; L = Ln; cur = dil_item(F.ws, L); par ^= 1; }
            }
#undef NEXT_ITEM
        }
#ifdef DUP_CHAIN
        __syncthreads(); if ((int)blockIdx.x < 64) gla_chain_unit(F, blockIdx.x >> 4, (blockIdx.x >> 2) & 3, blockIdx.x & 3);
#endif
        if (BOTH(3)) GRID_BARX();
    }
    if (IN(4)) {
        { const int lane = tid_now() & 63; for (int t = gw; t < M; t += NGW) mix_row(F, t, lane); }
        ffn_weights<0>(F, 2 * FW_IG, FW_P9_LO, gw, NGW);
        if constexpr (FFN_I8) { ffn_weights<1>(F, 0, 2 * FW_IG, gw, NGW); GRID_BAR(); }
        ffn_weights<0>(F, 0, FW_P6_LO, gw, NGW);
        if (BOTH(4)) GRID_BARX(); }
    if (IN(5)) {
        pg8::Gemm g{(const bf16*)(F.ws + WS_MIX), (const bf16*)(F.ws + WS_WOUT), M, DM, DM}; pg8::StaticOrder S; S.init(M, DM, F.G, (int)blockIdx.x);
        pg8::EpiResid E{F.kin[0], nullptr, (bf16*)(F.ws + WS_XN), SS1, DM, nullptr};
        pg8::gemm_phase<pg8::EpiResid, pg8::StaticOrder, PG_ALIGN, PG_SP2>(F.lds, g, S, E);
#ifdef DUP_P5
        { pg8::EpiResid E2{F.kin[0], nullptr, (bf16*)(F.ws + WS_XN), nullptr, DM, nullptr}; pg8::gemm_phase<pg8::EpiResid, pg8::StaticOrder, PG_ALIGN, PG_SP2>(F.lds, g, S, E2); }
#endif
        if (BOTH(5)) GRID_BARX();
    }
    if (IN(6)) {
        DUPK(6,
        if ((int)blockIdx.x < 128 || F.G < 144) {
        pg8::Gemm g{(const bf16*)(F.ws + WS_XN), (const bf16*)(F.ws + WS_WXQ), M, XW, DM}; pg8::StaticOrder S; S.init(M, XW, F.G < 144 ? F.G : 128, (int)blockIdx.x);
        pg8::EpiScaleBf16 E{(bf16*)(F.ws + WS_XQ), XW, SS1, 1.0f / 4096.0f};
        pg8::gemm_phase<pg8::EpiScaleBf16, pg8::StaticOrder, PG_ALIGN, PG_SP2>(F.lds, g, S, E);
        }
        if ((int)blockIdx.x >= 128 || F.G < 144) {
        pg8::Gemm g{(const bf16*)(F.ws + WS_MEMN), (const bf16*)(F.ws + WS_WXKV), MROWS, 1024, DM}; pg8::StaticOrder S; S.init(MROWS, 1024, F.G < 144 ? F.G : F.G - 128, F.G < 144 ? (int)blockIdx.x : (int)blockIdx.x - 128);
        pg8::EpiScaleBf16 E{(bf16*)(F.ws + WS_XKV), 1024, nullptr, 0.f};
        pg8::gemm_phase<pg8::EpiScaleBf16, pg8::StaticOrder, PG_ALIGN, PG_SP2>(F.lds, g, S, E);
        }
        if (F.G >= 256) { if ((int)blockIdx.x >= 144) ffn_weights<0>(F, FW_P6_LO, FW_P6_HI, ((int)blockIdx.x - 144) * NWAVES + F.wave, (F.G - 144) * NWAVES); }
        else ffn_weights<0>(F, FW_P6_LO, FW_P6_HI, gw, NGW);
        )
        if (BOTH(6)) GRID_BARX();
    }
    if (IN(7)) {
        DUPK(7,
        if ((int)blockIdx.x < 256) {
            int L = blockIdx.x; ABlk cur = xat_item(F.ws, L); att::Seam<att::bf16> S; int par = 0;
            att::causal_swa_prime<0, att::bf16, att::bf16>(cur, F.ldsg, S);
            unsigned char* const wsp = F.ws; auto itf = [wsp](int l) { return xat_item(wsp, l); };
            for (;;) { const int Ln = L + F.G; const bool last = Ln >= 256; const int Lx = last ? L : Ln;
                att::causal_swa_block<0, att::bf16, att::bf16>(cur, Lx, itf, par, F.ldsg, S);
                if (last) break; L = Ln; cur = xat_item(F.ws, L); par ^= 1; }
        }
        )
        if (BOTH(7)) GRID_BARX();
    }
    if (IN(8)) {
        pg8::Gemm g{(const bf16*)(F.ws + WS_XO), (const bf16*)(F.ws + WS_WXO), M, DM, XW}; pg8::StaticOrder S; S.init(M, DM, F.G, (int)blockIdx.x);
        pg8::EpiResid E{nullptr, (const bf16*)(F.ws + WS_XN), (bf16*)(F.ws + WS_XN), FFN_I8 ? nullptr : SS2, DM, nullptr};
        pg8::gemm_phase<pg8::EpiResid, pg8::StaticOrder, PG_ALIGN, PG_SP2>(F.lds, g, S, E);
        if constexpr (FFN_I8) { GRID_BAR(); const int lane = tid_now() & 63; for (int t = gw; t < M; t += NGW) quant_row(F, t, lane); }
        if (BOTH(8)) GRID_BARX();
    }
    if (IN(9)) {
        DUPK(9,
        typedef pg8::EpiGateUpT<FFN_I8 != 0> EpiGU;
        pg8::Gemm g{(const bf16*)(F.ws + (FFN_I8 ? WS_H2Q : WS_XN)), (const bf16*)(F.ws + WS_WGU), M, NGU, FFN_I8 ? DM / 2 : DM};
        const int G9 = (F.G == 256 && P9_GEMM_WGS > 0) ? P9_GEMM_WGS : F.G;
        pg8::StaticOrder S; S.init(M, NGU, G9, (int)blockIdx.x);
        float* GF = (float*)(F.ws + WS_HALO);
        EpiGU E{(bf16*)(F.ws + WS_ACT), DFF, SS2, 1.0f / 4096.0f, F.kin[18], F.kin[19], GF, GF + HALO_ONE / 4, GF + 2 * (HALO_ONE / 4), DFF, (LAS float*)(F.lds + 131072),
                (const unsigned*)(F.ws + WS_CTL + CTL_COLMAX), (const unsigned*)(F.ws + WS_CTL + CTL_AMAX)};
        if ((int)blockIdx.x < G9) pg8::gemm_phase<EpiGU, pg8::StaticOrder, PG_ALIGN, PG_SP2>(F.lds, g, S, E);
        if (G9 < F.G) { if ((int)blockIdx.x >= G9) ffn_weights<0>(F, FW_P9_LO, FW_P9_HI, ((int)blockIdx.x - G9) * NWAVES + F.wave, (F.G - G9) * NWAVES); }
        else if (F.G == 256) { if ((int)blockIdx.x >= 128) ffn_weights<0>(F, FW_P9_LO, FW_P9_HI, ((int)blockIdx.x - 128) * NWAVES + F.wave, 128 * NWAVES); }
        else ffn_weights<0>(F, FW_P9_LO, FW_P9_HI, gw, NGW);
        )
        if (BOTH(9)) GRID_BARX();
    }
    if (IN(10)) { DUPK(10, halo_fix(F);) if (BOTH(10)) GRID_BARX(); }
    if (IN(11)) {
        pg8::Gemm g{(const bf16*)(F.ws + WS_ACT), (const bf16*)(F.ws + WS_WDN), M, DM, DFF}; pg8::StaticOrder S; S.init(M, DM, F.G, (int)blockIdx.x);
        pg8::EpiResid E{nullptr, (const bf16*)(F.ws + WS_XN), (bf16*)(F.ws + WS_XN), nullptr, DM, nullptr};
        pg8::gemm_phase<pg8::EpiResid, pg8::StaticOrder, PG_ALIGN, PG_SP2>(F.lds, g, S, E);
        if (BOTH(11)) GRID_BARX();
    }
    if (IN(12)) { DUPK(12, const int lane = tid_now() & 63; for (int t = gw; t < M; t += NGW) final_norm_row(F, t, lane);)
    }
#undef IN
#undef BOTH
#undef GRID_BAR
}

extern "C" void kernel_launch(void* const* d_in, const int* in_sizes, int n_in, void* d_out, int out_size, void* d_ws, size_t ws_size, hipStream_t stream) {
    static int grid = 0;
    if (grid == 0) {
        if (n_in != 22 || in_sizes[0] != M * DM || out_size != M * DM || ws_size < WS_END) { fprintf(stderr, "kernel_launch: unexpected shapes (n_in %d, in0 %d, out %d, ws %zu)\n", n_in, n_in > 0 ? in_sizes[0] : -1, out_size, ws_size); grid = -1; return; }
        int dev = 0, cus = 0, per_cu = 0;
        if (hipGetDevice(&dev) != hipSuccess || hipDeviceGetAttribute(&cus, hipDeviceAttributeMultiprocessorCount, dev) != hipSuccess) { grid = -1; return; }
        if (hipFuncSetAttribute((const void*)hybrid_fwd, hipFuncAttributeMaxDynamicSharedMemorySize, LDS_BYTES) != hipSuccess) { fprintf(stderr, "kernel_launch: hipFuncSetAttribute failed\n"); grid = -1; return; }
        if (hipOccupancyMaxActiveBlocksPerMultiprocessor(&per_cu, (const void*)hybrid_fwd, NWAVES * 64, LDS_BYTES) != hipSuccess || per_cu < 1) fprintf(stderr, "kernel_launch: occupancy query reports %d\n", per_cu);
        (void)hipGetLastError();
        grid = cus;
    }
    if (grid < 0) return;
    if (hipMemsetAsync((char*)d_ws + WS_CTL, 0, CTL_ZERO_BYTES, stream) != hipSuccess) return;
    Args a{};
    for (int i = 0; i < 22; ++i) a.in[i] = (const float*)d_in[i];
    a.out = (float*)d_out; a.ws = (unsigned char*)d_ws;
    for (int li = 0; li < N_LAUNCHES; ++li) {
        a.ph_lo = (N_LAUNCHES == 1) ? 0 : li; a.ph_hi = (N_LAUNCHES == 1) ? NPH : li + 1;
        hipLaunchKernelGGL(hybrid_fwd, dim3(grid), dim3(NWAVES * 64), LDS_BYTES, stream, a);
    }
}
```

```cpp
#include <hip/hip_runtime.h>
#include <hip/hip_bf16.h>
#include <cstdio>
#include <cstdint>
#include <cmath>
#define FW_P9N 9216
#include <type_traits>
#ifndef MK_N_LAUNCHES
#define MK_N_LAUNCHES 1
#endif
namespace pg8 {
#define PG8_LAS __attribute__((address_space(3)))
typedef unsigned short bf16_t;
typedef short bf16x8 __attribute__((ext_vector_type(8)));
typedef float f32x4 __attribute__((ext_vector_type(4)));
typedef unsigned u32x4 __attribute__((ext_vector_type(4)));
constexpr int BM = 256, BK = 64, HALF = 128, HTB = HALF * BK * 2  , STAGE_BYTES = 8 * HTB, NXCD = 8, WGM = 8;

__host__ __device__ __forceinline__ int lds_byte(int r, int c) { const int st = (r >> 4) * 2 + (c >> 5), rr = r & 15, cc = c & 31, ob = rr * 64 + cc * 2; return st * 1024 + (ob ^ (((ob >> 9) & 1) << 5)); }
__host__ __device__ __forceinline__ void stage_rc(int b, int& R, int& C) { const int st = b / 1024, sb = b % 1024, swz = sb ^ (((sb >> 9) & 1) << 5); R = (st >> 1) * 16 + swz / 64; C = (st & 1) * 32 + (swz % 64) / 2; }
__host__ __device__ __forceinline__ int perm32(int rho) { const int n = rho >> 4, i = rho & 15; return 8 * (i >> 2) + 4 * n + (i & 3); }

struct Unit { int pm, pn; };
struct Gemm { const bf16_t* A; const bf16_t* Bt; int M, N, K; };

struct StaticOrder {
    int nM, nN, nwg, G, c;
    __host__ __device__ void init(int M, int N, int G_, int c_) { nM = M / BM; nN = N / BM; nwg = nM * nN; G = G_; c = c_; }
    __host__ __device__ bool next(int i, Unit& u) const {
        const long L = (long)i * G + c; if (L >= nwg) return false;
        int wgid = (int)L; { const int q = nwg / NXCD, r = nwg % NXCD, xcd = wgid % NXCD, off = wgid / NXCD; wgid = (xcd < r ? xcd * (q + 1) : r * (q + 1) + (xcd - r) * q) + off; }
        const int nig = WGM * nN, gid = wgid / nig, fm = gid * WGM, gsz = (nM - fm) < WGM ? (nM - fm) : WGM;
        u.pm = fm + ((wgid % nig) % gsz); u.pn = (wgid % nig) / gsz; return true;
    }
    __device__ __forceinline__ void a_ready(const Unit&) const {}
    __device__ __forceinline__ void done(const Unit&) const {}
};

__device__ __forceinline__ unsigned cvt_pk_bf16(float lo, float hi) { unsigned r; asm volatile("v_cvt_pk_bf16_f32 %0, %1, %2" : "=v"(r) : "v"(lo), "v"(hi)); return r; }
typedef float f32x2 __attribute__((ext_vector_type(2)));
typedef unsigned u32x2 __attribute__((ext_vector_type(2)));
typedef int i32x4 __attribute__((ext_vector_type(4)));
typedef __bf16 bf16x2v __attribute__((ext_vector_type(2)));
__device__ __forceinline__ unsigned cvtpk_e(float lo, float hi) { f32x2 v = {lo, hi}; bf16x2v b = __builtin_convertvector(v, bf16x2v); return __builtin_bit_cast(unsigned, b); }
constexpr float RMS_EPS = 1e-6f;
constexpr float SS_SCALE = 1048576.0f;
__device__ __forceinline__ float rstd_of(const unsigned long long* ss, int row, float inv_n) { return 1.0f / sqrtf((float)ss[row] * (inv_n / SS_SCALE) + RMS_EPS); }

struct Seg { bf16_t* base; int ld; int col0; int pad; };
struct EpiProj {
    static constexpr bool PERM = true, PERMA = false, AFTER_DRAIN = false, PREFETCH = false, I8 = false; typedef f32x4 AccT; static constexpr int NST = 16;
    bf16_t *gq, *gk, *gv, *gr, *dqkv;
    int nv;
    __device__ __forceinline__ void operator()(const f32x4 (&acc)[2][2][4][2], const Unit& u, int wr, int wc, int fr, int fq) const {
        const int colt = u.pn * BM; const int row0 = u.pm * BM + wr * 64 + fr;
        if (colt < 4096 + nv) {
            bf16_t* base; int ld, c0;
            if (colt < 1024) { base = gq; ld = 1024; c0 = colt; } else if (colt < 2048) { base = gk; ld = 1024; c0 = colt - 1024; }
            else if (colt < 2048 + nv) { base = gv; ld = 2048; c0 = colt - 2048; } else { base = gr; ld = 2048; c0 = colt - 2048 - nv; }
            const int col0 = c0 + wc * 32 + 8 * fq;
#pragma unroll
            for (int ai = 0; ai < 2; ++ai)
#pragma unroll
                for (int m = 0; m < 4; ++m) { bf16_t* rowp = base + (size_t)(row0 + ai * HALF + m * 16) * ld + col0;
#pragma unroll
                    for (int bj = 0; bj < 2; ++bj) { const f32x4 v0 = acc[ai][bj][m][0], v1 = acc[ai][bj][m][1];
                        u32x4 w; w.x = cvt_pk_bf16(v0[0], v0[1]); w.y = cvt_pk_bf16(v0[2], v0[3]); w.z = cvt_pk_bf16(v1[0], v1[1]); w.w = cvt_pk_bf16(v1[2], v1[3]);
                        __builtin_nontemporal_store(w, (u32x4*)(rowp + bj * HALF)); } }
        } else {
            const int c = colt - 4096 - nv, ten = c >> 11, h0 = (c & 2047) >> 7;
            bf16_t* base = dqkv + (size_t)ten * ((size_t)16384 * 2048) + wc * 32 + 8 * fq;
#pragma unroll
            for (int ai = 0; ai < 2; ++ai)
#pragma unroll
                for (int m = 0; m < 4; ++m) { const int row = row0 + ai * HALF + m * 16, b = row >> 12, sq = row & 4095;
#pragma unroll
                    for (int bj = 0; bj < 2; ++bj) { const f32x4 v0 = acc[ai][bj][m][0], v1 = acc[ai][bj][m][1];
                        u32x4 w; w.x = cvt_pk_bf16(v0[0], v0[1]); w.y = cvt_pk_bf16(v0[2], v0[3]); w.z = cvt_pk_bf16(v1[0], v1[1]); w.w = cvt_pk_bf16(v1[2], v1[3]);
                        __builtin_nontemporal_store(w, (u32x4*)(base + ((size_t)((b * 16 + h0 + bj) * 4096 + sq)) * 128)); } }
        }
    }
};
struct EpiProjQ {
    static constexpr bool PERM = true, PERMA = false, AFTER_DRAIN = false, PREFETCH = false, I8 = true; typedef i32x4 AccT; static constexpr int NST = 16;
    bf16_t* dqkv; const float* rsc; const unsigned* cmax; bf16_t* gv; int nv;
    __device__ __forceinline__ void operator()(const i32x4 (&acc)[2][2][4][2], const Unit& u, int wr, int wc, int fr, int fq) const {
        const int c = u.pn * BM, cd = c - nv, ten = cd >> 11, h0 = (cd & 2047) >> 7; const int row0 = u.pm * BM + wr * 64 + fr;
        const bool isv = c < nv;
        bf16_t* base = isv ? gv + c + wc * 32 + 8 * fq : dqkv + (size_t)ten * ((size_t)16384 * 2048) + wc * 32 + 8 * fq;
        float cs[2][8];
#pragma unroll
        for (int bj = 0; bj < 2; ++bj) { const u32x4 m0 = *(const u32x4*)(cmax + c + bj * HALF + wc * 32 + 8 * fq), m1 = *(const u32x4*)(cmax + c + bj * HALF + wc * 32 + 8 * fq + 4);
            cs[bj][0] = __uint_as_float(m0.x) * (1.0f / 127.0f); cs[bj][1] = __uint_as_float(m0.y) * (1.0f / 127.0f); cs[bj][2] = __uint_as_float(m0.z) * (1.0f / 127.0f); cs[bj][3] = __uint_as_float(m0.w) * (1.0f / 127.0f);
            cs[bj][4] = __uint_as_float(m1.x) * (1.0f / 127.0f); cs[bj][5] = __uint_as_float(m1.y) * (1.0f / 127.0f); cs[bj][6] = __uint_as_float(m1.z) * (1.0f / 127.0f); cs[bj][7] = __uint_as_float(m1.w) * (1.0f / 127.0f); }
#pragma unroll
        for (int ai = 0; ai < 2; ++ai)
#pragma unroll
            for (int m = 0; m < 4; ++m) { const int row = row0 + ai * HALF + m * 16, b = row >> 12, sq = row & 4095; const float rs = rsc[row];
#pragma unroll
                for (int bj = 0; bj < 2; ++bj) { const i32x4 a0 = acc[ai][bj][m][0], a1 = acc[ai][bj][m][1];
                    u32x4 w; w.x = cvt_pk_bf16((float)a0[0] * (rs * cs[bj][0]), (float)a0[1] * (rs * cs[bj][1])); w.y = cvt_pk_bf16((float)a0[2] * (rs * cs[bj][2]), (float)a0[3] * (rs * cs[bj][3]));
                    w.z = cvt_pk_bf16((float)a1[0] * (rs * cs[bj][4]), (float)a1[1] * (rs * cs[bj][5])); w.w = cvt_pk_bf16((float)a1[2] * (rs * cs[bj][6]), (float)a1[3] * (rs * cs[bj][7]));
                    __builtin_nontemporal_store(w, (u32x4*)(isv ? base + (size_t)row * 2048 + bj * HALF : base + ((size_t)((b * 16 + h0 + bj) * 4096 + sq)) * 128)); } }
    }
};
struct EpiScaleBf16 {
    static constexpr bool PERM = true, PERMA = false, AFTER_DRAIN = false, PREFETCH = false, I8 = false; typedef f32x4 AccT; static constexpr int NST = 16;
    bf16_t* O; int ldc; const unsigned long long* ss; float inv_n;
    __device__ __forceinline__ void operator()(const f32x4 (&acc)[2][2][4][2], const Unit& u, int wr, int wc, int fr, int fq) const {
        const int row0 = u.pm * BM + wr * 64 + fr, col0 = u.pn * BM + wc * 32 + 8 * fq;
#pragma unroll
        for (int ai = 0; ai < 2; ++ai)
#pragma unroll
            for (int m = 0; m < 4; ++m) { const int row = row0 + ai * HALF + m * 16; const float rs = ss ? rstd_of(ss, row, inv_n) : 1.0f; bf16_t* rowp = O + (size_t)row * ldc + col0;
#pragma unroll
                for (int bj = 0; bj < 2; ++bj) { const f32x4 v0 = acc[ai][bj][m][0] * rs, v1 = acc[ai][bj][m][1] * rs;
                    u32x4 w; w.x = cvt_pk_bf16(v0[0], v0[1]); w.y = cvt_pk_bf16(v0[2], v0[3]); w.z = cvt_pk_bf16(v1[0], v1[1]); w.w = cvt_pk_bf16(v1[2], v1[3]);
                    *(u32x4*)(rowp + bj * HALF) = w; } }
    }
};
struct EpiResid {
    static constexpr bool PERM = true, PERMA = false, AFTER_DRAIN = false, PREFETCH = false, I8 = false; typedef f32x4 AccT; static constexpr int NST = 32;
    const float* base32; const bf16_t* base16; bf16_t* hb; unsigned long long* ss; int ldc; unsigned* amax;
    __device__ __forceinline__ void operator()(const f32x4 (&acc)[2][2][4][2], const Unit& u, int wr, int wc, int fr, int fq) const {
        const int row0 = u.pm * BM + wr * 64 + fr, col0 = u.pn * BM + wc * 32 + 8 * fq;
        f32x4 bc[2][2], bn[2][2]; u32x4 hc[2], hn[2];
#define EPR_LOAD(d32, d16, g) do { const size_t o_ = (size_t)(row0 + ((g) >> 2) * HALF + ((g) & 3) * 16) * ldc + col0; \
        if (base32) { d32[0][0] = __builtin_nontemporal_load((const f32x4*)(base32 + o_)); d32[0][1] = __builtin_nontemporal_load((const f32x4*)(base32 + o_ + 4)); d32[1][0] = __builtin_nontemporal_load((const f32x4*)(base32 + o_ + HALF)); d32[1][1] = __builtin_nontemporal_load((const f32x4*)(base32 + o_ + HALF + 4)); } \
        else { d16[0] = *(const u32x4*)(base16 + o_); d16[1] = *(const u32x4*)(base16 + o_ + HALF); } } while (0)
        EPR_LOAD(bc, hc, 0);
#pragma unroll
        for (int g = 0; g < 8; ++g) {
            const int ai = g >> 2, m = g & 3; const int row = row0 + ai * HALF + m * 16; const size_t off = (size_t)row * ldc + col0; float s = 0.f; float mx = 0.f;
            if (g < 7) EPR_LOAD(bn, hn, g + 1);
#pragma unroll
            for (int bj = 0; bj < 2; ++bj) {
                f32x4 b0, b1;
                if (base32) { b0 = bc[bj][0]; b1 = bc[bj][1]; }
                else { const u32x4 w = hc[bj]; b0 = (f32x4){__uint_as_float(w.x << 16), __uint_as_float(w.x & 0xffff0000u), __uint_as_float(w.y << 16), __uint_as_float(w.y & 0xffff0000u)};
                                              b1 = (f32x4){__uint_as_float(w.z << 16), __uint_as_float(w.z & 0xffff0000u), __uint_as_float(w.w << 16), __uint_as_float(w.w & 0xffff0000u)}; }
                const f32x4 v0 = acc[ai][bj][m][0] + b0, v1 = acc[ai][bj][m][1] + b1;
                s += (v0[0] * v0[0] + v0[1] * v0[1]) + (v0[2] * v0[2] + v0[3] * v0[3]) + (v1[0] * v1[0] + v1[1] * v1[1]) + (v1[2] * v1[2] + v1[3] * v1[3]);
                if (amax) { const f32x4 a0 = __builtin_elementwise_abs(v0), a1 = __builtin_elementwise_abs(v1); mx = fmaxf(mx, fmaxf(fmaxf(fmaxf(a0[0], a0[1]), fmaxf(a0[2], a0[3])), fmaxf(fmaxf(a1[0], a1[1]), fmaxf(a1[2], a1[3])))); }
                u32x4 w; w.x = cvt_pk_bf16(v0[0], v0[1]); w.y = cvt_pk_bf16(v0[2], v0[3]); w.z = cvt_pk_bf16(v1[0], v1[1]); w.w = cvt_pk_bf16(v1[2], v1[3]); *(u32x4*)(hb + off + bj * HALF) = w; }
            s += __shfl_xor(s, 16); s += __shfl_xor(s, 32);
            if (ss && fq == 0) atomicAdd(ss + row, (unsigned long long)(s * SS_SCALE + 0.5f));
            if (amax) { mx = fmaxf(mx, __shfl_xor(mx, 16)); mx = fmaxf(mx, __shfl_xor(mx, 32)); if (fq == 0) atomicMax(amax + row, __float_as_uint(mx)); }
#pragma unroll
            for (int bj = 0; bj < 2; ++bj) { bc[bj][0] = bn[bj][0]; bc[bj][1] = bn[bj][1]; hc[bj] = hn[bj]; }
            asm volatile("" ::: "memory");
        }
#undef EPR_LOAD
    }
};
template <bool Q> struct EpiGateUpT {
    static constexpr bool PERM = true, PERMA = true, AFTER_DRAIN = false, PREFETCH = true, I8 = Q; typedef typename std::conditional<Q, i32x4, f32x4>::type AccT; static constexpr int NST = 32;
    static constexpr int AUXN = 1024;
    static constexpr float NLOG2E = -1.4426950408889634f, NLN2 = -0.6931471805599453f;
    bf16_t* act; int ldc; const unsigned long long* ss; float inv_n; const float* cw; const float* cb; float* GF; float* UF; float* GL; int nff;
    PG8_LAS float* aux;
    const unsigned* colmax; const unsigned* amax;
    __device__ __forceinline__ float rowscale(unsigned long long s2, unsigned am) const { const float r = 1.0f / sqrtf((float)s2 * (inv_n / SS_SCALE) + RMS_EPS); return Q ? r * __uint_as_float(am) * (1.0f / 127.0f) : r; }
    __device__ __forceinline__ void prefetch(const Unit& u, int par) const {
        int tid = (int)threadIdx.x; asm volatile("" : "+v"(tid)); const int arr = tid >> 7, c = u.pn * HALF + (tid & 127);
        const float gs = Q ? __uint_as_float(colmax[c]) * (1.0f / 127.0f) : 1.0f;
        const float v = (arr < 3 ? cw[arr * nff + c] * gs : cb[c]) * NLOG2E;
        PG8_LAS float* a = aux + par * AUXN; a[tid] = v;
        if (tid < 128) a[512 + tid] = (Q ? __uint_as_float(colmax[nff + c]) * (1.0f / 127.0f) : 1.0f) * NLN2;
        if (tid < 256) { const int row = u.pm * BM + tid; a[768 + tid] = rowscale(ss[row], Q ? amax[row] : 0u); }
    }
    __device__ __forceinline__ void run(const AccT (&acc)[2][2][4][2], const Unit& u, int wr, int wc, int fr, int fq, int par, const Unit& nxt) const {
        int tid = (int)threadIdx.x; asm volatile("" : "+v"(tid)); const int arr = tid >> 7, cn = nxt.pn * HALF + (tid & 127);
        const float ncw = arr < 3 ? cw[arr * nff + cn] : cb[cn];
        const unsigned ncg = Q ? colmax[cn] : 0u, ncu = Q ? colmax[nff + cn] : 0u;
        const int nrow = nxt.pm * BM + (tid & 255);
        const unsigned long long nss = ss[nrow]; const unsigned nam = Q ? amax[nrow] : 0u;
        const PG8_LAS float* a = aux + par * AUXN;
        const int c0 = wc * 32 + 8 * fq;
        const int ch0 = u.pn * HALF + c0;
        f32x2 w0[4], w1[4], w2[4], bb[4], sl[4];
#pragma unroll
        for (int h4 = 0; h4 < 2; ++h4) { const f32x4 x0 = *(const PG8_LAS f32x4*)(a + c0 + 4 * h4), x1 = *(const PG8_LAS f32x4*)(a + 128 + c0 + 4 * h4), x2 = *(const PG8_LAS f32x4*)(a + 256 + c0 + 4 * h4), x3 = *(const PG8_LAS f32x4*)(a + 384 + c0 + 4 * h4);
            const f32x4 x4 = *(const PG8_LAS f32x4*)(a + 512 + c0 + 4 * h4);
#pragma unroll
            for (int q = 0; q < 2; ++q) { w0[2 * h4 + q] = (f32x2){x0[2 * q], x0[2 * q + 1]}; w1[2 * h4 + q] = (f32x2){x1[2 * q], x1[2 * q + 1]}; w2[2 * h4 + q] = (f32x2){x2[2 * q], x2[2 * q + 1]};
                bb[2 * h4 + q] = (f32x2){x3[2 * q], x3[2 * q + 1]}; sl[2 * h4 + q] = (f32x2){x4[2 * q], x4[2 * q + 1]}; } }
#pragma unroll
        for (int ai = 0; ai < 2; ++ai) {
            const int lrow0 = ai * HALF + wr * 64 + fr * 4;
            const int blk = (u.pm * BM + ai * HALF + wr * 64) >> 6;
            const f32x4 rs4 = *(const PG8_LAS f32x4*)(a + 768 + lrow0);
            bf16_t* arow = act + (size_t)(u.pm * BM + lrow0) * ldc + ch0;
            f32x2 g[4][4];
#pragma unroll
            for (int m = 0; m < 4; ++m)
#pragma unroll
                for (int p = 0; p < 4; ++p) g[m][p] = (f32x2){(float)acc[ai][0][m][p >> 1][2 * (p & 1)], (float)acc[ai][0][m][p >> 1][2 * (p & 1) + 1]} * rs4[m];
            f32x2 gm1[4], gm2[4];
#pragma unroll
            for (int p = 0; p < 4; ++p) {
                gm1[p] = (f32x2){__int_as_float(__builtin_amdgcn_update_dpp(0, __float_as_int(g[3][p][0]), 0x111, 0xf, 0xf, true)), __int_as_float(__builtin_amdgcn_update_dpp(0, __float_as_int(g[3][p][1]), 0x111, 0xf, 0xf, true))};
                gm2[p] = (f32x2){__int_as_float(__builtin_amdgcn_update_dpp(0, __float_as_int(g[2][p][0]), 0x111, 0xf, 0xf, true)), __int_as_float(__builtin_amdgcn_update_dpp(0, __float_as_int(g[2][p][1]), 0x111, 0xf, 0xf, true))}; }
#pragma unroll
            for (int m = 0; m < 4; ++m) {
                u32x4 w; f32x2 upv[4];
#pragma unroll
                for (int p = 0; p < 4; ++p) {
                    const f32x2 r1 = m >= 1 ? g[m >= 1 ? m - 1 : 0][p] : gm1[p], r2 = m >= 2 ? g[m >= 2 ? m - 2 : 0][p] : (m == 1 ? gm1[p] : gm2[p]);
                    const f32x2 y = bb[p] + w2[p] * g[m][p] + w1[p] * r1 + w0[p] * r2;
                    const f32x2 d = (f32x2){__builtin_amdgcn_exp2f(y[0]), __builtin_amdgcn_exp2f(y[1])} + 1.0f;
                    const f32x2 sg = {__builtin_amdgcn_rcpf(d[0]), __builtin_amdgcn_rcpf(d[1])};
                    upv[p] = (f32x2){(float)acc[ai][1][m][p >> 1][2 * (p & 1)], (float)acc[ai][1][m][p >> 1][2 * (p & 1) + 1]} * (sl[p] * rs4[m]);
                    const f32x2 av = y * sg * upv[p];
                    w[p] = cvtpk_e(av[0], av[1]);
                }
                if (m >= 2 || fr != 0) __builtin_nontemporal_store(w, (u32x4*)(arow + (size_t)m * ldc));
                if (m < 2 && fr == 0) { float* gp = GF + ((size_t)blk * 2 + m) * nff + ch0; float* upp = UF + ((size_t)blk * 2 + m) * nff + ch0;
                    *(f32x4*)gp = (f32x4){g[m][0][0], g[m][0][1], g[m][1][0], g[m][1][1]}; *(f32x4*)(gp + 4) = (f32x4){g[m][2][0], g[m][2][1], g[m][3][0], g[m][3][1]};
                    *(f32x4*)upp = (f32x4){upv[0][0], upv[0][1], upv[1][0], upv[1][1]}; *(f32x4*)(upp + 4) = (f32x4){upv[2][0], upv[2][1], upv[3][0], upv[3][1]}; }
                if (m >= 2 && fr == 15) { float* gp = GL + ((size_t)blk * 2 + (m - 2)) * nff + ch0;
                    *(f32x4*)gp = (f32x4){g[m][0][0], g[m][0][1], g[m][1][0], g[m][1][1]}; *(f32x4*)(gp + 4) = (f32x4){g[m][2][0], g[m][2][1], g[m][3][0], g[m][3][1]}; }
            }
        }
        PG8_LAS float* an = aux + (par ^ 1) * AUXN;
        an[tid] = (arr < 3 ? ncw * (Q ? __uint_as_float(ncg) * (1.0f / 127.0f) : 1.0f) : ncw) * NLOG2E;
        if (tid < 128) an[512 + tid] = (Q ? __uint_as_float(ncu) * (1.0f / 127.0f) : 1.0f) * NLN2;
        if (tid < 256) an[768 + tid] = rowscale(nss, nam);
    }
};
typedef EpiGateUpT<false> EpiGateUp;
typedef EpiGateUpT<true> EpiGateUpQ;
struct EpiNull {
    static constexpr bool PERM = true, PERMA = false, AFTER_DRAIN = false, PREFETCH = false, I8 = false; typedef f32x4 AccT; static constexpr int NST = 0;
    __device__ __forceinline__ void operator()(const f32x4 (&acc)[2][2][4][2], const Unit& u, int wr, int wc, int fr, int fq) const {
#pragma unroll
        for (int ai = 0; ai < 2; ++ai)
#pragma unroll
            for (int bj = 0; bj < 2; ++bj)
#pragma unroll
                for (int m = 0; m < 4; ++m)
#pragma unroll
                    for (int n = 0; n < 2; ++n) asm volatile("" :: "v"(acc[ai][bj][m][n]));
    }
};
template <class AccT> __device__ __forceinline__ AccT pg8_zero4() {
    typedef unsigned long long u64x2_t __attribute__((ext_vector_type(2)));
    u64x2_t z; unsigned long long lo, hi;
    asm volatile("v_mov_b64 %0, 0" : "=v"(lo)); asm volatile("v_mov_b64 %0, 0" : "=v"(hi));
    z.x = lo; z.y = hi; return __builtin_bit_cast(AccT, z);
}
template <bool I8> __device__ __forceinline__ auto pg8_mma(bf16x8 b, bf16x8 a, typename std::conditional<I8, i32x4, f32x4>::type c) {
    if constexpr (I8) return __builtin_amdgcn_mfma_i32_16x16x64_i8(__builtin_bit_cast(i32x4, b), __builtin_bit_cast(i32x4, a), c, 0, 0, 0);
    else return __builtin_amdgcn_mfma_f32_16x16x32_bf16(b, a, c, 0, 0, 0);
}
#ifndef PG_RELAXW
#define PG_RELAXW 1
#endif
template <class Epi, class Sched, bool ALIGN_EPI = false, bool SP2 = false>
__device__ __forceinline__ void gemm_phase(PG8_LAS unsigned char* lds, const Gemm g, const Sched& S, const Epi& E) {
    const int tid = threadIdx.x, wid = __builtin_amdgcn_readfirstlane(tid >> 6), lane = tid & 63, wr = wid >> 2, wc = wid & 3, fr = lane & 15, fq = lane >> 4;
    const int K = g.K, nt = K / BK;
    unsigned voffA[2], voffB[2];
#pragma unroll
    for (int i = 0; i < 2; ++i) { int R, C; stage_rc(tid * 16 + i * 8192, R, C); const int Rb = Epi::PERM ? ((R & ~31) + perm32(R & 31)) : R;
        const int Ra = Epi::PERMA ? ((R & 64) | ((R & 15) << 2) | ((R >> 4) & 3)) : R;
        voffA[i] = (unsigned)(Ra * K + C) * 2u; voffB[i] = (unsigned)(Rb * K + C) * 2u; }
    const size_t kstep = (size_t)(BK * 2);
    const size_t hstep = (size_t)HALF * K * 2;
    const size_t tstep = 2 * hstep;
    const unsigned ldsw = (unsigned)wid * 1024u;
    const int aoff = lds_byte(wr * 64 + fr, fq * 8), boff = lds_byte(wc * 32 + fr, fq * 8);
#define PG8_SA(b, h) (((b) * 2 + (h)) * HTB)
#define PG8_SB(b, h) ((4 + (b) * 2 + (h)) * HTB)
#define PG8_STAGE(bufoff, gbase, voff) do { _Pragma("unroll") for (int _i = 0; _i < 2; ++_i) \
        __builtin_amdgcn_global_load_lds((const unsigned*)((const char*)(gbase) + (voff)[_i]), (PG8_LAS unsigned*)(lds + (bufoff) + ldsw + _i * 8192), 16, 0, 0); } while (0)
#define PG8_LDA(dst, b, h) do { _Pragma("unroll") for (int m = 0; m < 4; ++m) _Pragma("unroll") for (int k = 0; k < 2; ++k) dst[m][k] = *(const PG8_LAS bf16x8*)(lds + PG8_SA(b, h) + aoff + m * 2048 + k * 1024); } while (0)
#define PG8_LDB(dst, b, h) do { _Pragma("unroll") for (int n = 0; n < 2; ++n) _Pragma("unroll") for (int k = 0; k < 2; ++k) dst[n][k] = *(const PG8_LAS bf16x8*)(lds + PG8_SB(b, h) + boff + n * 2048 + k * 1024); } while (0)
#define PG8_MMA(ai, bj, At, Bt) do { __builtin_amdgcn_s_setprio(1); _Pragma("unroll") for (int m = 0; m < 4; ++m) _Pragma("unroll") for (int n = 0; n < 2; ++n) _Pragma("unroll") for (int k = 0; k < 2; ++k) \
        acc[ai][bj][m][n] = pg8_mma<Epi::I8>(Bt[n][k], At[m][k], acc[ai][bj][m][n]); __builtin_amdgcn_s_setprio(0); } while (0)
#define PG8_WAIT_V(n) asm volatile("s_waitcnt vmcnt(" #n ")" ::: "memory")
#define PG8_WAIT_L(n) asm volatile("s_waitcnt lgkmcnt(" #n ")" ::: "memory")
#define PG8_WAIT_VR(rlx, n) asm volatile("s_waitcnt vmcnt(%1)\n\ts_cmp_lg_u32 %0, 0\n\ts_cbranch_scc1 .Lrw%=\n\ts_waitcnt vmcnt(8)\n.Lrw%=:" :: "s"(rlx), "n"(n) : "scc", "memory")
#define PG8_BAR __builtin_amdgcn_s_barrier()
#define PG8_SCHED __builtin_amdgcn_sched_barrier(0)
    Unit cur, nxt; int ui = 0;
    if (!S.next(0, cur)) return;
    typedef typename Epi::AccT AccT; AccT acc[2][2][4][2];
#pragma unroll
    for (int a = 0; a < 2; ++a)
#pragma unroll
        for (int b = 0; b < 2; ++b)
#pragma unroll
            for (int m = 0; m < 4; ++m)
#pragma unroll
                for (int n = 0; n < 2; ++n) acc[a][b][m][n] = pg8_zero4<AccT>();
    bf16x8 At[4][2], B0[2][2], B1[2][2];
    const char* cA = (const char*)g.A + (size_t)cur.pm * tstep; const char* cB = (const char*)g.Bt + (size_t)cur.pn * tstep;
    S.a_ready(cur);
    if constexpr (Epi::PREFETCH) E.prefetch(cur, 0);
    if constexpr (SP2) {
        PG8_STAGE(PG8_SB(0, 0), cB, voffB); PG8_STAGE(PG8_SB(0, 1), cB + hstep, voffB); PG8_STAGE(PG8_SA(0, 0), cA, voffA); PG8_STAGE(PG8_SA(0, 1), cA + hstep, voffA);
        if (wr == 1) PG8_BAR;
        PG8_WAIT_V(2); PG8_BAR;
        PG8_STAGE(PG8_SB(1, 0), cB + kstep, voffB); PG8_STAGE(PG8_SA(1, 0), cA + kstep, voffA); PG8_STAGE(PG8_SB(1, 1), cB + hstep + kstep, voffB);
        PG8_WAIT_V(6); PG8_BAR;
    } else {
        PG8_STAGE(PG8_SB(0, 0), cB, voffB); PG8_STAGE(PG8_SA(0, 0), cA, voffA); PG8_STAGE(PG8_SB(0, 1), cB + hstep, voffB); PG8_STAGE(PG8_SA(0, 1), cA + hstep, voffA);
        if (wr == 1) PG8_BAR;
        PG8_WAIT_V(4); PG8_BAR;
        PG8_STAGE(PG8_SB(1, 0), cB + kstep, voffB); PG8_STAGE(PG8_SA(1, 0), cA + kstep, voffA); PG8_STAGE(PG8_SB(1, 1), cB + hstep + kstep, voffB);
        PG8_WAIT_V(6); PG8_BAR;
    }
    for (;;) {
        const bool has_next = S.next(ui + 1, nxt);
        const char* nA = has_next ? (const char*)g.A + (size_t)nxt.pm * tstep : cA; const char* nB = has_next ? (const char*)g.Bt + (size_t)nxt.pn * tstep : cB;
        for (int t = 0; t < nt; t += 2) {
            const bool last = (t == nt - 2);
            const char* a1 = cA + (size_t)(t + 1) * kstep;
            const char* a2 = last ? nA : cA + (size_t)(t + 2) * kstep; const char* b2 = last ? nB : cB + (size_t)(t + 2) * kstep;
            const char* a3 = a2 + kstep; const char* b3 = b2 + kstep;
            if (last && has_next) S.a_ready(nxt);
            const int rl = __builtin_amdgcn_readfirstlane((PG_RELAXW && (t == 0) && (ui > 0)) ? 1 : 0);
            if constexpr (SP2) {
            PG8_LDB(B0, 0, 0); PG8_LDB(B1, 0, 1); PG8_SCHED; PG8_LDA(At, 0, 0); PG8_STAGE(PG8_SA(1, 1), a1 + hstep, voffA);
            PG8_WAIT_VR(rl, 8 + Epi::NST); PG8_WAIT_L(0); PG8_BAR; PG8_MMA(0, 0, At, B0); PG8_MMA(0, 1, At, B1); PG8_BAR; PG8_SCHED;
            PG8_LDA(At, 0, 1); PG8_STAGE(PG8_SB(0, 0), b2, voffB); PG8_STAGE(PG8_SB(0, 1), b2 + hstep, voffB); PG8_STAGE(PG8_SA(0, 0), a2, voffA);
            PG8_WAIT_VR(rl, 8 + Epi::NST); PG8_WAIT_L(0); PG8_BAR; PG8_MMA(1, 0, At, B0); PG8_MMA(1, 1, At, B1); PG8_BAR; PG8_SCHED;
            PG8_LDB(B0, 1, 0); PG8_LDB(B1, 1, 1); PG8_SCHED; PG8_LDA(At, 1, 0); PG8_STAGE(PG8_SA(0, 1), a2 + hstep, voffA);
            PG8_WAIT_V(8); PG8_WAIT_L(0); PG8_BAR; PG8_MMA(0, 0, At, B0); PG8_MMA(0, 1, At, B1); PG8_BAR; PG8_SCHED;
            PG8_LDA(At, 1, 1); PG8_STAGE(PG8_SB(1, 0), b3, voffB); PG8_STAGE(PG8_SB(1, 1), b3 + hstep, voffB); PG8_STAGE(PG8_SA(1, 0), a3, voffA);
            PG8_WAIT_V(8); PG8_WAIT_L(0); PG8_BAR; PG8_MMA(1, 0, At, B0); PG8_MMA(1, 1, At, B1); PG8_BAR; PG8_SCHED;
            } else {
            PG8_LDB(B0, 0, 0); PG8_SCHED; PG8_LDA(At, 0, 0); PG8_STAGE(PG8_SA(1, 1), a1 + hstep, voffA);
            PG8_WAIT_L(8); PG8_BAR; PG8_WAIT_L(0); PG8_MMA(0, 0, At, B0); PG8_BAR; PG8_SCHED;
            PG8_LDB(B1, 0, 1); PG8_STAGE(PG8_SB(0, 0), b2, voffB);
            PG8_BAR; PG8_WAIT_L(0); PG8_MMA(0, 1, At, B1); PG8_BAR;
            PG8_LDA(At, 0, 1); PG8_STAGE(PG8_SA(0, 0), a2, voffA);
            PG8_BAR; PG8_WAIT_L(0); PG8_MMA(1, 0, At, B0); PG8_BAR; PG8_SCHED;
            PG8_STAGE(PG8_SB(0, 1), b2 + hstep, voffB);
            PG8_WAIT_V(6); PG8_BAR; PG8_MMA(1, 1, At, B1); PG8_BAR;
            PG8_LDB(B0, 1, 0); PG8_SCHED; PG8_LDA(At, 1, 0); PG8_STAGE(PG8_SA(0, 1), a2 + hstep, voffA);
            PG8_WAIT_L(8); PG8_BAR; PG8_WAIT_L(0); PG8_MMA(0, 0, At, B0); PG8_BAR; PG8_SCHED;
            PG8_LDB(B1, 1, 1); PG8_STAGE(PG8_SB(1, 0), b3, voffB);
            PG8_BAR; PG8_WAIT_L(0); PG8_MMA(0, 1, At, B1); PG8_BAR;
            PG8_LDA(At, 1, 1); PG8_STAGE(PG8_SA(1, 0), a3, voffA);
            PG8_BAR; PG8_WAIT_L(0); PG8_MMA(1, 0, At, B0); PG8_BAR; PG8_SCHED;
            PG8_STAGE(PG8_SB(1, 1), b3 + hstep, voffB);
            PG8_WAIT_V(6); PG8_BAR; PG8_MMA(1, 1, At, B1); PG8_BAR;
            }
        }
        if constexpr (ALIGN_EPI) { if (wr == 0) PG8_BAR; }
        if constexpr (!Epi::AFTER_DRAIN) { if constexpr (Epi::PREFETCH) E.run(acc, cur, wr, wc, fr, fq, ui & 1, has_next ? nxt : cur); else E(acc, cur, wr, wc, fr, fq); S.done(cur); }
        if (!has_next) break;
#pragma unroll
        for (int a = 0; a < 2; ++a)
#pragma unroll
            for (int b = 0; b < 2; ++b)
#pragma unroll
                for (int m = 0; m < 4; ++m)
#pragma unroll
                    for (int n = 0; n < 2; ++n) acc[a][b][m][n] = pg8_zero4<AccT>();
        cur = nxt; cA = nA; cB = nB; ++ui;
        if constexpr (ALIGN_EPI) { if (wr == 1) PG8_BAR; }
    }
    PG8_WAIT_V(0);
    if constexpr (!ALIGN_EPI) { if (wr == 0) PG8_BAR; }
    PG8_BAR;
    if constexpr (Epi::AFTER_DRAIN) { E.fused(acc, cur, wr, wc, fr, fq, lds, wid, lane); S.done(cur); }
#undef PG8_SA
#undef PG8_SB
#undef PG8_STAGE
#undef PG8_LDA
#undef PG8_LDB
#undef PG8_MMA
#undef PG8_WAIT_V
#undef PG8_WAIT_L
#undef PG8_WAIT_VR
#undef PG8_BAR
#undef PG8_SCHED
}
}
namespace att {
constexpr int D = 128; constexpr float THR = 8.f; constexpr bool WSKIP = true;
constexpr float SCALE = 0.08838834764831845f;
constexpr int NW = 8, QBLK = 32, KVBLK = 64, QB = NW * QBLK;
constexpr int SHM_V = KVBLK * D * 2, SHM_K = KVBLK * D * 2;
constexpr int LDS_TAB = 2 * SHM_V + 2 * SHM_K + NW * 64 * 4, TAB_N = 328, TAB_OFF = 100, TAB_PITCH = 4 * TAB_N;
constexpr int LDS_BYTES = LDS_TAB + 2 * TAB_PITCH * 4;
using bf16 = __hip_bfloat16;
typedef short bf16x8 __attribute__((ext_vector_type(8)));
typedef short s16x4 __attribute__((ext_vector_type(4)));
typedef float f32x16 __attribute__((ext_vector_type(16)));
typedef float f32x4 __attribute__((ext_vector_type(4)));
typedef float f32x2 __attribute__((ext_vector_type(2)));
typedef unsigned u32x4 __attribute__((ext_vector_type(4)));
template <class A, class Bt> struct same_t { static constexpr bool v = false; };
template <class A> struct same_t<A, A> { static constexpr bool v = true; };

#define KSWZ(row, colB) ((row) * 256 + ((colB) ^ (((row) & 7) << 4)))
#define SBAR() __builtin_amdgcn_sched_barrier(0)
__device__ __forceinline__ int v_st(int k, int c) { const int kk = (k & ~0xC) | ((k & 4) << 1) | ((k & 8) >> 1); return ((kk >> 3) * 4 + (c >> 5)) * 512 + ((kk & 7) * 32 + (c & 31)) * 2; }
__device__ __forceinline__ int v_rd_base(int lane) { return ((lane & 3) << 3) | (((lane >> 2) & 3) << 6) | (((lane >> 4) & 1) << 5) | (((lane >> 5) & 1) << 8); }
constexpr int v_rd_off(int d0, int ks, int half) { return d0 * 512 + ks * 4096 + half * 2048; }
__device__ __forceinline__ int crow(int r, int hi) { return (r & 3) + 8 * (r >> 2) + 4 * hi; }
__device__ __forceinline__ unsigned cvtpk(float lo, float hi) {
    unsigned r; asm volatile("v_cvt_pk_bf16_f32 %0, %1, %2" : "=v"(r) : "v"(lo), "v"(hi)); return r;
}
__device__ __forceinline__ bf16x8 pack8(f32x4 a, f32x4 b) {
    u32x4 w = {cvtpk(a[0], a[1]), cvtpk(a[2], a[3]), cvtpk(b[0], b[1]), cvtpk(b[2], b[3])};
    return *reinterpret_cast<bf16x8*>(&w);
}
template <class T> __device__ __forceinline__ bf16x8 load8(const T* p) {
    if constexpr (same_t<T, float>::v) { return pack8(*(const f32x4*)p, *(const f32x4*)(p + 4)); }
    else { return *reinterpret_cast<const bf16x8*>(p); }
}
__device__ __forceinline__ void mask_tile(f32x16& p0, f32x16& p1, int dq, unsigned W) {
    const float NEG = -__builtin_inff();
#pragma unroll
    for (int r = 0; r < 16; ++r) {
        const int c = (r & 3) + 8 * (r >> 2);
        if ((unsigned)(dq - c) >= W) p0[r] = NEG;
        if ((unsigned)(dq - c - 32) >= W) p1[r] = NEG;
    }
}
__device__ __forceinline__ void bias_mask_tile(f32x16& p0, f32x16& p1, int dq, unsigned W, const float* tabu, bool needmask) {
    const float NEG = -__builtin_inff();
    const int sft = (4 - ((int)threadIdx.x & 3)) & 3;
    const float* t0 = tabu + (sft * (TAB_N - 1) + TAB_OFF + 128 - dq);
#pragma unroll
    for (int J = 0; J < 8; ++J) {
        const f32x4 b = *(const f32x4*)(t0 + 8 * J);
#pragma unroll
        for (int e = 0; e < 4; ++e) {
            const int r = 4 * (J & 3) + e; const int c = e + 8 * (J & 3) + (J >= 4 ? 32 : 0);
            float v = (J < 4 ? p0[r] : p1[r]) + b[e];
            if (needmask) { if ((unsigned)(dq - c) >= W) v = NEG; }
            if (J < 4) p0[r] = v; else p1[r] = v;
        }
        if ((J & 1) == 1) asm volatile("" ::: "memory");
    }
}
__device__ __forceinline__ void bias_fill(float* T, const float* bsrc, int tid) {
    asm volatile("" : "+v"(tid));
    if (tid < TAB_N) {
#pragma unroll
        for (int sf = 0; sf < 4; ++sf) { const int i = tid - TAB_OFF + sf; T[sf * TAB_N + tid] = (i >= 0 && i <= 128) ? bsrc[128 - i] : 0.f; }
    }
}
__device__ __forceinline__ void partialSM(f32x16& p0, f32x16& p1, float& m_reg, float& mn, float& alpha) {
    float pmax = p0[0]; for (int r = 1; r < 16; ++r) pmax = fmaxf(pmax, p0[r]); for (int r = 0; r < 16; ++r) pmax = fmaxf(pmax, p1[r]);
    { auto rr = __builtin_amdgcn_permlane32_swap(__float_as_uint(pmax), __float_as_uint(pmax), false, false);
      pmax = fmaxf(__uint_as_float(rr[0]), __uint_as_float(rr[1])); }
    constexpr float C2 = 1.4426950408889634f * SCALE;
    if (__builtin_expect(__all((pmax - m_reg) * SCALE <= THR), 1)) { mn = m_reg; alpha = 1.f; }
    else { mn = fmaxf(m_reg, pmax); alpha = __builtin_amdgcn_exp2f((m_reg - mn) * C2); m_reg = mn; }
    const float mnL = -mn * C2;
    for (int r = 0; r < 16; ++r) p0[r] = fmaf(p0[r], C2, mnL); for (int r = 0; r < 16; ++r) p1[r] = fmaf(p1[r], C2, mnL);
    for (int r = 0; r < 16; ++r) p0[r] = __builtin_amdgcn_exp2f(p0[r]);
}
__device__ __forceinline__ void finishSM(f32x16& p0, f32x16& p1, float alpha, float& l_reg, bf16x8& pa0, bf16x8& pa1, bf16x8& pa2, bf16x8& pa3) {
    for (int r = 0; r < 16; ++r) p1[r] = __builtin_amdgcn_exp2f(p1[r]);
    float ps = 0; for (int r = 0; r < 16; ++r) ps += p0[r]; for (int r = 0; r < 16; ++r) ps += p1[r];
    { auto rr = __builtin_amdgcn_permlane32_swap(__float_as_uint(ps), __float_as_uint(ps), false, false);
      ps = __uint_as_float(rr[0]) + __uint_as_float(rr[1]); }
    l_reg = l_reg * alpha + ps;
#define PK4(P, B_, OUT) do { unsigned a0 = cvtpk(P[B_+0], P[B_+1]), a1 = cvtpk(P[B_+2], P[B_+3]);                          \
        unsigned b0 = cvtpk(P[B_+4], P[B_+5]), b1 = cvtpk(P[B_+6], P[B_+7]);                                             \
        auto r0 = __builtin_amdgcn_permlane32_swap(a0, b0, false, false); auto r1 = __builtin_amdgcn_permlane32_swap(a1, b1, false, false); \
        u32x4 w = {r0[0], r1[0], r0[1], r1[1]}; OUT = *reinterpret_cast<bf16x8*>(&w); } while (0)
    PK4(p0, 0, pa0); PK4(p0, 8, pa1); PK4(p1, 0, pa2); PK4(p1, 8, pa3);
#undef PK4
}
template <int KB, bool SK>
__device__ __forceinline__ void qkt(f32x16& p0, f32x16& p1, const char* K_lds, int r32, int hi, const bf16x8* qr, bool act) {
    if (SK && !act) { const float NEG = -__builtin_inff();
#pragma unroll
        for (int r = 0; r < 16; ++r) { p0[r] = NEG; p1[r] = NEG; } return; }
    p0 = f32x16{}; p1 = f32x16{};
    const char* kb[4];
#pragma unroll
    for (int dd = 0; dd < 4; ++dd) kb[dd] = K_lds + KB * SHM_K + KSWZ(r32, (dd * 16 + hi * 8) * 2);
#pragma unroll
    for (int d0 = 0; d0 < 8; ++d0) { const char* a = kb[d0 & 3] + (d0 >> 2) * 128;
        bf16x8 b0 = *reinterpret_cast<const bf16x8*>(a);
        bf16x8 b1 = *reinterpret_cast<const bf16x8*>(a + 32 * 256);
        p0 = __builtin_amdgcn_mfma_f32_32x32x16_bf16(b0, qr[d0], p0, 0, 0, 0);
        p1 = __builtin_amdgcn_mfma_f32_32x32x16_bf16(b1, qr[d0], p1, 0, 0, 0); }
}
template <int VB, bool SK>
__device__ __forceinline__ void pv_tile(f32x16* o, int vb0, bf16x8 pa0, bf16x8 pa1, bf16x8 pa2, bf16x8 pa3, bool act) {
    if (SK && !act) return;
#define TRRD(dst, off) asm volatile("ds_read_b64_tr_b16 %0, %1 offset:%2" : "=&v"(dst) : "v"(vb0), "i"(off) : "memory")
#define PV_D0(d0) do { s16x4 l0, l1, l2, l3, h0, h1, h2, h3; constexpr int b_ = VB * SHM_V + v_rd_off(d0, 0, 0);     \
        TRRD(l0, b_); TRRD(h0, b_ + 2048); TRRD(l1, b_ + 4096); TRRD(h1, b_ + 6144); TRRD(l2, b_ + 8192); TRRD(h2, b_ + 10240); TRRD(l3, b_ + 12288); TRRD(h3, b_ + 14336); \
        asm volatile("s_waitcnt lgkmcnt(0)" ::: "memory"); SBAR();                 \
        o[d0] = __builtin_amdgcn_mfma_f32_32x32x16_bf16(pa0, (bf16x8){l0[0], l0[1], l0[2], l0[3], h0[0], h0[1], h0[2], h0[3]}, o[d0], 0, 0, 0);   \
        o[d0] = __builtin_amdgcn_mfma_f32_32x32x16_bf16(pa1, (bf16x8){l1[0], l1[1], l1[2], l1[3], h1[0], h1[1], h1[2], h1[3]}, o[d0], 0, 0, 0);   \
        o[d0] = __builtin_amdgcn_mfma_f32_32x32x16_bf16(pa2, (bf16x8){l2[0], l2[1], l2[2], l2[3], h2[0], h2[1], h2[2], h2[3]}, o[d0], 0, 0, 0);   \
        o[d0] = __builtin_amdgcn_mfma_f32_32x32x16_bf16(pa3, (bf16x8){l3[0], l3[1], l3[2], l3[3], h3[0], h3[1], h3[2], h3[3]}, o[d0], 0, 0, 0); } while (0)
    PV_D0(0); PV_D0(1); PV_D0(2); PV_D0(3);
#undef PV_D0
#undef TRRD
}

template <class TIn, class TOut> struct BlockRef { const TIn* Q; const TIn* K; const TIn* V; TOut* O; float* L; const float* bsrc; int P0, pq, pk, po, pl, skv, W; };
template <class TIn> struct Seam {
    bf16x8 qr[8];
    bf16x8 st_v0, st_v1, st_k0, st_k1; f32x4 sf0, sf1, sf2, sf3;
    f32x4 tq[16];
};
__device__ __forceinline__ int swa_jlo(int P0, int W) { const int lowk = P0 - W + 1; return lowk > 0 ? lowk / KVBLK : 0; }
#define ROW(p, pit, k0, rr) ((p) + (unsigned)(((k0) + (rr)) * (pit) + sc))
#define VMW() asm volatile("s_waitcnt vmcnt(0)" ::: "memory")
#define VMWN(n) asm volatile("s_waitcnt vmcnt(%0)" :: "i"(n) : "memory")
#define SLOAD_H(Kp, Vp, pit, k0) do { S.st_v0 = load8<TIn>(ROW(Vp, pit, k0, sr)); S.st_v1 = load8<TIn>(ROW(Vp, pit, k0, 32 + sr));              \
                         S.st_k0 = load8<TIn>(ROW(Kp, pit, k0, sr)); S.st_k1 = load8<TIn>(ROW(Kp, pit, k0, 32 + sr)); } while (0)
#define SWRITE_HK(bf) do { *(bf16x8*)(K_lds + (bf) * SHM_K + kws) = S.st_k0; *(bf16x8*)(K_lds + (bf) * SHM_K + kws + 32 * 256) = S.st_k1; } while (0)
#define SWRITE_HV(bf) do { *(bf16x8*)(V_lds + (bf) * SHM_V + vst0) = S.st_v0; *(bf16x8*)(V_lds + (bf) * SHM_V + vst1) = S.st_v1; } while (0)
#define SWRITE_H(bf) do { SWRITE_HV(bf); SWRITE_HK(bf); } while (0)
#define SLOAD_F(p, k0) do { S.sf0 = *(const f32x4*)ROW(p, D, k0, sr); S.sf1 = *(const f32x4*)(ROW(p, D, k0, sr) + 4);                \
                            S.sf2 = *(const f32x4*)ROW(p, D, k0, 32 + sr); S.sf3 = *(const f32x4*)(ROW(p, D, k0, 32 + sr) + 4); } while (0)
#define SWRITE_KF(bf) do { *(bf16x8*)(K_lds + (bf) * SHM_K + kws) = pack8(S.sf0, S.sf1); *(bf16x8*)(K_lds + (bf) * SHM_K + kws + 32 * 256) = pack8(S.sf2, S.sf3); } while (0)
#define SWRITE_VF(bf) do { *(bf16x8*)(V_lds + (bf) * SHM_V + vst0) = pack8(S.sf0, S.sf1); *(bf16x8*)(V_lds + (bf) * SHM_V + vst1) = pack8(S.sf2, S.sf3); } while (0)
template <int BIAS, class TIn, class TOut>
__device__ __forceinline__ void causal_swa_prime(const BlockRef<TIn, TOut>& cur, char* lds, Seam<TIn>& S) {
    const int W = cur.W;
    constexpr bool F32 = same_t<TIn, float>::v;
    const int tid = threadIdx.x, wid = __builtin_amdgcn_readfirstlane(tid >> 6), lane = tid & 63, r32 = lane & 31, hi = lane >> 5;
    const int sr = tid >> 4, sc = (tid & 15) * 8, kws = KSWZ(sr, sc * 2); char* K_lds = lds + 2 * SHM_V;
    const int kb0 = swa_jlo(cur.P0, W) * KVBLK;
    if (BIAS == 1 || BIAS == 3) bias_fill((float*)(lds + LDS_TAB), cur.bsrc, tid);
    for (int d0 = 0; d0 < 8; ++d0) S.qr[d0] = load8<TIn>(cur.Q + (unsigned)((wid * QBLK + r32) * cur.pq + d0 * 16 + hi * 8));
    if constexpr (F32) { SLOAD_F((const float*)cur.K, kb0); VMW(); SWRITE_KF(0); SBAR(); SLOAD_F((const float*)cur.V, kb0); }
    else { SLOAD_H(cur.K, cur.V, cur.pk, kb0); VMW(); SWRITE_HK(0); }
    __syncthreads();
}
template <int BIAS, class TIn, class TOut, class ItemFn>
__device__ __forceinline__ void causal_swa_block(const BlockRef<TIn, TOut>& cur, int Lnext, const ItemFn& itemfn, int par, char* lds, Seam<TIn>& S) {
    const int skv = cur.skv, W = cur.W;
    const float* tab = (const float*)(lds + LDS_TAB) + par * TAB_PITCH;
    constexpr bool F32 = same_t<TIn, float>::v;
    const int tid = threadIdx.x, wid = __builtin_amdgcn_readfirstlane(tid >> 6), lane = tid & 63, r32 = lane & 31, hi = lane >> 5;
    const int j_lo = swa_jlo(cur.P0, W);
    int j_hi = (cur.P0 + QB - 1) / KVBLK + 1; if (j_hi > skv / KVBLK) j_hi = skv / KVBLK;
    const int NT = j_hi - j_lo;
    const int qlo = cur.P0 + wid * QBLK, qm = qlo + r32 - 4 * hi;
    char* V_lds = lds; char* K_lds = lds + 2 * SHM_V;
    float* ws = (float*)(lds + 2 * SHM_V + 2 * SHM_K) + wid * 64; float* li_l = ws, * al_l = ws + 32;
    float m_reg = -1e30f, l_reg = 0; f32x16 o[4] = {};
    const int sr = tid >> 4, sc = (tid & 15) * 8, vst0 = v_st(sr, sc), vst1 = v_st(32 + sr, sc), kws = KSWZ(sr, sc * 2);
    const int vb0 = (int)(uintptr_t)V_lds + v_rd_base(lane);
    const TIn* Kh = cur.K; const TIn* Vh = cur.V;
#define RESC(a) do { if (__any((a) < 1.f)) { if (hi == 0) al_l[r32] = (a); asm volatile("s_waitcnt lgkmcnt(0)" ::: "memory");              \
                     for (int d_ = 0; d_ < 4; ++d_) for (int r = 0; r < 16; ++r) o[d_][r] *= al_l[crow(r, hi)]; } } while (0)
#define KBASE(t) ((j_lo + (t)) * KVBLK)
#define ACT(t) (KBASE(t) <= qlo + QBLK - 1 && KBASE(t) + KVBLK - 1 >= qlo - W + 1)
#define MASKT(P0_, P1_, t) do { const int kb_ = KBASE(t); if constexpr (BIAS == 1 || BIAS == 2) { if (!SK || ACT(t)) bias_mask_tile(P0_, P1_, qm - kb_, (unsigned)W, tab, kb_ + KVBLK - 1 > qlo || kb_ <= qlo + QBLK - 1 - W); } \
        else { if ((!SK || ACT(t)) && (kb_ + KVBLK - 1 > qlo || kb_ <= qlo + QBLK - 1 - W)) mask_tile(P0_, P1_, qm - kb_, (unsigned)W); } } while (0)
    constexpr int NQL = F32 ? 16 : 8;
    constexpr bool SK = WSKIP && !F32;
#define SEAM_K0() do { VMWN(NQL); if constexpr (F32) { SWRITE_KF(0); SBAR(); SLOAD_F((const float*)nxt.V, kbn); } else { SWRITE_HK(0); } SBAR(); } while (0)
    f32x16 pA0, pA1, pB0, pB1; float mnA, mnB, alA, alB; bf16x8 pa0, pa1, pa2, pa3;
    if constexpr (F32) { VMW(); SWRITE_VF(0); SBAR(); } else { SWRITE_HV(0); SBAR(); }
    if (NT > 1) { if constexpr (F32) SLOAD_F((const float*)Kh, KBASE(1)); else SLOAD_H(Kh, Vh, cur.pk, KBASE(1)); }
    SBAR(); qkt<0, SK>(pA0, pA1, K_lds, r32, hi, S.qr, ACT(0));
    if constexpr (F32) { if (NT > 1) { VMW(); SWRITE_KF(1); SBAR(); SLOAD_F((const float*)Vh, KBASE(1)); } }
    MASKT(pA0, pA1, 0); partialSM(pA0, pA1, m_reg, mnA, alA);
    if (NT > 1) { VMW(); if constexpr (F32) { SWRITE_VF(1); SBAR(); if (NT > 2) SLOAD_F((const float*)Kh, KBASE(2)); } else SWRITE_H(1); }
    __syncthreads();
#define HALF_STEP(PX0, PX1, mnX, alX, PY0, PY1, alY, t, KB, VB, SB) do {                                                      \
        SBAR(); qkt<KB, SK>(PX0, PX1, K_lds, r32, hi, S.qr, ACT(t));                                             \
        finishSM(PY0, PY1, alY, l_reg, pa0, pa1, pa2, pa3); SBAR();                                                           \
        if ((t) + 1 < NT) { if constexpr (F32) { VMW(); SWRITE_KF(SB); SBAR(); SLOAD_F((const float*)Vh, KBASE((t) + 1)); }  \
                            else { SLOAD_H(Kh, Vh, cur.pk, KBASE((t) + 1)); } SBAR(); }                                               \
        pv_tile<VB, SK>(o, vb0, pa0, pa1, pa2, pa3, ACT((t) - 1)); MASKT(PX0, PX1, (t)); partialSM(PX0, PX1, m_reg, mnX, alX);                                        \
        __syncthreads();                                                                                                      \
        if ((t) + 1 < NT) { VMW(); if constexpr (F32) { SWRITE_VF(SB); SBAR(); if ((t) + 2 < NT) SLOAD_F((const float*)Kh, KBASE((t) + 2)); } \
                            else { SWRITE_H(SB); } }                                                                          \
        RESC(alX); __syncthreads(); } while (0)
    for (int t = 1; t + 1 < NT; t += 2) {
        HALF_STEP(pB0, pB1, mnB, alB, pA0, pA1, alA, t, 1, 0, 0);
        HALF_STEP(pA0, pA1, mnA, alA, pB0, pB1, alB, t + 1, 0, 1, 1);
    }
    asm volatile("" : "+s"(Lnext));
    const BlockRef<TIn, TOut> nxt = itemfn(Lnext); const int kbn = swa_jlo(nxt.P0, nxt.W) * KVBLK;
    const bool even = (NT & 1) == 0;
    if (even) { SBAR(); qkt<1, SK>(pB0, pB1, K_lds, r32, hi, S.qr, ACT(NT - 1)); SBAR(); }
#define QROW(e) (nxt.Q + (size_t)(wid * QBLK + r32) * D + ((e) >> 1) * 16 + hi * 8 + ((e) & 1) * 4)
    if constexpr (F32) { SLOAD_F((const float*)nxt.K, kbn); SBAR();
#pragma unroll
        for (int e = 0; e < 8; ++e) S.tq[e] = *(const f32x4*)QROW(e); }
    else { SLOAD_H(nxt.K, nxt.V, nxt.pk, kbn); SBAR();
#pragma unroll
        for (int d0 = 0; d0 < 8; ++d0) S.qr[d0] = load8<TIn>(nxt.Q + (unsigned)((wid * QBLK + r32) * nxt.pq + d0 * 16 + hi * 8)); }
    SBAR();
    finishSM(pA0, pA1, alA, l_reg, pa0, pa1, pa2, pa3); SBAR();
    if constexpr (F32) {
#pragma unroll
        for (int e = 8; e < 16; ++e) S.tq[e] = *(const f32x4*)QROW(e); SBAR(); }
#undef QROW
    pv_tile<0, SK>(o, vb0, pa0, pa1, pa2, pa3, ACT(even ? NT - 2 : NT - 1));
    if (even) { MASKT(pB0, pB1, NT - 1); partialSM(pB0, pB1, m_reg, mnB, alB); __syncthreads(); RESC(alB);
        finishSM(pB0, pB1, alB, l_reg, pa0, pa1, pa2, pa3); SBAR(); pv_tile<1, SK>(o, vb0, pa0, pa1, pa2, pa3, ACT(NT - 1)); }
    SBAR(); SEAM_K0();
    if (hi == 0) li_l[r32] = l_reg; asm volatile("s_waitcnt lgkmcnt(0)" ::: "memory");
    float rli[16];
#pragma unroll
    for (int r = 0; r < 16; ++r) rli[r] = __builtin_amdgcn_rcpf(li_l[crow(r, hi)]);
    TOut* Ow = cur.O + (unsigned)((wid * QBLK) * cur.po); const int po = cur.po;
    if constexpr (BIAS == 1 || BIAS == 3) { if (hi == 0) { f32x2 ml = {m_reg * (1.4426950408889634f * SCALE), l_reg}; *(f32x2*)(cur.L + (unsigned)((wid * QBLK + r32) * cur.pl)) = ml; }
                          bias_fill((float*)(lds + LDS_TAB) + (par ^ 1) * TAB_PITCH, nxt.bsrc, tid); }
#pragma unroll
    for (int r = 0; r < 16; ++r) { const int orow = crow(r, hi);
#pragma unroll
        for (int d0 = 0; d0 < 4; ++d0) { const float v = o[d0][r] * rli[r];
            if constexpr (same_t<TOut, float>::v) { Ow[(unsigned)(orow * po + d0 * 32 + r32)] = v; }
            else { const float vn = __shfl_xor(v, 1);
                   if ((r32 & 1) == 0) *(unsigned*)(Ow + (unsigned)(orow * po + d0 * 32 + r32)) = cvtpk(v, vn); } } }
    if constexpr (F32) {
#pragma unroll
        for (int d0 = 0; d0 < 8; ++d0) S.qr[d0] = pack8(S.tq[2 * d0], S.tq[2 * d0 + 1]); }
    __syncthreads();
#undef RESC
#undef KBASE
#undef ACT
#undef MASKT
#undef SEAM_K0
#undef HALF_STEP
}
#undef ROW
#undef VMW
#undef VMWN
#undef SLOAD_H
#undef SWRITE_HK
#undef SWRITE_HV
#undef SWRITE_H
#undef SLOAD_F
#undef SWRITE_KF
#undef SWRITE_VF

}
constexpr int NWAVES = 8;
#ifndef MK_N_LAUNCHES
#define MK_N_LAUNCHES 1
#endif
constexpr int NPH = 13;
constexpr int N_LAUNCHES = MK_N_LAUNCHES;
static_assert(N_LAUNCHES == 1 || N_LAUNCHES == NPH, "MK_N_LAUNCHES is 1 or 13");

#ifndef GV_I8
#define GV_I8 1
#endif
#ifndef FFN_I8
#define FFN_I8 1
#endif
constexpr int NB = 4, SEQ = 4096, DM = 4096, M = NB * SEQ;
constexpr int MEMLEN = 256, MROWS = NB * MEMLEN;
constexpr int NIN = 12304, NPROJ = 12288;
constexpr int DFF = 11008, NGU = 2 * DFF;
constexpr int NB1 = GV_I8 ? 4096 : 6144, NQ1 = GV_I8 ? 8192 : 6144;
constexpr int XW = 512;
constexpr float RMS_EPS = 1e-6f;

constexpr size_t MiB = 1u << 20;
constexpr size_t WS_CTL = 0, CTL_ZERO_BYTES = 1 * MiB;
constexpr size_t WS_BT = 1 * MiB;
constexpr size_t WS_Q0K0 = 1 * MiB + 64 * 1024;
constexpr size_t WS_RSC1 = 1 * MiB + 128 * 1024;
constexpr size_t WS_XNQ = 780 * MiB;
constexpr size_t WS_WINQ = 2 * MiB + (size_t)6144 * 4096 * 2;
constexpr size_t WS_WIN = 2 * MiB;
constexpr size_t WS_WLR = 98 * MiB;
constexpr size_t WS_WOUT = 99 * MiB;
constexpr size_t WS_WXQ = 131 * MiB;
constexpr size_t WS_WXKV = 135 * MiB;
constexpr size_t WS_WXO = 143 * MiB;
constexpr size_t WS_MEMN = 147 * MiB;
constexpr size_t WS_XKV = 155 * MiB;
constexpr size_t WS_WGU = 160 * MiB;
constexpr size_t WS_WDN = 332 * MiB;
constexpr size_t WS_DQKV = 160 * MiB;
constexpr size_t WS_GK = 352 * MiB;
constexpr size_t WS_GQ = 384 * MiB;
constexpr size_t WS_XN = 418 * MiB;
constexpr size_t WS_MIX = 546 * MiB;
constexpr size_t WS_GV = 546 * MiB;
constexpr size_t WS_VT = 610 * MiB;
constexpr size_t WS_GR = 674 * MiB;
constexpr size_t WS_KET = 738 * MiB;
constexpr size_t WS_ATT = 770 * MiB;
constexpr size_t WS_DEC = 778 * MiB;
constexpr size_t WS_OC = 780 * MiB;
constexpr size_t WS_LSE = 972 * MiB;
constexpr size_t WS_ACT = 546 * MiB;
constexpr size_t WS_HALO = 890 * MiB;
constexpr size_t WS_XQ = 980 * MiB;
constexpr size_t WS_XO = 996 * MiB;
constexpr size_t WS_GQ2 = 1012 * MiB;
constexpr size_t WS_H2Q = 980 * MiB;
constexpr size_t WS_END = 1044 * MiB;
constexpr size_t HALO_ONE = (size_t)256 * 2 * DFF * 4;
static_assert(WS_HALO + 3 * HALO_ONE <= WS_XQ && WS_ACT + (size_t)M * DFF * 2 <= WS_HALO && WS_WDN + (size_t)DM * DFF * 2 <= WS_XN && WS_WGU + (size_t)NGU * DM * 2 <= WS_WDN, "d_ws map");
static_assert(WS_OC + (size_t)3 * M * 2048 * 2 <= WS_LSE && WS_LSE + (size_t)3 * M * 16 * 2 * 4 <= WS_XQ && WS_GQ + (size_t)M * 1024 * 2 <= WS_XN, "d_ws map 2");
constexpr int CW_QUEUE = 2048;
constexpr int CW_BAR = 4096;
constexpr size_t CTL_COLMAX = 704 * 1024;
constexpr size_t CTL_CMAX1 = 864 * 1024;
constexpr size_t CTL_AMAX = 800 * 1024;
constexpr size_t CTL_SS = 256 * 1024;

constexpr int LDS_BYTES = 147456;
constexpr int MISC_OFF = LDS_BYTES - 256;

#define GAS __attribute__((address_space(1)))
#define LAS __attribute__((address_space(3)))
typedef unsigned short bf16;
typedef unsigned v4u __attribute__((ext_vector_type(4)));
typedef unsigned v2u __attribute__((ext_vector_type(2)));
typedef float f32x4 __attribute__((ext_vector_type(4)));
typedef float f32x2 __attribute__((ext_vector_type(2)));
typedef float f32x16 __attribute__((ext_vector_type(16)));
typedef short bf16x8 __attribute__((ext_vector_type(8)));
typedef short s16x4 __attribute__((ext_vector_type(4)));
typedef short v4i16_t __attribute__((ext_vector_type(4)));
typedef GAS unsigned gu32;
#define RLX_AGENT __ATOMIC_RELAXED, __HIP_MEMORY_SCOPE_AGENT
#define LDS_WAIT() asm volatile("s_waitcnt lgkmcnt(0)" ::: "memory")
#define VM_WAIT() asm volatile("s_waitcnt vmcnt(0)" ::: "memory")
__device__ __forceinline__ unsigned f2bf(float f) { unsigned u = __builtin_bit_cast(unsigned, f); return (u + 0x7fffu + ((u >> 16) & 1u)) >> 16; }
__device__ __forceinline__ float bf2f(unsigned short b) { return __builtin_bit_cast(float, (unsigned)b << 16); }
__device__ __forceinline__ float bflo(unsigned w) { return __builtin_bit_cast(float, w << 16); }
__device__ __forceinline__ float bfhi(unsigned w) { return __builtin_bit_cast(float, w & 0xffff0000u); }
__device__ __forceinline__ unsigned q8x4(float a, float b, float c, float d, float inv) {
    const float MG = 12582912.0f;
    const unsigned ua = __builtin_bit_cast(unsigned, __builtin_amdgcn_fmed3f(__builtin_fmaf(a, inv, MG), MG - 127.0f, MG + 127.0f)), ub = __builtin_bit_cast(unsigned, __builtin_amdgcn_fmed3f(__builtin_fmaf(b, inv, MG), MG - 127.0f, MG + 127.0f));
    const unsigned uc = __builtin_bit_cast(unsigned, __builtin_amdgcn_fmed3f(__builtin_fmaf(c, inv, MG), MG - 127.0f, MG + 127.0f)), ud = __builtin_bit_cast(unsigned, __builtin_amdgcn_fmed3f(__builtin_fmaf(d, inv, MG), MG - 127.0f, MG + 127.0f));
    return __builtin_amdgcn_perm(ub, ua, 0x0c0c0400u) | __builtin_amdgcn_perm(ud, uc, 0x04000c0cu);
}
typedef __bf16 bf16x2_t __attribute__((ext_vector_type(2)));
__device__ __forceinline__ unsigned cvtpk_s(float lo, float hi) { f32x2 v = {lo, hi}; bf16x2_t b = __builtin_convertvector(v, bf16x2_t); return __builtin_bit_cast(unsigned, b); }
__device__ __forceinline__ unsigned pk2(float lo, float hi) { return cvtpk_s(lo, hi); }
__device__ __forceinline__ bf16x8 pack8f(float a0, float a1, float a2, float a3, float a4, float a5, float a6, float a7) {
    v4u w = {cvtpk_s(a0, a1), cvtpk_s(a2, a3), cvtpk_s(a4, a5), cvtpk_s(a6, a7)}; return __builtin_bit_cast(bf16x8, w); }
#define XB_TMO      128
#define XB_XCNT(j)  (256  + 64 * (j))
#define XB_XSUB(j)  (1280 + 64 * (j))
#define XB_XGEN(j)  (2304 + 64 * (j))
#define XB_TOP      3328
#define XB_TOPGEN   3392
#define XCD_BAR_WORDS 3456
#define XB_SPIN_CAP (1u << 18)

__device__ __forceinline__ unsigned xb_ld(unsigned* p)              { return __hip_atomic_load(p, __ATOMIC_RELAXED, __HIP_MEMORY_SCOPE_AGENT); }
__device__ __forceinline__ unsigned xb_add(unsigned* p, unsigned v) { return __hip_atomic_fetch_add(p, v, __ATOMIC_RELAXED, __HIP_MEMORY_SCOPE_AGENT); }
__device__ __forceinline__ unsigned xb_xcc_id() { return (unsigned)__builtin_amdgcn_s_getreg((3 << 11) | 20) & 0xFu; }
#define XB_SPIN(cond, bar) do { unsigned _sp = 0; while (cond) { __builtin_amdgcn_s_sleep(1); \
    if ((++_sp & 255u) == 0u) { if (xb_ld(&(bar)[XB_TMO])) break; if (_sp > XB_SPIN_CAP) { atomicAdd(&(bar)[XB_TMO], 1u); break; } } } } while (0)

struct XcdBarrier {
    unsigned* bar; unsigned x;
    volatile LAS unsigned* st;
};

__device__ __forceinline__ XcdBarrier xcd_barrier_post(unsigned* bar, volatile LAS unsigned* st) {
    XcdBarrier b; b.bar = bar; b.x = xb_xcc_id(); b.st = st;
    if (threadIdx.x == 0) (void)xb_add(&bar[XB_XCNT(b.x)], 1u);
    return b;
}
__device__ __forceinline__ void xcd_barrier_complete(unsigned* bar, unsigned x, unsigned& nloc, unsigned& nx) {
    const unsigned G = gridDim.x * gridDim.y * gridDim.z;
    unsigned sum, cnt, mine, sp = 0u;
    for (;;) {
        sum = 0u; cnt = 0u; mine = 0u;
#pragma unroll
        for (unsigned j = 0; j < 16; ++j) { const unsigned c = xb_ld(&bar[XB_XCNT(j)]); sum += c; cnt += (c > 0u) ? 1u : 0u; mine = (j == x) ? c : mine; }
        if (sum == G) break;
        __builtin_amdgcn_s_sleep(1);
        if ((++sp & 255u) == 0u) { if (xb_ld(&bar[XB_TMO])) break; if (sp > XB_SPIN_CAP) { atomicAdd(&bar[XB_TMO], 1u); break; } }
    }
    nloc = mine > 0u ? mine : 1u; nx = cnt > 0u ? cnt : 1u;
}

__device__ __forceinline__ void xcd_barrier(const XcdBarrier& b) {
    asm volatile("s_waitcnt vmcnt(0)" ::: "memory");
    __syncthreads();
    if (threadIdx.x == 0) {
        unsigned* bar = b.bar;
        __builtin_amdgcn_s_waitcnt(0);
        unsigned nloc = b.st[0], nx = b.st[1];
        if (nloc == 0u) { xcd_barrier_complete(bar, b.x, nloc, nx); b.st[0] = nloc; b.st[1] = nx; }
        const unsigned old = xb_add(&bar[XB_XSUB(b.x)], 1u);
        const unsigned gen = old / nloc;
        if (old + 1u == (gen + 1u) * nloc) {
            __builtin_amdgcn_fence(__ATOMIC_RELEASE, "agent");
            asm volatile("s_waitcnt vmcnt(0)" ::: "memory");
            const unsigned og = xb_add(&bar[XB_TOP], 1u);
            const unsigned tg = og / nx;
            if (og + 1u == (tg + 1u) * nx) xb_add(&bar[XB_TOPGEN], 1u);
            else XB_SPIN(xb_ld(&bar[XB_TOPGEN]) == tg, bar);
            __builtin_amdgcn_fence(__ATOMIC_ACQUIRE, "agent");
            xb_add(&bar[XB_XGEN(b.x)], 1u);
            asm volatile("s_waitcnt vmcnt(0)" ::: "memory");
        } else {
            XB_SPIN(xb_ld(&bar[XB_XGEN(b.x)]) == gen, bar);
            __builtin_amdgcn_fence(__ATOMIC_ACQUIRE, "agent");
            asm volatile("s_waitcnt vmcnt(0)" ::: "memory");
        }
    }
    __syncthreads();
}
struct Frame {
    LAS unsigned char* lds; char* ldsg;
    volatile LAS unsigned* MISC;
    gu32* ctl;
    int wave, vcu, G;
    unsigned char* ws;
    const float* const __attribute__((address_space(4)))* kin;
    float* out;
};
__device__ __forceinline__ int tid_now() { int t = (int)threadIdx.x; asm volatile("" : "+v"(t)); return t; }
#define WAVE_RED_(v, OP) do { \
    v = OP(v, __builtin_bit_cast(decltype(v), __builtin_amdgcn_update_dpp(0, __builtin_bit_cast(int, v), 0xB1, 0xf, 0xf, true))); \
    v = OP(v, __builtin_bit_cast(decltype(v), __builtin_amdgcn_update_dpp(0, __builtin_bit_cast(int, v), 0x4E, 0xf, 0xf, true))); \
    v = OP(v, __builtin_bit_cast(decltype(v), __builtin_amdgcn_update_dpp(0, __builtin_bit_cast(int, v), 0x124, 0xf, 0xf, true))); \
    v = OP(v, __builtin_bit_cast(decltype(v), __builtin_amdgcn_update_dpp(0, __builtin_bit_cast(int, v), 0x128, 0xf, 0xf, true))); \
    { auto rr_ = __builtin_amdgcn_permlane16_swap(__builtin_bit_cast(unsigned, v), __builtin_bit_cast(unsigned, v), false, false); v = OP(__builtin_bit_cast(decltype(v), rr_[0]), __builtin_bit_cast(decltype(v), rr_[1])); } \
    { auto rr_ = __builtin_amdgcn_permlane32_swap(__builtin_bit_cast(unsigned, v), __builtin_bit_cast(unsigned, v), false, false); v = OP(__builtin_bit_cast(decltype(v), rr_[0]), __builtin_bit_cast(decltype(v), rr_[1])); } } while (0)
#define WR_ADD_(a, b) ((a) + (b))
#define WR_MAXF_(a, b) fmaxf((a), (b))
#define WR_MAXU_(a, b) ((a) > (b) ? (a) : (b))
__device__ __forceinline__ float wave_sum(float v) {
    v += __int_as_float(__builtin_amdgcn_update_dpp(0, __float_as_int(v), 0xB1, 0xf, 0xf, true));
    v += __int_as_float(__builtin_amdgcn_update_dpp(0, __float_as_int(v), 0x4E, 0xf, 0xf, true));
    v += __int_as_float(__builtin_amdgcn_update_dpp(0, __float_as_int(v), 0x124, 0xf, 0xf, true));
    v += __int_as_float(__builtin_amdgcn_update_dpp(0, __float_as_int(v), 0x128, 0xf, 0xf, true));
    v += __shfl_xor(v, 16);
    { auto rr_ = __builtin_amdgcn_permlane32_swap(__float_as_uint(v), __float_as_uint(v), false, false); v = __uint_as_float(rr_[0]) + __uint_as_float(rr_[1]); }
    return v;
}
__device__ __forceinline__ float wave_maxf(float v) {
#pragma unroll
    for (int o = 1; o < 64; o <<= 1) v = fmaxf(v, __shfl_xor(v, o));
    return v;
}
__device__ __forceinline__ unsigned wave_maxu(unsigned v) {
#pragma unroll
    for (int o = 1; o < 64; o <<= 1) { const unsigned u = (unsigned)__shfl_xor((int)v, o); v = v > u ? v : u; }
    return v;
}
__device__ const unsigned char kBucket[3][132] = {
 {0,1,2,3,4,5,6,7,8,9,10,11,12,13,14,15,16,16,16,16,16,16,17,17,17,17,17,17,17,17,18,18,18,18,18,18,18,18,18,18,19,19,19,19,19,19,19,19,19,19,19,19,19,19,20,20,20,20,20,20,20,20,20,20,20,20,20,20,20,20,20,20,20,21,21,21,21,21,21,21,21,21,21,21,21,21,21,21,21,21,21,21,21,21,21,21,21,21,21,22,22,22,22,22,22,22,22,22,22,22,22,22,22,22,22,22,22,22,22,22,22,22,22,22,22,22,22,22,22,0,0,0},
 {0,4,8,12,16,16,17,17,18,18,19,19,19,19,20,20,20,20,20,21,21,21,21,21,21,22,22,22,22,22,22,22,22,22,23,23,23,23,23,23,23,23,23,23,23,23,24,24,24,24,24,24,24,24,24,24,24,24,24,24,24,24,25,25,25,25,25,25,25,25,25,25,25,25,25,25,25,25,25,25,25,25,25,26,26,26,26,26,26,26,26,26,26,26,26,26,26,26,26,26,26,26,26,26,26,26,26,26,26,26,26,26,26,27,27,27,27,27,27,27,27,27,27,27,27,27,27,27,27,0,0,0},
 {0,16,18,19,20,21,21,22,22,23,23,23,24,24,24,24,25,25,25,25,25,26,26,26,26,26,26,26,26,27,27,27,27,27,27,27,27,27,27,28,28,28,28,28,28,28,28,28,28,28,28,28,29,29,29,29,29,29,29,29,29,29,29,29,29,29,29,29,29,29,30,30,30,30,30,30,30,30,30,30,30,30,30,30,30,30,30,30,30,30,30,30,30,30,30,31,31,31,31,31,31,31,31,31,31,31,31,31,31,31,31,31,31,31,31,31,31,31,31,31,31,31,31,31,31,31,31,31,31,0,0,0}};

#ifndef NT_LOADS
#define NT_LOADS 1
#endif
#if NT_LOADS
#define NTLD(p) __builtin_nontemporal_load(p)
#else
#define NTLD(p) (*(p))
#endif
constexpr int TR_SCR = 17408;
__device__ __forceinline__ void tr_item(const float* W, int ldw, bf16* WT, int ldt, int src_c0, int dst_r0, int nvalid, const float* gain, LAS float* scr, int kb, int lane) {
    const int k0 = 64 * kb, a = lane >> 4, c4 = 4 * (lane & 15);
#pragma unroll 8
    for (int i = 0; i < 16; ++i) { const int kk = 4 * i + a; f32x4 v = NTLD((const GAS f32x4*)(W + (size_t)(k0 + kk) * ldw + src_c0 + c4)); if (gain) v = v * gain[k0 + kk];
        LAS float* d = scr + kk * 65 + c4; d[0] = v.x; d[1] = v.y; d[2] = v.z; d[3] = v.w; }
    LDS_WAIT(); asm volatile("" ::: "memory");
    const int c = lane & 7;
#pragma unroll
    for (int j = 0; j < 8; ++j) { const int n = (lane >> 3) + 8 * j; const LAS float* s = scr + (8 * c) * 65 + n;
        v4u o; o.x = pk2(s[0 * 65], s[1 * 65]); o.y = pk2(s[2 * 65], s[3 * 65]); o.z = pk2(s[4 * 65], s[5 * 65]); o.w = pk2(s[6 * 65], s[7 * 65]);
        if (n < nvalid) *(GAS v4u*)(WT + (size_t)(dst_r0 + n) * ldt + k0 + 8 * c) = o; }
    LDS_WAIT(); asm volatile("" ::: "memory");
}
constexpr float CM_WIDEN = 1.0f;
__device__ __forceinline__ void absmax_item(const float* W, int ldw, int src_c0, const float* gain, unsigned* cmax, int kb, int lane) {
    const int k0 = 64 * kb, a = lane >> 4, c4 = 4 * (lane & 15);
    f32x4 m = {0.f, 0.f, 0.f, 0.f};
#pragma unroll 8
    for (int i = 0; i < 16; ++i) { const int kk = 4 * i + a; const f32x4 v = *(const GAS f32x4*)(W + (size_t)(k0 + kk) * ldw + src_c0 + c4) * (gain ? gain[k0 + kk] : 1.0f);
        m.x = fmaxf(m.x, fabsf(v.x)); m.y = fmaxf(m.y, fabsf(v.y)); m.z = fmaxf(m.z, fabsf(v.z)); m.w = fmaxf(m.w, fabsf(v.w)); }
#pragma unroll
    for (int o = 16; o < 64; o <<= 1) { m.x = fmaxf(m.x, __shfl_xor(m.x, o)); m.y = fmaxf(m.y, __shfl_xor(m.y, o)); m.z = fmaxf(m.z, __shfl_xor(m.z, o)); m.w = fmaxf(m.w, __shfl_xor(m.w, o)); }
    if (lane < 16) { unsigned* p = cmax + c4;   atomicMax(p, __float_as_uint(m.x)); atomicMax(p + 1, __float_as_uint(m.y)); atomicMax(p + 2, __float_as_uint(m.z)); atomicMax(p + 3, __float_as_uint(m.w)); }
}
__device__ __forceinline__ void quant_item(const float* W, int ldw, signed char* WQ, int ldq, int src_c0, int dst_r0, const float* gain, const unsigned* cmax, LAS float* scr, int kb, int lane) {
    const int k0 = 64 * kb, a = lane >> 4, c4 = 4 * (lane & 15);
#pragma unroll 8
    for (int i = 0; i < 16; ++i) { const int kk = 4 * i + a; const f32x4 v = NTLD((const GAS f32x4*)(W + (size_t)(k0 + kk) * ldw + src_c0 + c4)) * (gain ? gain[k0 + kk] : 1.0f);
        LAS float* d = scr + kk * 65 + c4; d[0] = v.x; d[1] = v.y; d[2] = v.z; d[3] = v.w; }
    LDS_WAIT(); asm volatile("" ::: "memory");
    const int c = lane & 3;
#pragma unroll
    for (int j = 0; j < 4; ++j) { const int n = (lane >> 2) + 16 * j; const LAS float* s = scr + (16 * c) * 65 + n;
        const float cm = __uint_as_float(cmax[n]) * CM_WIDEN; const float inv = cm > 0.f ? 127.0f / cm : 0.f;
        unsigned wq[4];
#pragma unroll
        for (int q = 0; q < 4; ++q) wq[q] = q8x4(s[(4 * q) * 65], s[(4 * q + 1) * 65], s[(4 * q + 2) * 65], s[(4 * q + 3) * 65], inv);
        v4u o = {wq[0], wq[1], wq[2], wq[3]};
        *(GAS v4u*)(WQ + (size_t)(dst_r0 + n) * ldq + k0 + 16 * c) = o; }
    LDS_WAIT(); asm volatile("" ::: "memory");
}

__device__ __forceinline__ void rms_row_to_bf16(const float* xrow, const float* g, bf16* orow, int lane, signed char* qrow = nullptr, float* qscale = nullptr) {
    const GAS f32x4* xr = (const GAS f32x4*)xrow + lane; const GAS f32x4* gr = (const GAS f32x4*)g + lane;
    f32x4 v[16]; float s = 0.f;
#pragma unroll
    for (int j = 0; j < 16; ++j) { v[j] = NTLD(xr + 64 * j); s += (v[j].x * v[j].x + v[j].y * v[j].y) + (v[j].z * v[j].z + v[j].w * v[j].w); }
    const float r = 1.0f / sqrtf(wave_sum(s) * (1.0f / 4096.0f) + RMS_EPS);
    GAS v2u* o8 = (GAS v2u*)orow + lane; float mx = 0.f;
#pragma unroll
    for (int j = 0; j < 16; ++j) { const f32x4 gg = gr[64 * j]; v[j] = (f32x4){v[j].x * r * gg.x, v[j].y * r * gg.y, v[j].z * r * gg.z, v[j].w * r * gg.w};
        v2u o; o.x = pk2(v[j].x, v[j].y); o.y = pk2(v[j].z, v[j].w); o8[64 * j] = o;
        mx = fmaxf(mx, fmaxf(fmaxf(fabsf(v[j].x), fabsf(v[j].y)), fmaxf(fabsf(v[j].z), fabsf(v[j].w)))); }
    if (qrow) {
        mx = wave_maxf(mx);
        const float inv = mx > 0.f ? 127.0f / mx : 0.f; GAS unsigned* q4 = (GAS unsigned*)qrow + lane;
#pragma unroll
        for (int j = 0; j < 16; ++j) q4[64 * j] = q8x4(v[j].x, v[j].y, v[j].z, v[j].w, inv);
        if (lane == 0) *qscale = mx * (1.0f / 127.0f);
    }
}

__device__ __forceinline__ void p0_first_token(Frame& F) {
    const int tid = tid_now(), lane = tid & 63, w = F.wave;
    LAS float* red = (LAS float*)F.lds;
    const float* x = F.kin[0]; const float* g = F.kin[3]; const float* W = F.kin[4];
    float* Q0K0 = (float*)(F.ws + WS_Q0K0);
    for (int cb = blockIdx.x; cb < 256; cb += F.G) {
        float xv[4][8]; float gg[8]; f32x4 w0[8], w1[8];
#pragma unroll
        for (int i = 0; i < 8; ++i) { gg[i] = g[tid + 512 * i]; const GAS f32x4* wp = (const GAS f32x4*)(W + (size_t)(tid + 512 * i) * NIN + 8 * cb); w0[i] = wp[0]; w1[i] = wp[1];
#pragma unroll
            for (int b = 0; b < 4; ++b) xv[b][i] = x[(size_t)b * SEQ * DM + tid + 512 * i]; }
        float acc[4][8], ss[4];
#pragma unroll
        for (int b = 0; b < 4; ++b) { ss[b] = 0.f;
#pragma unroll
            for (int c = 0; c < 8; ++c) acc[b][c] = 0.f; }
#pragma unroll
        for (int i = 0; i < 8; ++i) { const float wv[8] = {w0[i].x, w0[i].y, w0[i].z, w0[i].w, w1[i].x, w1[i].y, w1[i].z, w1[i].w};
#pragma unroll
            for (int b = 0; b < 4; ++b) { ss[b] += xv[b][i] * xv[b][i]; const float xg = xv[b][i] * gg[i];
#pragma unroll
                for (int c = 0; c < 8; ++c) acc[b][c] += xg * wv[c]; } }
#pragma unroll
        for (int b = 0; b < 4; ++b) { const float s2 = wave_sum(ss[b]); if (lane == 0) red[w * 40 + 32 + b] = s2;
#pragma unroll
            for (int c = 0; c < 8; ++c) { const float s = wave_sum(acc[b][c]); if (lane == 0) red[w * 40 + b * 8 + c] = s; } }
        __syncthreads();
        if (tid < 32) { float s = 0.f, q = 0.f;
#pragma unroll
            for (int k = 0; k < 8; ++k) { s += red[k * 40 + tid]; q += red[k * 40 + 32 + (tid >> 3)]; }
            Q0K0[(tid >> 3) * 2048 + 8 * cb + (tid & 7)] = s * (1.0f / sqrtf(q * (1.0f / 4096.0f) + RMS_EPS)); }
        __syncthreads();
    }
}
__device__ __forceinline__ int winq_src_col(int nb) { return GV_I8 ? (nb < 32 ? 2048 + 64 * nb : 6160 + 64 * (nb - 32)) : 6160 + 64 * nb; }
__device__ __forceinline__ void p0_prologue(Frame& F) {
    const int tid = tid_now(), lane = tid & 63;
    LAS float* scr = (LAS float*)(F.lds + F.wave * TR_SCR);
    const int gw = F.vcu * NWAVES + F.wave, NGW = F.G * NWAVES;
    bf16* Win = (bf16*)(F.ws + WS_WIN); bf16* Wlr = (bf16*)(F.ws + WS_WLR); bf16* Wout = (bf16*)(F.ws + WS_WOUT); bf16* Wxq = (bf16*)(F.ws + WS_WXQ); bf16* Wxkv = (bf16*)(F.ws + WS_WXKV); bf16* Wxo = (bf16*)(F.ws + WS_WXO);
    constexpr int NA = GV_I8 ? 2048 : 4096;
    constexpr int I_INA = 64 * (NA / 64), I_INB = 64 * (2048 / 64), I_INQ = 64 * (NQ1 / 64), I_LR = 64, I_OUT = 64 * 64, I_XQ = 64 * 8, I_XO = 8 * 64;
    constexpr int NIT = I_INA + I_INB + I_INQ + I_LR + I_OUT + 3 * I_XQ + I_XO;
    unsigned* cmax1 = (unsigned*)(F.ws + WS_CTL + CTL_CMAX1);
    for (int it = gw; it < NIT; it += NGW) {
        int r = it;
        if (r < I_INA) { const int nb = r % (NA / 64), kb = r / (NA / 64); tr_item(F.kin[4], NIN, Win, DM, 64 * nb, 64 * nb, 64, nullptr, scr, kb, lane); continue; } r -= I_INA;
        if (r < I_INB) { const int nb = r % 32, kb = r / 32; tr_item(F.kin[4], NIN, Win, DM, 4112 + 64 * nb, NA + 64 * nb, 64, nullptr, scr, kb, lane); continue; } r -= I_INB;
        if (r < I_INQ) { const int nb = r % (NQ1 / 64), kb = r / (NQ1 / 64); absmax_item(F.kin[4], NIN, winq_src_col(nb), nullptr, cmax1 + 64 * nb, kb, lane); continue; } r -= I_INQ;
        if (r < I_LR) { tr_item(F.kin[4], NIN, Wlr, DM, 4096, 0, 16, nullptr, scr, r, lane); continue; } r -= I_LR;
        if (r < I_OUT) { const int nb = r % 64, kb = r / 64; tr_item(F.kin[8], DM, Wout, DM, 64 * nb, 64 * nb, 64, nullptr, scr, kb, lane); continue; } r -= I_OUT;
        if (r < I_XQ) { const int nb = r % 8, kb = r / 8; tr_item(F.kin[11], XW, Wxq, DM, 64 * nb, 64 * nb, 64, F.kin[9], scr, kb, lane); continue; } r -= I_XQ;
        if (r < I_XQ) { const int nb = r % 8, kb = r / 8; tr_item(F.kin[12], XW, Wxkv, DM, 64 * nb, 64 * nb, 64, nullptr, scr, kb, lane); continue; } r -= I_XQ;
        if (r < I_XQ) { const int nb = r % 8, kb = r / 8; tr_item(F.kin[13], XW, Wxkv, DM, 64 * nb, 512 + 64 * nb, 64, nullptr, scr, kb, lane); continue; } r -= I_XQ;
        { const int nb = r % 64, kb = r / 64; tr_item(F.kin[14], DM, Wxo, XW, 64 * nb, 64 * nb, 64, nullptr, scr, kb, lane); }
    }
    bf16* XN = (bf16*)(F.ws + WS_XN); bf16* MEMN = (bf16*)(F.ws + WS_MEMN);
    for (int m = NGW - 1 - gw; m < M + MROWS; m += NGW) {
        if (m < M) rms_row_to_bf16(F.kin[0] + (size_t)m * DM, F.kin[3], XN + (size_t)m * DM, lane, (signed char*)(F.ws + WS_XNQ) + (size_t)m * DM, (float*)(F.ws + WS_RSC1) + m);
        else rms_row_to_bf16(F.kin[1] + (size_t)(m - M) * DM, F.kin[10], MEMN + (size_t)(m - M) * DM, lane);
    }
    float* BT = (float*)(F.ws + WS_BT);
    for (int i = blockIdx.x * 512 + tid; i < 3 * 16 * 132; i += F.G * 512) { const int rel = i % 132, h = (i / 132) % 16, cfg = i / (132 * 16);
        BT[i] = rel < 129 ? F.kin[2][kBucket[cfg][rel] * 16 + h] * 11.313708498984761f : 0.f; }
}
constexpr int FW_IG = 64 * (DFF / 64), FW_ID = (DFF / 64) * 64, FW_ALL = 2 * FW_IG + FW_ID;
#ifndef FW_P6N
#define FW_P6N 3584
#endif
constexpr int FW_P6_LO = 2 * FW_IG - (FW_P6N), FW_P6_HI = 2 * FW_IG;
#ifndef FW_P9N
#define FW_P9N 8448
#endif
#ifndef P9_GEMM_WGS
#define P9_GEMM_WGS 251
#endif
constexpr int FW_P9_LO = FW_ALL - (FW_P9N), FW_P9_HI = FW_ALL;
template <int MODE  >
__device__ __forceinline__ void ffn_weight_item(Frame& F, int r, LAS float* scr, int lane) {
    bf16* Wgu = (bf16*)(F.ws + WS_WGU); bf16* Wdn = (bf16*)(F.ws + WS_WDN); unsigned* cmax = (unsigned*)(F.ws + WS_CTL + CTL_COLMAX);
    if (r < 2 * FW_IG) { const int up = r >= FW_IG ? 1 : 0; const int rr = r - up * FW_IG; const int nb = rr % 172, kb = rr / 172, c0 = 64 * nb; const float* W = up ? F.kin[17] : F.kin[16];
        const int drow = 256 * (c0 >> 7) + 128 * up + (c0 & 127);
        if constexpr (MODE == 1) absmax_item(W, DFF, c0, F.kin[15], cmax + up * DFF + c0, kb, lane);
        else if constexpr (FFN_I8) quant_item(W, DFF, (signed char*)Wgu, DM, c0, drow, F.kin[15], cmax + up * DFF + c0, scr, kb, lane);
        else tr_item(W, DFF, Wgu, DM, c0, drow, 64, F.kin[15], scr, kb, lane);
        return; }
    if constexpr (MODE == 0) { r -= 2 * FW_IG; const int nb = r % 64, kb = r / 64; tr_item(F.kin[20], DM, Wdn, DFF, 64 * nb, 64 * nb, 64, nullptr, scr, kb, lane); }
}
template <int MODE> __device__ __forceinline__ void ffn_weights(Frame& F, int lo, int hi, int iw, int nw) {
    const int lane = tid_now() & 63; LAS float* scr = (LAS float*)(F.lds + F.wave * TR_SCR);
    for (int it = lo + iw; it < hi; it += nw) ffn_weight_item<MODE>(F, it, scr, lane);
}

__device__ __forceinline__ void p0_quant_win(Frame& F) {
    const int lane = tid_now() & 63; LAS float* scr = (LAS float*)(F.lds + F.wave * TR_SCR);
    const int gw = F.vcu * NWAVES + F.wave, NGW = F.G * NWAVES;
    const unsigned* cmax1 = (const unsigned*)(F.ws + WS_CTL + CTL_CMAX1);
    for (int r = gw; r < 64 * (NQ1 / 64); r += NGW) { const int nb = r % (NQ1 / 64), kb = r / (NQ1 / 64);
        quant_item(F.kin[4], NIN, (signed char*)(F.ws + WS_WINQ), DM, winq_src_col(nb), 64 * nb, nullptr, cmax1 + 64 * nb, scr, kb, lane); }
}
constexpr int PP = 520;
constexpr int PREP_GLR = 0, PREP_QM = 8192, PREP_KM = 8192 + 64 * PP * 2;
static_assert(PREP_KM + 64 * PP * 2 <= MISC_OFF, "prep LDS");
__device__ __forceinline__ void gla_prep_unit(Frame& F, int b, int n) {
    const int tid = tid_now(), lane = tid & 63, w = F.wave;
    const int t0 = b * SEQ + 64 * n;
    const bf16* XN = (const bf16*)(F.ws + WS_XN); const bf16* Wlr = (const bf16*)(F.ws + WS_WLR);
    const bf16* GQ = (const bf16*)(F.ws + WS_GQ); bf16* GQ2 = (bf16*)(F.ws + WS_GQ2); const bf16* GK = (const bf16*)(F.ws + WS_GK);
    bf16* KET = (bf16*)(F.ws + WS_KET); bf16* ATT = (bf16*)(F.ws + WS_ATT); float* DEC = (float*)(F.ws + WS_DEC);
    LAS float* glr = (LAS float*)(F.lds + PREP_GLR);
    LAS bf16* QMs = (LAS bf16*)(F.lds + PREP_QM); LAS bf16* KMs = (LAS bf16*)(F.lds + PREP_KM);
    {
        const int rg = w & 3, kh = w >> 2, rr = lane & 15, kg = lane >> 4;
        const bf16* ap = XN + (size_t)(t0 + 16 * rg + rr) * DM + kh * 2048 + 8 * kg; const bf16* bp = Wlr + (size_t)rr * DM + kh * 2048 + 8 * kg;
        f32x4 acc = {0.f, 0.f, 0.f, 0.f};
#pragma unroll 16
        for (int s = 0; s < 64; ++s) { const bf16x8 a = *(const GAS bf16x8*)(ap + 32 * s), bq = *(const GAS bf16x8*)(bp + 32 * s); acc = __builtin_amdgcn_mfma_f32_16x16x32_bf16(a, bq, acc, 0, 0, 0); }
#pragma unroll
        for (int i = 0; i < 4; ++i) glr[(kh * 64 + 16 * rg + 4 * kg + i) * 16 + rr] = acc[i];
    }
    __syncthreads();
    for (int i = tid; i < 1024; i += 512) glr[i] += glr[1024 + i];
    __syncthreads();
    const int cid = (b * 64 + n) * 4;
    for (int hp = 0; hp < 2; ++hp) {
        {
            const int col = hp * 512 + tid, h = col >> 8, dk = col & 255;
            float w2[16];
#pragma unroll
            for (int j = 0; j < 16; ++j) w2[j] = F.kin[5][j * 1024 + col];
            const float bg = F.kin[6][col];
            const bf16* qp = GQ + (size_t)t0 * 1024 + col; const bf16* kp = GK + (size_t)t0 * 1024 + col;
            typedef unsigned short us2_t __attribute__((ext_vector_type(2)));
            us2_t kv[32];
#pragma unroll
            for (int c2 = 0; c2 < 32; ++c2) { kv[c2].x = kp[(size_t)(2 * c2) * 1024]; kv[c2].y = kp[(size_t)(2 * c2 + 1) * 1024]; }
            float bc[64]; float run = 0.f;
#pragma unroll
            for (int c = 0; c < 64; ++c) {
                const LAS f32x4* gp = (const LAS f32x4*)(glr + c * 16); const f32x4 g0 = gp[0], g1 = gp[1], g2 = gp[2], g3 = gp[3];
                float za = bg, zb = 0.f;
                za = __builtin_fmaf(g0.x, w2[0], za); zb = __builtin_fmaf(g0.y, w2[1], zb); za = __builtin_fmaf(g0.z, w2[2], za); zb = __builtin_fmaf(g0.w, w2[3], zb);
                za = __builtin_fmaf(g1.x, w2[4], za); zb = __builtin_fmaf(g1.y, w2[5], zb); za = __builtin_fmaf(g1.z, w2[6], za); zb = __builtin_fmaf(g1.w, w2[7], zb);
                za = __builtin_fmaf(g2.x, w2[8], za); zb = __builtin_fmaf(g2.y, w2[9], zb); za = __builtin_fmaf(g2.z, w2[10], za); zb = __builtin_fmaf(g2.w, w2[11], zb);
                za = __builtin_fmaf(g3.x, w2[12], za); zb = __builtin_fmaf(g3.y, w2[13], zb); za = __builtin_fmaf(g3.z, w2[14], za); zb = __builtin_fmaf(g3.w, w2[15], zb);
                const float z = za + zb;
                const float ls = fminf(z, 0.f) - 0.6931471805599453f * __builtin_amdgcn_logf(1.0f + __builtin_amdgcn_exp2f(-1.4426950408889634f * fabsf(z)));
                run += ls * (1.0f / 16.0f); bc[c] = run;
            }
            const float blast = bc[63], bmid = bc[32]; const float Emid = __expf(bmid), Elm = __expf(blast - bmid);
            unsigned kep[32];
            bf16* qo = GQ2 + (size_t)t0 * 1024 + col;
#pragma unroll
            for (int c2 = 0; c2 < 32; ++c2) {
                const int c = 2 * c2;
                const float qa = bf2f(qp[(size_t)c * 1024]) * (1.0f / 16.0f), ka = bf2f(kv[c2].x);
                const float qb = bf2f(qp[(size_t)(c + 1) * 1024]) * (1.0f / 16.0f), kb = bf2f(kv[c2].y);
                const float Aa = __expf(bc[c] - bmid), Ab = __expf(bc[c + 1] - bmid), Ra = __builtin_amdgcn_rcpf(Aa), Rb = __builtin_amdgcn_rcpf(Ab);
                const unsigned qt = cvtpk_s(qa * (Aa * Emid), qb * (Ab * Emid));
                qo[(size_t)c * 1024] = (bf16)(qt & 0xffffu); qo[(size_t)(c + 1) * 1024] = (bf16)(qt >> 16);
                kep[c2] = cvtpk_s(ka * (Ra * Elm), kb * (Rb * Elm));
                const unsigned qm = cvtpk_s(qa * Aa, qb * Ab);
                const unsigned km = cvtpk_s(ka * Ra, kb * Rb);
                QMs[c * PP + tid] = (bf16)(qm & 0xffffu); QMs[(c + 1) * PP + tid] = (bf16)(qm >> 16);
                KMs[c * PP + tid] = (bf16)(km & 0xffffu); KMs[(c + 1) * PP + tid] = (bf16)(km >> 16);
            }
            bf16* kt = KET + ((size_t)(cid + h) * 256 + dk) * 64;
#pragma unroll
            for (int i = 0; i < 8; ++i) { v4u o = {kep[4 * i], kep[4 * i + 1], kep[4 * i + 2], kep[4 * i + 3]}; *(GAS v4u*)(kt + 8 * i) = o; }
            DEC[(size_t)(cid + h) * 256 + dk] = __expf(blast);
        }
        __syncthreads();
        {
            const int rr = lane & 15, kg = lane >> 4;
#pragma unroll
            for (int q4 = 0; q4 < 4; ++q4) {
                const int id = w * 4 + q4, hl = id >> 4, mt = (id >> 2) & 3, nt = id & 3;
                const LAS bf16* ap = KMs + (16 * mt + rr) * PP + hl * 256 + 8 * kg; const LAS bf16* bp = QMs + (16 * nt + rr) * PP + hl * 256 + 8 * kg;
                f32x4 acc = {0.f, 0.f, 0.f, 0.f};
#pragma unroll
                for (int s = 0; s < 8; ++s) { const bf16x8 a = *(const LAS bf16x8*)(ap + 32 * s), bq = *(const LAS bf16x8*)(bp + 32 * s); acc = __builtin_amdgcn_mfma_f32_16x16x32_bf16(a, bq, acc, 0, 0, 0); }
                const int c = 16 * nt + rr, cp0 = 16 * mt + 4 * kg;
                v2u o; o.x = pk2(cp0 <= c ? acc[0] : 0.f, cp0 + 1 <= c ? acc[1] : 0.f); o.y = pk2(cp0 + 2 <= c ? acc[2] : 0.f, cp0 + 3 <= c ? acc[3] : 0.f);
                *(GAS v2u*)(ATT + ((size_t)(cid + 2 * hp + hl) * 64 + c) * 64 + cp0) = o;
            }
        }
        __syncthreads();
    }
    if (n == 0 && w < 4) {
        const float* q0 = (const float*)(F.ws + WS_Q0K0) + b * 2048 + w * 256; const float* k0 = q0 + 1024; float s = 0.f;
#pragma unroll
        for (int i = 0; i < 4; ++i) s += q0[lane + 64 * i] * k0[lane + 64 * i];
        s = wave_sum(s) * (1.0f / 16.0f);
        if (lane == 0) ATT[(size_t)(cid + w) * 4096] = (bf16)f2bf(s);
    }
}

constexpr int CH_QT = 0, CH_QP = 528, CH_KE = 64 * CH_QP, CH_KP = 144, CH_AT = CH_KE + 256 * CH_KP, CH_DC = CH_AT + 64 * CH_KP, CH_VS = CH_DC + 1024, CH_END = CH_VS + 16384;
static_assert(CH_END <= MISC_OFF, "chain LDS");
__device__ __forceinline__ void gla_chain_unit(Frame& F, int b, int h, int qd) {
    const int tid = tid_now(), lane = tid & 63, w = F.wave, r32 = lane & 31, hi = lane >> 5;
    const bool helper = w >= 4; const int htid = tid - 256;
    const bf16* GQ = (const bf16*)(F.ws + WS_GQ2); const bf16* KET = (const bf16*)(F.ws + WS_KET); const bf16* ATT = (const bf16*)(F.ws + WS_ATT);
    const float* DEC = (const float*)(F.ws + WS_DEC); const bf16* GV = (const bf16*)(F.ws + WS_GV); bf16* ORAW = (bf16*)(F.ws + WS_XN);
    LAS unsigned char* L = F.lds;
    if (helper) {
        v4u st[23];
#define CH_LOADS(nn) do { const int ch_ = (b * 64 + (nn)) * 4 + h; const int t0_ = b * SEQ + 64 * (nn); \
            _Pragma("unroll") for (int i = 0; i < 8; ++i) { const int id = htid + 256 * i; st[i] = *(const GAS v4u*)(GQ + (size_t)(t0_ + (id >> 5)) * 1024 + h * 256 + 8 * (id & 31)); } \
            _Pragma("unroll") for (int i = 0; i < 8; ++i) { const int id = htid + 256 * i; st[8 + i] = *(const GAS v4u*)(KET + ((size_t)ch_ * 256 + (id >> 3)) * 64 + 8 * (id & 7)); } \
            _Pragma("unroll") for (int i = 0; i < 2; ++i) { const int id = htid + 256 * i; st[16 + i] = *(const GAS v4u*)(ATT + ((size_t)ch_ * 64 + (id >> 3)) * 64 + 8 * (id & 7)); } \
            _Pragma("unroll") for (int i = 0; i < 4; ++i) { const int id = htid + 256 * i; st[19 + i] = *(const GAS v4u*)(GV + (size_t)(t0_ + (id >> 4)) * 2048 + h * 512 + qd * 128 + 8 * (id & 15)); } \
            st[18] = *(const GAS v4u*)(DEC + (size_t)ch_ * 256 + 4 * (htid & 63)); } while (0)
        CH_LOADS(0);
        for (int n = 0; n < 64; ++n) {
#pragma unroll
            for (int i = 0; i < 8; ++i) { const int id = htid + 256 * i; *(LAS v4u*)(L + CH_QT + (id >> 5) * CH_QP + 16 * (id & 31)) = st[i]; }
#pragma unroll
            for (int i = 0; i < 8; ++i) { const int id = htid + 256 * i; *(LAS v4u*)(L + CH_KE + (id >> 3) * CH_KP + 16 * (id & 7)) = st[8 + i]; }
#pragma unroll
            for (int i = 0; i < 2; ++i) { const int id = htid + 256 * i; *(LAS v4u*)(L + CH_AT + (id >> 3) * CH_KP + 16 * (id & 7)) = st[16 + i]; }
#pragma unroll
            for (int i = 0; i < 4; ++i) { const int id = htid + 256 * i; *(LAS v4u*)(L + CH_VS + att::v_st(id >> 4, 8 * (id & 15))) = st[19 + i]; }
            if (htid < 64) *(LAS v4u*)(L + CH_DC + 16 * htid) = st[18];
            __syncthreads();
            if (n + 1 < 64) CH_LOADS(n + 1);
            __syncthreads();
        }
#undef CH_LOADS
    } else {
        f32x16 S[8];
#pragma unroll
        for (int i = 0; i < 8; ++i)
#pragma unroll
            for (int r = 0; r < 16; ++r) S[i][r] = 0.f;
        for (int n = 0; n < 64; ++n) {
            __syncthreads();
            const int t0 = b * SEQ + 64 * n;
            bf16x8 vc[4];
#pragma unroll
            for (int s = 0; s < 4; ++s) { const LAS unsigned char* vp = L + CH_VS + att::v_rd_base(lane) + w * 512 + s * 4096;
                const s16x4 lo = __builtin_bit_cast(s16x4, __builtin_amdgcn_ds_read_tr16_b64_v4i16((LAS v4i16_t*)vp)), hh = __builtin_bit_cast(s16x4, __builtin_amdgcn_ds_read_tr16_b64_v4i16((LAS v4i16_t*)(vp + 2048)));
                vc[s] = (bf16x8){lo[0], lo[1], lo[2], lo[3], hh[0], hh[1], hh[2], hh[3]}; }
            f32x16 O[2];
#pragma unroll
            for (int r = 0; r < 16; ++r) { O[0][r] = 0.f; O[1][r] = 0.f; }
#pragma unroll
            for (int mt = 0; mt < 8; ++mt)
#pragma unroll
                for (int sp = 0; sp < 2; ++sp) {
                    const bf16x8 bs = pack8f(S[mt][8 * sp], S[mt][8 * sp + 1], S[mt][8 * sp + 2], S[mt][8 * sp + 3], S[mt][8 * sp + 4], S[mt][8 * sp + 5], S[mt][8 * sp + 6], S[mt][8 * sp + 7]);
#pragma unroll
                    for (int mc = 0; mc < 2; ++mc) {
                        const LAS unsigned char* ap = L + CH_QT + (32 * mc + r32) * CH_QP + (32 * mt + 16 * sp + 4 * hi) * 2;
                        const s16x4 lo = *(const LAS s16x4*)ap, hh = *(const LAS s16x4*)(ap + 16);
                        const bf16x8 a = {lo[0], lo[1], lo[2], lo[3], hh[0], hh[1], hh[2], hh[3]};
                        O[mc] = __builtin_amdgcn_mfma_f32_32x32x16_bf16(a, bs, O[mc], 0, 0, 0);
                    }
                }
#pragma unroll
            for (int s = 0; s < 4; ++s)
#pragma unroll
                for (int mc = 0; mc < 2; ++mc) { const bf16x8 a = *(const LAS bf16x8*)(L + CH_AT + (32 * mc + r32) * CH_KP + (16 * s + 8 * hi) * 2); O[mc] = __builtin_amdgcn_mfma_f32_32x32x16_bf16(a, vc[s], O[mc], 0, 0, 0); }
            bf16* rowbase = ORAW + (size_t)t0 * 2048 + h * 512 + qd * 128 + 32 * w;
            const unsigned loff = (unsigned)(r32 + hi * 4 * 2048);
#pragma unroll
            for (int mc = 0; mc < 2; ++mc)
#pragma unroll
                for (int r = 0; r < 16; ++r) { const float v = O[mc][r], vn = __shfl_xor(v, 1);
                    if ((r32 & 1) == 0) *(unsigned*)(rowbase + (32 * mc + (r & 3) + 8 * (r >> 2)) * 2048 + loff) = cvtpk_s(v, vn); }
#pragma unroll
            for (int mt = 0; mt < 8; ++mt) {
#pragma unroll
                for (int j = 0; j < 4; ++j) { const f32x4 d4 = *(const LAS f32x4*)(L + CH_DC + (32 * mt + 8 * j + 4 * hi) * 4);
                    S[mt][4 * j] *= d4.x; S[mt][4 * j + 1] *= d4.y; S[mt][4 * j + 2] *= d4.z; S[mt][4 * j + 3] *= d4.w; }
#pragma unroll
                for (int s = 0; s < 4; ++s) { const bf16x8 a = *(const LAS bf16x8*)(L + CH_KE + (32 * mt + r32) * CH_KP + (16 * s + 8 * hi) * 2); S[mt] = __builtin_amdgcn_mfma_f32_32x32x16_bf16(a, vc[s], S[mt], 0, 0, 0); }
            }
            __syncthreads();
        }
    }
}

__device__ __forceinline__ void mix_row(Frame& F, int t, int lane) {
    const bf16* ORAW = (const bf16*)(F.ws + WS_XN); const bf16* GR = (const bf16*)(F.ws + WS_GR); const bf16* OC = (const bf16*)(F.ws + WS_OC); const float* LSE = (const float*)(F.ws + WS_LSE);
    bf16* MIX = (bf16*)(F.ws + WS_MIX);
#pragma unroll
    for (int h = 0; h < 4; ++h) {
        const v4u ow = *(const GAS v4u*)(ORAW + (size_t)t * 2048 + h * 512 + 8 * lane); const f32x4 o0 = {bflo(ow.x), bfhi(ow.x), bflo(ow.y), bfhi(ow.y)}, o1 = {bflo(ow.z), bfhi(ow.z), bflo(ow.w), bfhi(ow.w)};
        const float ss = wave_sum((o0.x * o0.x + o0.y * o0.y) + (o0.z * o0.z + o0.w * o0.w) + (o1.x * o1.x + o1.y * o1.y) + (o1.z * o1.z + o1.w * o1.w));
        const float r = __builtin_amdgcn_rsqf(ss * (1.0f / 512.0f) + RMS_EPS);
        const GAS f32x4* gp = (const GAS f32x4*)F.kin[7] + 2 * lane; const f32x4 g0 = gp[0], g1 = gp[1];
        const v4u gw = *(const GAS v4u*)(GR + (size_t)t * 2048 + h * 512 + 8 * lane);
        float y[8] = {o0.x * r * g0.x, o0.y * r * g0.y, o0.z * r * g0.z, o0.w * r * g0.w, o1.x * r * g1.x, o1.y * r * g1.y, o1.z * r * g1.z, o1.w * r * g1.w};
        const float gv[8] = {bflo(gw.x), bfhi(gw.x), bflo(gw.y), bfhi(gw.y), bflo(gw.z), bfhi(gw.z), bflo(gw.w), bfhi(gw.w)};
#pragma unroll
        for (int e = 0; e < 8; ++e) y[e] *= gv[e] * __builtin_amdgcn_rcpf(1.0f + __expf(-gv[e]));
        v4u o = {pk2(y[0], y[1]), pk2(y[2], y[3]), pk2(y[4], y[5]), pk2(y[6], y[7])};
        *(GAS v4u*)(MIX + (size_t)t * DM + h * 512 + 8 * lane) = o;
    }
    {
        const int hd = lane >> 2;
        float m2[3], l[3];
#pragma unroll
        for (int c = 0; c < 3; ++c) { const f32x2 v = *(const GAS f32x2*)(LSE + (((size_t)c * M + t) * 16 + hd) * 2); m2[c] = v.x; l[c] = v.y; }
        const float mx = fmaxf(m2[0], fmaxf(m2[1], m2[2]));
        float wgt[3]; float den = 0.f;
#pragma unroll
        for (int c = 0; c < 3; ++c) { wgt[c] = __builtin_amdgcn_exp2f(m2[c] - mx) * l[c]; den += wgt[c]; }
        const float rden = __builtin_amdgcn_rcpf(den);
        float acc[32];
#pragma unroll
        for (int e = 0; e < 32; ++e) acc[e] = 0.f;
#pragma unroll
        for (int c = 0; c < 3; ++c) { const float wc = wgt[c] * rden; const GAS v4u* p = (const GAS v4u*)(OC + (size_t)c * M * 2048 + ((size_t)((t >> 12) * 16 + hd) * SEQ + (t & 4095)) * 128 + 32 * (lane & 3));
#pragma unroll
            for (int q = 0; q < 4; ++q) { const v4u v = p[q];
                acc[8 * q + 0] += wc * bflo(v.x); acc[8 * q + 1] += wc * bfhi(v.x); acc[8 * q + 2] += wc * bflo(v.y); acc[8 * q + 3] += wc * bfhi(v.y);
                acc[8 * q + 4] += wc * bflo(v.z); acc[8 * q + 5] += wc * bfhi(v.z); acc[8 * q + 6] += wc * bflo(v.w); acc[8 * q + 7] += wc * bfhi(v.w); } }
        GAS v4u* op = (GAS v4u*)(MIX + (size_t)t * DM + 2048 + 32 * lane);
#pragma unroll
        for (int q = 0; q < 4; ++q) { v4u o = {pk2(acc[8 * q], acc[8 * q + 1]), pk2(acc[8 * q + 2], acc[8 * q + 3]), pk2(acc[8 * q + 4], acc[8 * q + 5]), pk2(acc[8 * q + 6], acc[8 * q + 7])}; op[q] = o; }
    }
}
__device__ __forceinline__ void halo_fix(Frame& F) {
    const int tid = tid_now();
    const float* GF = (const float*)(F.ws + WS_HALO); const float* UF = GF + HALO_ONE / 4; const float* GL = UF + HALO_ONE / 4;
    bf16* ACT = (bf16*)(F.ws + WS_ACT); const float* cw = F.kin[18]; const float* cb = F.kin[19]; const unsigned* colmax = (const unsigned*)(F.ws + WS_CTL + CTL_COLMAX);
    const int total = 256 * 2 * (DFF / 4);
    for (int i = blockIdx.x * 512 + tid; i < total; i += F.G * 512) {
        const int c4 = i % (DFF / 4), j = (i / (DFF / 4)) & 1, blk = i / (DFF / 2), ch = 4 * c4;
        const bool first = (blk & 63) == 0;
        const f32x4 g0 = *(const GAS f32x4*)(GF + ((size_t)blk * 2 + j) * DFF + ch), uu = *(const GAS f32x4*)(UF + ((size_t)blk * 2 + j) * DFF + ch);
        const f32x4 z = {0.f, 0.f, 0.f, 0.f};
        f32x4 g1, g2;
        if (j == 0) { g1 = first ? z : *(const GAS f32x4*)(GL + ((size_t)(blk - 1) * 2 + 1) * DFF + ch); g2 = first ? z : *(const GAS f32x4*)(GL + ((size_t)(blk - 1) * 2 + 0) * DFF + ch); }
        else { g1 = *(const GAS f32x4*)(GF + ((size_t)blk * 2 + 0) * DFF + ch); g2 = first ? z : *(const GAS f32x4*)(GL + ((size_t)(blk - 1) * 2 + 1) * DFF + ch); }
        const f32x4 w0 = *(const GAS f32x4*)(cw + ch), w1 = *(const GAS f32x4*)(cw + DFF + ch), w2 = *(const GAS f32x4*)(cw + 2 * DFF + ch), bb = *(const GAS f32x4*)(cb + ch);
        float a[4];
#pragma unroll
        for (int e = 0; e < 4; ++e) { const float sg = FFN_I8 ? __uint_as_float(colmax[ch + e]) * (1.0f / 127.0f) : 1.0f;
            const float y = bb[e] + sg * (w0[e] * g2[e] + w1[e] * g1[e] + w2[e] * g0[e]); a[e] = y / (1.0f + __expf(-y)) * (uu[e] * -1.4426950408889634f); }
        v2u o = {pk2(a[0], a[1]), pk2(a[2], a[3])};
        *(GAS v2u*)(ACT + (size_t)(64 * blk + j) * DFF + ch) = o;
    }
}
__device__ __forceinline__ void final_norm_row(Frame& F, int t, int lane) {
    const GAS v4u* hr = (const GAS v4u*)((const bf16*)(F.ws + WS_XN) + (size_t)t * DM) + lane; GAS f32x4* xr = (GAS f32x4*)(F.out + (size_t)t * DM) + 2 * lane; const GAS f32x4* gr = (const GAS f32x4*)F.kin[21] + 2 * lane;
    v4u w[8]; float s = 0.f;
#pragma unroll
    for (int j = 0; j < 8; ++j) { w[j] = NTLD(hr + 64 * j);
        const float a0 = bflo(w[j].x), a1 = bfhi(w[j].x), a2 = bflo(w[j].y), a3 = bfhi(w[j].y), a4 = bflo(w[j].z), a5 = bfhi(w[j].z), a6 = bflo(w[j].w), a7 = bfhi(w[j].w);
        s += ((a0 * a0 + a1 * a1) + (a2 * a2 + a3 * a3)) + ((a4 * a4 + a5 * a5) + (a6 * a6 + a7 * a7)); }
    const float r = 1.0f / sqrtf(wave_sum(s) * (1.0f / 4096.0f) + RMS_EPS);
#pragma unroll
    for (int j = 0; j < 8; ++j) { const f32x4 g0 = gr[128 * j], g1 = gr[128 * j + 1];
        xr[128 * j] = (f32x4){bflo(w[j].x) * r * g0.x, bfhi(w[j].x) * r * g0.y, bflo(w[j].y) * r * g0.z, bfhi(w[j].y) * r * g0.w};
        xr[128 * j + 1] = (f32x4){bflo(w[j].z) * r * g1.x, bfhi(w[j].z) * r * g1.y, bflo(w[j].w) * r * g1.z, bfhi(w[j].w) * r * g1.w}; }
}

__device__ __forceinline__ void quant_row(Frame& F, int t, int lane) {
    unsigned* amax = (unsigned*)(F.ws + WS_CTL + CTL_AMAX);
    const GAS v4u* hr = (const GAS v4u*)((const bf16*)(F.ws + WS_XN) + (size_t)t * DM) + lane; GAS v2u* qr = (GAS v2u*)((signed char*)(F.ws + WS_H2Q) + (size_t)t * DM) + lane;
    v4u w[8]; unsigned mb = 0u;
#pragma unroll
    for (int j = 0; j < 8; ++j) { w[j] = hr[64 * j];
        const unsigned a0 = w[j].x & 0x7fff7fffu, a1 = w[j].y & 0x7fff7fffu, a2 = w[j].z & 0x7fff7fffu, a3 = w[j].w & 0x7fff7fffu;
        mb = max(mb, max(max(a0 & 0xffffu, a0 >> 16), max(a1 & 0xffffu, a1 >> 16))); mb = max(mb, max(max(a2 & 0xffffu, a2 >> 16), max(a3 & 0xffffu, a3 >> 16))); }
    mb = wave_maxu(mb);
    const float am = __uint_as_float(mb << 16); const float inv = am > 0.f ? 127.0f / am : 0.f;
    float s2 = 0.f;
#pragma unroll
    for (int j = 0; j < 8; ++j) { const float a0 = bflo(w[j].x), a1 = bfhi(w[j].x), a2 = bflo(w[j].y), a3 = bfhi(w[j].y), a4 = bflo(w[j].z), a5 = bfhi(w[j].z), a6 = bflo(w[j].w), a7 = bfhi(w[j].w);
        s2 += ((a0 * a0 + a1 * a1) + (a2 * a2 + a3 * a3)) + ((a4 * a4 + a5 * a5) + (a6 * a6 + a7 * a7)); }
    s2 = wave_sum(s2);
    if (lane == 0) { amax[t] = __float_as_uint(am); ((unsigned long long*)(F.ws + WS_CTL + CTL_SS))[(size_t)M + t] = (unsigned long long)(s2 * 1048576.0f + 0.5f); }
#pragma unroll
    for (int j = 0; j < 8; ++j) {
        qr[64 * j] = (v2u){q8x4(bflo(w[j].x), bfhi(w[j].x), bflo(w[j].y), bfhi(w[j].y), inv), q8x4(bflo(w[j].z), bfhi(w[j].z), bflo(w[j].w), bfhi(w[j].w), inv)}; }
}
typedef att::BlockRef<att::bf16, att::bf16> ABlk;
__device__ __forceinline__ ABlk dil_item(unsigned char* ws, int L) {
    const int bh = L / 48, rem = L - 48 * bh, cfg = rem >> 4, x = rem & 15, h = bh & 15, b = bh >> 4;
    const int d = cfg == 0 ? 1 : (cfg == 1 ? 4 : 16);
    const int r = cfg == 0 ? 0 : (cfg == 1 ? (x >> 2) : x), qb = cfg == 0 ? x : (cfg == 1 ? (x & 3) : 0);
    const att::bf16* DQ = (const att::bf16*)(ws + WS_DQKV); const att::bf16* DK = DQ + (size_t)M * 2048; const att::bf16* DV = DK + (size_t)M * 2048;
    const int sq = r + d * 256 * qb, tq = b * SEQ + sq; const size_t hb = (size_t)(b * 16 + h) * SEQ;
    ABlk R;
    R.Q = DQ + (hb + sq) * 128; R.K = DK + (hb + r) * 128; R.V = DV + (hb + r) * 128;
    R.O = (att::bf16*)(ws + WS_OC) + ((size_t)cfg * M * 2048) + (hb + sq) * 128;
    R.L = (float*)(ws + WS_LSE) + (((size_t)cfg * M + tq) * 16 + h) * 2;
    R.bsrc = (const float*)(ws + WS_BT) + (cfg * 16 + h) * 132;
    R.P0 = 256 * qb; R.pq = 128 * d; R.pk = 128 * d; R.po = 128 * d; R.pl = 32 * d; R.skv = SEQ / d; R.W = 129;
    return R;
}
__device__ __forceinline__ ABlk xat_item(unsigned char* ws, int L) {
    const int qb = L & 15, h = (L >> 4) & 3, b = L >> 6;
    const att::bf16* XQ = (const att::bf16*)(ws + WS_XQ); const att::bf16* XKV = (const att::bf16*)(ws + WS_XKV);
    ABlk R;
    R.Q = XQ + (size_t)(b * SEQ + 256 * qb) * XW + h * 128; R.K = XKV + (size_t)(b * MEMLEN) * 1024 + h * 128; R.V = R.K + 512;
    R.O = (att::bf16*)(ws + WS_XO) + (size_t)(b * SEQ + 256 * qb) * XW + h * 128; R.L = nullptr; R.bsrc = nullptr;
    R.P0 = 1 << 20; R.pq = XW; R.pk = 1024; R.po = XW; R.pl = 0; R.skv = MEMLEN; R.W = 1 << 30;
    return R;
}

#ifndef PG_ALIGN
#define PG_ALIGN true
#endif
#ifndef PG_SP2
#define PG_SP2 true
#endif
struct Args { const float* in[22]; float* out; unsigned char* ws; int ph_lo, ph_hi; };
__global__ void __launch_bounds__(NWAVES * 64, 2) hybrid_fwd(Args args) {
    extern __shared__ __attribute__((aligned(16))) unsigned char lds[];
    Frame F;
    F.lds = (LAS unsigned char*)lds; F.ldsg = (char*)lds;
    F.MISC = (volatile LAS unsigned*)(F.lds + MISC_OFF);
    F.wave = __builtin_amdgcn_readfirstlane((int)threadIdx.x >> 6);
    F.G = gridDim.x; { const int bx = blockIdx.x; F.vcu = (F.G % 8 == 0) ? (bx % 8) * (F.G / 8) + bx / 8 : bx; }
    F.ws = args.ws; F.ctl = (gu32*)(args.ws + WS_CTL); F.out = args.out;
    F.kin = (const float* const __attribute__((address_space(4)))*)__builtin_amdgcn_kernarg_segment_ptr();
    if (threadIdx.x < 64) F.MISC[threadIdx.x] = 0u;
    __syncthreads();
    XcdBarrier bar; bar.bar = (unsigned*)(F.ctl + CW_BAR); bar.x = 0; bar.st = nullptr;
    if (N_LAUNCHES == 1) bar = xcd_barrier_post((unsigned*)(F.ctl + CW_BAR), F.MISC + 8);
#define GRID_BAR() do { if (N_LAUNCHES == 1) xcd_barrier(bar); } while (0)
    const int lo = args.ph_lo, hi = args.ph_hi;
#ifndef PH_MASK
#define PH_MASK 0x1fff
#endif
#define IN(k) ((((PH_MASK) >> (k)) & 1) && lo <= (k) && (k) < hi)
#define BOTH(k) (IN(k) && IN((k) + 1))
#ifndef DUPMASK
#define DUPMASK 0
#endif
#ifndef XBAR
#define XBAR 0
#endif
#define DUPK(k, ...) { __VA_ARGS__ } if constexpr ((((DUPMASK) >> (k)) & 1) != 0) { __syncthreads(); { __VA_ARGS__ } }
#define GRID_BARX() do { GRID_BAR(); if constexpr (XBAR != 0) GRID_BAR(); } while (0)
    unsigned long long* SS1 = (unsigned long long*)(F.ws + WS_CTL + CTL_SS); unsigned long long* SS2 = SS1 + M; unsigned long long* SS3 = SS2 + M;
    const int gw = F.vcu * NWAVES + F.wave, NGW = F.G * NWAVES;

    if (IN(0)) { DUPK(0, p0_first_token(F); p0_prologue(F);) GRID_BAR(); p0_quant_win(F);
#ifdef DUP_P0FT
        __syncthreads(); p0_first_token(F); __syncthreads(); p0_first_token(F); __syncthreads(); p0_first_token(F); __syncthreads(); p0_first_token(F);
#endif
        if (BOTH(0)) GRID_BARX(); }
    if (IN(1)) {
        { pg8::Gemm g{(const bf16*)(F.ws + WS_XN), (const bf16*)(F.ws + WS_WIN), M, NB1, DM}; pg8::StaticOrder S; S.init(M, NB1, F.G, (int)blockIdx.x);
          pg8::EpiProj E{(bf16*)(F.ws + WS_GQ), (bf16*)(F.ws + WS_GK), (bf16*)(F.ws + WS_GV), (bf16*)(F.ws + WS_GR), (bf16*)(F.ws + WS_DQKV), GV_I8 ? 0 : 2048};
          pg8::gemm_phase<pg8::EpiProj, pg8::StaticOrder, PG_ALIGN, PG_SP2>(F.lds, g, S, E);
          { pg8::Gemm gq{(const bf16*)(F.ws + WS_XNQ), (const bf16*)(F.ws + WS_WINQ), M, NQ1, DM / 2}; pg8::StaticOrder Sq; Sq.init(M, NQ1, F.G, (int)blockIdx.x);
            pg8::EpiProjQ Eq{(bf16*)(F.ws + WS_DQKV), (const float*)(F.ws + WS_RSC1), (const unsigned*)(F.ws + WS_CTL + CTL_CMAX1), (bf16*)(F.ws + WS_GV), GV_I8 ? 2048 : 0};
            pg8::gemm_phase<pg8::EpiProjQ, pg8::StaticOrder, PG_ALIGN, PG_SP2>(F.lds, gq, Sq, Eq); }
#ifdef DUP_P1NULL
          { pg8::EpiNull E0{}; pg8::Gemm g2{(const bf16*)(F.ws + WS_XN), (const bf16*)(F.ws + WS_WIN), M, 3072, DM}; pg8::StaticOrder S2; S2.init(M, 3072, F.G, (int)blockIdx.x); pg8::gemm_phase<pg8::EpiNull, pg8::StaticOrder, PG_ALIGN, PG_SP2>(F.lds, g2, S2, E0); pg8::gemm_phase<pg8::EpiNull, pg8::StaticOrder, PG_ALIGN, PG_SP2>(F.lds, g2, S2, E0); pg8::gemm_phase<pg8::EpiNull, pg8::StaticOrder, PG_ALIGN, PG_SP2>(F.lds, g2, S2, E0); pg8::gemm_phase<pg8::EpiNull, pg8::StaticOrder, PG_ALIGN, PG_SP2>(F.lds, g2, S2, E0); }
#endif
          }
        if (BOTH(1)) GRID_BARX();
    }
    if (IN(2)) { DUPK(2, for (int u = blockIdx.x; u < NB * 64; u += F.G) gla_prep_unit(F, u >> 6, u & 63);) if (BOTH(2)) GRID_BARX(); }
    if (IN(3)) {
#ifdef PRE_ATT_VARIANT
        {
            gu32* qctr = F.ctl + CW_QUEUE + 64;
#define NEXT_ITEM(dst) do { if (tid_now() == 0) F.MISC[16] = __hip_atomic_fetch_add(qctr, 1u, RLX_AGENT); __syncthreads(); dst = __builtin_amdgcn_readfirstlane((int)F.MISC[16]); __syncthreads(); } while (0)
            int L; NEXT_ITEM(L);
            if (L < 3072) {
                ABlk cur = dil_item(F.ws, L); att::Seam<att::bf16> S; int par = 0;
                att::causal_swa_prime<PRE_ATT_VARIANT, att::bf16, att::bf16>(cur, F.ldsg, S);
                unsigned char* const wsp = F.ws; auto itf = [wsp](int l) { return dil_item(wsp, l); };
                for (;;) { int Ln; NEXT_ITEM(Ln); const bool last = Ln >= 3072; const int Lx = last ? L : Ln;
                    att::causal_swa_block<PRE_ATT_VARIANT, att::bf16, att::bf16>(cur, Lx, itf, par, F.ldsg, S);
                    if (last) break; L = Ln; cur = dil_item(F.ws, L); par ^= 1; }
            }
#undef NEXT_ITEM
            __syncthreads();
        }
#endif
        if ((int)blockIdx.x < 64) gla_chain_unit(F, blockIdx.x >> 4, (blockIdx.x >> 2) & 3, blockIdx.x & 3);
        {
            gu32* qctr = F.ctl + CW_QUEUE;
#define NEXT_ITEM(dst) do { if (tid_now() == 0) F.MISC[16] = __hip_atomic_fetch_add(qctr, 1u, RLX_AGENT); __syncthreads(); dst = __builtin_amdgcn_readfirstlane((int)F.MISC[16]); __syncthreads(); } while (0)
            int L; NEXT_ITEM(L);
            if (L < 3072) {
                ABlk cur = dil_item(F.ws, L); att::Seam<att::bf16> S; int par = 0;
                att::causal_swa_prime<1, att::bf16, att::bf16>(cur, F.ldsg, S);
                unsigned char* const wsp = F.ws; auto itf = [wsp](int l) { return dil_item(wsp, l); };
                for (;;) { int Ln; NEXT_ITEM(Ln); const bool last = Ln >= 3072; const int Lx = last ? L : Ln;
                    att::causal_swa_block<1, att::bf16, att::bf16>(cur, Lx, itf, par, F.ldsg, S);
                    if (last) break; L = Ln; cur = dil_item(F.ws, L); par ^= 1; }
            }
#undef NEXT_ITEM
        }
#ifdef DUP_CHAIN
        __syncthreads(); if ((int)blockIdx.x < 64) gla_chain_unit(F, blockIdx.x >> 4, (blockIdx.x >> 2) & 3, blockIdx.x & 3);
#endif
        if (BOTH(3)) GRID_BARX();
    }
    if (IN(4)) {
        { const int lane = tid_now() & 63; for (int t = gw; t < M; t += NGW) mix_row(F, t, lane); }
        ffn_weights<0>(F, 2 * FW_IG, FW_P9_LO, gw, NGW);
        if constexpr (FFN_I8) { ffn_weights<1>(F, 0, 2 * FW_IG, gw, NGW); GRID_BAR(); }
        ffn_weights<0>(F, 0, FW_P6_LO, gw, NGW);
        if (BOTH(4)) GRID_BARX(); }
    if (IN(5)) {
        pg8::Gemm g{(const bf16*)(F.ws + WS_MIX), (const bf16*)(F.ws + WS_WOUT), M, DM, DM}; pg8::StaticOrder S; S.init(M, DM, F.G, (int)blockIdx.x);
        pg8::EpiResid E{F.kin[0], nullptr, (bf16*)(F.ws + WS_XN), SS1, DM, nullptr};
        pg8::gemm_phase<pg8::EpiResid, pg8::StaticOrder, PG_ALIGN, PG_SP2>(F.lds, g, S, E);
#ifdef DUP_P5
        { pg8::EpiResid E2{F.kin[0], nullptr, (bf16*)(F.ws + WS_XN), nullptr, DM, nullptr}; pg8::gemm_phase<pg8::EpiResid, pg8::StaticOrder, PG_ALIGN, PG_SP2>(F.lds, g, S, E2); }
#endif
        if (BOTH(5)) GRID_BARX();
    }
    if (IN(6)) {
        DUPK(6,
        if ((int)blockIdx.x < 128 || F.G < 144) {
        pg8::Gemm g{(const bf16*)(F.ws + WS_XN), (const bf16*)(F.ws + WS_WXQ), M, XW, DM}; pg8::StaticOrder S; S.init(M, XW, F.G < 144 ? F.G : 128, (int)blockIdx.x);
        pg8::EpiScaleBf16 E{(bf16*)(F.ws + WS_XQ), XW, SS1, 1.0f / 4096.0f};
        pg8::gemm_phase<pg8::EpiScaleBf16, pg8::StaticOrder, PG_ALIGN, PG_SP2>(F.lds, g, S, E);
        }
        if ((int)blockIdx.x >= 128 || F.G < 144) {
        pg8::Gemm g{(const bf16*)(F.ws + WS_MEMN), (const bf16*)(F.ws + WS_WXKV), MROWS, 1024, DM}; pg8::StaticOrder S; S.init(MROWS, 1024, F.G < 144 ? F.G : F.G - 128, F.G < 144 ? (int)blockIdx.x : (int)blockIdx.x - 128);
        pg8::EpiScaleBf16 E{(bf16*)(F.ws + WS_XKV), 1024, nullptr, 0.f};
        pg8::gemm_phase<pg8::EpiScaleBf16, pg8::StaticOrder, PG_ALIGN, PG_SP2>(F.lds, g, S, E);
        }
        if (F.G >= 256) { if ((int)blockIdx.x >= 144) ffn_weights<0>(F, FW_P6_LO, FW_P6_HI, ((int)blockIdx.x - 144) * NWAVES + F.wave, (F.G - 144) * NWAVES); }
        else ffn_weights<0>(F, FW_P6_LO, FW_P6_HI, gw, NGW);
        )
        if (BOTH(6)) GRID_BARX();
    }
    if (IN(7)) {
        DUPK(7,
        if ((int)blockIdx.x < 256) {
            int L = blockIdx.x; ABlk cur = xat_item(F.ws, L); att::Seam<att::bf16> S; int par = 0;
            att::causal_swa_prime<0, att::bf16, att::bf16>(cur, F.ldsg, S);
            unsigned char* const wsp = F.ws; auto itf = [wsp](int l) { return xat_item(wsp, l); };
            for (;;) { const int Ln = L + F.G; const bool last = Ln >= 256; const int Lx = last ? L : Ln;
                att::causal_swa_block<0, att::bf16, att::bf16>(cur, Lx, itf, par, F.ldsg, S);
                if (last) break; L = Ln; cur = xat_item(F.ws, L); par ^= 1; }
        }
        )
        if (BOTH(7)) GRID_BARX();
    }
    if (IN(8)) {
        pg8::Gemm g{(const bf16*)(F.ws + WS_XO), (const bf16*)(F.ws + WS_WXO), M, DM, XW}; pg8::StaticOrder S; S.init(M, DM, F.G, (int)blockIdx.x);
        pg8::EpiResid E{nullptr, (const bf16*)(F.ws + WS_XN), (bf16*)(F.ws + WS_XN), FFN_I8 ? nullptr : SS2, DM, nullptr};
        pg8::gemm_phase<pg8::EpiResid, pg8::StaticOrder, PG_ALIGN, PG_SP2>(F.lds, g, S, E);
        if constexpr (FFN_I8) { GRID_BAR(); const int lane = tid_now() & 63; for (int t = gw; t < M; t += NGW) quant_row(F, t, lane); }
        if (BOTH(8)) GRID_BARX();
    }
    if (IN(9)) {
        DUPK(9,
        typedef pg8::EpiGateUpT<FFN_I8 != 0> EpiGU;
        pg8::Gemm g{(const bf16*)(F.ws + (FFN_I8 ? WS_H2Q : WS_XN)), (const bf16*)(F.ws + WS_WGU), M, NGU, FFN_I8 ? DM / 2 : DM};
        const int G9 = (F.G == 256 && P9_GEMM_WGS > 0) ? P9_GEMM_WGS : F.G;
        pg8::StaticOrder S; S.init(M, NGU, G9, (int)blockIdx.x);
        float* GF = (float*)(F.ws + WS_HALO);
        EpiGU E{(bf16*)(F.ws + WS_ACT), DFF, SS2, 1.0f / 4096.0f, F.kin[18], F.kin[19], GF, GF + HALO_ONE / 4, GF + 2 * (HALO_ONE / 4), DFF, (LAS float*)(F.lds + 131072),
                (const unsigned*)(F.ws + WS_CTL + CTL_COLMAX), (const unsigned*)(F.ws + WS_CTL + CTL_AMAX)};
        if ((int)blockIdx.x < G9) pg8::gemm_phase<EpiGU, pg8::StaticOrder, PG_ALIGN, PG_SP2>(F.lds, g, S, E);
        if (G9 < F.G) { if ((int)blockIdx.x >= G9) ffn_weights<0>(F, FW_P9_LO, FW_P9_HI, ((int)blockIdx.x - G9) * NWAVES + F.wave, (F.G - G9) * NWAVES); }
        else if (F.G == 256) { if ((int)blockIdx.x >= 128) ffn_weights<0>(F, FW_P9_LO, FW_P9_HI, ((int)blockIdx.x - 128) * NWAVES + F.wave, 128 * NWAVES); }
        else ffn_weights<0>(F, FW_P9_LO, FW_P9_HI, gw, NGW);
        )
        if (BOTH(9)) GRID_BARX();
    }
    if (IN(10)) { DUPK(10, halo_fix(F);) if (BOTH(10)) GRID_BARX(); }
    if (IN(11)) {
        pg8::Gemm g{(const bf16*)(F.ws + WS_ACT), (const bf16*)(F.ws + WS_WDN), M, DM, DFF}; pg8::StaticOrder S; S.init(M, DM, F.G, (int)blockIdx.x);
        pg8::EpiResid E{nullptr, (const bf16*)(F.ws + WS_XN), (bf16*)(F.ws + WS_XN), nullptr, DM, nullptr};
        pg8::gemm_phase<pg8::EpiResid, pg8::StaticOrder, PG_ALIGN, PG_SP2>(F.lds, g, S, E);
        if (BOTH(11)) GRID_BARX();
    }
    if (IN(12)) { DUPK(12, const int lane = tid_now() & 63; for (int t = gw; t < M; t += NGW) final_norm_row(F, t, lane);)
    }
#undef IN
#undef BOTH
#undef GRID_BAR
}

extern "C" void kernel_launch(void* const* d_in, const int* in_sizes, int n_in, void* d_out, int out_size, void* d_ws, size_t ws_size, hipStream_t stream) {
    static int grid = 0;
    if (grid == 0) {
        if (n_in != 22 || in_sizes[0] != M * DM || out_size != M * DM || ws_size < WS_END) { fprintf(stderr, "kernel_launch: unexpected shapes (n_in %d, in0 %d, out %d, ws %zu)\n", n_in, n_in > 0 ? in_sizes[0] : -1, out_size, ws_size); grid = -1; return; }
        int dev = 0, cus = 0, per_cu = 0;
        if (hipGetDevice(&dev) != hipSuccess || hipDeviceGetAttribute(&cus, hipDeviceAttributeMultiprocessorCount, dev) != hipSuccess) { grid = -1; return; }
        if (hipFuncSetAttribute((const void*)hybrid_fwd, hipFuncAttributeMaxDynamicSharedMemorySize, LDS_BYTES) != hipSuccess) { fprintf(stderr, "kernel_launch: hipFuncSetAttribute failed\n"); grid = -1; return; }
        if (hipOccupancyMaxActiveBlocksPerMultiprocessor(&per_cu, (const void*)hybrid_fwd, NWAVES * 64, LDS_BYTES) != hipSuccess || per_cu < 1) fprintf(stderr, "kernel_launch: occupancy query reports %d\n", per_cu);
        (void)hipGetLastError();
        grid = cus;
    }
    if (grid < 0) return;
    if (hipMemsetAsync((char*)d_ws + WS_CTL, 0, CTL_ZERO_BYTES, stream) != hipSuccess) return;
    Args a{};
    for (int i = 0; i < 22; ++i) a.in[i] = (const float*)d_in[i];
    a.out = (float*)d_out; a.ws = (unsigned char*)d_ws;
    for (int li = 0; li < N_LAUNCHES; ++li) {
        a.ph_lo = (N_LAUNCHES == 1) ? 0 : li; a.ph_hi = (N_LAUNCHES == 1) ? NPH : li + 1;
        hipLaunchKernelGGL(hybrid_fwd, dim3(grid), dim3(NWAVES * 64), LDS_BYTES, stream, a);
    }
}
```
